# Optimizing an MI355X kernel written in HIP

```python
import math
import jax, jax.numpy as jnp
from jax import lax
import numpy as np

D_MODEL = 1024
BATCH = 8
SEQ = 4096
DEPTH = 4

GRID_W = 64
CTX_LEN = 256
HEAD_DIM = 64
N_HEADS_A = 8
N_KV_A = 2
REP_A = N_HEADS_A // N_KV_A
WINDOW = 128
ATTN_BLOCK = 128
N_HEADS_B = 4
RET_DK = 64
RET_DV = 128
RET_CHUNK = 128
N_HEADS_C = 4
DIFF_DK = 64
DIFF_DV = 128
N_BRANCH = 3
BRANCH_W = 512
D_FF = 2816
N_EXPERTS = 8
TOP_K = 2
EXPERT_BLOCK = 512
ROPE_BASE = 10000.0
ROPE_FREQS = HEAD_DIM // 4
NORM_EPS = 1e-6
NEG_INF = -1e30
IN_SIZES = (N_HEADS_A * HEAD_DIM, N_KV_A * HEAD_DIM, N_KV_A * HEAD_DIM,
            N_HEADS_B * RET_DK, N_HEADS_B * RET_DK, N_HEADS_B * RET_DV, N_HEADS_B * RET_DV,
            N_HEADS_C * 2 * DIFF_DK, N_HEADS_C * 2 * DIFF_DK, N_HEADS_C * DIFF_DV,
            N_BRANCH * D_MODEL)
D_IN = 6912

kernel_name = "hybrid_diffusion_gqa_retention_diffattn_moe"


def _rms(x):
    x32 = x.astype(jnp.float32)
    return x32 * lax.rsqrt(jnp.mean(jnp.square(x32), axis=-1, keepdims=True) + NORM_EPS)


def _rmsnorm(x, g):
    return (_rms(x) * g.astype(jnp.float32)).astype(x.dtype)


def _axial_rope_tables(n_tokens):
    rows = n_tokens // GRID_W
    row = jnp.repeat(jnp.arange(rows, dtype=jnp.float32), GRID_W)
    col = jnp.tile(jnp.arange(GRID_W, dtype=jnp.float32), rows)
    inv = 1.0 / (ROPE_BASE ** (jnp.arange(ROPE_FREQS, dtype=jnp.float32) / ROPE_FREQS))
    ang = jnp.stack([row[:, None] * inv, col[:, None] * inv], axis=1)
    return jnp.cos(ang), jnp.sin(ang)


def _rope(x, cos, sin):
    shp = x.shape
    xr = x.reshape(shp[:-1] + (2, 2, ROPE_FREQS))
    bshape = (shp[1],) + (1,) * (x.ndim - 3) + (2, ROPE_FREQS)
    c = cos.reshape(bshape).astype(x.dtype)
    s = sin.reshape(bshape).astype(x.dtype)
    x1, x2 = xr[..., 0, :], xr[..., 1, :]
    return jnp.stack([x1 * c - x2 * s, x2 * c + x1 * s], axis=-2).reshape(shp)


def _sink_softmax(s, sink):
    col = jnp.broadcast_to(sink.astype(jnp.float32)[None, :, :, None, None], s.shape[:-1] + (1,))
    return jax.nn.softmax(jnp.concatenate([s, col], axis=-1), axis=-1)[..., :-1]


def _window_gqa(q, k, v, k_ctx, v_ctx, sink):
    b, n, g, r, d = q.shape
    scale = d ** -0.5
    span = ATTN_BLOCK + 2 * WINDOW
    pad = ((0, 0), (WINDOW, WINDOW), (0, 0), (0, 0))
    kp, vp = jnp.pad(k, pad), jnp.pad(v, pad)
    qi = jnp.arange(ATTN_BLOCK)
    kj = jnp.arange(span)
    rel = kj[None, :] - qi[:, None]
    band = (rel >= 0) & (rel <= 2 * WINDOW)

    def block(i):
        start = i * ATTN_BLOCK
        qs = lax.dynamic_slice_in_dim(q, start, ATTN_BLOCK, axis=1)
        ks = lax.dynamic_slice_in_dim(kp, start, span, axis=1)
        vs = lax.dynamic_slice_in_dim(vp, start, span, axis=1)
        kpos = start - WINDOW + kj
        mask = band & ((kpos >= 0) & (kpos < n))[None, :]
        s_loc = jnp.einsum('bqgrd,bkgd->bgrqk', qs, ks).astype(jnp.float32) * scale
        s_loc = jnp.where(mask, s_loc, NEG_INF)
        s_ctx = jnp.einsum('bqgrd,bkgd->bgrqk', qs, k_ctx).astype(jnp.float32) * scale
        p = _sink_softmax(jnp.concatenate([s_loc, s_ctx], axis=-1), sink).astype(v.dtype)
        return (jnp.einsum('bgrqk,bkgd->bqgrd', p[..., :span], vs)
                + jnp.einsum('bgrqk,bkgd->bqgrd', p[..., span:], v_ctx))

    o = lax.map(block, jnp.arange(n // ATTN_BLOCK))
    return jnp.moveaxis(o, 0, 1).reshape(b, n, g * r * d)


def _ctx_gqa(q, k, v, sink):
    b, n, g, r, d = q.shape
    s = jnp.einsum('bqgrd,bkgd->bgrqk', q, k).astype(jnp.float32) * d ** -0.5
    p = _sink_softmax(s, sink).astype(v.dtype)
    return jnp.einsum('bgrqk,bkgd->bqgrd', p, v).reshape(b, n, g * r * d)


def _retention_scan(q, k, v, log_gamma, s0):
    b, t, h, dk = q.shape
    dv = v.shape[-1]
    c = RET_CHUNK
    n = t // c
    qc = q.reshape(b, n, c, h, dk)
    kc = k.reshape(b, n, c, h, dk)
    vc = v.reshape(b, n, c, h, dv)
    pos = jnp.arange(c, dtype=jnp.float32)
    diff = pos[:, None] - pos[None, :]
    dmat = jnp.where(diff >= 0, jnp.exp(jnp.maximum(diff, 0.0) * log_gamma[:, None, None]), 0.0)
    scores = jnp.einsum('bnchd,bnkhd->bnhck', qc, kc) * dmat
    intra = jnp.einsum('bnhck,bnkhe->bnche', scores, vc)
    k_dec = jnp.exp((c - 1 - pos)[None, :] * log_gamma[:, None])
    kv = jnp.einsum('bnkhd,hk,bnkhe->nbhde', kc, k_dec, vc)
    chunk_dec = jnp.exp(c * log_gamma)[None, :, None, None]

    def step(state, kv_n):
        return state * chunk_dec + kv_n, state

    s_last, s_prev = lax.scan(step, s0, kv)
    q_dec = jnp.exp((pos + 1.0)[None, :] * log_gamma[:, None])
    inter = jnp.einsum('bnchd,hc,nbhde->bnche', qc, q_dec, s_prev)
    return (intra + inter).reshape(b, t, h, dv), s_last


def _retention_bidir(q, k, v, lg_f, lg_b, s0_f, s0_b):
    o_f, s_f = _retention_scan(q, k, v, lg_f, s0_f)
    flip = lambda a: jnp.flip(a, axis=1)
    o_b, s_b = _retention_scan(flip(q), flip(k), flip(v), lg_b, s0_b)
    return o_f + flip(o_b), s_f, s_b


def _ret_out(o, g):
    b, t = o.shape[:2]
    y = _rms(o) * jax.nn.silu(g.astype(jnp.float32)).reshape(o.shape)
    return y.astype(g.dtype).reshape(b, t, -1)


def _diff_attend(q, k, v, lam):
    s = jnp.einsum('bqhcd,bkhcd->bhcqk', q, k).astype(jnp.float32) * q.shape[-1] ** -0.5
    p = jax.nn.softmax(s, axis=-1)
    a = p[:, :, 0] - lam * p[:, :, 1]
    return jnp.einsum('bhqk,bkhe->bqhe', a.astype(v.dtype), v)


def _diff_latent(q, k_all, v_all, lam):
    b, n = q.shape[:2]

    def block(i):
        qs = lax.dynamic_slice_in_dim(q, i * ATTN_BLOCK, ATTN_BLOCK, axis=1)
        return _diff_attend(qs, k_all, v_all, lam)

    o = lax.map(block, jnp.arange(n // ATTN_BLOCK))
    return jnp.moveaxis(o, 0, 1).reshape((b, n) + o.shape[-2:])


def _diff_norm(o, gain, lam_init):
    b, t = o.shape[:2]
    y = _rms(o) * gain.astype(jnp.float32) * (1.0 - lam_init)
    return y.astype(o.dtype).reshape(b, t, -1)


def _split_in(p):
    out, off = [], 0
    for sz in IN_SIZES:
        out.append(p[..., off:off + sz])
        off += sz
    return out


def _merge(outs, gate_logits, w_branch, w_out):
    g = gate_logits.reshape(gate_logits.shape[:2] + (N_BRANCH, D_MODEL))
    y = sum(jax.nn.sigmoid(g[:, :, i]) * (o @ w_branch[i]) for i, o in enumerate(outs))
    return y @ w_out


def _rs(t, *shape):
    return t.reshape(t.shape[:2] + shape)


def _mixer(h, hc, cos, sin, w_in, sink, dec_f, dec_b, lam_p, lam_init, d_gain, w_branch, w_out, ctx_out):
    f32 = jnp.float32
    b = h.shape[0]
    qa, ka, va, qb, kb, vb, gb, qd, kd, vd, gl = _split_in(h @ w_in)
    qa_c, ka_c, va_c, qb_c, kb_c, vb_c, gb_c, qd_c, kd_c, vd_c, gl_c = _split_in(hc @ w_in)
    sink = sink.reshape(N_KV_A, REP_A)
    qa = _rope(_rs(qa, N_KV_A, REP_A, HEAD_DIM), cos, sin)
    ka = _rope(_rs(ka, N_KV_A, HEAD_DIM), cos, sin)
    va = _rs(va, N_KV_A, HEAD_DIM)
    ka_c, va_c = _rs(ka_c, N_KV_A, HEAD_DIM), _rs(va_c, N_KV_A, HEAD_DIM)
    o_a = _window_gqa(qa, ka, va, ka_c, va_c, sink)
    lg_f = jax.nn.log_sigmoid(dec_f.astype(f32))
    lg_b = jax.nn.log_sigmoid(dec_b.astype(f32))
    qb = _rope(_rs(qb, N_HEADS_B, RET_DK), cos, sin).astype(f32)
    kb = _rope(_rs(kb, N_HEADS_B, RET_DK), cos, sin).astype(f32) * RET_DK ** -0.5
    vb = _rs(vb, N_HEADS_B, RET_DV).astype(f32)
    qb_c = _rs(qb_c, N_HEADS_B, RET_DK).astype(f32)
    kb_c = _rs(kb_c, N_HEADS_B, RET_DK).astype(f32) * RET_DK ** -0.5
    vb_c = _rs(vb_c, N_HEADS_B, RET_DV).astype(f32)
    zero = jnp.zeros((b, N_HEADS_B, RET_DK, RET_DV), f32)
    o_bc, s_f, s_b = _retention_bidir(qb_c, kb_c, vb_c, lg_f, lg_b, zero, zero)
    o_b, _, _ = _retention_bidir(qb, kb, vb, lg_f, lg_b, s_f, s_b)
    o_b = _ret_out(o_b, gb)
    lp = lam_p.astype(f32)
    lam = jnp.exp(jnp.sum(lp[0] * lp[1])) - jnp.exp(jnp.sum(lp[2] * lp[3])) + lam_init
    qd = _rope(_rs(qd, N_HEADS_C, 2, DIFF_DK), cos, sin)
    kd = _rope(_rs(kd, N_HEADS_C, 2, DIFF_DK), cos, sin)
    vd = _rs(vd, N_HEADS_C, DIFF_DV)
    kd_c, vd_c = _rs(kd_c, N_HEADS_C, 2, DIFF_DK), _rs(vd_c, N_HEADS_C, DIFF_DV)
    k_all = jnp.concatenate([kd, kd_c], axis=1)
    v_all = jnp.concatenate([vd, vd_c], axis=1)
    o_c = _diff_norm(_diff_latent(qd, k_all, v_all, lam), d_gain, lam_init)
    y = _merge([o_a, o_b, o_c], gl, w_branch, w_out)
    if not ctx_out:
        return y, None
    o_ac = _ctx_gqa(_rs(qa_c, N_KV_A, REP_A, HEAD_DIM), ka_c, va_c, sink)
    o_bc = _ret_out(o_bc, gb_c)
    o_cc = _diff_norm(_diff_attend(_rs(qd_c, N_HEADS_C, 2, DIFF_DK), kd_c, vd_c, lam), d_gain, lam_init)
    yc = _merge([o_ac, o_bc, o_cc], gl_c, w_branch, w_out)
    return y, yc


def _swiglu(h, w1, w3, w2):
    return (jax.nn.silu(h @ w1) * (h @ w3)) @ w2


def _moe(h, w_router, w1, w3, w2):
    t, d = h.shape
    logits = (h @ w_router).astype(jnp.float32)
    top_val, top_idx = lax.top_k(logits, TOP_K)
    gates = jax.nn.softmax(top_val, axis=-1).astype(h.dtype)
    flat_e = top_idx.reshape(-1)
    flat_t = jnp.repeat(jnp.arange(t), TOP_K)
    order = jnp.argsort(flat_e)
    e_s, t_s, g_s = flat_e[order], flat_t[order], gates.reshape(-1)[order]
    counts = jnp.bincount(flat_e, length=N_EXPERTS)
    starts = jnp.cumsum(counts) - counts
    padded = (counts + EXPERT_BLOCK - 1) // EXPERT_BLOCK * EXPERT_BLOCK
    pad_ends = jnp.cumsum(padded)
    dest = (pad_ends - padded)[e_s] + jnp.arange(t * TOP_K) - starts[e_s]
    n_blocks = (t * TOP_K + EXPERT_BLOCK - 1) // EXPERT_BLOCK + N_EXPERTS
    buf = jnp.zeros((n_blocks * EXPERT_BLOCK, d), h.dtype).at[dest].set(h[t_s])
    block_e = jnp.minimum(jnp.searchsorted(pad_ends, jnp.arange(n_blocks) * EXPERT_BLOCK, side='right'),
                          N_EXPERTS - 1)

    def expert_block(args):
        xb, e = args
        return _swiglu(xb, w1[e], w3[e], w2[e])

    out_buf = lax.map(expert_block, (buf.reshape(n_blocks, EXPERT_BLOCK, d), block_e)).reshape(-1, d)
    return jnp.zeros_like(h).at[t_s].add(out_buf[dest] * g_s[:, None])


def setup_inputs(seed: int = 0) -> dict:
    key = jax.random.key(seed)
    ks = jax.random.split(key, 26)
    nrm = lambda k, shape, s: jax.random.normal(k, shape, jnp.float32) * s
    n_dense = (DEPTH + 1) // 2
    n_moe = DEPTH // 2
    D = D_MODEL
    hb = jnp.arange(N_HEADS_B, dtype=jnp.float32)
    ret_logit = jnp.log(1.0 - 2.0 ** (-5.0 - hb)) + (5.0 + hb) * math.log(2.0)
    return {
        "x": nrm(ks[0], (BATCH, SEQ, D), 1.0),
        "c": nrm(ks[1], (BATCH, D), 1.0),
        "ctx": nrm(ks[2], (BATCH, CTX_LEN, D), 1.0),
        "c_ctx": nrm(ks[3], (D,), 1.0),
        "w_mod": nrm(ks[4], (DEPTH, D, 6 * D), 0.5 * D ** -0.5),
        "b_mod": nrm(ks[5], (DEPTH, 6 * D), 0.02),
        "norm_mix": 1.0 + nrm(ks[6], (DEPTH, D), 0.02),
        "norm_ffn": 1.0 + nrm(ks[7], (DEPTH, D), 0.02),
        "norm_final": 1.0 + nrm(ks[8], (D,), 0.02),
        "w_in": nrm(ks[9], (DEPTH, D, D_IN), D ** -0.5),
        "attn_sink": nrm(ks[10], (DEPTH, N_HEADS_A), 0.5),
        "ret_decay_fwd": ret_logit[None, :] + nrm(ks[11], (DEPTH, N_HEADS_B), 0.1),
        "ret_decay_bwd": ret_logit[None, :] + nrm(ks[12], (DEPTH, N_HEADS_B), 0.1),
        "diff_lambda": nrm(ks[13], (DEPTH, 4, DIFF_DK), 0.1),
        "diff_norm": 1.0 + nrm(ks[14], (DEPTH, DIFF_DV), 0.02),
        "w_branch": nrm(ks[15], (DEPTH, N_BRANCH, BRANCH_W, D), BRANCH_W ** -0.5),
        "w_out": nrm(ks[16], (DEPTH, D, D), D ** -0.5),
        "ffn_w1": nrm(ks[17], (n_dense, D, D_FF), D ** -0.5),
        "ffn_w3": nrm(ks[18], (n_dense, D, D_FF), D ** -0.5),
        "ffn_w2": nrm(ks[19], (n_dense, D_FF, D), D_FF ** -0.5),
        "moe_router": nrm(ks[20], (n_moe, D, N_EXPERTS), D ** -0.5),
        "moe_w1": nrm(ks[21], (n_moe, N_EXPERTS, D, D_FF), D ** -0.5),
        "moe_w3": nrm(ks[22], (n_moe, N_EXPERTS, D, D_FF), D ** -0.5),
        "moe_w2": nrm(ks[23], (n_moe, N_EXPERTS, D_FF, D), D_FF ** -0.5),
    }


def reference(x, c, ctx, c_ctx, w_mod, b_mod, norm_mix, norm_ffn, norm_final, w_in, attn_sink,
              ret_decay_fwd, ret_decay_bwd, diff_lambda, diff_norm, w_branch, w_out,
              ffn_w1, ffn_w3, ffn_w2, moe_router, moe_w1, moe_w3, moe_w2):
    b, n, d = x.shape
    cos, sin = _axial_rope_tables(n)
    cs = jax.nn.silu(c)
    ccs = jax.nn.silu(c_ctx)
    xc = ctx
    for l in range(DEPTH):
        ctx_out = l < DEPTH - 1
        lam_init = 0.8 - 0.6 * math.exp(-0.3 * l)
        mod = cs @ w_mod[l] + b_mod[l]
        mod_c = ccs @ w_mod[l] + b_mod[l]
        sh1, sc1, g1, sh2, sc2, g2 = [m[:, None, :] for m in jnp.split(mod, 6, axis=-1)]
        sh1c, sc1c, g1c, sh2c, sc2c, g2c = jnp.split(mod_c, 6, axis=-1)
        h = _rmsnorm(x, norm_mix[l]) * (1 + sc1) + sh1
        hc = _rmsnorm(xc, norm_mix[l]) * (1 + sc1c) + sh1c
        y, yc = _mixer(h, hc, cos, sin, w_in[l], attn_sink[l], ret_decay_fwd[l], ret_decay_bwd[l],
                       diff_lambda[l], lam_init, diff_norm[l], w_branch[l], w_out[l], ctx_out)
        x = x + g1 * y
        tok = (_rmsnorm(x, norm_ffn[l]) * (1 + sc2) + sh2).reshape(-1, d)
        if ctx_out:
            xc = xc + g1c * yc
            hc2 = _rmsnorm(xc, norm_ffn[l]) * (1 + sc2c) + sh2c
            tok = jnp.concatenate([tok, hc2.reshape(-1, d)], axis=0)
        if l % 2 == 0:
            f = _swiglu(tok, ffn_w1[l // 2], ffn_w3[l // 2], ffn_w2[l // 2])
        else:
            f = _moe(tok, moe_router[l // 2], moe_w1[l // 2], moe_w3[l // 2], moe_w2[l // 2])
        x = x + g2 * f[:b * n].reshape(b, n, d)
        if ctx_out:
            xc = xc + g2c * f[b * n:].reshape(xc.shape)
    return _rmsnorm(x, norm_final)
```

```cpp
#include <hip/hip_runtime.h>
#include <cstdio>
#include <cstdint>

#ifndef MK_SINGLE
#define MK_SINGLE 1
#endif

#define LAS __attribute__((address_space(3)))
#define GAS __attribute__((address_space(1)))

typedef unsigned short bf16_t;
typedef short bf16x8 __attribute__((ext_vector_type(8)));
typedef short s16x4 __attribute__((ext_vector_type(4)));
typedef float f32x2 __attribute__((ext_vector_type(2)));
typedef float f32x4 __attribute__((ext_vector_type(4)));
typedef float f32x16 __attribute__((ext_vector_type(16)));
typedef unsigned u32x2 __attribute__((ext_vector_type(2)));
typedef unsigned u32x4 __attribute__((ext_vector_type(4)));
typedef int i32x4 __attribute__((ext_vector_type(4)));
typedef int i32x8 __attribute__((ext_vector_type(8)));
typedef __bf16 bf16x2_t __attribute__((ext_vector_type(2)));

constexpr int DM = 1024, NB = 8, SEQ = 4096, CTXL = 256, DEPTH = 4;
constexpr int TL = NB * SEQ;
constexpr int TC = NB * CTXL;
constexpr int TT = TL + TC;
constexpr int DIN = 6912, DFF = 2816, NEXP = 8, OCW = 1536;
constexpr int DINP = 3840;
constexpr int NMT = 136;
constexpr int C_QA = 0, C_KA = 512, C_VA = 640, C_QB = 768, C_KB = 1024, C_VB = 1280, C_GB = 1792, C_QD = 2304, C_KD = 2816, C_VD = 3328, C_GL = 3840;
constexpr float NORM_EPS = 1e-6f;
constexpr float SM_C2 = 0.125f * 1.4426950408889634f;
constexpr float LOG2E = 1.4426950408889634f;
constexpr int NCHK = 34;

__device__ __forceinline__ unsigned pk2(float lo, float hi) { f32x2 v = {lo, hi}; bf16x2_t b = __builtin_convertvector(v, bf16x2_t); return __builtin_bit_cast(unsigned, b); }
constexpr int DENSE_F8 = 0;
constexpr float F8_SH = 8.0f, F8_SW13 = 256.0f, F8_SU = 8.0f, F8_SW2 = 256.0f, F8_INV13 = 1.0f / (F8_SH * F8_SW13), F8_INV2 = 1.0f / (F8_SU * F8_SW2);
__device__ __forceinline__ unsigned pk4f8(float a, float b, float c, float d) {
    a = __builtin_amdgcn_fmed3f(a, -448.0f, 448.0f); b = __builtin_amdgcn_fmed3f(b, -448.0f, 448.0f); c = __builtin_amdgcn_fmed3f(c, -448.0f, 448.0f); d = __builtin_amdgcn_fmed3f(d, -448.0f, 448.0f);
    int w = __builtin_amdgcn_cvt_pk_fp8_f32(a, b, 0, false); w = __builtin_amdgcn_cvt_pk_fp8_f32(c, d, w, true); return (unsigned)w;
}
__device__ __forceinline__ float bf_lo(unsigned u) { return __uint_as_float(u << 16); }
__device__ __forceinline__ float bf_hi(unsigned u) { return __uint_as_float(u & 0xffff0000u); }
__device__ __forceinline__ float bf1(bf16_t u) { return __uint_as_float(((unsigned)u) << 16); }
__device__ __forceinline__ float wave_sum(float v) {
#pragma unroll
    for (int o = 1; o < 64; o <<= 1) v += __shfl_xor(v, o);
    return v;
}
__device__ __forceinline__ float fexp2(float x) { return __builtin_amdgcn_exp2f(x); }
__device__ __forceinline__ float sigmoidf_(float x) { return __builtin_amdgcn_rcpf(1.0f + __builtin_amdgcn_exp2f(-LOG2E * x)); }
__device__ __forceinline__ float siluf_(float x) { return x * __builtin_amdgcn_rcpf(1.0f + __builtin_amdgcn_exp2f(-LOG2E * x)); }
#define LDS_WAIT() asm volatile("s_waitcnt lgkmcnt(0)" ::: "memory")
#define VM_WAIT() asm volatile("s_waitcnt vmcnt(0)" ::: "memory")

namespace pg8 {
#define PG8_LAS __attribute__((address_space(3)))
constexpr int BM = 256, BK = 64, HALF = 128, HTB = HALF * BK * 2  , STAGE_BYTES = 8 * HTB, NXCD = 8, WGM = 8;

__host__ __device__ __forceinline__ int lds_byte(int r, int c) { const int st = (r >> 4) * 2 + (c >> 5), rr = r & 15, cc = c & 31, ob = rr * 64 + cc * 2; return st * 1024 + (ob ^ (((ob >> 9) & 1) << 5)); }
__host__ __device__ __forceinline__ void stage_rc(int b, int& R, int& C) { const int st = b / 1024, sb = b % 1024, swz = sb ^ (((sb >> 9) & 1) << 5); R = (st >> 1) * 16 + swz / 64; C = (st & 1) * 32 + (swz % 64) / 2; }
__host__ __device__ __forceinline__ int perm32(int rho) { const int n = rho >> 4, i = rho & 15; return 8 * (i >> 2) + 4 * n + (i & 3); }

struct Unit { int pm, pn; size_t bo; };
struct Gemm { const bf16_t* A; const bf16_t* Bt; int K; };

struct GSched {
    int nM, nN, nwg, G, c, wgm; int grouped; size_t bstride; const PG8_LAS int* ts;
    int nx; unsigned long long xtab;
    __device__ __forceinline__ void init(int nM_, int nN_, int G_, int c_, int wgm_ = 4) { nM = nM_; nN = nN_; nwg = nM * nN; G = G_; c = c_; wgm = wgm_; grouped = 0; bstride = 0; ts = nullptr; nx = 0; xtab = 0; }
    __device__ __forceinline__ bool next(int i, Unit& u) const {
        const long L = (long)i * G + c; if (L >= nwg) return false;
        const int nmain = nwg - nx;
        if (L >= nmain) { const int j = (int)L - nmain; u.pm = nM + (j >> 3); u.pn = (int)((xtab >> (4 * (j & 7))) & 15ull); u.bo = 0; return true; }
        int wgid = (int)L; { const int q = nmain / NXCD, r = nmain % NXCD, xcd = wgid % NXCD, off = wgid / NXCD; wgid = (xcd < r ? xcd * (q + 1) : r * (q + 1) + (xcd - r) * q) + off; }
        const int nig = wgm * nN, gid = wgid / nig, fm = gid * wgm, gsz = (nM - fm) < wgm ? (nM - fm) : wgm;
        u.pm = fm + ((wgid % nig) % gsz); u.pn = (wgid % nig) / gsz; u.bo = 0;
        if (grouped) { int e = 0;
#pragma unroll
            for (int j = 1; j < 8; ++j) e += (u.pm >= ts[j]) ? 1 : 0;
            e = __builtin_amdgcn_readfirstlane(e);
            u.bo = (size_t)e * bstride; }
        return true;
    }
    __device__ __forceinline__ void a_ready(const Unit&) const {}
    __device__ __forceinline__ void done(const Unit&) const {}
};
#define ROT2(V, I, c, s) do { const float a_ = V[I] * (c) - V[I + 1] * (s), b_ = V[I + 1] * (c) + V[I] * (s); V[I] = a_; V[I + 1] = b_; } while (0)

struct EpiProj {
    static constexpr bool PERM = true, AFTER_DRAIN = false, KHOOK = false;
    bf16_t* O; const float* rope; u32x2* GB;
    __device__ __forceinline__ void operator()(const f32x4 (&acc)[2][2][4][2], const Unit& u, int wr, int wc, int fr, int fq) const {
        const int pn = u.pn; const bool latent = u.pm < TL / 256;
        if (pn >= 15) {
            const int gi = (pn - 15) >> 2, pnl = (pn - 15) & 3;
            u32x2* gp = GB + ((size_t)(((gi * NMT + u.pm) * 4 + pnl) * 8 + wr * 4 + wc) * 16) * 64 + fq * 16 + fr;
#pragma unroll
            for (int ai = 0; ai < 2; ++ai)
#pragma unroll
                for (int m = 0; m < 4; ++m)
#pragma unroll
                    for (int bj = 0; bj < 2; ++bj) { const f32x4 v0 = acc[ai][bj][m][0], v1 = acc[ai][bj][m][1];
#define SG_(x) ((unsigned)fminf(fmaxf(sigmoidf_(x) * 255.0f + 0.5f, 1.0f), 255.0f))
                        u32x2 w; w.x = SG_(v0[0]) | (SG_(v0[1]) << 8) | (SG_(v0[2]) << 16) | (SG_(v0[3]) << 24); w.y = SG_(v1[0]) | (SG_(v1[1]) << 8) | (SG_(v1[2]) << 16) | (SG_(v1[3]) << 24);
#undef SG_
                        __builtin_nontemporal_store(w, gp + (ai * 8 + m * 2 + bj) * 64); }
            return;
        }
        int rmask = 0; if (pn <= 1 || pn == 3 || pn == 4 || (pn >= 9 && pn <= 12)) rmask = 3; else if (pn == 2) rmask = 1;
        if (!latent) rmask = 0;
        const float sc = (pn == 4) ? 0.125f : SM_C2;
        const int row0 = u.pm * 256 + wr * 64 + fr, col0 = pn * 256 + wc * 32 + 8 * fq, axis = wc & 1;
#pragma unroll
        for (int ai = 0; ai < 2; ++ai)
#pragma unroll
            for (int m = 0; m < 4; ++m) {
                const int row = row0 + ai * 128 + m * 16;
                f32x4 cs0 = {1.f, 0.f, 1.f, 0.f}, cs1 = {1.f, 0.f, 1.f, 0.f};
                if (rmask) { const int pos = axis ? (row & 63) : ((row >> 6) & 63); const f32x4* tp = (const f32x4*)(rope + (pos * 16 + 4 * fq) * 2); cs0 = tp[0]; cs1 = tp[1]; }
                bf16_t* rowp = O + (size_t)row * DINP + col0;
#pragma unroll
                for (int bj = 0; bj < 2; ++bj) {
                    f32x4 v0 = acc[ai][bj][m][0], v1 = acc[ai][bj][m][1];
                    if ((rmask >> bj) & 1) { ROT2(v0, 0, cs0[0], cs0[1]); ROT2(v0, 2, cs0[2], cs0[3]); ROT2(v1, 0, cs1[0], cs1[1]); ROT2(v1, 2, cs1[2], cs1[3]); }
                    if (pn == 4 || pn <= 1 || pn == 9 || pn == 10) { v0 = v0 * sc; v1 = v1 * sc; }
                    u32x4 w; w.x = pk2(v0[0], v0[1]); w.y = pk2(v0[2], v0[3]); w.z = pk2(v1[0], v1[1]); w.w = pk2(v1[2], v1[3]);
                    __builtin_nontemporal_store(w, (u32x4*)(rowp + bj * 128));
                }
            }
    }
};

struct EpiMerge {
    static constexpr bool PERM = true, AFTER_DRAIN = false, KHOOK = true;
    bf16_t* Y; const u32x2* GB;
#define UB_(w, k) ((float)(((w) >> (8 * (k))) & 0xffu))
    __device__ __forceinline__ void khook(int t, f32x4 (&acc)[2][2][4][2], const Unit& u, int wr, int wc, int fr, int fq) const {
        const int gi = (t == 8) ? 0 : 1;
        const u32x2* ga = GB + ((size_t)(((gi * NMT + u.pm) * 4 + u.pn) * 8 + wr * 4 + wc) * 16) * 64 + fq * 16 + fr;
        const u32x2* gb = ga + (size_t)NMT * 4 * 8 * 16 * 64;
        u32x2 a[16], b[16];
#pragma unroll
        for (int j = 0; j < 16; ++j) { a[j] = ga[j * 64]; b[j] = gb[j * 64]; }
        __builtin_amdgcn_sched_barrier(0);
#pragma unroll
        for (int grp = 0; grp < 16; ++grp) { const int ai = grp >> 3, m = (grp >> 1) & 3, bj = grp & 1;
            f32x4 v0 = acc[ai][bj][m][0], v1 = acc[ai][bj][m][1];
#define MG_R(wa, wb, k) (UB_(wa, k) * __builtin_amdgcn_rcpf(UB_(wb, k)))
            v0[0] *= MG_R(a[grp].x, b[grp].x, 0); v0[1] *= MG_R(a[grp].x, b[grp].x, 1); v0[2] *= MG_R(a[grp].x, b[grp].x, 2); v0[3] *= MG_R(a[grp].x, b[grp].x, 3);
            v1[0] *= MG_R(a[grp].y, b[grp].y, 0); v1[1] *= MG_R(a[grp].y, b[grp].y, 1); v1[2] *= MG_R(a[grp].y, b[grp].y, 2); v1[3] *= MG_R(a[grp].y, b[grp].y, 3);
#undef MG_R
            acc[ai][bj][m][0] = v0; acc[ai][bj][m][1] = v1; }
        asm volatile("" ::: "memory"); __builtin_amdgcn_sched_barrier(0);
    }
    __device__ __forceinline__ void operator()(const f32x4 (&acc)[2][2][4][2], const Unit& u, int wr, int wc, int fr, int fq) const {
        const int row0 = u.pm * 256 + wr * 64 + fr, col0 = u.pn * 256 + wc * 32 + 8 * fq;
        const u32x2* gc = GB + ((size_t)(((2 * NMT + u.pm) * 4 + u.pn) * 8 + wr * 4 + wc) * 16) * 64 + fq * 16 + fr;
        u32x2 g[16];
#pragma unroll
        for (int j = 0; j < 16; ++j) g[j] = gc[j * 64];
        constexpr float q = 1.0f / 255.0f;
#pragma unroll
        for (int grp = 0; grp < 16; ++grp) { const int ai = grp >> 3, m = (grp >> 1) & 3, bj = grp & 1;
            const f32x4 v0 = acc[ai][bj][m][0] * q, v1 = acc[ai][bj][m][1] * q;
            u32x4 w; w.x = pk2(v0[0] * UB_(g[grp].x, 0), v0[1] * UB_(g[grp].x, 1)); w.y = pk2(v0[2] * UB_(g[grp].x, 2), v0[3] * UB_(g[grp].x, 3));
            w.z = pk2(v1[0] * UB_(g[grp].y, 0), v1[1] * UB_(g[grp].y, 1)); w.w = pk2(v1[2] * UB_(g[grp].y, 2), v1[3] * UB_(g[grp].y, 3));
            *(u32x4*)(Y + (size_t)(row0 + ai * 128 + m * 16) * DM + col0 + bj * 128) = w; }
    }
#undef UB_
};

struct EpiRes {
    static constexpr bool PERM = true, AFTER_DRAIN = false, KHOOK = false;
    const float* srcL; const float* srcC; float* dstL; float* dstC; const float* mod; int goff; float scl;
    __device__ __forceinline__ void operator()(const f32x4 (&acc)[2][2][4][2], const Unit& u, int wr, int wc, int fr, int fq) const {
        const bool latent = u.pm < TL / 256; const int mb = latent ? (u.pm >> 4) : 8;
        const float* g = mod + mb * 6144 + goff;
        const int rloc = (latent ? u.pm * 256 : u.pm * 256 - TL) + wr * 64 + fr, col0 = u.pn * 256 + wc * 32 + 8 * fq;
        const float* src = latent ? srcL : srcC; float* dst = latent ? dstL : dstC;
        f32x4 gv[2][2];
#pragma unroll
        for (int bj = 0; bj < 2; ++bj) { gv[bj][0] = *(const f32x4*)(g + col0 + bj * 128) * scl; gv[bj][1] = *(const f32x4*)(g + col0 + bj * 128 + 4) * scl; }
#pragma unroll
        for (int ai = 0; ai < 2; ++ai)
#pragma unroll
            for (int m = 0; m < 4; ++m) {
                const size_t off = (size_t)(rloc + ai * 128 + m * 16) * DM + col0;
#pragma unroll
                for (int bj = 0; bj < 2; ++bj) {
                    const f32x4 x0 = *(const f32x4*)(src + off + bj * 128), x1 = *(const f32x4*)(src + off + bj * 128 + 4);
                    *(f32x4*)(dst + off + bj * 128) = x0 + gv[bj][0] * acc[ai][bj][m][0];
                    *(f32x4*)(dst + off + bj * 128 + 4) = x1 + gv[bj][1] * acc[ai][bj][m][1];
                }
                if (m & 1) asm volatile("" ::: "memory");
            }
    }
};

struct EpiSwiglu {
    static constexpr bool PERM = true, AFTER_DRAIN = false, KHOOK = false;
    unsigned char* U;
    __device__ __forceinline__ void operator()(const f32x4 (&acc)[2][2][4][2], const Unit& u, int wr, int wc, int fr, int fq) const {
        const int row0 = u.pm * 256 + wr * 64 + fr, col0 = u.pn * 128 + wc * 32 + 8 * fq;
#pragma unroll
        for (int ai = 0; ai < 2; ++ai)
#pragma unroll
            for (int m = 0; m < 4; ++m) {
                const f32x4 a0 = acc[ai][0][m][0] * F8_INV13, a1 = acc[ai][0][m][1] * F8_INV13, b0 = acc[ai][1][m][0] * (F8_INV13 * F8_SU), b1 = acc[ai][1][m][1] * (F8_INV13 * F8_SU);
                u32x2 w; w.x = pk4f8(siluf_(a0[0]) * b0[0], siluf_(a0[1]) * b0[1], siluf_(a0[2]) * b0[2], siluf_(a0[3]) * b0[3]);
                w.y = pk4f8(siluf_(a1[0]) * b1[0], siluf_(a1[1]) * b1[1], siluf_(a1[2]) * b1[2], siluf_(a1[3]) * b1[3]);
                *(u32x2*)(U + (size_t)(row0 + ai * 128 + m * 16) * DFF + col0) = w;
            }
    }
};

struct EpiSwigluB {
    static constexpr bool PERM = true, AFTER_DRAIN = false, KHOOK = false;
    bf16_t* U;
    __device__ __forceinline__ void operator()(const f32x4 (&acc)[2][2][4][2], const Unit& u, int wr, int wc, int fr, int fq) const {
        const int row0 = u.pm * 256 + wr * 64 + fr, col0 = u.pn * 128 + wc * 32 + 8 * fq;
#pragma unroll
        for (int ai = 0; ai < 2; ++ai)
#pragma unroll
            for (int m = 0; m < 4; ++m) {
                const f32x4 a0 = acc[ai][0][m][0], a1 = acc[ai][0][m][1], b0 = acc[ai][1][m][0], b1 = acc[ai][1][m][1];
                u32x4 w; w.x = pk2(siluf_(a0[0]) * b0[0], siluf_(a0[1]) * b0[1]); w.y = pk2(siluf_(a0[2]) * b0[2], siluf_(a0[3]) * b0[3]);
                w.z = pk2(siluf_(a1[0]) * b1[0], siluf_(a1[1]) * b1[1]); w.w = pk2(siluf_(a1[2]) * b1[2], siluf_(a1[3]) * b1[3]);
                *(u32x4*)(U + (size_t)(row0 + ai * 128 + m * 16) * DFF + col0) = w;
            }
    }
};

struct EpiBf16 {
    static constexpr bool PERM = true, AFTER_DRAIN = false, KHOOK = false;
    bf16_t* O; int ldc; float scl;
    __device__ __forceinline__ void operator()(const f32x4 (&acc)[2][2][4][2], const Unit& u, int wr, int wc, int fr, int fq) const {
        const int row0 = u.pm * 256 + wr * 64 + fr, col0 = u.pn * 256 + wc * 32 + 8 * fq;
#pragma unroll
        for (int ai = 0; ai < 2; ++ai)
#pragma unroll
            for (int m = 0; m < 4; ++m) { bf16_t* rowp = O + (size_t)(row0 + ai * 128 + m * 16) * ldc + col0;
#pragma unroll
                for (int bj = 0; bj < 2; ++bj) { const f32x4 v0 = acc[ai][bj][m][0] * scl, v1 = acc[ai][bj][m][1] * scl;
                    u32x4 w; w.x = pk2(v0[0], v0[1]); w.y = pk2(v0[2], v0[3]); w.z = pk2(v1[0], v1[1]); w.w = pk2(v1[2], v1[3]);
                    *(u32x4*)(rowp + bj * 128) = w; } }
    }
};

template <class Epi, class Sched, bool ALIGN_EPI = false, bool SP2 = false, bool F8 = false>
__device__ __forceinline__ void gemm_phase(PG8_LAS unsigned char* lds, const Gemm g, const Sched& S, const Epi& E, int tid_in) {
    int tid = tid_in; asm volatile("" : "+v"(tid));
    const int wid = __builtin_amdgcn_readfirstlane(tid >> 6), lane = tid & 63, wr = wid >> 2, wc = wid & 3, fr = lane & 15, fq = lane >> 4;
    const int K = g.K, nt = K / BK;
    unsigned voffA[2], voffB[2];
#pragma unroll
    for (int i = 0; i < 2; ++i) { int R, C; stage_rc(tid * 16 + i * 8192, R, C); const int Rb = Epi::PERM ? ((R & ~31) + perm32(R & 31)) : R;
        voffA[i] = (unsigned)(R * K + C) * 2u; voffB[i] = (unsigned)(Rb * K + C) * 2u; }
    const size_t kstep = (size_t)(BK * 2);
    const size_t hstep = (size_t)HALF * K * 2;
    const size_t tstep = 2 * hstep;
    const unsigned ldsw = (unsigned)wid * 1024u;
    const int aoff = lds_byte(wr * 64 + fr, fq * 8), boff = lds_byte(wc * 32 + fr, fq * 8);
#define PG8_SA(b, h) (((b) * 2 + (h)) * HTB)
#define PG8_SB(b, h) ((4 + (b) * 2 + (h)) * HTB)
#define PG8_STAGE(bufoff, gbase, voff) do { _Pragma("unroll") for (int _i = 0; _i < 2; ++_i) \
        __builtin_amdgcn_global_load_lds((const unsigned*)((const char*)(gbase) + (voff)[_i]), (PG8_LAS unsigned*)(lds + (bufoff) + ldsw + _i * 8192), 16, 0, 0); } while (0)
#define PG8_LDA(dst, b, h) do { _Pragma("unroll") for (int m = 0; m < 4; ++m) _Pragma("unroll") for (int k = 0; k < 2; ++k) dst[m][k] = *(const PG8_LAS bf16x8*)(lds + PG8_SA(b, h) + aoff + m * 2048 + k * 1024); } while (0)
#define PG8_LDB(dst, b, h) do { _Pragma("unroll") for (int n = 0; n < 2; ++n) _Pragma("unroll") for (int k = 0; k < 2; ++k) dst[n][k] = *(const PG8_LAS bf16x8*)(lds + PG8_SB(b, h) + boff + n * 2048 + k * 1024); } while (0)
#define PG8_CAT(x) __builtin_shufflevector(__builtin_bit_cast(i32x4, (x)[0]), __builtin_bit_cast(i32x4, (x)[1]), 0, 1, 2, 3, 4, 5, 6, 7)
#define PG8_MMA(ai, bj, At, Bt) do { __builtin_amdgcn_s_setprio(1); _Pragma("unroll") for (int m = 0; m < 4; ++m) _Pragma("unroll") for (int n = 0; n < 2; ++n) { \
        if constexpr (F8) { const i32x8 b8_ = PG8_CAT(Bt[n]), a8_ = PG8_CAT(At[m]); asm volatile("v_mfma_f32_16x16x128_f8f6f4 %0, %1, %2, %0" : "+v"(acc[ai][bj][m][n]) : "v"(b8_), "v"(a8_)); } \
          \
        else { _Pragma("unroll") for (int k = 0; k < 2; ++k) acc[ai][bj][m][n] = __builtin_amdgcn_mfma_f32_16x16x32_bf16(Bt[n][k], At[m][k], acc[ai][bj][m][n], 0, 0, 0); } } \
        __builtin_amdgcn_s_setprio(0); } while (0)
#define PG8_WAIT_V(n) asm volatile("s_waitcnt vmcnt(" #n ")" ::: "memory")
#define PG8_WAIT_L(n) asm volatile("s_waitcnt lgkmcnt(" #n ")" ::: "memory")
#define PG8_BAR __builtin_amdgcn_s_barrier()
#define PG8_SCHED __builtin_amdgcn_sched_barrier(0)
    Unit cur, nxt; int ui = 0;
    if (!S.next(0, cur)) return;
    f32x4 acc[2][2][4][2];
#pragma unroll
    for (int a = 0; a < 2; ++a)
#pragma unroll
        for (int b = 0; b < 2; ++b)
#pragma unroll
            for (int m = 0; m < 4; ++m)
#pragma unroll
                for (int n = 0; n < 2; ++n) acc[a][b][m][n] = (f32x4){0.f, 0.f, 0.f, 0.f};
    bf16x8 At[4][2], B0[2][2], B1[2][2];
    const char* cA = (const char*)g.A + (size_t)cur.pm * tstep; const char* cB = (const char*)g.Bt + cur.bo * 2 + (size_t)cur.pn * tstep;
    S.a_ready(cur);
    if constexpr (SP2) {
        PG8_STAGE(PG8_SB(0, 0), cB, voffB); PG8_STAGE(PG8_SB(0, 1), cB + hstep, voffB); PG8_STAGE(PG8_SA(0, 0), cA, voffA); PG8_STAGE(PG8_SA(0, 1), cA + hstep, voffA);
        if (wr == 1) PG8_BAR;
        PG8_WAIT_V(2); PG8_BAR;
        PG8_STAGE(PG8_SB(1, 0), cB + kstep, voffB); PG8_STAGE(PG8_SA(1, 0), cA + kstep, voffA); PG8_STAGE(PG8_SB(1, 1), cB + hstep + kstep, voffB);
        PG8_WAIT_V(6); PG8_BAR;
    } else {
        PG8_STAGE(PG8_SB(0, 0), cB, voffB); PG8_STAGE(PG8_SA(0, 0), cA, voffA); PG8_STAGE(PG8_SB(0, 1), cB + hstep, voffB); PG8_STAGE(PG8_SA(0, 1), cA + hstep, voffA);
        if (wr == 1) PG8_BAR;
        PG8_WAIT_V(4); PG8_BAR;
        PG8_STAGE(PG8_SB(1, 0), cB + kstep, voffB); PG8_STAGE(PG8_SA(1, 0), cA + kstep, voffA); PG8_STAGE(PG8_SB(1, 1), cB + hstep + kstep, voffB);
        PG8_WAIT_V(6); PG8_BAR;
    }
    for (;;) {
        const bool has_next = S.next(ui + 1, nxt);
        const char* nA = has_next ? (const char*)g.A + (size_t)nxt.pm * tstep : cA; const char* nB = has_next ? (const char*)g.Bt + nxt.bo * 2 + (size_t)nxt.pn * tstep : cB;
        for (int t = 0; t < nt; t += 2) {
            const bool last = (t == nt - 2);
            const char* a1 = cA + (size_t)(t + 1) * kstep;
            const char* a2 = last ? nA : cA + (size_t)(t + 2) * kstep; const char* b2 = last ? nB : cB + (size_t)(t + 2) * kstep;
            const char* a3 = a2 + kstep; const char* b3 = b2 + kstep;
            if (last && has_next) S.a_ready(nxt);
            if constexpr (Epi::KHOOK) { if (t == 8 || t == 16) E.khook(t, acc, cur, wr, wc, fr, fq); }
            if constexpr (SP2) {
            PG8_LDB(B0, 0, 0); PG8_LDB(B1, 0, 1); PG8_SCHED; PG8_LDA(At, 0, 0); PG8_STAGE(PG8_SA(1, 1), a1 + hstep, voffA);
            PG8_WAIT_V(8); PG8_WAIT_L(0); PG8_BAR; PG8_MMA(0, 0, At, B0); PG8_MMA(0, 1, At, B1); PG8_BAR; PG8_SCHED;
            PG8_LDA(At, 0, 1); PG8_STAGE(PG8_SB(0, 0), b2, voffB); PG8_STAGE(PG8_SB(0, 1), b2 + hstep, voffB); PG8_STAGE(PG8_SA(0, 0), a2, voffA);
            PG8_WAIT_V(8); PG8_WAIT_L(0); PG8_BAR; PG8_MMA(1, 0, At, B0); PG8_MMA(1, 1, At, B1); PG8_BAR; PG8_SCHED;
            PG8_LDB(B0, 1, 0); PG8_LDB(B1, 1, 1); PG8_SCHED; PG8_LDA(At, 1, 0); PG8_STAGE(PG8_SA(0, 1), a2 + hstep, voffA);
            PG8_WAIT_V(8); PG8_WAIT_L(0); PG8_BAR; PG8_MMA(0, 0, At, B0); PG8_MMA(0, 1, At, B1); PG8_BAR; PG8_SCHED;
            PG8_LDA(At, 1, 1); PG8_STAGE(PG8_SB(1, 0), b3, voffB); PG8_STAGE(PG8_SB(1, 1), b3 + hstep, voffB); PG8_STAGE(PG8_SA(1, 0), a3, voffA);
            PG8_WAIT_V(8); PG8_WAIT_L(0); PG8_BAR; PG8_MMA(1, 0, At, B0); PG8_MMA(1, 1, At, B1); PG8_BAR; PG8_SCHED;
            } else {
            PG8_LDB(B0, 0, 0); PG8_SCHED; PG8_LDA(At, 0, 0); PG8_STAGE(PG8_SA(1, 1), a1 + hstep, voffA);
            PG8_WAIT_L(8); PG8_BAR; PG8_WAIT_L(0); PG8_MMA(0, 0, At, B0); PG8_BAR; PG8_SCHED;
            PG8_LDB(B1, 0, 1); PG8_STAGE(PG8_SB(0, 0), b2, voffB);
            PG8_BAR; PG8_WAIT_L(0); PG8_MMA(0, 1, At, B1); PG8_BAR;
            PG8_LDA(At, 0, 1); PG8_STAGE(PG8_SA(0, 0), a2, voffA);
            PG8_BAR; PG8_WAIT_L(0); PG8_MMA(1, 0, At, B0); PG8_BAR; PG8_SCHED;
            PG8_STAGE(PG8_SB(0, 1), b2 + hstep, voffB);
            PG8_WAIT_V(6); PG8_BAR; PG8_MMA(1, 1, At, B1); PG8_BAR;
            PG8_LDB(B0, 1, 0); PG8_SCHED; PG8_LDA(At, 1, 0); PG8_STAGE(PG8_SA(0, 1), a2 + hstep, voffA);
            PG8_WAIT_L(8); PG8_BAR; PG8_WAIT_L(0); PG8_MMA(0, 0, At, B0); PG8_BAR; PG8_SCHED;
            PG8_LDB(B1, 1, 1); PG8_STAGE(PG8_SB(1, 0), b3, voffB);
            PG8_BAR; PG8_WAIT_L(0); PG8_MMA(0, 1, At, B1); PG8_BAR;
            PG8_LDA(At, 1, 1); PG8_STAGE(PG8_SA(1, 0), a3, voffA);
            PG8_BAR; PG8_WAIT_L(0); PG8_MMA(1, 0, At, B0); PG8_BAR; PG8_SCHED;
            PG8_STAGE(PG8_SB(1, 1), b3 + hstep, voffB);
            PG8_WAIT_V(6); PG8_BAR; PG8_MMA(1, 1, At, B1); PG8_BAR;
            }
        }
        if constexpr (F8) asm volatile("s_nop 15\n\ts_nop 15" ::: "memory");
        if constexpr (ALIGN_EPI) { if (wr == 0) PG8_BAR; }
        if constexpr (!Epi::AFTER_DRAIN) { int ln_; asm volatile("v_mbcnt_lo_u32_b32 %0, -1, 0\n\tv_mbcnt_hi_u32_b32 %0, -1, %0" : "=v"(ln_));
            E(acc, cur, wr, wc, ln_ & 15, ln_ >> 4); S.done(cur); }
        if (!has_next) break;
#pragma unroll
        for (int a = 0; a < 2; ++a)
#pragma unroll
            for (int b = 0; b < 2; ++b)
#pragma unroll
                for (int m = 0; m < 4; ++m)
#pragma unroll
                    for (int n = 0; n < 2; ++n) acc[a][b][m][n] = (f32x4){0.f, 0.f, 0.f, 0.f};
        cur = nxt; cA = nA; cB = nB; ++ui;
        if constexpr (ALIGN_EPI) { if (wr == 1) PG8_BAR; }
    }
    PG8_WAIT_V(0);
    if constexpr (!ALIGN_EPI) { if (wr == 0) PG8_BAR; }
    PG8_BAR;
    if constexpr (Epi::AFTER_DRAIN) { E.fused(acc, cur, wr, wc, fr, fq, lds, wid, lane); S.done(cur); }
#undef PG8_SA
#undef PG8_SB
#undef PG8_STAGE
#undef PG8_LDA
#undef PG8_LDB
#undef PG8_MMA
#undef PG8_CAT
#undef PG8_WAIT_V
#undef PG8_WAIT_L
#undef PG8_BAR
#undef PG8_SCHED
}
}
namespace at {
__device__ __forceinline__ int crow(int r, int hi) { return (r & 3) + 8 * (r >> 2) + 4 * hi; }
typedef short v4i16_t __attribute__((ext_vector_type(4)));
__device__ __forceinline__ s16x4 vtr(const LAS unsigned char* p) { return __builtin_bit_cast(s16x4, __builtin_amdgcn_ds_read_tr16_b64_v4i16((LAS v4i16_t*)p)); }
__device__ __forceinline__ bf16x8 cat8(s16x4 lo, s16x4 hi) { return (bf16x8){lo[0], lo[1], lo[2], lo[3], hi[0], hi[1], hi[2], hi[3]}; }
#define MFMA32(a, b, c) __builtin_amdgcn_mfma_f32_32x32x16_bf16((a), (b), (c), 0, 0, 0)
constexpr int KSTR = 144;
constexpr float NEG_BIG = -1.0e30f;

__device__ __forceinline__ bf16x8 tr_frag(const LAS unsigned char* tile, int vstr, int ks, int colb, int lane) {
    const int hi = lane >> 5, ql = (lane & 15) >> 2, blk = (lane >> 4) & 1, p = lane & 3;
    const LAS unsigned char* a = tile + (16 * ks + 4 * hi + ql) * vstr + (colb + 16 * blk + 4 * p) * 2;
    return cat8(vtr(a), vtr(a + 8 * vstr));
}

template <int N> __device__ __forceinline__ void wait_bar() { asm volatile("s_waitcnt vmcnt(%0) lgkmcnt(0)\n\ts_barrier" :: "n"(N) : "memory"); }
template <int DV, int NK> struct AtGeo { static constexpr int KB = 8192, VB = DV * 128, STAGE = NK * KB + VB, NP = (NK * 8 + DV / 8) / 8  , LDS = 3 * STAGE + 2048; };
__device__ __forceinline__ bf16x8 v_frag(const LAS unsigned char* Vt, int ks, int c, int lane) {
    const int hi = lane >> 5, ql = (lane & 15) >> 2, blk = (lane >> 4) & 1, p = lane & 3;
    const int ch = (4 * (c & 1) + 2 * blk + (p >> 1)) ^ ((ql & 2) << 1);
    const LAS unsigned char* a = Vt + (c >> 1) * 8192 + (16 * ks + 4 * hi + ql) * 128 + ch * 16 + 8 * (p & 1);
    return cat8(vtr(a), vtr(a + 1024));
}
template <int DV, int NK> struct AtCtx {
    LAS unsigned char* lds; LAS float* scr; bf16x8 qr[4]; f32x16 o[DV / 32]; f32x16 negm; float m, l; int lane, r32, hi, ksel, qpos, kpos0, nloc; bool exact0;
};
template <int DV, int NK, bool BAND, bool HAS_QK, bool HAS_PV, bool EX0>
__device__ __forceinline__ void at_step(AtCtx<DV, NK>& C, int t, int koff, int voff, const u32x4 (&pw)[4], u32x4 (&pn)[4]) {
    constexpr int KB = 8192, NC = DV / 32, NG = NC * 4  , EPG = 16 / NG  ;
    const LAS unsigned char* Kt = C.lds + koff + C.ksel * KB;
    const LAS unsigned char* Vt = C.lds + voff;
    const int lane = C.lane, r32 = C.r32, hi = C.hi;
    f32x16 s0, s1; bf16x8 vf[2][4];
    bool resc = false;
    if (HAS_QK) {
        bf16x8 kf[8];
#pragma unroll
        for (int d0 = 0; d0 < 4; ++d0) { const int ko = r32 * 128 + (((2 * d0 + hi) ^ ((r32 >> 1) & 7)) << 4);
            kf[2 * d0] = *(const LAS bf16x8*)(Kt + ko); kf[2 * d0 + 1] = *(const LAS bf16x8*)(Kt + 4096 + ko); }
        __builtin_amdgcn_sched_barrier(0);
        __builtin_amdgcn_s_setprio(1);
        s0 = MFMA32(kf[0], C.qr[0], C.negm); s1 = MFMA32(kf[1], C.qr[0], C.negm);
#pragma unroll
        for (int d0 = 1; d0 < 4; ++d0) { s0 = MFMA32(kf[2 * d0], C.qr[d0], s0); s1 = MFMA32(kf[2 * d0 + 1], C.qr[d0], s1); }
        __builtin_amdgcn_s_setprio(0);
        __builtin_amdgcn_sched_barrier(0);
    }
    if (HAS_PV) {
#pragma unroll
        for (int c = 0; c < 2; ++c)
#pragma unroll
            for (int ks = 0; ks < 4; ++ks) vf[c][ks] = v_frag(Vt, ks, c, lane);
        __builtin_amdgcn_sched_barrier(0);
    }
    if (HAS_QK) {
        if (BAND && t < C.nloc) {
            const int kb = C.kpos0 + 64 * t - C.qpos;
#pragma unroll
            for (int r = 0; r < 16; ++r) { const int d = kb + crow(r, hi); if (d > 128 || d < -128) s0[r] = NEG_BIG; if (d + 32 > 128 || d + 32 < -128) s1[r] = NEG_BIG; }
        }
        float mt = fmaxf(fmaxf(s0[0], s1[0]), s0[1]);
#pragma unroll
        for (int r = 2; r < 16; r += 2) mt = fmaxf(fmaxf(mt, s0[r]), s0[r + 1]);
#pragma unroll
        for (int r = 1; r < 16; r += 2) mt = fmaxf(fmaxf(mt, s1[r]), s1[(r + 1) & 15]);
        { const auto sw = __builtin_amdgcn_permlane32_swap(__float_as_uint(mt), __float_as_uint(mt), false, false); mt = fmaxf(__uint_as_float(sw[0]), __uint_as_float(sw[1])); }
        const float dl = (!HAS_PV && EX0) ? mt : ((mt > 8.0f) ? mt : 0.0f);
        resc = (!HAS_PV && EX0) ? true : __any(dl > 0.0f);
        if (resc) { const float f = (!HAS_PV && EX0) ? 1.0f : fexp2(-dl);     C.l *= f; C.m += dl; if (hi == 0) C.scr[r32] = f;
#pragma unroll
            for (int r = 0; r < 16; ++r) { s0[r] -= dl; s1[r] -= dl; C.negm[r] = -C.m; } }
        __builtin_amdgcn_sched_barrier(0);
    }
    {
        float ls = 0.f;
        __builtin_amdgcn_s_setprio(1);
#pragma unroll
        for (int g = 0; g < NG; ++g) {
            const int c = g >> 2, ks = g & 3;
            if (HAS_PV) {
                C.o[c] = MFMA32(__builtin_bit_cast(bf16x8, pw[ks]), vf[c & 1][ks], C.o[c]);
                if (ks == 3 && c + 2 < NC) {
#pragma unroll
                    for (int k2 = 0; k2 < 4; ++k2) vf[c & 1][k2] = v_frag(Vt, k2, c + 2, lane);
                }
            }
            if (HAS_QK) {
#pragma unroll
                for (int e = 0; e < EPG; ++e) { const int r = g * EPG + e;
                    s0[r] = fexp2(s0[r]); s1[r] = fexp2(s1[r]); ls += s0[r] + s1[r];
                    if (r & 1) { const unsigned w0 = pk2(s0[r - 1], s0[r]), w1 = pk2(s1[r - 1], s1[r]); pn[r >> 3][(r >> 1) & 3] = w0; pn[2 + (r >> 3)][(r >> 1) & 3] = w1; } }
            }
        }
        if (HAS_QK) { C.l += ls; asm volatile("" : "+v"(pn[0]), "+v"(pn[1]), "+v"(pn[2]), "+v"(pn[3]), "+v"(C.l)); }
        __builtin_amdgcn_s_setprio(0);
        if (HAS_QK && HAS_PV) {
#pragma unroll
            for (int g = 0; g < NG; ++g) { __builtin_amdgcn_sched_group_barrier(0x008, 1, 0); __builtin_amdgcn_sched_group_barrier(0x002, 6 * EPG, 0); if (g < (NC - 2) * 4) __builtin_amdgcn_sched_group_barrier(0x100, 2, 0); }
        }
        __builtin_amdgcn_sched_barrier(0);
    }
    if (resc) {
        LDS_WAIT();
#pragma unroll
        for (int j = 0; j < 4; ++j) { const f32x4 fv = *(const LAS f32x4*)(C.scr + 8 * j + 4 * hi);
#pragma unroll
            for (int c = 0; c < NC; ++c) { C.o[c][4 * j] *= fv[0]; C.o[c][4 * j + 1] *= fv[1]; C.o[c][4 * j + 2] *= fv[2]; C.o[c][4 * j + 3] *= fv[3]; } }
        LDS_WAIT();
    }
}
template <int DV, int NK, bool BAND, bool EX0>
__device__ __forceinline__ void attn_core(LAS unsigned char* lds, const bf16_t* __restrict__ proj, int NT, int nloc, int locrow0, int ctxrow0, int kcol, int vcol,
                                          const bf16_t* qp, int ksel, int qpos, int kpos0, float m_init, float l_init, f32x16 (&o)[DV / 32], float& l_out, int tid) {
    typedef AtGeo<DV, NK> Geo;
    constexpr int KB = Geo::KB, VB = Geo::VB, NPK = NK, NPV = DV / 64, NP = NPK + NPV;
    AtCtx<DV, NK> C;
    C.lds = lds; C.lane = tid & 63; C.r32 = C.lane & 31; C.hi = C.lane >> 5; C.ksel = ksel; C.qpos = qpos; C.kpos0 = kpos0; C.nloc = nloc;
    const int lane = C.lane; const int wid = __builtin_amdgcn_readfirstlane(tid >> 6);
    C.scr = (LAS float*)(lds + 3 * Geo::STAGE) + wid * 64;
#pragma unroll
    for (int d0 = 0; d0 < 4; ++d0) C.qr[d0] = *(const bf16x8*)(qp + d0 * 16 + C.hi * 8);
    unsigned ksoff[NPK], vsoff[NPV]; int kdoff[NPK], vdoff[NPV];
#pragma unroll
    for (int i = 0; i < NPK; ++i) { const int pc = wid + 8 * i, j = pc >> 3, key = 8 * (pc & 7) + (lane >> 3), ch = (lane & 7) ^ ((key >> 1) & 7);
        ksoff[i] = (unsigned)key * DINP + kcol + j * 64 + ch * 8; kdoff[i] = pc * 1024; }
#pragma unroll
    for (int i = 0; i < NPV; ++i) { const int pv = wid + 8 * i, cp = pv >> 3, key = 8 * (pv & 7) + (lane >> 3), ch = (lane & 7) ^ (((key >> 1) & 1) << 2);
        vsoff[i] = (unsigned)key * DINP + vcol + cp * 64 + ch * 8; vdoff[i] = 3 * NK * KB + pv * 1024; }
#define AT_ROW0(t) ((t) < nloc ? locrow0 + 64 * (t) : ctxrow0 + 64 * ((t) - nloc))
#define AT_DMA_K(t, s) do { const bf16_t* tb = proj + (size_t)AT_ROW0(t) * DINP; \
        _Pragma("unroll") for (int i = 0; i < NPK; ++i) __builtin_amdgcn_global_load_lds((const unsigned*)(tb + ksoff[i]), (LAS unsigned*)(lds + (s) * (NK * KB) + kdoff[i]), 16, 0, 0); } while (0)
#define AT_DMA_V(t, s) do { const bf16_t* tb = proj + (size_t)AT_ROW0(t) * DINP; \
        _Pragma("unroll") for (int i = 0; i < NPV; ++i) __builtin_amdgcn_global_load_lds((const unsigned*)(tb + vsoff[i]), (LAS unsigned*)(lds + (s) * VB + vdoff[i]), 16, 0, 0); } while (0)
    C.m = m_init; C.l = l_init; C.exact0 = EX0;
#pragma unroll
    for (int r = 0; r < 16; ++r) C.negm[r] = -m_init;
#pragma unroll
    for (int c = 0; c < DV / 32; ++c) C.o[c] = (f32x16){0.f};
    u32x4 pa[4], pb[4];
    AT_DMA_K(0, 0);
    AT_DMA_K(1, 1); AT_DMA_V(0, 0);
    wait_bar<NP>();
    if (2 < NT) AT_DMA_K(2, 2);
    AT_DMA_V(1, 1);
    at_step<DV, NK, BAND, true, false, EX0>(C, 0, 0, 0, pb, pa);
    int s1 = 1, s0 = 0;
    for (int t = 1; t < NT; ++t) {
        if (t + 1 < NT) wait_bar<NP>(); else wait_bar<NPV>();
        const int s2 = s1 == 2 ? 0 : s1 + 1;
        if (t + 2 < NT) AT_DMA_K(t + 2, s0);
        if (t + 1 < NT) AT_DMA_V(t + 1, s2);
        at_step<DV, NK, BAND, true, true, EX0>(C, t, s1 * (NK * KB), 3 * NK * KB + s0 * VB, pa, pb);
#pragma unroll
        for (int i_ = 0; i_ < 4; ++i_) pa[i_] = pb[i_];
        s0 = s1; s1 = s2;
    }
    wait_bar<0>();
    at_step<DV, NK, BAND, false, true, EX0>(C, NT, 0, 3 * NK * KB + s0 * VB, pa, pb);
    wait_bar<0>();
#undef AT_ROW0
#undef AT_DMA_K
#undef AT_DMA_V
#pragma unroll
    for (int c = 0; c < DV / 32; ++c) o[c] = C.o[c];
    l_out = C.l + __shfl_xor(C.l, 32);
}
template <int DV, int NK> struct AtGeoP { static constexpr int KT = NK * 8192, VT = DV * 128, VRING = 4 * KT, SCR = 4 * KT + 4 * VT, LDS = SCR + 2048; };
template <int DV, int NK, bool EX0>
__device__ __forceinline__ void attn_core_pair(LAS unsigned char* lds, const bf16_t* __restrict__ proj, int NT, int nloc, int locrow0, int ctxrow0, int kcol, int vcol,
                                               const bf16_t* qp, int ksel, float m_init, float l_init, f32x16 (&o)[DV / 32], float& l_out, int tid) {
    typedef AtGeoP<DV, NK> Geo;
    constexpr int KT = Geo::KT, VT = Geo::VT, VRING = Geo::VRING, NPK = NK, NPV = DV / 64;
    AtCtx<DV, NK> C;
    C.lds = lds; C.lane = tid & 63; C.r32 = C.lane & 31; C.hi = C.lane >> 5; C.ksel = ksel; C.qpos = 0; C.kpos0 = 0; C.nloc = nloc;
    const int lane = C.lane; const int wid = __builtin_amdgcn_readfirstlane(tid >> 6);
    C.scr = (LAS float*)(lds + Geo::SCR) + wid * 64;
#pragma unroll
    for (int d0 = 0; d0 < 4; ++d0) C.qr[d0] = *(const bf16x8*)(qp + d0 * 16 + C.hi * 8);
    unsigned ksoff[NPK], vsoff[NPV]; int kdoff[NPK], vdoff[NPV];
#pragma unroll
    for (int i = 0; i < NPK; ++i) { const int pc = wid + 8 * i, j = pc >> 3, key = 8 * (pc & 7) + (lane >> 3), ch = (lane & 7) ^ ((key >> 1) & 7);
        ksoff[i] = (unsigned)key * DINP + kcol + j * 64 + ch * 8; kdoff[i] = pc * 1024; }
#pragma unroll
    for (int i = 0; i < NPV; ++i) { const int pv = wid + 8 * i, cp = pv >> 3, key = 8 * (pv & 7) + (lane >> 3), ch = (lane & 7) ^ (((key >> 1) & 1) << 2);
        vsoff[i] = (unsigned)key * DINP + vcol + cp * 64 + ch * 8; vdoff[i] = VRING + pv * 1024; }
#define ATP_ROW0(t) ((t) < nloc ? locrow0 + 64 * (t) : ctxrow0 + 64 * ((t) - nloc))
#define ATP_OFF(t, T_) ((((t) >> 1) & 1) * 2 * (T_) + ((t) & 1) * (T_))
#define ATP_DMA_K(t) do { const bf16_t* tb = proj + (size_t)ATP_ROW0(t) * DINP; const int so_ = ATP_OFF(t, KT); \
        _Pragma("unroll") for (int i = 0; i < NPK; ++i) __builtin_amdgcn_global_load_lds((const unsigned*)(tb + ksoff[i]), (LAS unsigned*)(lds + so_ + kdoff[i]), 16, 0, 0); } while (0)
#define ATP_DMA_V(t) do { const bf16_t* tb = proj + (size_t)ATP_ROW0(t) * DINP; const int so_ = ATP_OFF(t, VT); \
        _Pragma("unroll") for (int i = 0; i < NPV; ++i) __builtin_amdgcn_global_load_lds((const unsigned*)(tb + vsoff[i]), (LAS unsigned*)(lds + so_ + vdoff[i]), 16, 0, 0); } while (0)
    C.m = m_init; C.l = l_init; C.exact0 = EX0;
#pragma unroll
    for (int r = 0; r < 16; ++r) C.negm[r] = -m_init;
#pragma unroll
    for (int c = 0; c < DV / 32; ++c) C.o[c] = (f32x16){0.f};
    u32x4 pa[4], pb[4];
    ATP_DMA_K(0); ATP_DMA_K(1); ATP_DMA_V(0);
    wait_bar<0>();
    if (2 < NT) { ATP_DMA_K(2); ATP_DMA_K(3); ATP_DMA_V(2); }
    ATP_DMA_V(1);
    at_step<DV, NK, false, true, false, EX0>(C, 0, ATP_OFF(0, KT), 0, pb, pa);
    at_step<DV, NK, false, true, true, EX0>(C, 1, ATP_OFF(1, KT), VRING + ATP_OFF(0, VT), pa, pb);
#pragma unroll
    for (int i_ = 0; i_ < 4; ++i_) pa[i_] = pb[i_];
    for (int t = 2; t < NT; t += 2) {
        wait_bar<0>();
        if (t + 2 < NT) { ATP_DMA_K(t + 2); ATP_DMA_K(t + 3); ATP_DMA_V(t + 2); }
        ATP_DMA_V(t + 1);
        at_step<DV, NK, false, true, true, EX0>(C, t, ATP_OFF(t, KT), VRING + ATP_OFF(t - 1, VT), pa, pb);
#pragma unroll
        for (int i_ = 0; i_ < 4; ++i_) pa[i_] = pb[i_];
        at_step<DV, NK, false, true, true, EX0>(C, t + 1, ATP_OFF(t + 1, KT), VRING + ATP_OFF(t, VT), pa, pb);
#pragma unroll
        for (int i_ = 0; i_ < 4; ++i_) pa[i_] = pb[i_];
    }
    wait_bar<0>();
    at_step<DV, NK, false, false, true, EX0>(C, NT, 0, VRING + ATP_OFF(NT - 1, VT), pa, pb);
    wait_bar<0>();
#undef ATP_ROW0
#undef ATP_OFF
#undef ATP_DMA_K
#undef ATP_DMA_V
#pragma unroll
    for (int c = 0; c < DV / 32; ++c) o[c] = C.o[c];
    l_out = C.l + __shfl_xor(C.l, 32);
}
template <int NC>
__device__ __forceinline__ void scale_rows(f32x16 (&o)[NC], float v, LAS float* scr, int r32, int hi) {
    LDS_WAIT();
    if (hi == 0) scr[r32] = v;
    LDS_WAIT();
#pragma unroll
    for (int j = 0; j < 4; ++j) { const f32x4 fv = *(const LAS f32x4*)(scr + 8 * j + 4 * hi);
#pragma unroll
        for (int c = 0; c < NC; ++c) { o[c][4 * j] *= fv[0]; o[c][4 * j + 1] *= fv[1]; o[c][4 * j + 2] *= fv[2]; o[c][4 * j + 3] *= fv[3]; } }
    LDS_WAIT();
}
constexpr int AT_A_LDS = AtGeo<64, 1>::LDS;
constexpr int AT_C_LDS = AtGeoP<128, 2>::LDS;

__device__ __forceinline__ void attnA_unit(LAS unsigned char* lds, const bf16_t* proj, bf16_t* ocat, const float* sink, int b, int g, int qb, int lat, int tid) {
    const int lane = tid & 63, r32 = lane & 31, hi = lane >> 5; const int wid = __builtin_amdgcn_readfirstlane(tid >> 6);
    const int head = g * 4 + (wid >> 1), qloc = qb * 64 + (wid & 1) * 32;
    const int qrow0 = (lat ? b * SEQ : TL + b * CTXL) + qloc;
    int nloc = 0, kt0 = 0;
    if (lat) { kt0 = qb - 2 < 0 ? 0 : qb - 2; const int kt1 = qb + 2 > 63 ? 63 : qb + 2; nloc = kt1 - kt0 + 1; }
    const int NT = nloc + 4;
    f32x16 o[2]; float l;
    attn_core<64, 1, true, false>(lds, proj, NT, nloc, b * SEQ + 64 * kt0, TL + b * CTXL, C_KA + g * 64, C_VA + g * 64,
                           proj + (size_t)(qrow0 + r32) * DINP + C_QA + head * 64, 0, qloc + r32, 64 * kt0, sink[head] * LOG2E, hi == 0 ? 1.0f : 0.0f, o, l, tid);
    LAS float* scr = (LAS float*)(lds + 3 * AtGeo<64, 1>::STAGE) + wid * 64;
    scale_rows<2>(o, __builtin_amdgcn_rcpf(l), scr, r32, hi);
    bf16_t* op = ocat + (size_t)qrow0 * OCW + head * 64 + r32;
#pragma unroll
    for (int r = 0; r < 16; ++r) { const int row = crow(r, hi);
#pragma unroll
        for (int c = 0; c < 2; ++c) op[(size_t)row * OCW + 32 * c] = (bf16_t)(pk2(o[c][r], 0.f) & 0xffffu); }
}

__device__ __forceinline__ void attnC_unit(LAS unsigned char* lds, const bf16_t* proj, bf16_t* ocat, const float* dgain, float lam, float oml, int b, int h, int qb, int lat, int tid) {
    const int lane = tid & 63, r32 = lane & 31, hi = lane >> 5; const int wid = __builtin_amdgcn_readfirstlane(tid >> 6);
    const int comp = wid >> 2, qloc = qb * 128 + (wid & 3) * 32;
    const int qrow0 = (lat ? b * SEQ : TL + b * CTXL) + qloc;
    const int nloc = lat ? 64 : 0, NT = nloc + 4;
    f32x16 o[4]; float l;
    attn_core_pair<128, 2, true>(lds, proj, NT, nloc, b * SEQ, TL + b * CTXL, C_KD + h * 128, C_VD + h * 128,
                           proj + (size_t)(qrow0 + r32) * DINP + C_QD + h * 128 + comp * 64, comp, 0.0f, 0.0f, o, l, tid);
    LAS float* scr = (LAS float*)(lds + AtGeoP<128, 2>::SCR) + wid * 64;
    scale_rows<4>(o, __builtin_amdgcn_rcpf(l), scr, r32, hi);
    LAS float* X = (LAS float*)lds + (wid & 3) * 4096;
    if (comp == 1) {
#pragma unroll
        for (int c = 0; c < 4; ++c)
#pragma unroll
            for (int r = 0; r < 16; ++r) X[(c * 16 + r) * 64 + lane] = o[c][r];
    }
    __syncthreads();
    if (comp == 0) {
        float ss[16];
#pragma unroll
        for (int r = 0; r < 16; ++r) ss[r] = 0.f;
#pragma unroll
        for (int c = 0; c < 4; ++c)
#pragma unroll
            for (int r = 0; r < 16; ++r) { const float v = o[c][r] - lam * X[(c * 16 + r) * 64 + lane]; o[c][r] = v; ss[r] += v * v; }
#pragma unroll
        for (int r = 0; r < 16; ++r) {
#pragma unroll
            for (int s = 1; s < 32; s <<= 1) ss[r] += __shfl_xor(ss[r], s);
            ss[r] = __builtin_amdgcn_rsqf(ss[r] * (1.0f / 128.0f) + NORM_EPS) * oml;
        }
        bf16_t* op = ocat + (size_t)qrow0 * OCW + 1024 + h * 128 + r32;
#pragma unroll
        for (int c = 0; c < 4; ++c) { const float gn = dgain[32 * c + r32];
#pragma unroll
            for (int r = 0; r < 16; ++r) op[(size_t)crow(r, hi) * OCW + 32 * c] = (bf16_t)(pk2(o[c][r] * ss[r] * gn, 0.f) & 0xffffu); }
    }
    __syncthreads();
}
__device__ __forceinline__ int chunk_row0(int b, int ci) { return ci < 2 ? TL + b * CTXL + ci * 128 : b * SEQ + (ci - 2) * 128; }
constexpr int RSTR = 192;
constexpr int VSTR128 = 320;
constexpr int R1_LDS = 2 * 128 * RSTR + 128 * VSTR128;
__device__ __forceinline__ void ret_kv_phase(LAS unsigned char* lds, const bf16_t* __restrict__ proj, bf16_t* kvT, const float* lg2, int blk, int G, int tid) {
    const int lane = tid & 63, hi = lane >> 5; const int wid = __builtin_amdgcn_readfirstlane(tid >> 6);
    LAS unsigned char* Kf = lds; LAS unsigned char* Kb = lds + 128 * RSTR; LAS unsigned char* Vt = lds + 2 * 128 * RSTR;
    constexpr int NU = NB * 4 * NCHK;
    int u = blk; if (u >= NU) return;
    u32x4 kreg[2], vreg[4];
#define R1_LOAD(uu) do { const int ci_ = (uu) % NCHK, bh_ = (uu) / NCHK, row0_ = chunk_row0(bh_ >> 2, ci_), h_ = bh_ & 3; \
        _Pragma("unroll") for (int i = 0; i < 2; ++i) { const int c = tid + 512 * i, k = c >> 3, ch = c & 7; kreg[i] = *(const u32x4*)(proj + (size_t)(row0_ + k) * DINP + C_KB + h_ * 64 + ch * 8); } \
        _Pragma("unroll") for (int i = 0; i < 4; ++i) { const int c = tid + 512 * i, k = c >> 4, ch = c & 15; vreg[i] = *(const u32x4*)(proj + (size_t)(row0_ + k) * DINP + C_VB + h_ * 128 + ch * 8); } } while (0)
    R1_LOAD(u);
    for (;;) {
        const int ci = u % NCHK, bh = u / NCHK, b = bh >> 2, h = bh & 3;
        const float lgf2 = lg2[h], lgb2 = lg2[4 + h];
#pragma unroll
        for (int i = 0; i < 2; ++i) { const int c = tid + 512 * i, k = c >> 3, ch = c & 7;
            const u32x4 v = kreg[i];
            const float wf = fexp2((float)(127 - k) * lgf2), wb = fexp2((float)k * lgb2);
            u32x4 a, d;
#pragma unroll
            for (int j = 0; j < 4; ++j) { const float x0 = bf_lo(v[j]), x1 = bf_hi(v[j]); a[j] = pk2(x0 * wf, x1 * wf); d[j] = pk2(x0 * wb, x1 * wb); }
            *(LAS u32x4*)(Kf + k * RSTR + ch * 16) = a; *(LAS u32x4*)(Kb + k * RSTR + ch * 16) = d; }
#pragma unroll
        for (int i = 0; i < 4; ++i) { const int c = tid + 512 * i, k = c >> 4, ch = c & 15; *(LAS u32x4*)(Vt + k * VSTR128 + ch * 16) = vreg[i]; }
        __syncthreads();
        const int un = u + G;
        if (un < NU) R1_LOAD(un);
        const int dir = wid >> 2, mt = (wid >> 1) & 1, nt0 = (wid & 1) * 2;
        const LAS unsigned char* Kt = dir ? Kb : Kf;
        f32x16 acc0 = (f32x16){0.f}, acc1 = (f32x16){0.f};
#pragma unroll
        for (int ks = 0; ks < 8; ++ks) {
            const bf16x8 af = tr_frag(Kt, RSTR, ks, 32 * mt, lane);
            acc0 = MFMA32(af, tr_frag(Vt, VSTR128, ks, 32 * nt0, lane), acc0);
            acc1 = MFMA32(af, tr_frag(Vt, VSTR128, ks, 32 * nt0 + 32, lane), acc1);
        }
        bf16_t* out = kvT + ((size_t)(((b * 4 + h) * NCHK + ci) * 2 + dir)) * 8192;
#pragma unroll
        for (int j = 0; j < 4; ++j) {
            u32x2 w0, w1; w0.x = pk2(acc0[4 * j], acc0[4 * j + 1]); w0.y = pk2(acc0[4 * j + 2], acc0[4 * j + 3]); w1.x = pk2(acc1[4 * j], acc1[4 * j + 1]); w1.y = pk2(acc1[4 * j + 2], acc1[4 * j + 3]);
            *(u32x2*)(out + (size_t)(32 * nt0 + (lane & 31)) * 64 + 32 * mt + 8 * j + 4 * hi) = w0;
            *(u32x2*)(out + (size_t)(32 * nt0 + 32 + (lane & 31)) * 64 + 32 * mt + 8 * j + 4 * hi) = w1;
        }
        __syncthreads();
        if (un >= NU) break;
        u = un;
    }
#undef R1_LOAD
}
__device__ __forceinline__ void ret_scan(const bf16_t* kvT, bf16_t* SpT, const float* lg2  , int gtid, int gthreads) {
    for (int q = gtid; q < 64 * 2048; q += gthreads) {
        const int combo = q >> 11, e4 = (q & 2047) * 4, dir = combo & 1, h = (combo >> 1) & 3, b = combo >> 3;
        const float g128 = fexp2(128.0f * lg2[dir * 4 + h]);
        f32x4 S = {0.f, 0.f, 0.f, 0.f};
        for (int s = 0; s < NCHK; ++s) {
            const int ci = dir ? (s == 0 ? 1 : (s == 1 ? 0 : 35 - s)) : s;
            const size_t off = ((size_t)(((b * 4 + h) * NCHK + ci) * 2 + dir)) * 8192 + e4;
            const u32x2 kw = *(const u32x2*)(kvT + off); const f32x4 kv = {bf_lo(kw.x), bf_hi(kw.x), bf_lo(kw.y), bf_hi(kw.y)};
            u32x2 w; w.x = pk2(S[0], S[1]); w.y = pk2(S[2], S[3]);
            *(u32x2*)(SpT + off) = w;
            S = S * g128 + kv;
        }
    }
}
constexpr int R3_K = 0, R3_V = 128 * KSTR, R3_SF = R3_V + 128 * VSTR128, R3_SB = R3_SF + 128 * KSTR, R3_X = R3_SB + 128 * KSTR, R3_SCR = R3_X + 1024, R3_LDS = R3_SCR + 2048;
__device__ __forceinline__ void ret_out_unit(LAS unsigned char* lds, const bf16_t* __restrict__ proj, const bf16_t* __restrict__ SpT, bf16_t* ocat, float lgf2, float lgb2, int b, int h, int ci, int tid) {
    const int lane = tid & 63, r32 = lane & 31, hi = lane >> 5; const int wid = __builtin_amdgcn_readfirstlane(tid >> 6);
    const int row0 = chunk_row0(b, ci), qs = wid & 3, dh = wid >> 2;
    const bf16_t* sp = SpT + ((size_t)(((b * 4 + h) * NCHK + ci) * 2)) * 8192;
#pragma unroll
    for (int i = 0; i < 2; ++i) { const int c = tid + 512 * i, k = c >> 3, ch = c & 7;
        *(LAS u32x4*)(lds + R3_K + k * KSTR + ch * 16) = *(const u32x4*)(proj + (size_t)(row0 + k) * DINP + C_KB + h * 64 + ch * 8);
        *(LAS u32x4*)(lds + R3_SF + k * KSTR + ch * 16) = *(const u32x4*)(sp + (size_t)k * 64 + ch * 8);
        *(LAS u32x4*)(lds + R3_SB + k * KSTR + ch * 16) = *(const u32x4*)(sp + 8192 + (size_t)k * 64 + ch * 8); }
#pragma unroll
    for (int i = 0; i < 4; ++i) { const int c = tid + 512 * i, k = c >> 4, ch = c & 15;
        *(LAS u32x4*)(lds + R3_V + k * VSTR128 + ch * 16) = *(const u32x4*)(proj + (size_t)(row0 + k) * DINP + C_VB + h * 128 + ch * 8); }
    bf16x8 qr[4];
    { const bf16_t* qp = proj + (size_t)(row0 + 32 * qs + r32) * DINP + C_QB + h * 64;
#pragma unroll
      for (int d0 = 0; d0 < 4; ++d0) qr[d0] = *(const bf16x8*)(qp + d0 * 16 + hi * 8); }
    bf16_t gt[2][16];
    { const bf16_t* gp0 = proj + (size_t)(row0 + 32 * qs) * DINP + C_GB + h * 128 + 64 * dh + r32;
#pragma unroll
      for (int r = 0; r < 16; ++r)
#pragma unroll
          for (int c = 0; c < 2; ++c) gt[c][r] = gp0[(size_t)crow(r, hi) * DINP + 32 * c]; }
    __syncthreads();
    f32x16 o[2];
#pragma unroll
    for (int c = 0; c < 2; ++c) {
        f32x16 tf = (f32x16){0.f}, tb = (f32x16){0.f};
        const int srow = 64 * dh + 32 * c + r32;
#pragma unroll
        for (int d0 = 0; d0 < 4; ++d0) {
            tf = MFMA32(qr[d0], *(const LAS bf16x8*)(lds + R3_SF + srow * KSTR + (16 * d0 + 8 * hi) * 2), tf);
            tb = MFMA32(qr[d0], *(const LAS bf16x8*)(lds + R3_SB + srow * KSTR + (16 * d0 + 8 * hi) * 2), tb);
        }
#pragma unroll
        for (int r = 0; r < 16; ++r) { const int cp = 32 * qs + crow(r, hi); o[c][r] = fexp2((float)(cp + 1) * lgf2) * tf[r] + fexp2((float)(128 - cp) * lgb2) * tb[r]; }
    }
    const int qpos = 32 * qs + r32;
#pragma unroll 1
    for (int kt = 0; kt < 4; ++kt) {
        f32x16 p = (f32x16){0.f};
#pragma unroll
        for (int d0 = 0; d0 < 4; ++d0) p = MFMA32(*(const LAS bf16x8*)(lds + R3_K + (32 * kt + r32) * KSTR + (16 * d0 + 8 * hi) * 2), qr[d0], p);
#pragma unroll
        for (int r = 0; r < 16; ++r) { const int d = qpos - (32 * kt + crow(r, hi));
            const float wf = d >= 0 ? fexp2((float)d * lgf2) : 0.f, wb = d <= 0 ? fexp2((float)(-d) * lgb2) : 0.f; p[r] *= (wf + wb); }
        u32x4 w0, w1;
        w0.x = pk2(p[0], p[1]); w0.y = pk2(p[2], p[3]); w0.z = pk2(p[4], p[5]); w0.w = pk2(p[6], p[7]);
        w1.x = pk2(p[8], p[9]); w1.y = pk2(p[10], p[11]); w1.z = pk2(p[12], p[13]); w1.w = pk2(p[14], p[15]);
        const bf16x8 pa = __builtin_bit_cast(bf16x8, w0), pb = __builtin_bit_cast(bf16x8, w1);
#pragma unroll
        for (int c = 0; c < 2; ++c) {
            o[c] = MFMA32(pa, tr_frag(lds + R3_V, VSTR128, 2 * kt, 64 * dh + 32 * c, lane), o[c]);
            o[c] = MFMA32(pb, tr_frag(lds + R3_V, VSTR128, 2 * kt + 1, 64 * dh + 32 * c, lane), o[c]);
        }
    }
    float ss[16];
#pragma unroll
    for (int r = 0; r < 16; ++r) { ss[r] = o[0][r] * o[0][r] + o[1][r] * o[1][r];
#pragma unroll
        for (int s = 1; s < 32; s <<= 1) ss[r] += __shfl_xor(ss[r], s); }
    LAS float* X = (LAS float*)(lds + R3_X);
    if (r32 == 0) {
#pragma unroll
        for (int r = 0; r < 16; ++r) X[dh * 128 + 32 * qs + crow(r, hi)] = ss[r];
    }
    __syncthreads();
    bf16_t* op = ocat + (size_t)(row0 + 32 * qs) * OCW + 512 + h * 128 + 64 * dh + r32;
#pragma unroll
    for (int r = 0; r < 16; ++r) { const int row = crow(r, hi);
        const float rstd = __builtin_amdgcn_rsqf((X[32 * qs + row] + X[128 + 32 * qs + row]) * (1.0f / 128.0f) + NORM_EPS);
#pragma unroll
        for (int c = 0; c < 2; ++c) { const float gte = bf1(gt[c][r]);
            op[(size_t)row * OCW + 32 * c] = (bf16_t)(pk2(o[c][r] * rstd * siluf_(gte), 0.f) & 0xffffu); } }
    __syncthreads();
}
#undef MFMA32
}
constexpr size_t MiB = 1u << 20;
constexpr size_t WS_CTL = 0, CTL_ZERO_BYTES = 128 * 1024;
constexpr int CW_BAR = 1024;
constexpr int CW_MOE = 8192;
constexpr int CW_CUR = 12288;
constexpr int CW_DEP = 20480;
constexpr int CW_DONE = 16384;
constexpr size_t WS_TAB = 1 * MiB;
constexpr int TAB_MOD = 0, TAB_ROPE = DEPTH * 9 * 6144, TAB_LAM = TAB_ROPE + 2048, TAB_LG2 = TAB_LAM + 8;
constexpr size_t WS_XC = 2 * MiB;
constexpr size_t WS_ROUTE = 10 * MiB;
constexpr size_t WS_MIX = 12 * MiB, MIX_STRIDE = 19 * MiB;
constexpr size_t MIX_WB = 14 * MiB, MIX_WO = 17 * MiB;
constexpr size_t WS_FD = 88 * MiB, FD_STRIDE = 17 * MiB, FD_W2 = 11 * MiB;
constexpr size_t WS_W13 = 122 * MiB;
constexpr size_t WS_W2 = 210 * MiB;
constexpr size_t WS_H = 254 * MiB;
constexpr size_t WS_PROJ = 322 * MiB;
constexpr size_t WS_GATE = WS_PROJ + 256 * MiB;
constexpr size_t WS_OCAT = 782 * MiB;
constexpr size_t WS_Y = 884 * MiB;
constexpr size_t WS_END = 952 * MiB;
static_assert((size_t)DIN * DM * 2 <= MIX_WB && MIX_WB + (size_t)DM * OCW * 2 <= MIX_WO && MIX_WO + (size_t)DM * DM * 2 <= MIX_STRIDE && WS_MIX + DEPTH * MIX_STRIDE <= WS_FD, "ws map (mixer weights)");
static_assert((size_t)2 * DFF * DM * 2 <= FD_W2 && FD_W2 + (size_t)DM * DFF * 2 <= FD_STRIDE && WS_FD + 2 * FD_STRIDE <= WS_W13, "ws map (dense ffn weights)");
static_assert(WS_W13 + (size_t)NEXP * 2 * DFF * DM * 2 <= WS_W2 && WS_W2 + (size_t)NEXP * DM * DFF * 2 <= WS_H && WS_H + (size_t)TT * DM * 2 <= WS_PROJ, "ws map (moe weights, h)");
static_assert(WS_PROJ + (size_t)TT * DINP * 2 <= WS_GATE && WS_GATE + (size_t)3 * NMT * 4 * 8 * 16 * 64 * 16 <= WS_OCAT && WS_OCAT + (size_t)TT * OCW * 2 <= WS_Y && WS_Y + (size_t)TT * DM * 2 <= WS_END, "ws map (activations)");
constexpr int MOE_SLOTS = 2 * TT + NEXP * 256;
static_assert(WS_PROJ + (size_t)MOE_SLOTS * DFF * 2 <= WS_OCAT && WS_OCAT + (size_t)MOE_SLOTS * DM * 2 <= WS_END, "ws map (MoE overlays)");
static_assert((size_t)NB * 4 * NCHK * 2 * 8192 * 4 <= (size_t)TT * DM * 2 && (size_t)NB * 4 * NCHK * 2 * 8192 * 2 <= (size_t)TT * DM * 2, "ws map (retention overlays)");

#define XB_TMO      128
#define XB_XCNT(j)  (256  + 64 * (j))
#define XB_XSUB(j)  (1280 + 64 * (j))
#define XB_XGEN(j)  (2304 + 64 * (j))
#define XB_TOP      3328
#define XB_TOPGEN   3392
#define XCD_BAR_WORDS 3456
#define XB_SPIN_CAP (1u << 18)

__device__ __forceinline__ unsigned xb_ld(unsigned* p)              { return __hip_atomic_load(p, __ATOMIC_RELAXED, __HIP_MEMORY_SCOPE_AGENT); }
__device__ __forceinline__ unsigned xb_add(unsigned* p, unsigned v) { return __hip_atomic_fetch_add(p, v, __ATOMIC_RELAXED, __HIP_MEMORY_SCOPE_AGENT); }
__device__ __forceinline__ unsigned xb_xcc_id() { return (unsigned)__builtin_amdgcn_s_getreg((3 << 11) | 20) & 0xFu; }
#define XB_SPIN(cond, bar) do { unsigned _sp = 0; while (cond) { __builtin_amdgcn_s_sleep(1); \
    if ((++_sp & 255u) == 0u) { if (xb_ld(&(bar)[XB_TMO])) break; if (_sp > XB_SPIN_CAP) { atomicAdd(&(bar)[XB_TMO], 1u); break; } } } } while (0)

struct XcdBarrier {
    unsigned* bar; unsigned x;
    volatile LAS unsigned* st;
};
__device__ __forceinline__ XcdBarrier xcd_barrier_post(unsigned* bar, volatile LAS unsigned* st, int tid) {
    XcdBarrier b; b.bar = bar; b.x = xb_xcc_id(); b.st = st;
    if (tid == 0) (void)xb_add(&bar[XB_XCNT(b.x)], 1u);
    return b;
}
__device__ __forceinline__ void xcd_barrier_complete(unsigned* bar, unsigned x, unsigned& nloc, unsigned& nx) {
    const unsigned G = gridDim.x * gridDim.y * gridDim.z;
    unsigned sum, cnt, mine, sp = 0u;
    for (;;) {
        sum = 0u; cnt = 0u; mine = 0u;
#pragma unroll
        for (unsigned j = 0; j < 16; ++j) { const unsigned c = xb_ld(&bar[XB_XCNT(j)]); sum += c; cnt += (c > 0u) ? 1u : 0u; mine = (j == x) ? c : mine; }
        if (sum == G) break;
        __builtin_amdgcn_s_sleep(1);
        if ((++sp & 255u) == 0u) { if (xb_ld(&bar[XB_TMO])) break; if (sp > XB_SPIN_CAP) { atomicAdd(&bar[XB_TMO], 1u); break; } }
    }
    nloc = mine > 0u ? mine : 1u; nx = cnt > 0u ? cnt : 1u;
}
__device__ __forceinline__ void xcd_barrier(const XcdBarrier& b_in, int tid) {
    XcdBarrier b = b_in; b.x = xb_xcc_id();
    asm volatile("s_waitcnt vmcnt(0)" ::: "memory");
    __syncthreads();
    if (tid == 0) {
        unsigned* bar = b.bar; asm volatile("" : "+s"(bar));
        __builtin_amdgcn_s_waitcnt(0);
        unsigned nloc = b.st[0], nx = b.st[1];
        if (nloc == 0u) { xcd_barrier_complete(bar, b.x, nloc, nx); b.st[0] = nloc; b.st[1] = nx; }
        const unsigned old = xb_add(&bar[XB_XSUB(b.x)], 1u);
        const unsigned gen = old / nloc;
        if (old + 1u == (gen + 1u) * nloc) {
            __builtin_amdgcn_fence(__ATOMIC_RELEASE, "agent");
            asm volatile("s_waitcnt vmcnt(0)" ::: "memory");
            const unsigned og = xb_add(&bar[XB_TOP], 1u);
            const unsigned tg = og / nx;
            if (og + 1u == (tg + 1u) * nx) xb_add(&bar[XB_TOPGEN], 1u);
            else XB_SPIN(xb_ld(&bar[XB_TOPGEN]) == tg, bar);
            __builtin_amdgcn_fence(__ATOMIC_ACQUIRE, "agent");
            xb_add(&bar[XB_XGEN(b.x)], 1u);
            asm volatile("s_waitcnt vmcnt(0)" ::: "memory");
        } else {
            XB_SPIN(xb_ld(&bar[XB_XGEN(b.x)]) == gen, bar);
            __builtin_amdgcn_fence(__ATOMIC_ACQUIRE, "agent");
            asm volatile("s_waitcnt vmcnt(0)" ::: "memory");
        }
    }
    __syncthreads();
}
struct Route { int sa, sb; float ga, gb; int ea, pa, eb, pb; };

__device__ __forceinline__ void p0_mod(LAS unsigned char* lds, const float* c, const float* cctx, const float* wmod, const float* bmod, float* mod, int blk, int G, int tid) {
    LAS float* sc = (LAS float*)lds;
    LAS float* red = sc + 9 * 1024;
    for (int i = tid; i < 9 * 1024; i += 512) { const float v = i < 8192 ? c[i] : cctx[i - 8192]; sc[i] = siluf_(v); }
    __syncthreads();
    const int cq = tid & 31, kg = tid >> 5;
    for (int u = blk; u < DEPTH * 48; u += G) {
        const int l = u / 48, n = (u % 48) * 128 + 4 * cq;
        f32x4 acc[9];
#pragma unroll
        for (int r = 0; r < 9; ++r) acc[r] = (f32x4){0.f, 0.f, 0.f, 0.f};
        const float* wp = wmod + ((size_t)l * DM + kg * 64) * 6144 + n;
        for (int k0 = 0; k0 < 64; k0 += 16) {
            f32x4 w[16];
#pragma unroll
            for (int k = 0; k < 16; ++k) w[k] = *(const f32x4*)(wp + (size_t)(k0 + k) * 6144);
#pragma unroll
            for (int k = 0; k < 16; ++k)
#pragma unroll
                for (int r = 0; r < 9; ++r) acc[r] += w[k] * sc[r * 1024 + kg * 64 + k0 + k];
        }
#pragma unroll
        for (int r = 0; r < 9; ++r) *(LAS f32x4*)(red + ((kg * 32 + cq) * 9 + r) * 4) = acc[r];
        __syncthreads();
        if (tid < 32 * 9) { const int q = tid / 9, r = tid % 9; f32x4 s = {0.f, 0.f, 0.f, 0.f};
#pragma unroll
            for (int g = 0; g < 16; ++g) s += *(const LAS f32x4*)(red + ((g * 32 + q) * 9 + r) * 4);
            const int nn = (u % 48) * 128 + 4 * q;
            *(f32x4*)(mod + ((size_t)l * 9 + r) * 6144 + nn) = s + *(const f32x4*)(bmod + (size_t)l * 6144 + nn); }
        __syncthreads();
    }
}
__device__ __forceinline__ void p0_tables(float* tab, const float* dlam, const float* decf, const float* decb, int tid) {
    for (int i = tid; i < 1024; i += 512) { const int pos = i >> 4, f = i & 15;
        const float inv = 1.0f / powf(10000.0f, (float)f / 16.0f), ang = (float)pos * inv;
        tab[TAB_ROPE + 2 * i] = cosf(ang); tab[TAB_ROPE + 2 * i + 1] = sinf(ang); }
    if (tid < 4) { const float* lp = dlam + tid * 256; float s01 = 0.f, s23 = 0.f;
        for (int k = 0; k < 64; ++k) { s01 += lp[k] * lp[64 + k]; s23 += lp[128 + k] * lp[192 + k]; }
        const float li = 0.8f - 0.6f * expf(-0.3f * (float)tid);
        tab[TAB_LAM + 2 * tid] = expf(s01) - expf(s23) + li; tab[TAB_LAM + 2 * tid + 1] = 1.0f - li; }
    if (tid >= 64 && tid < 96) { const int i = tid - 64, l = i >> 3, dir = (i >> 2) & 1, h = i & 3;
        const float x = (dir ? decb : decf)[l * 4 + h];
        tab[TAB_LG2 + i] = -log1pf(expf(-x)) * LOG2E; }
}

__device__ __forceinline__ void cvt_item(const float* W, int ldw, int k0, int sc, bf16_t* WTrow0, int ldt, LAS float* scr, int lane) {
    float v[32];
#pragma unroll
    for (int i = 0; i < 32; ++i) v[i] = __builtin_nontemporal_load(W + (size_t)(k0 + 2 * i + (lane >> 5)) * ldw + sc);
#pragma unroll
    for (int i = 0; i < 32; ++i) scr[(2 * i + (lane >> 5)) * 33 + (lane & 31)] = v[i];
    LDS_WAIT(); asm volatile("" ::: "memory");
    const int c = lane & 7;
#pragma unroll
    for (int j = 0; j < 4; ++j) { const int n = (lane >> 3) + 8 * j; const LAS float* s = scr + (8 * c) * 33 + n;
        u32x4 o; o.x = pk2(s[0 * 33], s[1 * 33]); o.y = pk2(s[2 * 33], s[3 * 33]); o.z = pk2(s[4 * 33], s[5 * 33]); o.w = pk2(s[6 * 33], s[7 * 33]);
        *(u32x4*)(WTrow0 + (size_t)n * ldt + 8 * c) = o; }
    LDS_WAIT(); asm volatile("" ::: "memory");
}
__device__ __forceinline__ void cvt_item8(const float* W, int ldw, int k0, int sc, unsigned char* WTrow0, int ldt, float scale, LAS float* scr, int lane) {
    float v[32];
#pragma unroll
    for (int i = 0; i < 32; ++i) v[i] = __builtin_nontemporal_load(W + (size_t)(k0 + 2 * i + (lane >> 5)) * ldw + sc);
#pragma unroll
    for (int i = 0; i < 32; ++i) scr[(2 * i + (lane >> 5)) * 33 + (lane & 31)] = v[i] * scale;
    LDS_WAIT(); asm volatile("" ::: "memory");
    const int c = lane & 7;
#pragma unroll
    for (int j = 0; j < 4; ++j) { const int n = (lane >> 3) + 8 * j; const LAS float* s = scr + (8 * c) * 33 + n;
        u32x2 o; o.x = pk4f8(s[0 * 33], s[1 * 33], s[2 * 33], s[3 * 33]); o.y = pk4f8(s[4 * 33], s[5 * 33], s[6 * 33], s[7 * 33]);
        *(u32x2*)(WTrow0 + (size_t)n * ldt + 8 * c) = o; }
    LDS_WAIT(); asm volatile("" ::: "memory");
}
__device__ __forceinline__ int win_src(int n) {
    const bool rp = (n < 640) || (n >= 768 && n < 1280) || (n >= 2304 && n < 3328);
    if (!rp) return n;
    const int p = n & 63, j = p >> 1, e = p & 1;
    return (n & ~63) + (j >> 4) * 32 + e * 16 + (j & 15);
}
constexpr int I_IN = 16 * 216, I_B = 3 * 8 * 32, I_O = 16 * 32, I_MIX = I_IN + I_B + I_O, I_F1 = 16 * 88, I_F2 = 44 * 32, I_FE = 2 * I_F1 + I_F2;
__device__ __forceinline__ void cvt_mix(const float* win, const float* wb, const float* wo, unsigned char* mixbase, int r, LAS float* scr, int lane) {
    bf16_t* WinT = (bf16_t*)mixbase; bf16_t* WbT = (bf16_t*)(mixbase + MIX_WB); bf16_t* WoT = (bf16_t*)(mixbase + MIX_WO);
    if (r < I_IN) { const int kb = r / 216, nb = r % 216; cvt_item(win, DIN, 64 * kb, win_src(32 * nb + (lane & 31)), WinT + (size_t)(32 * nb) * DM + 64 * kb, DM, scr, lane); return; } r -= I_IN;
    if (r < I_B) { const int i = r / 256, q = r % 256, kb = q / 32, nb = q % 32;
        cvt_item(wb + (size_t)i * 512 * DM, DM, 64 * kb, 32 * nb + (lane & 31), WbT + (size_t)(32 * nb) * OCW + i * 512 + 64 * kb, OCW, scr, lane); return; } r -= I_B;
    { const int kb = r / 32, nb = r % 32; cvt_item(wo, DM, 64 * kb, 32 * nb + (lane & 31), WoT + (size_t)(32 * nb) * DM + 64 * kb, DM, scr, lane); }
}
__device__ __forceinline__ void cvt_ffn(const float* f1, const float* f3, const float* f2, unsigned char* w13, unsigned char* w2, int r, int f8, LAS float* scr, int lane) {
    if (r < 2 * I_F1) { const int which = r / I_F1, q = r % I_F1, kb = q / 88, nb = q % 88, j0 = 32 * nb;
        const int drow = (j0 >> 7) * 256 + which * 128 + (j0 & 127);
        if (f8) cvt_item8(which ? f3 : f1, DFF, 64 * kb, j0 + (lane & 31), w13 + (size_t)drow * DM + 64 * kb, DM, F8_SW13, scr, lane);
        else cvt_item(which ? f3 : f1, DFF, 64 * kb, j0 + (lane & 31), (bf16_t*)w13 + (size_t)drow * DM + 64 * kb, DM, scr, lane);
        return; } r -= 2 * I_F1;
    { const int kb = r / 32, nb = r % 32;
        if (f8) cvt_item8(f2, DM, 64 * kb, 32 * nb + (lane & 31), w2 + (size_t)(32 * nb) * DFF + 64 * kb, DFF, F8_SW2, scr, lane);
        else cvt_item(f2, DM, 64 * kb, 32 * nb + (lane & 31), (bf16_t*)w2 + (size_t)(32 * nb) * DFF + 64 * kb, DFF, scr, lane); }
}
constexpr int N_RANGES = 7;
__device__ __forceinline__ int range_items(int k) { return (k == 0 || k == 4) ? I_FE : (k == 3 || k == 6) ? NEXP * I_FE : I_MIX; }
__device__ __forceinline__ void range_item(int k, int r, LAS unsigned char* lds, unsigned char* ws, LAS float* scr, int lane);

__device__ __forceinline__ void norm_rows(LAS unsigned char* lds, const float* xinL, const float* xinC, float* xoutL, float* xoutC, const float* gain, const float* mod, const float* modc, int shoff,
                                          bf16_t* hout, int f8out, int nrows, int combine, const Route* route, const bf16_t* fbuf, const float* wrouter, int do_route, Route* route_out, unsigned* gcnt,
                                          int blk, int G, int wave, int lane, int tid) {
    LAS float* wr = (LAS float*)lds;
    LAS int* lcnt = (LAS int*)(lds + 32768);
    LAS int* rec = (LAS int*)(lds + 32768 + 64);
    if (do_route) { for (int i = tid; i < 8192; i += 512) wr[i] = wrouter[i]; }
    const int per = (nrows + G - 1) / G, r0 = blk * per, r1 = (r0 + per < nrows) ? r0 + per : nrows;
    for (int cs = r0; cs < r1; cs += 256) {
        const int ce = cs + 256 < r1 ? cs + 256 : r1;
        if (do_route) { if (tid < 8) lcnt[tid] = 0; __syncthreads(); }
        f32x4 vn[4];
#define NR_LOAD(rr) do { const float* xi_ = (rr) < TL ? xinL + (size_t)(rr) * DM : xinC + (size_t)((rr) - TL) * DM; \
            _Pragma("unroll") for (int j = 0; j < 4; ++j) vn[j] = *(const f32x4*)(xi_ + 4 * lane + 256 * j); } while (0)
        if (cs + wave < ce) NR_LOAD(cs + wave);
        for (int row = cs + wave; row < ce; row += 8) {
            const bool lat = row < TL; const int mb = lat ? (row >> 12) : 8;
            f32x4 v[4];
#pragma unroll
            for (int j = 0; j < 4; ++j) v[j] = vn[j];
            if (row + 8 < ce) NR_LOAD(row + 8);
            if (combine) {
                const Route rt = route[row]; const float* g2 = modc + mb * 6144 + 5120;
                float* xo = lat ? xoutL + (size_t)row * DM : xoutC + (size_t)(row - TL) * DM;
#pragma unroll
                for (int j = 0; j < 4; ++j) { const int col = 4 * lane + 256 * j;
                    const u32x2 fa = *(const u32x2*)(fbuf + (size_t)rt.sa * DM + col), fb = *(const u32x2*)(fbuf + (size_t)rt.sb * DM + col);
                    const f32x4 gg = *(const f32x4*)(g2 + col);
                    v[j][0] += gg[0] * (rt.ga * bf_lo(fa.x) + rt.gb * bf_lo(fb.x)); v[j][1] += gg[1] * (rt.ga * bf_hi(fa.x) + rt.gb * bf_hi(fb.x));
                    v[j][2] += gg[2] * (rt.ga * bf_lo(fa.y) + rt.gb * bf_lo(fb.y)); v[j][3] += gg[3] * (rt.ga * bf_hi(fa.y) + rt.gb * bf_hi(fb.y));
                    *(f32x4*)(xo + col) = v[j]; }
            }
            float s = 0.f;
#pragma unroll
            for (int j = 0; j < 4; ++j) s += (v[j][0] * v[j][0] + v[j][1] * v[j][1]) + (v[j][2] * v[j][2] + v[j][3] * v[j][3]);
            const float rstd = 1.0f / sqrtf(wave_sum(s) * (1.0f / DM) + NORM_EPS);
            const float* sh = mod + mb * 6144 + shoff; const float* scp = sh + 1024;
            float lg[8];
#pragma unroll
            for (int e = 0; e < 8; ++e) lg[e] = 0.f;
#pragma unroll
            for (int j = 0; j < 4; ++j) { const int col = 4 * lane + 256 * j;
                const f32x4 gn = *(const f32x4*)(gain + col), s1 = *(const f32x4*)(scp + col), s0 = *(const f32x4*)(sh + col);
                f32x4 hv;
#pragma unroll
                for (int k = 0; k < 4; ++k) hv[k] = v[j][k] * rstd * gn[k] * (1.0f + s1[k]) + s0[k];
                if (f8out) *(unsigned*)((unsigned char*)hout + (size_t)row * DM + col) = pk4f8(hv[0] * F8_SH, hv[1] * F8_SH, hv[2] * F8_SH, hv[3] * F8_SH);
                else { u32x2 w; w.x = pk2(hv[0], hv[1]); w.y = pk2(hv[2], hv[3]); *(u32x2*)(hout + (size_t)row * DM + col) = w; }
                if (do_route) {
#pragma unroll
                    for (int k = 0; k < 4; ++k) { const f32x4 wa = *(const LAS f32x4*)(wr + (col + k) * 8), wb = *(const LAS f32x4*)(wr + (col + k) * 8 + 4);
                        lg[0] += hv[k] * wa[0]; lg[1] += hv[k] * wa[1]; lg[2] += hv[k] * wa[2]; lg[3] += hv[k] * wa[3];
                        lg[4] += hv[k] * wb[0]; lg[5] += hv[k] * wb[1]; lg[6] += hv[k] * wb[2]; lg[7] += hv[k] * wb[3]; }
                }
            }
            if (do_route) {
#pragma unroll
                for (int e = 0; e < 8; ++e) lg[e] = wave_sum(lg[e]);
                if (lane == 0) {
                    int e1 = 0; float v1 = lg[0];
#pragma unroll
                    for (int e = 1; e < 8; ++e) if (lg[e] > v1) { v1 = lg[e]; e1 = e; }
                    int e2 = -1; float v2 = -3.0e38f;
#pragma unroll
                    for (int e = 0; e < 8; ++e) if (e != e1 && lg[e] > v2) { v2 = lg[e]; e2 = e; }
                    const float gb_ = 1.0f / (1.0f + __expf(v1 - v2)), ga_ = 1.0f - gb_;
                    const int i = row - cs;
                    rec[i * 6 + 0] = e1; rec[i * 6 + 1] = __hip_atomic_fetch_add(&lcnt[e1], 1, __ATOMIC_RELAXED, __HIP_MEMORY_SCOPE_WORKGROUP); rec[i * 6 + 2] = e2; rec[i * 6 + 3] = __hip_atomic_fetch_add(&lcnt[e2], 1, __ATOMIC_RELAXED, __HIP_MEMORY_SCOPE_WORKGROUP);
                    rec[i * 6 + 4] = __float_as_int(ga_); rec[i * 6 + 5] = __float_as_int(gb_);
                }
            }
        }
        if (do_route) {
            __syncthreads();
            if (tid < 8) lcnt[8 + tid] = (int)__hip_atomic_fetch_add(gcnt + 64 * tid, (unsigned)lcnt[tid], __ATOMIC_RELAXED, __HIP_MEMORY_SCOPE_AGENT);
            __syncthreads();
            for (int i = tid; i < ce - cs; i += 512) { Route rt; rt.sa = 0; rt.sb = 0;
                rt.ea = rec[i * 6 + 0]; rt.pa = lcnt[8 + rt.ea] + rec[i * 6 + 1]; rt.eb = rec[i * 6 + 2]; rt.pb = lcnt[8 + rt.eb] + rec[i * 6 + 3];
                rt.ga = __int_as_float(rec[i * 6 + 4]); rt.gb = __int_as_float(rec[i * 6 + 5]); route_out[cs + i] = rt; }
            __syncthreads();
        }
    }
}
__device__ __forceinline__ void moe_gather(const unsigned char* h2, unsigned char* hs, Route* route, unsigned* gcnt, int nrows, int gw, int ngw, int lane) {
    int off[8]; { int a = 0;
#pragma unroll
        for (int e = 0; e < 8; ++e) { off[e] = a; const int c = (int)__hip_atomic_load(gcnt + 64 * e, __ATOMIC_RELAXED, __HIP_MEMORY_SCOPE_AGENT); a += (c + 255) & ~255; } }
    u32x4 an; Route rn;
    if (gw < nrows) { rn = route[gw]; an = *(const u32x4*)(h2 + (size_t)gw * DM + 16 * lane); }
    for (int row = gw; row < nrows; row += ngw) {
        const Route rt = rn; const u32x4 a = an;
        if (row + ngw < nrows) { rn = route[row + ngw]; an = *(const u32x4*)(h2 + (size_t)(row + ngw) * DM + 16 * lane); }
        int oa = 0, ob = 0;
#pragma unroll
        for (int e = 0; e < 8; ++e) { oa = (rt.ea == e) ? off[e] : oa; ob = (rt.eb == e) ? off[e] : ob; }
        const int sa = oa + rt.pa, sb = ob + rt.pb;
        *(u32x4*)(hs + (size_t)sa * DM + 16 * lane) = a;
        *(u32x4*)(hs + (size_t)sb * DM + 16 * lane) = a;
        if (lane == 0) { route[row].sa = sa; route[row].sb = sb; }
    }
}
__device__ __forceinline__ void final_norm(float* x, const float* gain, const float* mod, const Route* route, const bf16_t* fbuf, int gw, int ngw, int lane) {
    for (int row = gw; row < TL; row += ngw) {
        const int mb = row >> 12; float* xr = x + (size_t)row * DM;
        const Route rt = route[row]; const float* g2 = mod + mb * 6144 + 5120;
        f32x4 v[4]; float s = 0.f;
#pragma unroll
        for (int j = 0; j < 4; ++j) { const int col = 4 * lane + 256 * j; v[j] = *(const f32x4*)(xr + col);
            const u32x2 fa = *(const u32x2*)(fbuf + (size_t)rt.sa * DM + col), fb = *(const u32x2*)(fbuf + (size_t)rt.sb * DM + col);
            const f32x4 gg = *(const f32x4*)(g2 + col);
            v[j][0] += gg[0] * (rt.ga * bf_lo(fa.x) + rt.gb * bf_lo(fb.x)); v[j][1] += gg[1] * (rt.ga * bf_hi(fa.x) + rt.gb * bf_hi(fb.x));
            v[j][2] += gg[2] * (rt.ga * bf_lo(fa.y) + rt.gb * bf_lo(fb.y)); v[j][3] += gg[3] * (rt.ga * bf_hi(fa.y) + rt.gb * bf_hi(fb.y));
            s += (v[j][0] * v[j][0] + v[j][1] * v[j][1]) + (v[j][2] * v[j][2] + v[j][3] * v[j][3]); }
        const float rstd = 1.0f / sqrtf(wave_sum(s) * (1.0f / DM) + NORM_EPS);
#pragma unroll
        for (int j = 0; j < 4; ++j) { const int col = 4 * lane + 256 * j; const f32x4 gn = *(const f32x4*)(gain + col); *(f32x4*)(xr + col) = v[j] * rstd * gn; }
    }
}
constexpr int NWAVES = 8;
constexpr int LDS_MISC = pg8::STAGE_BYTES + 2048, LDS_PTAB = LDS_MISC + 64;
constexpr int LDS_BYTES = pg8::STAGE_BYTES + 2048 + 1024;
static_assert(at::AT_A_LDS <= pg8::STAGE_BYTES && at::AT_C_LDS <= pg8::STAGE_BYTES + 2048 && at::R1_LDS <= pg8::STAGE_BYTES && at::R3_LDS <= pg8::STAGE_BYTES, "LDS");
constexpr int NPH = 11;
constexpr int N_PHASES = 1 + DEPTH * NPH + 1;

struct Args { const float* in[24]; float* out; unsigned char* ws; int ph_lo, ph_hi; };
static_assert(sizeof(Args) == 24 * 8 + 8 + 8 + 8, "Args has no padding");

__device__ __forceinline__ void* ldptr(LAS unsigned char* lds, int i) {
    const u32x2 v = *(const LAS u32x2*)(lds + LDS_PTAB + 8 * i);
    const unsigned lo = __builtin_amdgcn_readfirstlane(v.x), hi = __builtin_amdgcn_readfirstlane(v.y);
    GAS void* g = (GAS void*)(((unsigned long long)hi << 32) | lo);
    return (void*)g;
}
#define PIN(i) ((const float*)ldptr(lds, (i)))
#define PWS() ((unsigned char*)ldptr(lds, 25))
#define POUT() ((float*)ldptr(lds, 24))
__device__ __forceinline__ void range_item(int k, int r, LAS unsigned char* lds, unsigned char* ws, LAS float* scr, int lane) {
    if (k == 1 || k == 2 || k == 5) { const int l = (k == 5) ? 3 : k;
        cvt_mix(PIN(9) + (size_t)l * DM * DIN, PIN(15) + (size_t)l * 3 * 512 * DM, PIN(16) + (size_t)l * DM * DM, ws + WS_MIX + l * MIX_STRIDE, r, scr, lane); }
    else if (k == 0 || k == 4) { const int j = (k == 0) ? 0 : 1;
        cvt_ffn(PIN(17) + (size_t)j * DM * DFF, PIN(18) + (size_t)j * DM * DFF, PIN(19) + (size_t)j * DFF * DM, ws + WS_FD + j * FD_STRIDE, ws + WS_FD + j * FD_STRIDE + FD_W2, r, DENSE_F8, scr, lane); }
    else { const int j = (k == 3) ? 0 : 1, e = r / I_FE, rr = r % I_FE; const size_t eo = ((size_t)j * NEXP + e) * DM * DFF;
        cvt_ffn(PIN(21) + eo, PIN(22) + eo, PIN(23) + eo, ws + WS_W13 + (size_t)e * 2 * DFF * DM, ws + WS_W2 + (size_t)e * DM * DFF, rr, 1, scr, lane); }
}
__device__ __forceinline__ int range_base(int k) { return k == 0 ? 0 : k == 1 ? I_FE : k == 2 ? I_FE + I_MIX : k == 3 ? I_FE + 2 * I_MIX : k == 4 ? I_FE + 2 * I_MIX + NEXP * I_FE : k == 5 ? 2 * I_FE + 2 * I_MIX + NEXP * I_FE
                                                          : k == 6 ? 2 * I_FE + 3 * I_MIX + NEXP * I_FE : 2 * I_FE + 3 * I_MIX + 2 * NEXP * I_FE; }
__device__ __forceinline__ void bg_static(LAS unsigned char* lds, unsigned char* ws, int g0, int g1, int worker, int nworkers, int wave, int lane) {
    LAS float* scr = (LAS float*)lds + wave * (64 * 33);
    for (int g = g0 + worker; g < g1; g += nworkers) {
        int k = 0;
#pragma unroll
        for (int j = 1; j < N_RANGES; ++j) k += (g >= range_base(j)) ? 1 : 0;
        range_item(k, g - range_base(k), lds, ws, scr, lane);
    }
}
constexpr int WGM_MOE = 4;
constexpr int Q_B = 4, Q_F = 7, Q_G = 5, Q_I = 4, Q_J = 14;
#define TAIL_BOOK(nwg_in, quota, drain) const int tb_nwg = (nwg_in), tb_maxu = (tb_nwg + G - 1) / G, tb_nh = (tb_nwg % G == 0) ? G : tb_nwg - (tb_maxu - 1) * G, tb_nt = G - tb_nh; \
        const int tb_lim = range_base(kmax + 1), tb_g0 = gc; int tb_take = tb_nt * NWAVES * (quota); if (tb_take > tb_lim - gc) tb_take = tb_lim - gc; if (tb_take < 0) tb_take = 0; \
        const int tb_g1 = tb_g0 + tb_take; const int tb_e = (drain) >= 0 ? range_base((drain) + 1) : 0; const int tb_g2 = tb_e > tb_g1 ? tb_e : tb_g1; gc = tb_g2
#define TAIL_RUN() do { if (blk >= tb_nh && tb_take > 0) bg_static(lds, ws, tb_g0, tb_g1, (blk - tb_nh) * NWAVES + wave, tb_nt * NWAVES, wave, LANE()); \
        if (tb_g2 > tb_g1) bg_static(lds, ws, tb_g1, tb_g2, GW(), NGW(), wave, LANE()); } while (0)

__global__ void __launch_bounds__(NWAVES * 64, 2) mega(Args a) {
    extern __shared__ __attribute__((aligned(16))) unsigned char lds_raw[];
    LAS unsigned char* lds = (LAS unsigned char*)lds_raw;
    LAS unsigned char* const lds_k = lds;
#define LDSL() ({ LAS unsigned char* p_ = lds_k; asm volatile("" : "+s"(p_)); p_; })
    const int wave = __builtin_amdgcn_readfirstlane((int)threadIdx.x >> 6);
    const int G = gridDim.x, blk = blockIdx.x;
#define LANE0() ({ int t_; asm volatile("v_mbcnt_lo_u32_b32 %0, -1, 0\n\tv_mbcnt_hi_u32_b32 %0, -1, %0" : "=v"(t_)); t_; })
#define LANE() LANE0()
#define TID0() ((wave << 6) | LANE0())
#define TID() TID0()
    if (threadIdx.x == 0) {
        LAS unsigned long long* pt = (LAS unsigned long long*)(lds + LDS_PTAB);
#pragma unroll
        for (int i = 0; i < 24; ++i) pt[i] = (unsigned long long)a.in[i];
        pt[24] = (unsigned long long)a.out; pt[25] = (unsigned long long)a.ws;
        ((LAS unsigned*)(lds + LDS_MISC))[0] = 0u; ((LAS unsigned*)(lds + LDS_MISC))[1] = 0u; ((LAS unsigned*)(lds + LDS_MISC))[2] = 0u; ((LAS unsigned*)(lds + LDS_MISC))[3] = 0u;
    }
    __syncthreads();
#if MK_SINGLE
    (void)xcd_barrier_post((unsigned*)PWS() + CW_BAR, (volatile LAS unsigned*)(lds + LDS_MISC), TID());
#define GRID_BAR() do { XcdBarrier b_; b_.bar = (unsigned*)PWS() + CW_BAR; b_.x = 0; b_.st = (volatile LAS unsigned*)(lds_k + LDS_MISC); xcd_barrier(b_, TID()); } while (0)
#else
#define GRID_BAR() do { } while (0)
#endif
#if !MK_SINGLE
    const int lo = a.ph_lo, hi = a.ph_hi;
#endif
#ifndef PROBE_MASK
#define PROBE_MASK 0xffff
#endif
#define EN(k) (((PROBE_MASK) >> ((k) >= 100 ? (k) - 89 : (k))) & 1)
#if MK_SINGLE
#define IN(k) true
#else
#define IN(k) (lo <= (k) && (k) < hi)
#endif
#define SEAM(k) do { if (IN(k) && IN((k) + 1)) GRID_BAR(); } while (0)
#define LAUNDER_S(x) ({ int x_ = (x); asm volatile("" : "+s"(x_)); x_; })
#ifndef PROBE_DUP
#define PROBE_DUP 0
#endif
#define DUP(k) (1 + (((PROBE_DUP) >> (k)) & 1))
#define GW() (blk * NWAVES + wave)
#define NGW() (G * NWAVES)

    if (IN(0) && EN(100)) { LAS unsigned char* lds = LDSL();
        float* tab = (float*)(PWS() + WS_TAB);
        p0_mod(lds, PIN(1), PIN(3), PIN(4), PIN(5), tab + TAB_MOD, blk, G, TID());
        if (blk == G - 1) p0_tables(tab, PIN(13), PIN(11), PIN(12), TID());
        __syncthreads();
        {
            unsigned char* ws = PWS(); LAS float* scr = (LAS float*)lds + wave * (64 * 33); const int ln = LANE();
            for (int it = (G - 1 - blk) * NWAVES + wave; it < I_MIX; it += NGW()) cvt_mix(PIN(9), PIN(15), PIN(16), ws + WS_MIX, it, scr, ln);
        }
    }
    SEAM(0);

    int gc = 0;
    for (int l = 0; l < DEPTH; ++l) {
        const int pb = 1 + l * NPH;
        const bool moe = (l & 1) != 0, last = (l == DEPTH - 1), first = (l == 0);
        const int nrows = last ? TL : TT;
        const int kmax = l <= 1 ? 5 : 6;
        if (IN(pb + 0) && EN(0)) { LAS unsigned char* lds = LDSL();
            unsigned char* ws = PWS();
            __syncthreads();
            const bool comb = (l == 2);
            const float* modl = (const float*)(ws + WS_TAB) + TAB_MOD + (size_t)l * 9 * 6144;
            float* xL = POUT(); float* xc = (float*)(ws + WS_XC);
            for (int dup = 0; dup < (comb ? 1 : DUP(8)); ++dup) norm_rows(lds, first ? PIN(0) : xL, first ? PIN(2) : xc, xL, xc, PIN(6) + l * DM, modl, modl - 9 * 6144, 0, (bf16_t*)(ws + WS_H), 0, TT, comb ? 1 : 0,
                      (const Route*)(ws + WS_ROUTE), (const bf16_t*)(ws + WS_OCAT), nullptr, 0, nullptr, nullptr, blk, G, wave, LANE(), TID());
        }
        SEAM(pb + 0);
        { TAIL_BOOK(last ? (TL / 256) * (DIN / 256) + 64 : (TT / 256) * (DIN / 256), Q_B, -1);
        if (IN(pb + 1) && EN(1)) { LAS unsigned char* lds = LDSL();
            unsigned char* ws = PWS();
            pg8::Gemm g{(const bf16_t*)(ws + WS_H), (const bf16_t*)(ws + WS_MIX + l * MIX_STRIDE), DM}; pg8::GSched S; S.init(last ? TL / 256 : TT / 256, DIN / 256, LAUNDER_S(G), LAUNDER_S(blk));
            if (last) { S.nx = 64; S.nwg += 64; S.xtab = 0xEDCB6542ull; }
            pg8::EpiProj E{(bf16_t*)(ws + WS_PROJ), (const float*)(ws + WS_TAB) + TAB_ROPE, (u32x2*)(ws + WS_GATE)};
            pg8::gemm_phase<pg8::EpiProj, pg8::GSched, true, true>(lds, g, S, E, TID());
            TAIL_RUN();
        } }
        SEAM(pb + 1);
        if (IN(pb + 2) && EN(2)) { LAS unsigned char* lds = LDSL();
            unsigned char* ws = PWS(); const float* lg2 = (const float*)(ws + WS_TAB) + TAB_LG2 + l * 8;
            for (int dup = 0; dup < DUP(10); ++dup) at::ret_kv_phase(lds, (const bf16_t*)(ws + WS_PROJ), (bf16_t*)(ws + WS_Y), lg2, blk, G, TID());
        }
        SEAM(pb + 2);
        if (IN(pb + 3) && EN(3)) for (int dup = 0; dup < DUP(11); ++dup) { unsigned char* ws = PWS(); at::ret_scan((const bf16_t*)(ws + WS_Y), (bf16_t*)(ws + WS_H), (const float*)(ws + WS_TAB) + TAB_LG2 + l * 8, blk * 512 + TID(), G * 512); }
        SEAM(pb + 3);
        if (IN(pb + 4) && EN(4)) { LAS unsigned char* lds = LDSL();
            {
                unsigned char* ws = PWS(); const float* tab = (const float*)(ws + WS_TAB);
                const float lam = tab[TAB_LAM + 2 * l], oml = tab[TAB_LAM + 2 * l + 1]; const float* dn = PIN(14) + l * 128;
                for (int dup = 0; dup < DUP(0); ++dup) for (int r = blk; r < 1024; r += G) { const int rnd = r >> 8, bi = r & 255, bh = rnd * 8 + (bi & 7), qb = bi >> 3;
                    at::attnC_unit(lds, (const bf16_t*)(ws + WS_PROJ), (bf16_t*)(ws + WS_OCAT), dn, lam, oml, bh >> 2, bh & 3, qb, 1, TID()); }
                if (!last) for (int r = blk; r < 64; r += G) { const int bh = r >> 1, qb = r & 1;
                    at::attnC_unit(lds, (const bf16_t*)(ws + WS_PROJ), (bf16_t*)(ws + WS_OCAT), dn, lam, oml, bh >> 2, bh & 3, qb, 0, TID()); }
            }
            {
                unsigned char* ws = PWS(); const float* lg2 = (const float*)(ws + WS_TAB) + TAB_LG2 + l * 8;
                const int nR = last ? NB * 4 * 32 : NB * 4 * NCHK;
                for (int dup = 0; dup < DUP(3); ++dup) for (int r = blk; r < nR; r = (r + G < (nR / G) * G) ? r + G : (r < (nR / G) * G ? (nR / G) * G + ((blk + G - 64) % G) : nR)) { int bh, ci; if (last) { bh = r >> 5; ci = 2 + (r & 31); } else { bh = r / NCHK; ci = r % NCHK; }
                    at::ret_out_unit(lds, (const bf16_t*)(ws + WS_PROJ), (const bf16_t*)(ws + WS_H), (bf16_t*)(ws + WS_OCAT), lg2[bh & 3], lg2[4 + (bh & 3)], bh >> 2, bh & 3, ci, TID()); }
            }
            {
                unsigned char* ws = PWS(); const float* sink = PIN(10) + l * 8;
                for (int dup = 0; dup < DUP(13); ++dup) for (int r = blk; r < 1024; r += G) { const int bg = r >> 6, qb = r & 63; at::attnA_unit(lds, (const bf16_t*)(ws + WS_PROJ), (bf16_t*)(ws + WS_OCAT), sink, bg >> 1, bg & 1, qb, 1, TID()); }
                if (!last) for (int r = (blk + G - 128) % G; r < 64; r += G) { const int bg = r >> 2, qb = r & 3; at::attnA_unit(lds, (const bf16_t*)(ws + WS_PROJ), (bf16_t*)(ws + WS_OCAT), sink, bg >> 1, bg & 1, qb, 0, TID()); }
            }
        }
        SEAM(pb + 4);
#ifdef PROBE_XBAR
        for (int xb_ = 0; xb_ < PROBE_XBAR; ++xb_) GRID_BAR();
#endif
        { TAIL_BOOK((nrows / 256) * (DM / 256), Q_F, -1);
        if (IN(pb + 5) && EN(5)) { LAS unsigned char* lds = LDSL();
            unsigned char* ws = PWS();
            pg8::Gemm g{(const bf16_t*)(ws + WS_OCAT), (const bf16_t*)(ws + WS_MIX + l * MIX_STRIDE + MIX_WB), OCW}; pg8::GSched S; S.init(nrows / 256, DM / 256, LAUNDER_S(G), LAUNDER_S(blk));
            pg8::EpiMerge E{(bf16_t*)(ws + WS_Y), (const u32x2*)(ws + WS_GATE)};
            pg8::gemm_phase<pg8::EpiMerge, pg8::GSched, true, true>(lds, g, S, E, TID());
            TAIL_RUN();
        } }
        SEAM(pb + 5);
        { TAIL_BOOK((nrows / 256) * (DM / 256), Q_G, (l == 0 ? 0 : l == 1 ? 3 : l == 2 ? 4 : 6));
        if (IN(pb + 6) && EN(6)) { LAS unsigned char* lds = LDSL();
            unsigned char* ws = PWS(); float* xL = POUT(); float* xc = (float*)(ws + WS_XC);
            pg8::Gemm g{(const bf16_t*)(ws + WS_Y), (const bf16_t*)(ws + WS_MIX + l * MIX_STRIDE + MIX_WO), DM}; pg8::GSched S; S.init(nrows / 256, DM / 256, LAUNDER_S(G), LAUNDER_S(blk));
            pg8::EpiRes E{first ? PIN(0) : xL, first ? PIN(2) : xc, xL, xc, (const float*)(ws + WS_TAB) + TAB_MOD + (size_t)l * 9 * 6144, 2048, 1.0f};
            pg8::gemm_phase<pg8::EpiRes, pg8::GSched, true, true>(lds, g, S, E, TID());
            TAIL_RUN();
        } }
        SEAM(pb + 6);
        if (IN(pb + 7) && EN(7)) { LAS unsigned char* lds = LDSL();
            unsigned char* ws = PWS(); float* xL = POUT(); float* xc = (float*)(ws + WS_XC);
            const float* modl = (const float*)(ws + WS_TAB) + TAB_MOD + (size_t)l * 9 * 6144;
            for (int dup = 0; dup < (moe ? 1 : DUP(9)); ++dup) norm_rows(lds, xL, xc, xL, xc, PIN(7) + l * DM, modl, modl, 3072, (bf16_t*)(ws + WS_H), (moe || DENSE_F8) ? 1 : 0, nrows, 0, (const Route*)(ws + WS_ROUTE), (const bf16_t*)(ws + WS_OCAT),
                      moe ? PIN(20) + (size_t)(l >> 1) * DM * NEXP : nullptr, moe ? 1 : 0, (Route*)(ws + WS_ROUTE), (unsigned*)ws + CW_MOE + (l >> 1) * 1024, blk, G, wave, LANE(), TID());
        }
        SEAM(pb + 7);
        if (!moe) {
            { TAIL_BOOK((nrows / 256) * (2 * DFF / 256), Q_I, -1);
            if (IN(pb + 9) && EN(9)) { LAS unsigned char* lds = LDSL();
                unsigned char* ws = PWS();
                pg8::Gemm g{(const bf16_t*)(ws + WS_H), (const bf16_t*)(ws + WS_FD + (l >> 1) * FD_STRIDE), DENSE_F8 ? DM / 2 : DM}; pg8::GSched S; S.init(nrows / 256, 2 * DFF / 256, LAUNDER_S(G), LAUNDER_S(blk));
                if constexpr (DENSE_F8) { pg8::EpiSwiglu E{ws + WS_PROJ}; pg8::gemm_phase<pg8::EpiSwiglu, pg8::GSched, true, true, true>(lds, g, S, E, TID()); }
                else { pg8::EpiSwigluB E{(bf16_t*)(ws + WS_PROJ)}; pg8::gemm_phase<pg8::EpiSwigluB, pg8::GSched, true, true, false>(lds, g, S, E, TID()); }
                TAIL_RUN();
            } }
            SEAM(pb + 9);
            { TAIL_BOOK((nrows / 256) * (DM / 256), Q_J, (l == 0 ? 1 : 5));
            if (IN(pb + 10) && EN(10)) { LAS unsigned char* lds = LDSL();
                unsigned char* ws = PWS(); float* xL = POUT(); float* xc = (float*)(ws + WS_XC);
                pg8::Gemm g{(const bf16_t*)(ws + WS_PROJ), (const bf16_t*)(ws + WS_FD + (l >> 1) * FD_STRIDE + FD_W2), DENSE_F8 ? DFF / 2 : DFF}; pg8::GSched S; S.init(nrows / 256, DM / 256, LAUNDER_S(G), LAUNDER_S(blk));
                pg8::EpiRes E{xL, xc, xL, xc, (const float*)(ws + WS_TAB) + TAB_MOD + (size_t)l * 9 * 6144, 5120, DENSE_F8 ? F8_INV2 : 1.0f};
                pg8::gemm_phase<pg8::EpiRes, pg8::GSched, true, true, DENSE_F8 != 0>(lds, g, S, E, TID());
                TAIL_RUN();
            } }
            SEAM(pb + 10);
        } else {
            if (IN(pb + 8) && EN(8)) for (int dup = 0; dup < DUP(12); ++dup) { unsigned char* ws = PWS(); moe_gather(ws + WS_H, ws + WS_OCAT, (Route*)(ws + WS_ROUTE), (unsigned*)ws + CW_MOE + (l >> 1) * 1024, nrows, GW(), NGW(), LANE()); }
            SEAM(pb + 8);
            if (IN(pb + 9) && EN(9)) { LAS unsigned char* lds = LDSL();
                unsigned char* ws = PWS(); unsigned* gcnt = (unsigned*)ws + CW_MOE + (l >> 1) * 1024;
                pg8::GSched S; LAS int* tsl = (LAS int*)(lds + LDS_MISC + 512);
                if (TID() == 0) { int a0 = 0;
                    for (int e = 0; e < 8; ++e) { tsl[e] = a0; const int c = (int)__hip_atomic_load(gcnt + 64 * e, __ATOMIC_RELAXED, __HIP_MEMORY_SCOPE_AGENT); a0 += (c + 255) >> 8; }
                    tsl[8] = a0; }
                __syncthreads();
                S.ts = tsl; S.nM = __builtin_amdgcn_readfirstlane(tsl[8]); S.nN = 2 * DFF / 256; S.nwg = S.nM * S.nN; S.G = LAUNDER_S(G); S.c = LAUNDER_S(blk); S.wgm = WGM_MOE; S.nx = 0; S.xtab = 0; S.grouped = 1; S.bstride = (size_t)DFF * DM;
                pg8::Gemm g{(const bf16_t*)(ws + WS_OCAT), (const bf16_t*)(ws + WS_W13), DM / 2}; pg8::EpiSwiglu E{ws + WS_PROJ};
                pg8::gemm_phase<pg8::EpiSwiglu, pg8::GSched, true, true, true>(lds, g, S, E, TID());
            }
            SEAM(pb + 9);
            if (IN(pb + 10) && EN(10)) { LAS unsigned char* lds = LDSL();
                unsigned char* ws = PWS(); unsigned* gcnt = (unsigned*)ws + CW_MOE + (l >> 1) * 1024;
                pg8::GSched S; LAS int* tsl = (LAS int*)(lds + LDS_MISC + 512);
                if (TID() == 0) { int a0 = 0;
                    for (int e = 0; e < 8; ++e) { tsl[e] = a0; const int c = (int)__hip_atomic_load(gcnt + 64 * e, __ATOMIC_RELAXED, __HIP_MEMORY_SCOPE_AGENT); a0 += (c + 255) >> 8; }
                    tsl[8] = a0; }
                __syncthreads();
                S.ts = tsl; S.nM = __builtin_amdgcn_readfirstlane(tsl[8]); S.nN = DM / 256; S.nwg = S.nM * S.nN; S.G = LAUNDER_S(G); S.c = LAUNDER_S(blk); S.wgm = WGM_MOE; S.nx = 0; S.xtab = 0; S.grouped = 1; S.bstride = (size_t)DM * DFF / 2;
                pg8::Gemm g{(const bf16_t*)(ws + WS_PROJ), (const bf16_t*)(ws + WS_W2), DFF / 2}; pg8::EpiBf16 E{(bf16_t*)(ws + WS_OCAT), DM, F8_INV2};
                pg8::gemm_phase<pg8::EpiBf16, pg8::GSched, true, true, true>(lds, g, S, E, TID());
            }
            SEAM(pb + 10);
        }
    }
    if (IN(1 + DEPTH * NPH) && EN(101)) { LAS unsigned char* lds = LDSL(); unsigned char* ws = PWS();
        final_norm(POUT(), PIN(8), (const float*)(ws + WS_TAB) + TAB_MOD + (size_t)3 * 9 * 6144, (const Route*)(ws + WS_ROUTE), (const bf16_t*)(ws + WS_OCAT), GW(), NGW(), LANE()); }
#undef IN
#undef SEAM
}

extern "C" void kernel_launch(void* const* d_in, const int* in_sizes, int n_in, void* d_out, int out_size, void* d_ws, size_t ws_size, hipStream_t stream) {
    static int grid = 0;
    if (grid == 0) {
        if (n_in != 24 || out_size != TL * DM || ws_size < WS_END) { fprintf(stderr, "kernel_launch: unexpected shapes (n_in %d, out %d, ws %zu)\n", n_in, out_size, ws_size); grid = -1; return; }
        int dev = 0, cus = 0, per_cu = 0;
        if (hipGetDevice(&dev) != hipSuccess || hipDeviceGetAttribute(&cus, hipDeviceAttributeMultiprocessorCount, dev) != hipSuccess) { grid = -1; return; }
        if (hipFuncSetAttribute((const void*)mega, hipFuncAttributeMaxDynamicSharedMemorySize, LDS_BYTES) != hipSuccess) { fprintf(stderr, "kernel_launch: hipFuncSetAttribute failed\n"); grid = -1; return; }
        if (hipOccupancyMaxActiveBlocksPerMultiprocessor(&per_cu, (const void*)mega, NWAVES * 64, LDS_BYTES) != hipSuccess || per_cu < 1) { fprintf(stderr, "kernel_launch: occupancy query reports %d\n", per_cu); }
        (void)hipGetLastError();
        grid = cus;
    }
    if (grid < 0) return;
    if (hipMemsetAsync((char*)d_ws + WS_CTL, 0, CTL_ZERO_BYTES, stream) != hipSuccess) return;
    Args a{};
    for (int i = 0; i < 24; ++i) a.in[i] = (const float*)d_in[i];
    a.out = (float*)d_out; a.ws = (unsigned char*)d_ws;
#if MK_SINGLE
    a.ph_lo = 0; a.ph_hi = N_PHASES;
    hipLaunchKernelGGL(mega, dim3(grid), dim3(NWAVES * 64), LDS_BYTES, stream, a);
#else
    for (int p = 0; p < N_PHASES; ++p) {
        const int k = (p - 1) % NPH, l = (p - 1) / NPH;
        if (p >= 1 && p < 1 + DEPTH * NPH && k == 8 && !(l & 1)) continue;
        a.ph_lo = p; a.ph_hi = p + 1;
        hipLaunchKernelGGL(mega, dim3(grid), dim3(NWAVES * 64), LDS_BYTES, stream, a);
    }
#endif
}
```

```cpp
#include <hip/hip_runtime.h>
#include <cstdio>
#include <cstdint>

#ifndef MK_SINGLE
#define MK_SINGLE 1
#endif

#define LAS __attribute__((address_space(3)))
#define GAS __attribute__((address_space(1)))

typedef unsigned short bf16_t;
typedef short bf16x8 __attribute__((ext_vector_type(8)));
typedef short s16x4 __attribute__((ext_vector_type(4)));
typedef float f32x2 __attribute__((ext_vector_type(2)));
typedef float f32x4 __attribute__((ext_vector_type(4)));
typedef float f32x16 __attribute__((ext_vector_type(16)));
typedef unsigned u32x2 __attribute__((ext_vector_type(2)));
typedef unsigned u32x4 __attribute__((ext_vector_type(4)));
typedef int i32x4 __attribute__((ext_vector_type(4)));
typedef int i32x8 __attribute__((ext_vector_type(8)));
typedef __bf16 bf16x2_t __attribute__((ext_vector_type(2)));

constexpr int DM = 1024, NB = 8, SEQ = 4096, CTXL = 256, DEPTH = 4;
constexpr int TL = NB * SEQ;
constexpr int TC = NB * CTXL;
constexpr int TT = TL + TC;
constexpr int DIN = 6912, DFF = 2816, NEXP = 8, OCW = 1536;
constexpr int DINP = 3840;
constexpr int NMT = 136;
constexpr int C_QA = 0, C_KA = 512, C_VA = 640, C_QB = 768, C_KB = 1024, C_VB = 1280, C_GB = 1792, C_QD = 2304, C_KD = 2816, C_VD = 3328, C_GL = 3840;
constexpr float NORM_EPS = 1e-6f;
constexpr float SM_C2 = 0.125f * 1.4426950408889634f;
constexpr float LOG2E = 1.4426950408889634f;
constexpr int NCHK = 34;

__device__ __forceinline__ unsigned pk2(float lo, float hi) { f32x2 v = {lo, hi}; bf16x2_t b = __builtin_convertvector(v, bf16x2_t); return __builtin_bit_cast(unsigned, b); }
constexpr int DENSE_F8 = 0;
constexpr float F8_SH = 8.0f, F8_SW13 = 256.0f, F8_SU = 8.0f, F8_SW2 = 256.0f, F8_INV13 = 1.0f / (F8_SH * F8_SW13), F8_INV2 = 1.0f / (F8_SU * F8_SW2);
__device__ __forceinline__ unsigned pk4f8(float a, float b, float c, float d) {
    a = __builtin_amdgcn_fmed3f(a, -448.0f, 448.0f); b = __builtin_amdgcn_fmed3f(b, -448.0f, 448.0f); c = __builtin_amdgcn_fmed3f(c, -448.0f, 448.0f); d = __builtin_amdgcn_fmed3f(d, -448.0f, 448.0f);
    int w = __builtin_amdgcn_cvt_pk_fp8_f32(a, b, 0, false); w = __builtin_amdgcn_cvt_pk_fp8_f32(c, d, w, true); return (unsigned)w;
}
constexpr float I8_CLIP = 5.5f;
__device__ __forceinline__ unsigned pk4i8(float a, float b, float c, float d) {
    const float M = 12582912.0f;
    const unsigned ua = __float_as_uint(a + M), ub = __float_as_uint(b + M), uc = __float_as_uint(c + M), ud = __float_as_uint(d + M);
    return __builtin_amdgcn_perm(ub, ua, 0x0c0c0400u) | __builtin_amdgcn_perm(ud, uc, 0x04000c0cu);
}
__device__ __forceinline__ f32x4 acc_i2f(const f32x4& a) { return __builtin_convertvector(__builtin_bit_cast(i32x4, a), f32x4); }
__device__ __forceinline__ float wave_max(float v) {
#pragma unroll
    for (int o = 1; o < 64; o <<= 1) v = fmaxf(v, __shfl_xor(v, o));
    return v;
}
__device__ __forceinline__ float bf_lo(unsigned u) { return __uint_as_float(u << 16); }
__device__ __forceinline__ float bf_hi(unsigned u) { return __uint_as_float(u & 0xffff0000u); }
__device__ __forceinline__ float bf1(bf16_t u) { return __uint_as_float(((unsigned)u) << 16); }
__device__ __forceinline__ float wave_sum(float v) {
#pragma unroll
    for (int o = 1; o < 64; o <<= 1) v += __shfl_xor(v, o);
    return v;
}
__device__ __forceinline__ float fexp2(float x) { return __builtin_amdgcn_exp2f(x); }
__device__ __forceinline__ float sigmoidf_(float x) { return __builtin_amdgcn_rcpf(1.0f + __builtin_amdgcn_exp2f(-LOG2E * x)); }
__device__ __forceinline__ float siluf_(float x) { return x * __builtin_amdgcn_rcpf(1.0f + __builtin_amdgcn_exp2f(-LOG2E * x)); }
#define LDS_WAIT() asm volatile("s_waitcnt lgkmcnt(0)" ::: "memory")
#define VM_WAIT() asm volatile("s_waitcnt vmcnt(0)" ::: "memory")

namespace pg8 {
#define PG8_LAS __attribute__((address_space(3)))
constexpr int BM = 256, BK = 64, HALF = 128, HTB = HALF * BK * 2  , STAGE_BYTES = 8 * HTB, NXCD = 8, WGM = 8;

__host__ __device__ __forceinline__ int lds_byte(int r, int c) { const int st = (r >> 4) * 2 + (c >> 5), rr = r & 15, cc = c & 31, ob = rr * 64 + cc * 2; return st * 1024 + (ob ^ (((ob >> 9) & 1) << 5)); }
__host__ __device__ __forceinline__ void stage_rc(int b, int& R, int& C) { const int st = b / 1024, sb = b % 1024, swz = sb ^ (((sb >> 9) & 1) << 5); R = (st >> 1) * 16 + swz / 64; C = (st & 1) * 32 + (swz % 64) / 2; }
__host__ __device__ __forceinline__ int perm32(int rho) { const int n = rho >> 4, i = rho & 15; return 8 * (i >> 2) + 4 * n + (i & 3); }

struct Unit { int pm, pn; size_t bo; int ge; };
struct Gemm { const bf16_t* A; const bf16_t* Bt; int K; };

struct GSched {
    int nM, nN, nwg, G, c, wgm; int grouped; size_t bstride; const PG8_LAS int* ts;
    int nx; unsigned long long xtab;
    __device__ __forceinline__ void init(int nM_, int nN_, int G_, int c_, int wgm_ = 4) { nM = nM_; nN = nN_; nwg = nM * nN; G = G_; c = c_; wgm = wgm_; grouped = 0; bstride = 0; ts = nullptr; nx = 0; xtab = 0; }
    __device__ __forceinline__ bool next(int i, Unit& u) const {
        const long L = (long)i * G + c; if (L >= nwg) return false;
        const int nmain = nwg - nx;
        u.ge = 0; if (L >= nmain) { const int j = (int)L - nmain; u.pm = nM + (j >> 3); u.pn = (int)((xtab >> (4 * (j & 7))) & 15ull); u.bo = 0; return true; }
        int wgid = (int)L; { const int q = nmain / NXCD, r = nmain % NXCD, xcd = wgid % NXCD, off = wgid / NXCD; wgid = (xcd < r ? xcd * (q + 1) : r * (q + 1) + (xcd - r) * q) + off; }
        const int nig = wgm * nN, gid = wgid / nig, fm = gid * wgm, gsz = (nM - fm) < wgm ? (nM - fm) : wgm;
        u.pm = fm + ((wgid % nig) % gsz); u.pn = (wgid % nig) / gsz; u.bo = 0;
        if (grouped) { int e = 0;
#pragma unroll
            for (int j = 1; j < 8; ++j) e += (u.pm >= ts[j]) ? 1 : 0;
            e = __builtin_amdgcn_readfirstlane(e);
            u.bo = (size_t)e * bstride; u.ge = e; }
        return true;
    }
    __device__ __forceinline__ void a_ready(const Unit&) const {}
    __device__ __forceinline__ void done(const Unit&) const {}
};
#define ROT2(V, I, c, s) do { const float a_ = V[I] * (c) - V[I + 1] * (s), b_ = V[I + 1] * (c) + V[I] * (s); V[I] = a_; V[I + 1] = b_; } while (0)

struct EpiProj {
    static constexpr bool PERM = true, AFTER_DRAIN = false, KHOOK = false;
    bf16_t* O; const float* rope; u32x2* GB; const float* rs; float wsc;
    __device__ __forceinline__ void operator()(const f32x4 (&acc)[2][2][4][2], const Unit& u, int wr, int wc, int fr, int fq) const {
        const int pn = u.pn; const bool latent = u.pm < TL / 256;
        float rsc[2][4];
#pragma unroll
        for (int ai = 0; ai < 2; ++ai)
#pragma unroll
            for (int m = 0; m < 4; ++m) rsc[ai][m] = rs[u.pm * 256 + wr * 64 + fr + ai * 128 + m * 16] * wsc;
        if (pn >= 15) {
            const int gi = (pn - 15) >> 2, pnl = (pn - 15) & 3;
            u32x2* gp = GB + ((size_t)(((gi * NMT + u.pm) * 4 + pnl) * 8 + wr * 4 + wc) * 16) * 64 + fq * 16 + fr;
#pragma unroll
            for (int ai = 0; ai < 2; ++ai)
#pragma unroll
                for (int m = 0; m < 4; ++m)
#pragma unroll
                    for (int bj = 0; bj < 2; ++bj) { const f32x4 v0 = acc_i2f(acc[ai][bj][m][0]) * rsc[ai][m], v1 = acc_i2f(acc[ai][bj][m][1]) * rsc[ai][m];
#define SG_(x) ((unsigned)fminf(fmaxf(sigmoidf_(x) * 255.0f + 0.5f, 1.0f), 255.0f))
                        u32x2 w; w.x = SG_(v0[0]) | (SG_(v0[1]) << 8) | (SG_(v0[2]) << 16) | (SG_(v0[3]) << 24); w.y = SG_(v1[0]) | (SG_(v1[1]) << 8) | (SG_(v1[2]) << 16) | (SG_(v1[3]) << 24);
#undef SG_
                        __builtin_nontemporal_store(w, gp + (ai * 8 + m * 2 + bj) * 64); }
            return;
        }
        int rmask = 0; if (pn <= 1 || pn == 3 || pn == 4 || (pn >= 9 && pn <= 12)) rmask = 3; else if (pn == 2) rmask = 1;
        if (!latent) rmask = 0;
        const float sc = (pn == 4) ? 0.125f : SM_C2;
        const int row0 = u.pm * 256 + wr * 64 + fr, col0 = pn * 256 + wc * 32 + 8 * fq, axis = wc & 1;
#pragma unroll
        for (int ai = 0; ai < 2; ++ai)
#pragma unroll
            for (int m = 0; m < 4; ++m) {
                const int row = row0 + ai * 128 + m * 16;
                f32x4 cs0 = {1.f, 0.f, 1.f, 0.f}, cs1 = {1.f, 0.f, 1.f, 0.f};
                if (rmask) { const int pos = axis ? (row & 63) : ((row >> 6) & 63); const f32x4* tp = (const f32x4*)(rope + (pos * 16 + 4 * fq) * 2); cs0 = tp[0]; cs1 = tp[1]; }
                bf16_t* rowp = O + (size_t)row * DINP + col0;
#pragma unroll
                for (int bj = 0; bj < 2; ++bj) {
                    f32x4 v0 = acc_i2f(acc[ai][bj][m][0]) * rsc[ai][m], v1 = acc_i2f(acc[ai][bj][m][1]) * rsc[ai][m];
                    if ((rmask >> bj) & 1) { ROT2(v0, 0, cs0[0], cs0[1]); ROT2(v0, 2, cs0[2], cs0[3]); ROT2(v1, 0, cs1[0], cs1[1]); ROT2(v1, 2, cs1[2], cs1[3]); }
                    if (pn == 4 || pn <= 1 || pn == 9 || pn == 10) { v0 = v0 * sc; v1 = v1 * sc; }
                    u32x4 w; w.x = pk2(v0[0], v0[1]); w.y = pk2(v0[2], v0[3]); w.z = pk2(v1[0], v1[1]); w.w = pk2(v1[2], v1[3]);
                    __builtin_nontemporal_store(w, (u32x4*)(rowp + bj * 128));
                }
            }
    }
};

struct EpiMerge {
    static constexpr bool PERM = true, AFTER_DRAIN = false, KHOOK = true;
    bf16_t* Y; const u32x2* GB;
#define UB_(w, k) ((float)(((w) >> (8 * (k))) & 0xffu))
    __device__ __forceinline__ void khook(int t, f32x4 (&acc)[2][2][4][2], const Unit& u, int wr, int wc, int fr, int fq) const {
        const int gi = (t == 8) ? 0 : 1;
        const u32x2* ga = GB + ((size_t)(((gi * NMT + u.pm) * 4 + u.pn) * 8 + wr * 4 + wc) * 16) * 64 + fq * 16 + fr;
        const u32x2* gb = ga + (size_t)NMT * 4 * 8 * 16 * 64;
        u32x2 a[16], b[16];
#pragma unroll
        for (int j = 0; j < 16; ++j) { a[j] = ga[j * 64]; b[j] = gb[j * 64]; }
        __builtin_amdgcn_sched_barrier(0);
#pragma unroll
        for (int grp = 0; grp < 16; ++grp) { const int ai = grp >> 3, m = (grp >> 1) & 3, bj = grp & 1;
            f32x4 v0 = acc[ai][bj][m][0], v1 = acc[ai][bj][m][1];
#define MG_R(wa, wb, k) (UB_(wa, k) * __builtin_amdgcn_rcpf(UB_(wb, k)))
            v0[0] *= MG_R(a[grp].x, b[grp].x, 0); v0[1] *= MG_R(a[grp].x, b[grp].x, 1); v0[2] *= MG_R(a[grp].x, b[grp].x, 2); v0[3] *= MG_R(a[grp].x, b[grp].x, 3);
            v1[0] *= MG_R(a[grp].y, b[grp].y, 0); v1[1] *= MG_R(a[grp].y, b[grp].y, 1); v1[2] *= MG_R(a[grp].y, b[grp].y, 2); v1[3] *= MG_R(a[grp].y, b[grp].y, 3);
#undef MG_R
            acc[ai][bj][m][0] = v0; acc[ai][bj][m][1] = v1; }
        asm volatile("" ::: "memory"); __builtin_amdgcn_sched_barrier(0);
    }
    __device__ __forceinline__ void operator()(const f32x4 (&acc)[2][2][4][2], const Unit& u, int wr, int wc, int fr, int fq) const {
        const int row0 = u.pm * 256 + wr * 64 + fr, col0 = u.pn * 256 + wc * 32 + 8 * fq;
        const u32x2* gc = GB + ((size_t)(((2 * NMT + u.pm) * 4 + u.pn) * 8 + wr * 4 + wc) * 16) * 64 + fq * 16 + fr;
        u32x2 g[16];
#pragma unroll
        for (int j = 0; j < 16; ++j) g[j] = gc[j * 64];
        constexpr float q = 1.0f / 255.0f;
#pragma unroll
        for (int grp = 0; grp < 16; ++grp) { const int ai = grp >> 3, m = (grp >> 1) & 3, bj = grp & 1;
            const f32x4 v0 = acc[ai][bj][m][0] * q, v1 = acc[ai][bj][m][1] * q;
            u32x4 w; w.x = pk2(v0[0] * UB_(g[grp].x, 0), v0[1] * UB_(g[grp].x, 1)); w.y = pk2(v0[2] * UB_(g[grp].x, 2), v0[3] * UB_(g[grp].x, 3));
            w.z = pk2(v1[0] * UB_(g[grp].y, 0), v1[1] * UB_(g[grp].y, 1)); w.w = pk2(v1[2] * UB_(g[grp].y, 2), v1[3] * UB_(g[grp].y, 3));
            *(u32x4*)(Y + (size_t)(row0 + ai * 128 + m * 16) * DM + col0 + bj * 128) = w; }
    }
#undef UB_
};

struct EpiRes {
    static constexpr bool PERM = true, AFTER_DRAIN = false, KHOOK = false;
    const float* srcL; const float* srcC; float* dstL; float* dstC; const float* mod; int goff; float scl;
    __device__ __forceinline__ void operator()(const f32x4 (&acc)[2][2][4][2], const Unit& u, int wr, int wc, int fr, int fq) const {
        const bool latent = u.pm < TL / 256; const int mb = latent ? (u.pm >> 4) : 8;
        const float* g = mod + mb * 6144 + goff;
        const int rloc = (latent ? u.pm * 256 : u.pm * 256 - TL) + wr * 64 + fr, col0 = u.pn * 256 + wc * 32 + 8 * fq;
        const float* src = latent ? srcL : srcC; float* dst = latent ? dstL : dstC;
        f32x4 gv[2][2];
#pragma unroll
        for (int bj = 0; bj < 2; ++bj) { gv[bj][0] = *(const f32x4*)(g + col0 + bj * 128) * scl; gv[bj][1] = *(const f32x4*)(g + col0 + bj * 128 + 4) * scl; }
#pragma unroll
        for (int ai = 0; ai < 2; ++ai)
#pragma unroll
            for (int m = 0; m < 4; ++m) {
                const size_t off = (size_t)(rloc + ai * 128 + m * 16) * DM + col0;
#pragma unroll
                for (int bj = 0; bj < 2; ++bj) {
                    const f32x4 x0 = *(const f32x4*)(src + off + bj * 128), x1 = *(const f32x4*)(src + off + bj * 128 + 4);
                    *(f32x4*)(dst + off + bj * 128) = x0 + gv[bj][0] * acc[ai][bj][m][0];
                    *(f32x4*)(dst + off + bj * 128 + 4) = x1 + gv[bj][1] * acc[ai][bj][m][1];
                }
                if (m & 1) asm volatile("" ::: "memory");
            }
    }
};

struct EpiSwiglu {
    static constexpr bool PERM = true, AFTER_DRAIN = false, KHOOK = false;
    unsigned char* U;
    __device__ __forceinline__ void operator()(const f32x4 (&acc)[2][2][4][2], const Unit& u, int wr, int wc, int fr, int fq) const {
        const int row0 = u.pm * 256 + wr * 64 + fr, col0 = u.pn * 128 + wc * 32 + 8 * fq;
#pragma unroll
        for (int ai = 0; ai < 2; ++ai)
#pragma unroll
            for (int m = 0; m < 4; ++m) {
                const f32x4 a0 = acc[ai][0][m][0] * F8_INV13, a1 = acc[ai][0][m][1] * F8_INV13, b0 = acc[ai][1][m][0] * (F8_INV13 * F8_SU), b1 = acc[ai][1][m][1] * (F8_INV13 * F8_SU);
                u32x2 w; w.x = pk4f8(siluf_(a0[0]) * b0[0], siluf_(a0[1]) * b0[1], siluf_(a0[2]) * b0[2], siluf_(a0[3]) * b0[3]);
                w.y = pk4f8(siluf_(a1[0]) * b1[0], siluf_(a1[1]) * b1[1], siluf_(a1[2]) * b1[2], siluf_(a1[3]) * b1[3]);
                *(u32x2*)(U + (size_t)(row0 + ai * 128 + m * 16) * DFF + col0) = w;
            }
    }
};

struct EpiSwigluB {
    static constexpr bool PERM = true, AFTER_DRAIN = false, KHOOK = false;
    bf16_t* U;
    __device__ __forceinline__ void operator()(const f32x4 (&acc)[2][2][4][2], const Unit& u, int wr, int wc, int fr, int fq) const {
        const int row0 = u.pm * 256 + wr * 64 + fr, col0 = u.pn * 128 + wc * 32 + 8 * fq;
#pragma unroll
        for (int ai = 0; ai < 2; ++ai)
#pragma unroll
            for (int m = 0; m < 4; ++m) {
                const f32x4 a0 = acc[ai][0][m][0], a1 = acc[ai][0][m][1], b0 = acc[ai][1][m][0], b1 = acc[ai][1][m][1];
                u32x4 w; w.x = pk2(siluf_(a0[0]) * b0[0], siluf_(a0[1]) * b0[1]); w.y = pk2(siluf_(a0[2]) * b0[2], siluf_(a0[3]) * b0[3]);
                w.z = pk2(siluf_(a1[0]) * b1[0], siluf_(a1[1]) * b1[1]); w.w = pk2(siluf_(a1[2]) * b1[2], siluf_(a1[3]) * b1[3]);
                *(u32x4*)(U + (size_t)(row0 + ai * 128 + m * 16) * DFF + col0) = w;
            }
    }
};

struct EpiBf16 {
    static constexpr bool PERM = true, AFTER_DRAIN = false, KHOOK = false;
    bf16_t* O; int ldc; float scl;
    __device__ __forceinline__ void operator()(const f32x4 (&acc)[2][2][4][2], const Unit& u, int wr, int wc, int fr, int fq) const {
        const int row0 = u.pm * 256 + wr * 64 + fr, col0 = u.pn * 256 + wc * 32 + 8 * fq;
#pragma unroll
        for (int ai = 0; ai < 2; ++ai)
#pragma unroll
            for (int m = 0; m < 4; ++m) { bf16_t* rowp = O + (size_t)(row0 + ai * 128 + m * 16) * ldc + col0;
#pragma unroll
                for (int bj = 0; bj < 2; ++bj) { const f32x4 v0 = acc[ai][bj][m][0] * scl, v1 = acc[ai][bj][m][1] * scl;
                    u32x4 w; w.x = pk2(v0[0], v0[1]); w.y = pk2(v0[2], v0[3]); w.z = pk2(v1[0], v1[1]); w.w = pk2(v1[2], v1[3]);
                    *(u32x4*)(rowp + bj * 128) = w; } }
    }
};

template <class Epi, class Sched, bool ALIGN_EPI = false, bool SP2 = false, int MODE = 0>
__device__ __forceinline__ void gemm_phase(PG8_LAS unsigned char* lds, const Gemm g, const Sched& S, const Epi& E, int tid_in) {
    int tid = tid_in; asm volatile("" : "+v"(tid));
    const int wid = __builtin_amdgcn_readfirstlane(tid >> 6), lane = tid & 63, wr = wid >> 2, wc = wid & 3, fr = lane & 15, fq = lane >> 4;
    const int K = g.K, nt = K / BK;
    unsigned voffA[2], voffB[2];
#pragma unroll
    for (int i = 0; i < 2; ++i) { int R, C; stage_rc(tid * 16 + i * 8192, R, C); const int Rb = Epi::PERM ? ((R & ~31) + perm32(R & 31)) : R;
        voffA[i] = (unsigned)(R * K + C) * 2u; voffB[i] = (unsigned)(Rb * K + C) * 2u; }
    const size_t kstep = (size_t)(BK * 2);
    const size_t hstep = (size_t)HALF * K * 2;
    const size_t tstep = 2 * hstep;
    const unsigned ldsw = (unsigned)wid * 1024u;
    const int aoff = lds_byte(wr * 64 + fr, fq * 8), boff = lds_byte(wc * 32 + fr, fq * 8);
#define PG8_SA(b, h) (((b) * 2 + (h)) * HTB)
#define PG8_SB(b, h) ((4 + (b) * 2 + (h)) * HTB)
#define PG8_STAGE(bufoff, gbase, voff) do { _Pragma("unroll") for (int _i = 0; _i < 2; ++_i) \
        __builtin_amdgcn_global_load_lds((const unsigned*)((const char*)(gbase) + (voff)[_i]), (PG8_LAS unsigned*)(lds + (bufoff) + ldsw + _i * 8192), 16, 0, 0); } while (0)
#define PG8_LDA(dst, b, h) do { _Pragma("unroll") for (int m = 0; m < 4; ++m) _Pragma("unroll") for (int k = 0; k < 2; ++k) dst[m][k] = *(const PG8_LAS bf16x8*)(lds + PG8_SA(b, h) + aoff + m * 2048 + k * 1024); } while (0)
#define PG8_LDB(dst, b, h) do { _Pragma("unroll") for (int n = 0; n < 2; ++n) _Pragma("unroll") for (int k = 0; k < 2; ++k) dst[n][k] = *(const PG8_LAS bf16x8*)(lds + PG8_SB(b, h) + boff + n * 2048 + k * 1024); } while (0)
#define PG8_CAT(x) __builtin_shufflevector(__builtin_bit_cast(i32x4, (x)[0]), __builtin_bit_cast(i32x4, (x)[1]), 0, 1, 2, 3, 4, 5, 6, 7)
#define PG8_MMA(ai, bj, At, Bt) do { __builtin_amdgcn_s_setprio(1); _Pragma("unroll") for (int m = 0; m < 4; ++m) _Pragma("unroll") for (int n = 0; n < 2; ++n) { \
        if constexpr (MODE == 1) { const i32x8 b8_ = PG8_CAT(Bt[n]), a8_ = PG8_CAT(At[m]); asm volatile("v_mfma_f32_16x16x128_f8f6f4 %0, %1, %2, %0" : "+v"(acc[ai][bj][m][n]) : "v"(b8_), "v"(a8_)); } \
          \
        else if constexpr (MODE == 2) { _Pragma("unroll") for (int k = 0; k < 2; ++k) asm volatile("v_mfma_i32_16x16x64_i8 %0, %1, %2, %0" : "+v"(acc[ai][bj][m][n]) : "v"(Bt[n][k]), "v"(At[m][k])); } \
        else { _Pragma("unroll") for (int k = 0; k < 2; ++k) acc[ai][bj][m][n] = __builtin_amdgcn_mfma_f32_16x16x32_bf16(Bt[n][k], At[m][k], acc[ai][bj][m][n], 0, 0, 0); } } \
        __builtin_amdgcn_s_setprio(0); } while (0)
#define PG8_WAIT_V(n) asm volatile("s_waitcnt vmcnt(" #n ")" ::: "memory")
#define PG8_WAIT_L(n) asm volatile("s_waitcnt lgkmcnt(" #n ")" ::: "memory")
#define PG8_BAR __builtin_amdgcn_s_barrier()
#define PG8_SCHED __builtin_amdgcn_sched_barrier(0)
    Unit cur, nxt; int ui = 0;
    if (!S.next(0, cur)) return;
    f32x4 acc[2][2][4][2];
#pragma unroll
    for (int a = 0; a < 2; ++a)
#pragma unroll
        for (int b = 0; b < 2; ++b)
#pragma unroll
            for (int m = 0; m < 4; ++m)
#pragma unroll
                for (int n = 0; n < 2; ++n) acc[a][b][m][n] = (f32x4){0.f, 0.f, 0.f, 0.f};
    bf16x8 At[4][2], B0[2][2], B1[2][2];
    const char* cA = (const char*)g.A + (size_t)cur.pm * tstep; const char* cB = (const char*)g.Bt + cur.bo * 2 + (size_t)cur.pn * tstep;
    S.a_ready(cur);
    if constexpr (SP2) {
        PG8_STAGE(PG8_SB(0, 0), cB, voffB); PG8_STAGE(PG8_SB(0, 1), cB + hstep, voffB); PG8_STAGE(PG8_SA(0, 0), cA, voffA); PG8_STAGE(PG8_SA(0, 1), cA + hstep, voffA);
        if (wr == 1) PG8_BAR;
        PG8_WAIT_V(2); PG8_BAR;
        PG8_STAGE(PG8_SB(1, 0), cB + kstep, voffB); PG8_STAGE(PG8_SA(1, 0), cA + kstep, voffA); PG8_STAGE(PG8_SB(1, 1), cB + hstep + kstep, voffB);
        PG8_WAIT_V(6); PG8_BAR;
    } else {
        PG8_STAGE(PG8_SB(0, 0), cB, voffB); PG8_STAGE(PG8_SA(0, 0), cA, voffA); PG8_STAGE(PG8_SB(0, 1), cB + hstep, voffB); PG8_STAGE(PG8_SA(0, 1), cA + hstep, voffA);
        if (wr == 1) PG8_BAR;
        PG8_WAIT_V(4); PG8_BAR;
        PG8_STAGE(PG8_SB(1, 0), cB + kstep, voffB); PG8_STAGE(PG8_SA(1, 0), cA + kstep, voffA); PG8_STAGE(PG8_SB(1, 1), cB + hstep + kstep, voffB);
        PG8_WAIT_V(6); PG8_BAR;
    }
    for (;;) {
        const bool has_next = S.next(ui + 1, nxt);
        const char* nA = has_next ? (const char*)g.A + (size_t)nxt.pm * tstep : cA; const char* nB = has_next ? (const char*)g.Bt + nxt.bo * 2 + (size_t)nxt.pn * tstep : cB;
        for (int t = 0; t < nt; t += 2) {
            const bool last = (t == nt - 2);
            const char* a1 = cA + (size_t)(t + 1) * kstep;
            const char* a2 = last ? nA : cA + (size_t)(t + 2) * kstep; const char* b2 = last ? nB : cB + (size_t)(t + 2) * kstep;
            const char* a3 = a2 + kstep; const char* b3 = b2 + kstep;
            if (last && has_next) S.a_ready(nxt);
            if constexpr (Epi::KHOOK) { if (t == 8 || t == 16) E.khook(t, acc, cur, wr, wc, fr, fq); }
            if constexpr (SP2) {
            PG8_LDB(B0, 0, 0); PG8_LDB(B1, 0, 1); PG8_SCHED; PG8_LDA(At, 0, 0); PG8_STAGE(PG8_SA(1, 1), a1 + hstep, voffA);
            PG8_WAIT_V(8); PG8_WAIT_L(0); PG8_BAR; PG8_MMA(0, 0, At, B0); PG8_MMA(0, 1, At, B1); PG8_BAR; PG8_SCHED;
            PG8_LDA(At, 0, 1); PG8_STAGE(PG8_SB(0, 0), b2, voffB); PG8_STAGE(PG8_SB(0, 1), b2 + hstep, voffB); PG8_STAGE(PG8_SA(0, 0), a2, voffA);
            PG8_WAIT_V(8); PG8_WAIT_L(0); PG8_BAR; PG8_MMA(1, 0, At, B0); PG8_MMA(1, 1, At, B1); PG8_BAR; PG8_SCHED;
            PG8_LDB(B0, 1, 0); PG8_LDB(B1, 1, 1); PG8_SCHED; PG8_LDA(At, 1, 0); PG8_STAGE(PG8_SA(0, 1), a2 + hstep, voffA);
            PG8_WAIT_V(8); PG8_WAIT_L(0); PG8_BAR; PG8_MMA(0, 0, At, B0); PG8_MMA(0, 1, At, B1); PG8_BAR; PG8_SCHED;
            PG8_LDA(At, 1, 1); PG8_STAGE(PG8_SB(1, 0), b3, voffB); PG8_STAGE(PG8_SB(1, 1), b3 + hstep, voffB); PG8_STAGE(PG8_SA(1, 0), a3, voffA);
            PG8_WAIT_V(8); PG8_WAIT_L(0); PG8_BAR; PG8_MMA(1, 0, At, B0); PG8_MMA(1, 1, At, B1); PG8_BAR; PG8_SCHED;
            } else {
            PG8_LDB(B0, 0, 0); PG8_SCHED; PG8_LDA(At, 0, 0); PG8_STAGE(PG8_SA(1, 1), a1 + hstep, voffA);
            PG8_WAIT_L(8); PG8_BAR; PG8_WAIT_L(0); PG8_MMA(0, 0, At, B0); PG8_BAR; PG8_SCHED;
            PG8_LDB(B1, 0, 1); PG8_STAGE(PG8_SB(0, 0), b2, voffB);
            PG8_BAR; PG8_WAIT_L(0); PG8_MMA(0, 1, At, B1); PG8_BAR;
            PG8_LDA(At, 0, 1); PG8_STAGE(PG8_SA(0, 0), a2, voffA);
            PG8_BAR; PG8_WAIT_L(0); PG8_MMA(1, 0, At, B0); PG8_BAR; PG8_SCHED;
            PG8_STAGE(PG8_SB(0, 1), b2 + hstep, voffB);
            PG8_WAIT_V(6); PG8_BAR; PG8_MMA(1, 1, At, B1); PG8_BAR;
            PG8_LDB(B0, 1, 0); PG8_SCHED; PG8_LDA(At, 1, 0); PG8_STAGE(PG8_SA(0, 1), a2 + hstep, voffA);
            PG8_WAIT_L(8); PG8_BAR; PG8_WAIT_L(0); PG8_MMA(0, 0, At, B0); PG8_BAR; PG8_SCHED;
            PG8_LDB(B1, 1, 1); PG8_STAGE(PG8_SB(1, 0), b3, voffB);
            PG8_BAR; PG8_WAIT_L(0); PG8_MMA(0, 1, At, B1); PG8_BAR;
            PG8_LDA(At, 1, 1); PG8_STAGE(PG8_SA(1, 0), a3, voffA);
            PG8_BAR; PG8_WAIT_L(0); PG8_MMA(1, 0, At, B0); PG8_BAR; PG8_SCHED;
            PG8_STAGE(PG8_SB(1, 1), b3 + hstep, voffB);
            PG8_WAIT_V(6); PG8_BAR; PG8_MMA(1, 1, At, B1); PG8_BAR;
            }
        }
        if constexpr (MODE != 0) asm volatile("s_nop 15\n\ts_nop 15" ::: "memory");
        if constexpr (ALIGN_EPI) { if (wr == 0) PG8_BAR; }
        if constexpr (!Epi::AFTER_DRAIN) { int ln_; asm volatile("v_mbcnt_lo_u32_b32 %0, -1, 0\n\tv_mbcnt_hi_u32_b32 %0, -1, %0" : "=v"(ln_));
            E(acc, cur, wr, wc, ln_ & 15, ln_ >> 4); S.done(cur); }
        if (!has_next) break;
#pragma unroll
        for (int a = 0; a < 2; ++a)
#pragma unroll
            for (int b = 0; b < 2; ++b)
#pragma unroll
                for (int m = 0; m < 4; ++m)
#pragma unroll
                    for (int n = 0; n < 2; ++n) acc[a][b][m][n] = (f32x4){0.f, 0.f, 0.f, 0.f};
        cur = nxt; cA = nA; cB = nB; ++ui;
        if constexpr (ALIGN_EPI) { if (wr == 1) PG8_BAR; }
    }
    PG8_WAIT_V(0);
    if constexpr (!ALIGN_EPI) { if (wr == 0) PG8_BAR; }
    PG8_BAR;
    if constexpr (Epi::AFTER_DRAIN) { E.fused(acc, cur, wr, wc, fr, fq, lds, wid, lane); S.done(cur); }
#undef PG8_SA
#undef PG8_SB
#undef PG8_STAGE
#undef PG8_LDA
#undef PG8_LDB
#undef PG8_MMA
#undef PG8_CAT
#undef PG8_WAIT_V
#undef PG8_WAIT_L
#undef PG8_BAR
#undef PG8_SCHED
}
}
namespace at {
__device__ __forceinline__ int crow(int r, int hi) { return (r & 3) + 8 * (r >> 2) + 4 * hi; }
typedef short v4i16_t __attribute__((ext_vector_type(4)));
__device__ __forceinline__ s16x4 vtr(const LAS unsigned char* p) { return __builtin_bit_cast(s16x4, __builtin_amdgcn_ds_read_tr16_b64_v4i16((LAS v4i16_t*)p)); }
__device__ __forceinline__ bf16x8 cat8(s16x4 lo, s16x4 hi) { return (bf16x8){lo[0], lo[1], lo[2], lo[3], hi[0], hi[1], hi[2], hi[3]}; }
#define MFMA32(a, b, c) __builtin_amdgcn_mfma_f32_32x32x16_bf16((a), (b), (c), 0, 0, 0)
constexpr int KSTR = 144;
constexpr float NEG_BIG = -1.0e30f;

__device__ __forceinline__ bf16x8 tr_frag(const LAS unsigned char* tile, int vstr, int ks, int colb, int lane) {
    const int hi = lane >> 5, ql = (lane & 15) >> 2, blk = (lane >> 4) & 1, p = lane & 3;
    const LAS unsigned char* a = tile + (16 * ks + 4 * hi + ql) * vstr + (colb + 16 * blk + 4 * p) * 2;
    return cat8(vtr(a), vtr(a + 8 * vstr));
}

template <int N> __device__ __forceinline__ void wait_bar() { asm volatile("s_waitcnt vmcnt(%0) lgkmcnt(0)\n\ts_barrier" :: "n"(N) : "memory"); }
template <int DV, int NK> struct AtGeo { static constexpr int KB = 8192, VB = DV * 128, STAGE = NK * KB + VB, NP = (NK * 8 + DV / 8) / 8  , LDS = 3 * STAGE + 2048; };
__device__ __forceinline__ bf16x8 v_frag(const LAS unsigned char* Vt, int ks, int c, int lane) {
    const int hi = lane >> 5, ql = (lane & 15) >> 2, blk = (lane >> 4) & 1, p = lane & 3;
    const int ch = (4 * (c & 1) + 2 * blk + (p >> 1)) ^ ((ql & 2) << 1);
    const LAS unsigned char* a = Vt + (c >> 1) * 8192 + (16 * ks + 4 * hi + ql) * 128 + ch * 16 + 8 * (p & 1);
    return cat8(vtr(a), vtr(a + 1024));
}
template <int DV, int NK> struct AtCtx {
    LAS unsigned char* lds; LAS float* scr; bf16x8 qr[4]; f32x16 o[DV / 32]; f32x16 negm; float m, l; int lane, r32, hi, ksel, qpos, kpos0, nloc; bool exact0;
};
template <int DV, int NK, bool BAND, bool HAS_QK, bool HAS_PV, bool EX0>
__device__ __forceinline__ void at_step(AtCtx<DV, NK>& C, int t, int koff, int voff, const u32x4 (&pw)[4], u32x4 (&pn)[4]) {
    constexpr int KB = 8192, NC = DV / 32, NG = NC * 4  , EPG = 16 / NG  ;
    const LAS unsigned char* Kt = C.lds + koff + C.ksel * KB;
    const LAS unsigned char* Vt = C.lds + voff;
    const int lane = C.lane, r32 = C.r32, hi = C.hi;
    f32x16 s0, s1; bf16x8 vf[2][4];
    bool resc = false;
    if (HAS_QK) {
        bf16x8 kf[8];
#pragma unroll
        for (int d0 = 0; d0 < 4; ++d0) { const int ko = r32 * 128 + (((2 * d0 + hi) ^ ((r32 >> 1) & 7)) << 4);
            kf[2 * d0] = *(const LAS bf16x8*)(Kt + ko); kf[2 * d0 + 1] = *(const LAS bf16x8*)(Kt + 4096 + ko); }
        __builtin_amdgcn_sched_barrier(0);
        __builtin_amdgcn_s_setprio(1);
        s0 = MFMA32(kf[0], C.qr[0], C.negm); s1 = MFMA32(kf[1], C.qr[0], C.negm);
#pragma unroll
        for (int d0 = 1; d0 < 4; ++d0) { s0 = MFMA32(kf[2 * d0], C.qr[d0], s0); s1 = MFMA32(kf[2 * d0 + 1], C.qr[d0], s1); }
        __builtin_amdgcn_s_setprio(0);
        __builtin_amdgcn_sched_barrier(0);
    }
    if (HAS_PV) {
#pragma unroll
        for (int c = 0; c < 2; ++c)
#pragma unroll
            for (int ks = 0; ks < 4; ++ks) vf[c][ks] = v_frag(Vt, ks, c, lane);
        __builtin_amdgcn_sched_barrier(0);
    }
    if (HAS_QK) {
        if (BAND && t < C.nloc) {
            const int kb = C.kpos0 + 64 * t - C.qpos;
#pragma unroll
            for (int r = 0; r < 16; ++r) { const int d = kb + crow(r, hi); if (d > 128 || d < -128) s0[r] = NEG_BIG; if (d + 32 > 128 || d + 32 < -128) s1[r] = NEG_BIG; }
        }
        float mt = fmaxf(fmaxf(s0[0], s1[0]), s0[1]);
#pragma unroll
        for (int r = 2; r < 16; r += 2) mt = fmaxf(fmaxf(mt, s0[r]), s0[r + 1]);
#pragma unroll
        for (int r = 1; r < 16; r += 2) mt = fmaxf(fmaxf(mt, s1[r]), s1[(r + 1) & 15]);
        { const auto sw = __builtin_amdgcn_permlane32_swap(__float_as_uint(mt), __float_as_uint(mt), false, false); mt = fmaxf(__uint_as_float(sw[0]), __uint_as_float(sw[1])); }
        const float dl = (!HAS_PV && EX0) ? mt : ((mt > 8.0f) ? mt : 0.0f);
        resc = (!HAS_PV && EX0) ? true : __any(dl > 0.0f);
        if (resc) { const float f = (!HAS_PV && EX0) ? 1.0f : fexp2(-dl);     C.l *= f; C.m += dl; if (hi == 0) C.scr[r32] = f;
#pragma unroll
            for (int r = 0; r < 16; ++r) { s0[r] -= dl; s1[r] -= dl; C.negm[r] = -C.m; } }
        __builtin_amdgcn_sched_barrier(0);
    }
    {
        float ls = 0.f;
        __builtin_amdgcn_s_setprio(1);
#pragma unroll
        for (int g = 0; g < NG; ++g) {
            const int c = g >> 2, ks = g & 3;
            if (HAS_PV) {
                C.o[c] = MFMA32(__builtin_bit_cast(bf16x8, pw[ks]), vf[c & 1][ks], C.o[c]);
                if (ks == 3 && c + 2 < NC) {
#pragma unroll
                    for (int k2 = 0; k2 < 4; ++k2) vf[c & 1][k2] = v_frag(Vt, k2, c + 2, lane);
                }
            }
            if (HAS_QK) {
#pragma unroll
                for (int e = 0; e < EPG; ++e) { const int r = g * EPG + e;
                    s0[r] = fexp2(s0[r]); s1[r] = fexp2(s1[r]); ls += s0[r] + s1[r];
                    if (r & 1) { const unsigned w0 = pk2(s0[r - 1], s0[r]), w1 = pk2(s1[r - 1], s1[r]); pn[r >> 3][(r >> 1) & 3] = w0; pn[2 + (r >> 3)][(r >> 1) & 3] = w1; } }
            }
        }
        if (HAS_QK) { C.l += ls; asm volatile("" : "+v"(pn[0]), "+v"(pn[1]), "+v"(pn[2]), "+v"(pn[3]), "+v"(C.l)); }
        __builtin_amdgcn_s_setprio(0);
        if (HAS_QK && HAS_PV) {
#pragma unroll
            for (int g = 0; g < NG; ++g) { __builtin_amdgcn_sched_group_barrier(0x008, 1, 0); __builtin_amdgcn_sched_group_barrier(0x002, 6 * EPG, 0); if (g < (NC - 2) * 4) __builtin_amdgcn_sched_group_barrier(0x100, 2, 0); }
        }
        __builtin_amdgcn_sched_barrier(0);
    }
    if (resc) {
        LDS_WAIT();
#pragma unroll
        for (int j = 0; j < 4; ++j) { const f32x4 fv = *(const LAS f32x4*)(C.scr + 8 * j + 4 * hi);
#pragma unroll
            for (int c = 0; c < NC; ++c) { C.o[c][4 * j] *= fv[0]; C.o[c][4 * j + 1] *= fv[1]; C.o[c][4 * j + 2] *= fv[2]; C.o[c][4 * j + 3] *= fv[3]; } }
        LDS_WAIT();
    }
}
template <int DV, int NK, bool BAND, bool EX0>
__device__ __forceinline__ void attn_core(LAS unsigned char* lds, const bf16_t* __restrict__ proj, int NT, int nloc, int locrow0, int ctxrow0, int kcol, int vcol,
                                          const bf16_t* qp, int ksel, int qpos, int kpos0, float m_init, float l_init, f32x16 (&o)[DV / 32], float& l_out, int tid) {
    typedef AtGeo<DV, NK> Geo;
    constexpr int KB = Geo::KB, VB = Geo::VB, NPK = NK, NPV = DV / 64, NP = NPK + NPV;
    AtCtx<DV, NK> C;
    C.lds = lds; C.lane = tid & 63; C.r32 = C.lane & 31; C.hi = C.lane >> 5; C.ksel = ksel; C.qpos = qpos; C.kpos0 = kpos0; C.nloc = nloc;
    const int lane = C.lane; const int wid = __builtin_amdgcn_readfirstlane(tid >> 6);
    C.scr = (LAS float*)(lds + 3 * Geo::STAGE) + wid * 64;
#pragma unroll
    for (int d0 = 0; d0 < 4; ++d0) C.qr[d0] = *(const bf16x8*)(qp + d0 * 16 + C.hi * 8);
    unsigned ksoff[NPK], vsoff[NPV]; int kdoff[NPK], vdoff[NPV];
#pragma unroll
    for (int i = 0; i < NPK; ++i) { const int pc = wid + 8 * i, j = pc >> 3, key = 8 * (pc & 7) + (lane >> 3), ch = (lane & 7) ^ ((key >> 1) & 7);
        ksoff[i] = (unsigned)key * DINP + kcol + j * 64 + ch * 8; kdoff[i] = pc * 1024; }
#pragma unroll
    for (int i = 0; i < NPV; ++i) { const int pv = wid + 8 * i, cp = pv >> 3, key = 8 * (pv & 7) + (lane >> 3), ch = (lane & 7) ^ (((key >> 1) & 1) << 2);
        vsoff[i] = (unsigned)key * DINP + vcol + cp * 64 + ch * 8; vdoff[i] = 3 * NK * KB + pv * 1024; }
#define AT_ROW0(t) ((t) < nloc ? locrow0 + 64 * (t) : ctxrow0 + 64 * ((t) - nloc))
#define AT_DMA_K(t, s) do { const bf16_t* tb = proj + (size_t)AT_ROW0(t) * DINP; \
        _Pragma("unroll") for (int i = 0; i < NPK; ++i) __builtin_amdgcn_global_load_lds((const unsigned*)(tb + ksoff[i]), (LAS unsigned*)(lds + (s) * (NK * KB) + kdoff[i]), 16, 0, 0); } while (0)
#define AT_DMA_V(t, s) do { const bf16_t* tb = proj + (size_t)AT_ROW0(t) * DINP; \
        _Pragma("unroll") for (int i = 0; i < NPV; ++i) __builtin_amdgcn_global_load_lds((const unsigned*)(tb + vsoff[i]), (LAS unsigned*)(lds + (s) * VB + vdoff[i]), 16, 0, 0); } while (0)
    C.m = m_init; C.l = l_init; C.exact0 = EX0;
#pragma unroll
    for (int r = 0; r < 16; ++r) C.negm[r] = -m_init;
#pragma unroll
    for (int c = 0; c < DV / 32; ++c) C.o[c] = (f32x16){0.f};
    u32x4 pa[4], pb[4];
    AT_DMA_K(0, 0);
    AT_DMA_K(1, 1); AT_DMA_V(0, 0);
    wait_bar<NP>();
    if (2 < NT) AT_DMA_K(2, 2);
    AT_DMA_V(1, 1);
    at_step<DV, NK, BAND, true, false, EX0>(C, 0, 0, 0, pb, pa);
    int s1 = 1, s0 = 0;
    for (int t = 1; t < NT; ++t) {
        if (t + 1 < NT) wait_bar<NP>(); else wait_bar<NPV>();
        const int s2 = s1 == 2 ? 0 : s1 + 1;
        if (t + 2 < NT) AT_DMA_K(t + 2, s0);
        if (t + 1 < NT) AT_DMA_V(t + 1, s2);
        at_step<DV, NK, BAND, true, true, EX0>(C, t, s1 * (NK * KB), 3 * NK * KB + s0 * VB, pa, pb);
#pragma unroll
        for (int i_ = 0; i_ < 4; ++i_) pa[i_] = pb[i_];
        s0 = s1; s1 = s2;
    }
    wait_bar<0>();
    at_step<DV, NK, BAND, false, true, EX0>(C, NT, 0, 3 * NK * KB + s0 * VB, pa, pb);
    wait_bar<0>();
#undef AT_ROW0
#undef AT_DMA_K
#undef AT_DMA_V
#pragma unroll
    for (int c = 0; c < DV / 32; ++c) o[c] = C.o[c];
    l_out = C.l + __shfl_xor(C.l, 32);
}
template <int DV, int NK> struct AtGeoP { static constexpr int KT = NK * 8192, VT = DV * 128, VRING = 4 * KT, SCR = 4 * KT + 4 * VT, LDS = SCR + 2048; };
template <int DV, int NK, bool EX0>
__device__ __forceinline__ void attn_core_pair(LAS unsigned char* lds, const bf16_t* __restrict__ proj, int NT, int nloc, int locrow0, int ctxrow0, int kcol, int vcol,
                                               const bf16_t* qp, int ksel, float m_init, float l_init, f32x16 (&o)[DV / 32], float& l_out, int tid) {
    typedef AtGeoP<DV, NK> Geo;
    constexpr int KT = Geo::KT, VT = Geo::VT, VRING = Geo::VRING, NPK = NK, NPV = DV / 64;
    AtCtx<DV, NK> C;
    C.lds = lds; C.lane = tid & 63; C.r32 = C.lane & 31; C.hi = C.lane >> 5; C.ksel = ksel; C.qpos = 0; C.kpos0 = 0; C.nloc = nloc;
    const int lane = C.lane; const int wid = __builtin_amdgcn_readfirstlane(tid >> 6);
    C.scr = (LAS float*)(lds + Geo::SCR) + wid * 64;
#pragma unroll
    for (int d0 = 0; d0 < 4; ++d0) C.qr[d0] = *(const bf16x8*)(qp + d0 * 16 + C.hi * 8);
    unsigned ksoff[NPK], vsoff[NPV]; int kdoff[NPK], vdoff[NPV];
#pragma unroll
    for (int i = 0; i < NPK; ++i) { const int pc = wid + 8 * i, j = pc >> 3, key = 8 * (pc & 7) + (lane >> 3), ch = (lane & 7) ^ ((key >> 1) & 7);
        ksoff[i] = (unsigned)key * DINP + kcol + j * 64 + ch * 8; kdoff[i] = pc * 1024; }
#pragma unroll
    for (int i = 0; i < NPV; ++i) { const int pv = wid + 8 * i, cp = pv >> 3, key = 8 * (pv & 7) + (lane >> 3), ch = (lane & 7) ^ (((key >> 1) & 1) << 2);
        vsoff[i] = (unsigned)key * DINP + vcol + cp * 64 + ch * 8; vdoff[i] = VRING + pv * 1024; }
#define ATP_ROW0(t) ((t) < nloc ? locrow0 + 64 * (t) : ctxrow0 + 64 * ((t) - nloc))
#define ATP_OFF(t, T_) ((((t) >> 1) & 1) * 2 * (T_) + ((t) & 1) * (T_))
#define ATP_DMA_K(t) do { const bf16_t* tb = proj + (size_t)ATP_ROW0(t) * DINP; const int so_ = ATP_OFF(t, KT); \
        _Pragma("unroll") for (int i = 0; i < NPK; ++i) __builtin_amdgcn_global_load_lds((const unsigned*)(tb + ksoff[i]), (LAS unsigned*)(lds + so_ + kdoff[i]), 16, 0, 0); } while (0)
#define ATP_DMA_V(t) do { const bf16_t* tb = proj + (size_t)ATP_ROW0(t) * DINP; const int so_ = ATP_OFF(t, VT); \
        _Pragma("unroll") for (int i = 0; i < NPV; ++i) __builtin_amdgcn_global_load_lds((const unsigned*)(tb + vsoff[i]), (LAS unsigned*)(lds + so_ + vdoff[i]), 16, 0, 0); } while (0)
    C.m = m_init; C.l = l_init; C.exact0 = EX0;
#pragma unroll
    for (int r = 0; r < 16; ++r) C.negm[r] = -m_init;
#pragma unroll
    for (int c = 0; c < DV / 32; ++c) C.o[c] = (f32x16){0.f};
    u32x4 pa[4], pb[4];
    ATP_DMA_K(0); ATP_DMA_K(1); ATP_DMA_V(0);
    wait_bar<0>();
    if (2 < NT) { ATP_DMA_K(2); ATP_DMA_K(3); ATP_DMA_V(2); }
    ATP_DMA_V(1);
    at_step<DV, NK, false, true, false, EX0>(C, 0, ATP_OFF(0, KT), 0, pb, pa);
    at_step<DV, NK, false, true, true, EX0>(C, 1, ATP_OFF(1, KT), VRING + ATP_OFF(0, VT), pa, pb);
#pragma unroll
    for (int i_ = 0; i_ < 4; ++i_) pa[i_] = pb[i_];
    for (int t = 2; t < NT; t += 2) {
        wait_bar<0>();
        if (t + 2 < NT) { ATP_DMA_K(t + 2); ATP_DMA_K(t + 3); ATP_DMA_V(t + 2); }
        ATP_DMA_V(t + 1);
        at_step<DV, NK, false, true, true, EX0>(C, t, ATP_OFF(t, KT), VRING + ATP_OFF(t - 1, VT), pa, pb);
#pragma unroll
        for (int i_ = 0; i_ < 4; ++i_) pa[i_] = pb[i_];
        at_step<DV, NK, false, true, true, EX0>(C, t + 1, ATP_OFF(t + 1, KT), VRING + ATP_OFF(t, VT), pa, pb);
#pragma unroll
        for (int i_ = 0; i_ < 4; ++i_) pa[i_] = pb[i_];
    }
    wait_bar<0>();
    at_step<DV, NK, false, false, true, EX0>(C, NT, 0, VRING + ATP_OFF(NT - 1, VT), pa, pb);
    wait_bar<0>();
#undef ATP_ROW0
#undef ATP_OFF
#undef ATP_DMA_K
#undef ATP_DMA_V
#pragma unroll
    for (int c = 0; c < DV / 32; ++c) o[c] = C.o[c];
    l_out = C.l + __shfl_xor(C.l, 32);
}
template <int NC>
__device__ __forceinline__ void scale_rows(f32x16 (&o)[NC], float v, LAS float* scr, int r32, int hi) {
    LDS_WAIT();
    if (hi == 0) scr[r32] = v;
    LDS_WAIT();
#pragma unroll
    for (int j = 0; j < 4; ++j) { const f32x4 fv = *(const LAS f32x4*)(scr + 8 * j + 4 * hi);
#pragma unroll
        for (int c = 0; c < NC; ++c) { o[c][4 * j] *= fv[0]; o[c][4 * j + 1] *= fv[1]; o[c][4 * j + 2] *= fv[2]; o[c][4 * j + 3] *= fv[3]; } }
    LDS_WAIT();
}
constexpr int AT_A_LDS = AtGeo<64, 1>::LDS;
constexpr int AT_C_LDS = AtGeoP<128, 2>::LDS;

__device__ __forceinline__ void attnA_unit(LAS unsigned char* lds, const bf16_t* proj, bf16_t* ocat, const float* sink, int b, int g, int qb, int lat, int tid) {
    const int lane = tid & 63, r32 = lane & 31, hi = lane >> 5; const int wid = __builtin_amdgcn_readfirstlane(tid >> 6);
    const int head = g * 4 + (wid >> 1), qloc = qb * 64 + (wid & 1) * 32;
    const int qrow0 = (lat ? b * SEQ : TL + b * CTXL) + qloc;
    int nloc = 0, kt0 = 0;
    if (lat) { kt0 = qb - 2 < 0 ? 0 : qb - 2; const int kt1 = qb + 2 > 63 ? 63 : qb + 2; nloc = kt1 - kt0 + 1; }
    const int NT = nloc + 4;
    f32x16 o[2]; float l;
    attn_core<64, 1, true, false>(lds, proj, NT, nloc, b * SEQ + 64 * kt0, TL + b * CTXL, C_KA + g * 64, C_VA + g * 64,
                           proj + (size_t)(qrow0 + r32) * DINP + C_QA + head * 64, 0, qloc + r32, 64 * kt0, sink[head] * LOG2E, hi == 0 ? 1.0f : 0.0f, o, l, tid);
    LAS float* scr = (LAS float*)(lds + 3 * AtGeo<64, 1>::STAGE) + wid * 64;
    scale_rows<2>(o, __builtin_amdgcn_rcpf(l), scr, r32, hi);
    bf16_t* op = ocat + (size_t)qrow0 * OCW + head * 64 + r32;
#pragma unroll
    for (int r = 0; r < 16; ++r) { const int row = crow(r, hi);
#pragma unroll
        for (int c = 0; c < 2; ++c) op[(size_t)row * OCW + 32 * c] = (bf16_t)(pk2(o[c][r], 0.f) & 0xffffu); }
}

__device__ __forceinline__ void attnC_unit(LAS unsigned char* lds, const bf16_t* proj, bf16_t* ocat, const float* dgain, float lam, float oml, int b, int h, int qb, int lat, int tid) {
    const int lane = tid & 63, r32 = lane & 31, hi = lane >> 5; const int wid = __builtin_amdgcn_readfirstlane(tid >> 6);
    const int comp = wid >> 2, qloc = qb * 128 + (wid & 3) * 32;
    const int qrow0 = (lat ? b * SEQ : TL + b * CTXL) + qloc;
    const int nloc = lat ? 64 : 0, NT = nloc + 4;
    f32x16 o[4]; float l;
    attn_core_pair<128, 2, true>(lds, proj, NT, nloc, b * SEQ, TL + b * CTXL, C_KD + h * 128, C_VD + h * 128,
                           proj + (size_t)(qrow0 + r32) * DINP + C_QD + h * 128 + comp * 64, comp, 0.0f, 0.0f, o, l, tid);
    LAS float* scr = (LAS float*)(lds + AtGeoP<128, 2>::SCR) + wid * 64;
    scale_rows<4>(o, __builtin_amdgcn_rcpf(l), scr, r32, hi);
    LAS float* X = (LAS float*)lds + (wid & 3) * 4096;
    if (comp == 1) {
#pragma unroll
        for (int c = 0; c < 4; ++c)
#pragma unroll
            for (int r = 0; r < 16; ++r) X[(c * 16 + r) * 64 + lane] = o[c][r];
    }
    __syncthreads();
    if (comp == 0) {
        float ss[16];
#pragma unroll
        for (int r = 0; r < 16; ++r) ss[r] = 0.f;
#pragma unroll
        for (int c = 0; c < 4; ++c)
#pragma unroll
            for (int r = 0; r < 16; ++r) { const float v = o[c][r] - lam * X[(c * 16 + r) * 64 + lane]; o[c][r] = v; ss[r] += v * v; }
#pragma unroll
        for (int r = 0; r < 16; ++r) {
#pragma unroll
            for (int s = 1; s < 32; s <<= 1) ss[r] += __shfl_xor(ss[r], s);
            ss[r] = __builtin_amdgcn_rsqf(ss[r] * (1.0f / 128.0f) + NORM_EPS) * oml;
        }
        bf16_t* op = ocat + (size_t)qrow0 * OCW + 1024 + h * 128 + r32;
#pragma unroll
        for (int c = 0; c < 4; ++c) { const float gn = dgain[32 * c + r32];
#pragma unroll
            for (int r = 0; r < 16; ++r) op[(size_t)crow(r, hi) * OCW + 32 * c] = (bf16_t)(pk2(o[c][r] * ss[r] * gn, 0.f) & 0xffffu); }
    }
    __syncthreads();
}
__device__ __forceinline__ int chunk_row0(int b, int ci) { return ci < 2 ? TL + b * CTXL + ci * 128 : b * SEQ + (ci - 2) * 128; }
constexpr int RSTR = 192;
constexpr int VSTR128 = 320;
constexpr int R1_LDS = 2 * 128 * RSTR + 128 * VSTR128;
__device__ __forceinline__ void ret_kv_phase(LAS unsigned char* lds, const bf16_t* __restrict__ proj, bf16_t* kvT, const float* lg2, int blk, int G, int tid) {
    const int lane = tid & 63, hi = lane >> 5; const int wid = __builtin_amdgcn_readfirstlane(tid >> 6);
    LAS unsigned char* Kf = lds; LAS unsigned char* Kb = lds + 128 * RSTR; LAS unsigned char* Vt = lds + 2 * 128 * RSTR;
    constexpr int NU = NB * 4 * NCHK;
    int u = blk; if (u >= NU) return;
    u32x4 kreg[2], vreg[4];
#define R1_LOAD(uu) do { const int ci_ = (uu) % NCHK, bh_ = (uu) / NCHK, row0_ = chunk_row0(bh_ >> 2, ci_), h_ = bh_ & 3; \
        _Pragma("unroll") for (int i = 0; i < 2; ++i) { const int c = tid + 512 * i, k = c >> 3, ch = c & 7; kreg[i] = *(const u32x4*)(proj + (size_t)(row0_ + k) * DINP + C_KB + h_ * 64 + ch * 8); } \
        _Pragma("unroll") for (int i = 0; i < 4; ++i) { const int c = tid + 512 * i, k = c >> 4, ch = c & 15; vreg[i] = *(const u32x4*)(proj + (size_t)(row0_ + k) * DINP + C_VB + h_ * 128 + ch * 8); } } while (0)
    R1_LOAD(u);
    for (;;) {
        const int ci = u % NCHK, bh = u / NCHK, b = bh >> 2, h = bh & 3;
        const float lgf2 = lg2[h], lgb2 = lg2[4 + h];
#pragma unroll
        for (int i = 0; i < 2; ++i) { const int c = tid + 512 * i, k = c >> 3, ch = c & 7;
            const u32x4 v = kreg[i];
            const float wf = fexp2((float)(127 - k) * lgf2), wb = fexp2((float)k * lgb2);
            u32x4 a, d;
#pragma unroll
            for (int j = 0; j < 4; ++j) { const float x0 = bf_lo(v[j]), x1 = bf_hi(v[j]); a[j] = pk2(x0 * wf, x1 * wf); d[j] = pk2(x0 * wb, x1 * wb); }
            *(LAS u32x4*)(Kf + k * RSTR + ch * 16) = a; *(LAS u32x4*)(Kb + k * RSTR + ch * 16) = d; }
#pragma unroll
        for (int i = 0; i < 4; ++i) { const int c = tid + 512 * i, k = c >> 4, ch = c & 15; *(LAS u32x4*)(Vt + k * VSTR128 + ch * 16) = vreg[i]; }
        __syncthreads();
        const int un = u + G;
        if (un < NU) R1_LOAD(un);
        const int dir = wid >> 2, mt = (wid >> 1) & 1, nt0 = (wid & 1) * 2;
        const LAS unsigned char* Kt = dir ? Kb : Kf;
        f32x16 acc0 = (f32x16){0.f}, acc1 = (f32x16){0.f};
#pragma unroll
        for (int ks = 0; ks < 8; ++ks) {
            const bf16x8 af = tr_frag(Kt, RSTR, ks, 32 * mt, lane);
            acc0 = MFMA32(af, tr_frag(Vt, VSTR128, ks, 32 * nt0, lane), acc0);
            acc1 = MFMA32(af, tr_frag(Vt, VSTR128, ks, 32 * nt0 + 32, lane), acc1);
        }
        bf16_t* out = kvT + ((size_t)(((b * 4 + h) * NCHK + ci) * 2 + dir)) * 8192;
#pragma unroll
        for (int j = 0; j < 4; ++j) {
            u32x2 w0, w1; w0.x = pk2(acc0[4 * j], acc0[4 * j + 1]); w0.y = pk2(acc0[4 * j + 2], acc0[4 * j + 3]); w1.x = pk2(acc1[4 * j], acc1[4 * j + 1]); w1.y = pk2(acc1[4 * j + 2], acc1[4 * j + 3]);
            *(u32x2*)(out + (size_t)(32 * nt0 + (lane & 31)) * 64 + 32 * mt + 8 * j + 4 * hi) = w0;
            *(u32x2*)(out + (size_t)(32 * nt0 + 32 + (lane & 31)) * 64 + 32 * mt + 8 * j + 4 * hi) = w1;
        }
        __syncthreads();
        if (un >= NU) break;
        u = un;
    }
#undef R1_LOAD
}
__device__ __forceinline__ void ret_scan(const bf16_t* kvT, bf16_t* SpT, const float* lg2  , int gtid, int gthreads) {
    for (int q = gtid; q < 64 * 2048; q += gthreads) {
        const int combo = q >> 11, e4 = (q & 2047) * 4, dir = combo & 1, h = (combo >> 1) & 3, b = combo >> 3;
        const float g128 = fexp2(128.0f * lg2[dir * 4 + h]);
        f32x4 S = {0.f, 0.f, 0.f, 0.f};
        for (int s = 0; s < NCHK; ++s) {
            const int ci = dir ? (s == 0 ? 1 : (s == 1 ? 0 : 35 - s)) : s;
            const size_t off = ((size_t)(((b * 4 + h) * NCHK + ci) * 2 + dir)) * 8192 + e4;
            const u32x2 kw = *(const u32x2*)(kvT + off); const f32x4 kv = {bf_lo(kw.x), bf_hi(kw.x), bf_lo(kw.y), bf_hi(kw.y)};
            u32x2 w; w.x = pk2(S[0], S[1]); w.y = pk2(S[2], S[3]);
            *(u32x2*)(SpT + off) = w;
            S = S * g128 + kv;
        }
    }
}
constexpr int R3_K = 0, R3_V = 128 * KSTR, R3_SF = R3_V + 128 * VSTR128, R3_SB = R3_SF + 128 * KSTR, R3_X = R3_SB + 128 * KSTR, R3_SCR = R3_X + 1024, R3_LDS = R3_SCR + 2048;
__device__ __forceinline__ void ret_out_unit(LAS unsigned char* lds, const bf16_t* __restrict__ proj, const bf16_t* __restrict__ SpT, bf16_t* ocat, float lgf2, float lgb2, int b, int h, int ci, int tid) {
    const int lane = tid & 63, r32 = lane & 31, hi = lane >> 5; const int wid = __builtin_amdgcn_readfirstlane(tid >> 6);
    const int row0 = chunk_row0(b, ci), qs = wid & 3, dh = wid >> 2;
    const bf16_t* sp = SpT + ((size_t)(((b * 4 + h) * NCHK + ci) * 2)) * 8192;
#pragma unroll
    for (int i = 0; i < 2; ++i) { const int c = tid + 512 * i, k = c >> 3, ch = c & 7;
        *(LAS u32x4*)(lds + R3_K + k * KSTR + ch * 16) = *(const u32x4*)(proj + (size_t)(row0 + k) * DINP + C_KB + h * 64 + ch * 8);
        *(LAS u32x4*)(lds + R3_SF + k * KSTR + ch * 16) = *(const u32x4*)(sp + (size_t)k * 64 + ch * 8);
        *(LAS u32x4*)(lds + R3_SB + k * KSTR + ch * 16) = *(const u32x4*)(sp + 8192 + (size_t)k * 64 + ch * 8); }
#pragma unroll
    for (int i = 0; i < 4; ++i) { const int c = tid + 512 * i, k = c >> 4, ch = c & 15;
        *(LAS u32x4*)(lds + R3_V + k * VSTR128 + ch * 16) = *(const u32x4*)(proj + (size_t)(row0 + k) * DINP + C_VB + h * 128 + ch * 8); }
    bf16x8 qr[4];
    { const bf16_t* qp = proj + (size_t)(row0 + 32 * qs + r32) * DINP + C_QB + h * 64;
#pragma unroll
      for (int d0 = 0; d0 < 4; ++d0) qr[d0] = *(const bf16x8*)(qp + d0 * 16 + hi * 8); }
    bf16_t gt[2][16];
    { const bf16_t* gp0 = proj + (size_t)(row0 + 32 * qs) * DINP + C_GB + h * 128 + 64 * dh + r32;
#pragma unroll
      for (int r = 0; r < 16; ++r)
#pragma unroll
          for (int c = 0; c < 2; ++c) gt[c][r] = gp0[(size_t)crow(r, hi) * DINP + 32 * c]; }
    __syncthreads();
    f32x16 o[2];
#pragma unroll
    for (int c = 0; c < 2; ++c) {
        f32x16 tf = (f32x16){0.f}, tb = (f32x16){0.f};
        const int srow = 64 * dh + 32 * c + r32;
#pragma unroll
        for (int d0 = 0; d0 < 4; ++d0) {
            tf = MFMA32(qr[d0], *(const LAS bf16x8*)(lds + R3_SF + srow * KSTR + (16 * d0 + 8 * hi) * 2), tf);
            tb = MFMA32(qr[d0], *(const LAS bf16x8*)(lds + R3_SB + srow * KSTR + (16 * d0 + 8 * hi) * 2), tb);
        }
#pragma unroll
        for (int r = 0; r < 16; ++r) { const int cp = 32 * qs + crow(r, hi); o[c][r] = fexp2((float)(cp + 1) * lgf2) * tf[r] + fexp2((float)(128 - cp) * lgb2) * tb[r]; }
    }
    const int qpos = 32 * qs + r32;
#pragma unroll 1
    for (int kt = 0; kt < 4; ++kt) {
        f32x16 p = (f32x16){0.f};
#pragma unroll
        for (int d0 = 0; d0 < 4; ++d0) p = MFMA32(*(const LAS bf16x8*)(lds + R3_K + (32 * kt + r32) * KSTR + (16 * d0 + 8 * hi) * 2), qr[d0], p);
#pragma unroll
        for (int r = 0; r < 16; ++r) { const int d = qpos - (32 * kt + crow(r, hi));
            const float wf = d >= 0 ? fexp2((float)d * lgf2) : 0.f, wb = d <= 0 ? fexp2((float)(-d) * lgb2) : 0.f; p[r] *= (wf + wb); }
        u32x4 w0, w1;
        w0.x = pk2(p[0], p[1]); w0.y = pk2(p[2], p[3]); w0.z = pk2(p[4], p[5]); w0.w = pk2(p[6], p[7]);
        w1.x = pk2(p[8], p[9]); w1.y = pk2(p[10], p[11]); w1.z = pk2(p[12], p[13]); w1.w = pk2(p[14], p[15]);
        const bf16x8 pa = __builtin_bit_cast(bf16x8, w0), pb = __builtin_bit_cast(bf16x8, w1);
#pragma unroll
        for (int c = 0; c < 2; ++c) {
            o[c] = MFMA32(pa, tr_frag(lds + R3_V, VSTR128, 2 * kt, 64 * dh + 32 * c, lane), o[c]);
            o[c] = MFMA32(pb, tr_frag(lds + R3_V, VSTR128, 2 * kt + 1, 64 * dh + 32 * c, lane), o[c]);
        }
    }
    float ss[16];
#pragma unroll
    for (int r = 0; r < 16; ++r) { ss[r] = o[0][r] * o[0][r] + o[1][r] * o[1][r];
#pragma unroll
        for (int s = 1; s < 32; s <<= 1) ss[r] += __shfl_xor(ss[r], s); }
    LAS float* X = (LAS float*)(lds + R3_X);
    if (r32 == 0) {
#pragma unroll
        for (int r = 0; r < 16; ++r) X[dh * 128 + 32 * qs + crow(r, hi)] = ss[r];
    }
    __syncthreads();
    bf16_t* op = ocat + (size_t)(row0 + 32 * qs) * OCW + 512 + h * 128 + 64 * dh + r32;
#pragma unroll
    for (int r = 0; r < 16; ++r) { const int row = crow(r, hi);
        const float rstd = __builtin_amdgcn_rsqf((X[32 * qs + row] + X[128 + 32 * qs + row]) * (1.0f / 128.0f) + NORM_EPS);
#pragma unroll
        for (int c = 0; c < 2; ++c) { const float gte = bf1(gt[c][r]);
            op[(size_t)row * OCW + 32 * c] = (bf16_t)(pk2(o[c][r] * rstd * siluf_(gte), 0.f) & 0xffffu); } }
    __syncthreads();
}
#undef MFMA32
}
constexpr size_t MiB = 1u << 20;
constexpr size_t WS_CTL = 0, CTL_ZERO_BYTES = 128 * 1024;
constexpr int CW_BAR = 1024;
constexpr int CW_MOE = 8192;
constexpr int CW_CUR = 12288;
constexpr int CW_DEP = 20480;
constexpr int CW_DONE = 16384;
constexpr size_t WS_TAB = 1 * MiB;
constexpr int TAB_MOD = 0, TAB_ROPE = DEPTH * 9 * 6144, TAB_LAM = TAB_ROPE + 2048, TAB_LG2 = TAB_LAM + 8, TAB_WSC = TAB_LG2 + 32;
constexpr size_t WS_XC = 2 * MiB;
constexpr size_t WS_ROUTE = 10 * MiB;
constexpr size_t WS_RS = 11 * MiB + 256 * 1024;
constexpr size_t WS_MIX = 12 * MiB, MIX_STRIDE = 19 * MiB;
constexpr size_t MIX_WB = 14 * MiB, MIX_WO = 17 * MiB;
constexpr size_t WS_FD = 88 * MiB, FD_STRIDE = 17 * MiB, FD_W2 = 11 * MiB;
constexpr size_t WS_W13 = 122 * MiB;
constexpr size_t WS_W2 = 210 * MiB;
constexpr size_t WS_H = 254 * MiB;
constexpr size_t WS_PROJ = 322 * MiB;
constexpr size_t WS_GATE = WS_PROJ + 256 * MiB;
constexpr size_t WS_OCAT = 782 * MiB;
constexpr size_t WS_Y = 884 * MiB;
constexpr size_t WS_END = 952 * MiB;
static_assert((size_t)DIN * DM * 2 <= MIX_WB && MIX_WB + (size_t)DM * OCW * 2 <= MIX_WO && MIX_WO + (size_t)DM * DM * 2 <= MIX_STRIDE && WS_MIX + DEPTH * MIX_STRIDE <= WS_FD, "ws map (mixer weights)");
static_assert((size_t)2 * DFF * DM * 2 <= FD_W2 && FD_W2 + (size_t)DM * DFF * 2 <= FD_STRIDE && WS_FD + 2 * FD_STRIDE <= WS_W13, "ws map (dense ffn weights)");
static_assert(WS_W13 + (size_t)NEXP * 2 * DFF * DM * 2 <= WS_W2 && WS_W2 + (size_t)NEXP * DM * DFF * 2 <= WS_H && WS_H + (size_t)TT * DM * 2 <= WS_PROJ, "ws map (moe weights, h)");
static_assert(WS_PROJ + (size_t)TT * DINP * 2 <= WS_GATE && WS_GATE + (size_t)3 * NMT * 4 * 8 * 16 * 64 * 16 <= WS_OCAT && WS_OCAT + (size_t)TT * OCW * 2 <= WS_Y && WS_Y + (size_t)TT * DM * 2 <= WS_END, "ws map (activations)");
constexpr int MOE_SLOTS = 2 * TT + NEXP * 256;
static_assert(WS_PROJ + (size_t)MOE_SLOTS * DFF * 2 <= WS_OCAT && WS_OCAT + (size_t)MOE_SLOTS * DM * 2 <= WS_END, "ws map (MoE overlays)");
static_assert((size_t)NB * 4 * NCHK * 2 * 8192 * 4 <= (size_t)TT * DM * 2 && (size_t)NB * 4 * NCHK * 2 * 8192 * 2 <= (size_t)TT * DM * 2, "ws map (retention overlays)");

#define XB_TMO      128
#define XB_XCNT(j)  (256  + 64 * (j))
#define XB_XSUB(j)  (1280 + 64 * (j))
#define XB_XGEN(j)  (2304 + 64 * (j))
#define XB_TOP      3328
#define XB_TOPGEN   3392
#define XCD_BAR_WORDS 3456
#define XB_SPIN_CAP (1u << 18)

__device__ __forceinline__ unsigned xb_ld(unsigned* p)              { return __hip_atomic_load(p, __ATOMIC_RELAXED, __HIP_MEMORY_SCOPE_AGENT); }
__device__ __forceinline__ unsigned xb_add(unsigned* p, unsigned v) { return __hip_atomic_fetch_add(p, v, __ATOMIC_RELAXED, __HIP_MEMORY_SCOPE_AGENT); }
__device__ __forceinline__ unsigned xb_xcc_id() { return (unsigned)__builtin_amdgcn_s_getreg((3 << 11) | 20) & 0xFu; }
#define XB_SPIN(cond, bar) do { unsigned _sp = 0; while (cond) { __builtin_amdgcn_s_sleep(1); \
    if ((++_sp & 255u) == 0u) { if (xb_ld(&(bar)[XB_TMO])) break; if (_sp > XB_SPIN_CAP) { atomicAdd(&(bar)[XB_TMO], 1u); break; } } } } while (0)

struct XcdBarrier {
    unsigned* bar; unsigned x;
    volatile LAS unsigned* st;
};
__device__ __forceinline__ XcdBarrier xcd_barrier_post(unsigned* bar, volatile LAS unsigned* st, int tid) {
    XcdBarrier b; b.bar = bar; b.x = xb_xcc_id(); b.st = st;
    if (tid == 0) (void)xb_add(&bar[XB_XCNT(b.x)], 1u);
    return b;
}
__device__ __forceinline__ void xcd_barrier_complete(unsigned* bar, unsigned x, unsigned& nloc, unsigned& nx) {
    const unsigned G = gridDim.x * gridDim.y * gridDim.z;
    unsigned sum, cnt, mine, sp = 0u;
    for (;;) {
        sum = 0u; cnt = 0u; mine = 0u;
#pragma unroll
        for (unsigned j = 0; j < 16; ++j) { const unsigned c = xb_ld(&bar[XB_XCNT(j)]); sum += c; cnt += (c > 0u) ? 1u : 0u; mine = (j == x) ? c : mine; }
        if (sum == G) break;
        __builtin_amdgcn_s_sleep(1);
        if ((++sp & 255u) == 0u) { if (xb_ld(&bar[XB_TMO])) break; if (sp > XB_SPIN_CAP) { atomicAdd(&bar[XB_TMO], 1u); break; } }
    }
    nloc = mine > 0u ? mine : 1u; nx = cnt > 0u ? cnt : 1u;
}
__device__ __forceinline__ void xcd_barrier(const XcdBarrier& b_in, int tid) {
    XcdBarrier b = b_in; b.x = xb_xcc_id();
    asm volatile("s_waitcnt vmcnt(0)" ::: "memory");
    __syncthreads();
    if (tid == 0) {
        unsigned* bar = b.bar; asm volatile("" : "+s"(bar));
        __builtin_amdgcn_s_waitcnt(0);
        unsigned nloc = b.st[0], nx = b.st[1];
        if (nloc == 0u) { xcd_barrier_complete(bar, b.x, nloc, nx); b.st[0] = nloc; b.st[1] = nx; }
        const unsigned old = xb_add(&bar[XB_XSUB(b.x)], 1u);
        const unsigned gen = old / nloc;
        if (old + 1u == (gen + 1u) * nloc) {
            __builtin_amdgcn_fence(__ATOMIC_RELEASE, "agent");
            asm volatile("s_waitcnt vmcnt(0)" ::: "memory");
            const unsigned og = xb_add(&bar[XB_TOP], 1u);
            const unsigned tg = og / nx;
            if (og + 1u == (tg + 1u) * nx) xb_add(&bar[XB_TOPGEN], 1u);
            else XB_SPIN(xb_ld(&bar[XB_TOPGEN]) == tg, bar);
            __builtin_amdgcn_fence(__ATOMIC_ACQUIRE, "agent");
            xb_add(&bar[XB_XGEN(b.x)], 1u);
            asm volatile("s_waitcnt vmcnt(0)" ::: "memory");
        } else {
            XB_SPIN(xb_ld(&bar[XB_XGEN(b.x)]) == gen, bar);
            __builtin_amdgcn_fence(__ATOMIC_ACQUIRE, "agent");
            asm volatile("s_waitcnt vmcnt(0)" ::: "memory");
        }
    }
    __syncthreads();
}
struct Route { int sa, sb; float ga, gb; int ea, pa, eb, pb; };

__device__ __forceinline__ void p0_mod(LAS unsigned char* lds, const float* c, const float* cctx, const float* wmod, const float* bmod, float* mod, int blk, int G, int tid) {
    LAS float* sc = (LAS float*)lds;
    LAS float* red = sc + 9 * 1024;
    for (int i = tid; i < 9 * 1024; i += 512) { const float v = i < 8192 ? c[i] : cctx[i - 8192]; sc[i] = siluf_(v); }
    __syncthreads();
    const int cq = tid & 31, kg = tid >> 5;
    for (int u = blk; u < DEPTH * 48; u += G) {
        const int l = u / 48, n = (u % 48) * 128 + 4 * cq;
        f32x4 acc[9];
#pragma unroll
        for (int r = 0; r < 9; ++r) acc[r] = (f32x4){0.f, 0.f, 0.f, 0.f};
        const float* wp = wmod + ((size_t)l * DM + kg * 64) * 6144 + n;
        for (int k0 = 0; k0 < 64; k0 += 16) {
            f32x4 w[16];
#pragma unroll
            for (int k = 0; k < 16; ++k) w[k] = *(const f32x4*)(wp + (size_t)(k0 + k) * 6144);
#pragma unroll
            for (int k = 0; k < 16; ++k)
#pragma unroll
                for (int r = 0; r < 9; ++r) acc[r] += w[k] * sc[r * 1024 + kg * 64 + k0 + k];
        }
#pragma unroll
        for (int r = 0; r < 9; ++r) *(LAS f32x4*)(red + ((kg * 32 + cq) * 9 + r) * 4) = acc[r];
        __syncthreads();
        if (tid < 32 * 9) { const int q = tid / 9, r = tid % 9; f32x4 s = {0.f, 0.f, 0.f, 0.f};
#pragma unroll
            for (int g = 0; g < 16; ++g) s += *(const LAS f32x4*)(red + ((g * 32 + q) * 9 + r) * 4);
            const int nn = (u % 48) * 128 + 4 * q;
            *(f32x4*)(mod + ((size_t)l * 9 + r) * 6144 + nn) = s + *(const f32x4*)(bmod + (size_t)l * 6144 + nn); }
        __syncthreads();
    }
}
__device__ __forceinline__ void p0_tables(float* tab, const float* dlam, const float* decf, const float* decb, int tid) {
    for (int i = tid; i < 1024; i += 512) { const int pos = i >> 4, f = i & 15;
        const float inv = 1.0f / powf(10000.0f, (float)f / 16.0f), ang = (float)pos * inv;
        tab[TAB_ROPE + 2 * i] = cosf(ang); tab[TAB_ROPE + 2 * i + 1] = sinf(ang); }
    if (tid < 4) { const float* lp = dlam + tid * 256; float s01 = 0.f, s23 = 0.f;
        for (int k = 0; k < 64; ++k) { s01 += lp[k] * lp[64 + k]; s23 += lp[128 + k] * lp[192 + k]; }
        const float li = 0.8f - 0.6f * expf(-0.3f * (float)tid);
        tab[TAB_LAM + 2 * tid] = expf(s01) - expf(s23) + li; tab[TAB_LAM + 2 * tid + 1] = 1.0f - li; }
    if (tid >= 64 && tid < 96) { const int i = tid - 64, l = i >> 3, dir = (i >> 2) & 1, h = i & 3;
        const float x = (dir ? decb : decf)[l * 4 + h];
        tab[TAB_LG2 + i] = -log1pf(expf(-x)) * LOG2E; }
}

__device__ __forceinline__ float sample_rms(const float* W, int n, LAS float* red, int tid) {
    const int stride = n / 16384 - 1; float s = 0.f; float v[32];
#pragma unroll
    for (int i = 0; i < 32; ++i) v[i] = W[(size_t)(tid * 32 + i) * stride];
#pragma unroll
    for (int i = 0; i < 32; ++i) s += v[i] * v[i];
    s = wave_sum(s);
    __syncthreads(); if ((tid & 63) == 0) red[tid >> 6] = s; __syncthreads();
    float t = 0.f;
#pragma unroll
    for (int w = 0; w < 8; ++w) t += red[w];
    __syncthreads();
    return sqrtf(t * (1.0f / 16384.0f));
}
__device__ __forceinline__ void cvt_item(const float* W, int ldw, int k0, int sc, bf16_t* WTrow0, int ldt, LAS float* scr, int lane) {
    float v[32];
#pragma unroll
    for (int i = 0; i < 32; ++i) v[i] = __builtin_nontemporal_load(W + (size_t)(k0 + 2 * i + (lane >> 5)) * ldw + sc);
#pragma unroll
    for (int i = 0; i < 32; ++i) scr[(2 * i + (lane >> 5)) * 33 + (lane & 31)] = v[i];
    LDS_WAIT(); asm volatile("" ::: "memory");
    const int c = lane & 7;
#pragma unroll
    for (int j = 0; j < 4; ++j) { const int n = (lane >> 3) + 8 * j; const LAS float* s = scr + (8 * c) * 33 + n;
        u32x4 o; o.x = pk2(s[0 * 33], s[1 * 33]); o.y = pk2(s[2 * 33], s[3 * 33]); o.z = pk2(s[4 * 33], s[5 * 33]); o.w = pk2(s[6 * 33], s[7 * 33]);
        *(u32x4*)(WTrow0 + (size_t)n * ldt + 8 * c) = o; }
    LDS_WAIT(); asm volatile("" ::: "memory");
}
template <bool I8>
__device__ __forceinline__ void cvt_item8(const float* W, int ldw, int k0, int sc, unsigned char* WTrow0, int ldt, float scale, LAS float* scr, int lane) {
    float v[32];
#pragma unroll
    for (int i = 0; i < 32; ++i) v[i] = __builtin_nontemporal_load(W + (size_t)(k0 + 2 * i + (lane >> 5)) * ldw + sc);
#pragma unroll
    for (int i = 0; i < 32; ++i) scr[(2 * i + (lane >> 5)) * 33 + (lane & 31)] = v[i] * scale;
    LDS_WAIT(); asm volatile("" ::: "memory");
    const int c = lane & 7;
#pragma unroll
    for (int j = 0; j < 4; ++j) { const int n = (lane >> 3) + 8 * j; const LAS float* s = scr + (8 * c) * 33 + n;
        u32x2 o;
        if constexpr (I8) {
#define CL_(x) __builtin_amdgcn_fmed3f((x), -127.0f, 127.0f)
            o.x = pk4i8(CL_(s[0 * 33]), CL_(s[1 * 33]), CL_(s[2 * 33]), CL_(s[3 * 33])); o.y = pk4i8(CL_(s[4 * 33]), CL_(s[5 * 33]), CL_(s[6 * 33]), CL_(s[7 * 33]));
#undef CL_
        } else { o.x = pk4f8(s[0 * 33], s[1 * 33], s[2 * 33], s[3 * 33]); o.y = pk4f8(s[4 * 33], s[5 * 33], s[6 * 33], s[7 * 33]); }
        *(u32x2*)(WTrow0 + (size_t)n * ldt + 8 * c) = o; }
    LDS_WAIT(); asm volatile("" ::: "memory");
}
__device__ __forceinline__ int win_src(int n) {
    const bool rp = (n < 640) || (n >= 768 && n < 1280) || (n >= 2304 && n < 3328);
    if (!rp) return n;
    const int p = n & 63, j = p >> 1, e = p & 1;
    return (n & ~63) + (j >> 4) * 32 + e * 16 + (j & 15);
}
constexpr int I_IN = 16 * 216, I_B = 3 * 8 * 32, I_O = 16 * 32, I_MIX = I_IN + I_B + I_O, I_F1 = 16 * 88, I_F2 = 44 * 32, I_FE = 2 * I_F1 + I_F2;
__device__ __forceinline__ void cvt_mix(const float* win, const float* wb, const float* wo, unsigned char* mixbase, int r, float qs_in, LAS float* scr, int lane) {
    bf16_t* WbT = (bf16_t*)(mixbase + MIX_WB); bf16_t* WoT = (bf16_t*)(mixbase + MIX_WO);
    if (r < I_IN) { const int kb = r / 216, nb = r % 216; cvt_item8<true>(win, DIN, 64 * kb, win_src(32 * nb + (lane & 31)), mixbase + (size_t)(32 * nb) * DM + 64 * kb, DM, qs_in, scr, lane); return; } r -= I_IN;
    if (r < I_B) { const int i = r / 256, q = r % 256, kb = q / 32, nb = q % 32;
        cvt_item(wb + (size_t)i * 512 * DM, DM, 64 * kb, 32 * nb + (lane & 31), WbT + (size_t)(32 * nb) * OCW + i * 512 + 64 * kb, OCW, scr, lane); return; } r -= I_B;
    { const int kb = r / 32, nb = r % 32; cvt_item(wo, DM, 64 * kb, 32 * nb + (lane & 31), WoT + (size_t)(32 * nb) * DM + 64 * kb, DM, scr, lane); }
}
__device__ __forceinline__ void cvt_ffn(const float* f1, const float* f3, const float* f2, unsigned char* w13, unsigned char* w2, int r, int f8, LAS float* scr, int lane) {
    if (r < 2 * I_F1) { const int which = r / I_F1, q = r % I_F1, kb = q / 88, nb = q % 88, j0 = 32 * nb;
        const int drow = (j0 >> 7) * 256 + which * 128 + (j0 & 127);
        if (f8) cvt_item8<false>(which ? f3 : f1, DFF, 64 * kb, j0 + (lane & 31), w13 + (size_t)drow * DM + 64 * kb, DM, F8_SW13, scr, lane);
        else cvt_item(which ? f3 : f1, DFF, 64 * kb, j0 + (lane & 31), (bf16_t*)w13 + (size_t)drow * DM + 64 * kb, DM, scr, lane);
        return; } r -= 2 * I_F1;
    { const int kb = r / 32, nb = r % 32;
        if (f8) cvt_item8<false>(f2, DM, 64 * kb, 32 * nb + (lane & 31), w2 + (size_t)(32 * nb) * DFF + 64 * kb, DFF, F8_SW2, scr, lane);
        else cvt_item(f2, DM, 64 * kb, 32 * nb + (lane & 31), (bf16_t*)w2 + (size_t)(32 * nb) * DFF + 64 * kb, DFF, scr, lane); }
}
constexpr int N_RANGES = 7;
__device__ __forceinline__ int range_items(int k) { return (k == 0 || k == 4) ? I_FE : (k == 3 || k == 6) ? NEXP * I_FE : I_MIX; }
__device__ __forceinline__ void range_item(int k, int r, LAS unsigned char* lds, unsigned char* ws, LAS float* scr, int lane);

__device__ __forceinline__ void norm_rows(LAS unsigned char* lds, const float* xinL, const float* xinC, float* xoutL, float* xoutC, const float* gain, const float* mod, const float* modc, int shoff,
                                          bf16_t* hout, int qmode, float* rsout, int nrows, int combine, const Route* route, const bf16_t* fbuf, const float* wrouter, int do_route, Route* route_out, unsigned* gcnt,
                                          int blk, int G, int wave, int lane, int tid) {
    LAS float* wr = (LAS float*)lds;
    LAS int* lcnt = (LAS int*)(lds + 32768);
    LAS int* rec = (LAS int*)(lds + 32768 + 64);
    if (do_route) { for (int i = tid; i < 8192; i += 512) wr[i] = wrouter[i]; }
    const int per = (nrows + G - 1) / G, r0 = blk * per, r1 = (r0 + per < nrows) ? r0 + per : nrows;
    for (int cs = r0; cs < r1; cs += 256) {
        const int ce = cs + 256 < r1 ? cs + 256 : r1;
        if (do_route) { if (tid < 8) lcnt[tid] = 0; __syncthreads(); }
        f32x4 vn[4];
#define NR_LOAD(rr) do { const float* xi_ = (rr) < TL ? xinL + (size_t)(rr) * DM : xinC + (size_t)((rr) - TL) * DM; \
            _Pragma("unroll") for (int j = 0; j < 4; ++j) vn[j] = *(const f32x4*)(xi_ + 4 * lane + 256 * j); } while (0)
        if (cs + wave < ce) NR_LOAD(cs + wave);
        for (int row = cs + wave; row < ce; row += 8) {
            const bool lat = row < TL; const int mb = lat ? (row >> 12) : 8;
            f32x4 v[4];
#pragma unroll
            for (int j = 0; j < 4; ++j) v[j] = vn[j];
            if (row + 8 < ce) NR_LOAD(row + 8);
            if (combine) {
                const Route rt = route[row]; const float* g2 = modc + mb * 6144 + 5120;
                float* xo = lat ? xoutL + (size_t)row * DM : xoutC + (size_t)(row - TL) * DM;
#pragma unroll
                for (int j = 0; j < 4; ++j) { const int col = 4 * lane + 256 * j;
                    const u32x2 fa = *(const u32x2*)(fbuf + (size_t)rt.sa * DM + col), fb = *(const u32x2*)(fbuf + (size_t)rt.sb * DM + col);
                    const f32x4 gg = *(const f32x4*)(g2 + col);
                    v[j][0] += gg[0] * (rt.ga * bf_lo(fa.x) + rt.gb * bf_lo(fb.x)); v[j][1] += gg[1] * (rt.ga * bf_hi(fa.x) + rt.gb * bf_hi(fb.x));
                    v[j][2] += gg[2] * (rt.ga * bf_lo(fa.y) + rt.gb * bf_lo(fb.y)); v[j][3] += gg[3] * (rt.ga * bf_hi(fa.y) + rt.gb * bf_hi(fb.y));
                    *(f32x4*)(xo + col) = v[j]; }
            }
            float s = 0.f;
#pragma unroll
            for (int j = 0; j < 4; ++j) s += (v[j][0] * v[j][0] + v[j][1] * v[j][1]) + (v[j][2] * v[j][2] + v[j][3] * v[j][3]);
            const float rstd = 1.0f / sqrtf(wave_sum(s) * (1.0f / DM) + NORM_EPS);
            const float* sh = mod + mb * 6144 + shoff; const float* scp = sh + 1024;
            float lg[8];
#pragma unroll
            for (int e = 0; e < 8; ++e) lg[e] = 0.f;
            float qs = 1.0f;
            if (qmode == 2) {
                float am = 0.f;
#pragma unroll
                for (int j = 0; j < 4; ++j) { const int col = 4 * lane + 256 * j;
                    const f32x4 gn = *(const f32x4*)(gain + col), s1 = *(const f32x4*)(scp + col), s0 = *(const f32x4*)(sh + col);
#pragma unroll
                    for (int k = 0; k < 4; ++k) am = fmaxf(am, fabsf(v[j][k] * rstd * gn[k] * (1.0f + s1[k]) + s0[k])); }
                am = fmaxf(wave_max(am), 1.0e-20f); qs = 127.0f / am;
                if (lane == 0) rsout[row] = am * (1.0f / 127.0f);
            }
#pragma unroll
            for (int j = 0; j < 4; ++j) { const int col = 4 * lane + 256 * j;
                const f32x4 gn = *(const f32x4*)(gain + col), s1 = *(const f32x4*)(scp + col), s0 = *(const f32x4*)(sh + col);
                f32x4 hv;
#pragma unroll
                for (int k = 0; k < 4; ++k) hv[k] = v[j][k] * rstd * gn[k] * (1.0f + s1[k]) + s0[k];
                if (qmode == 2) *(unsigned*)((unsigned char*)hout + (size_t)row * DM + col) = pk4i8(fminf(hv[0] * qs, 127.0f), fminf(hv[1] * qs, 127.0f), fminf(hv[2] * qs, 127.0f), fminf(hv[3] * qs, 127.0f));
                else if (qmode == 1) *(unsigned*)((unsigned char*)hout + (size_t)row * DM + col) = pk4f8(hv[0] * F8_SH, hv[1] * F8_SH, hv[2] * F8_SH, hv[3] * F8_SH);
                else { u32x2 w; w.x = pk2(hv[0], hv[1]); w.y = pk2(hv[2], hv[3]); *(u32x2*)(hout + (size_t)row * DM + col) = w; }
                if (do_route) {
#pragma unroll
                    for (int k = 0; k < 4; ++k) { const f32x4 wa = *(const LAS f32x4*)(wr + (col + k) * 8), wb = *(const LAS f32x4*)(wr + (col + k) * 8 + 4);
                        lg[0] += hv[k] * wa[0]; lg[1] += hv[k] * wa[1]; lg[2] += hv[k] * wa[2]; lg[3] += hv[k] * wa[3];
                        lg[4] += hv[k] * wb[0]; lg[5] += hv[k] * wb[1]; lg[6] += hv[k] * wb[2]; lg[7] += hv[k] * wb[3]; }
                }
            }
            if (do_route) {
#pragma unroll
                for (int e = 0; e < 8; ++e) lg[e] = wave_sum(lg[e]);
                if (lane == 0) {
                    int e1 = 0; float v1 = lg[0];
#pragma unroll
                    for (int e = 1; e < 8; ++e) if (lg[e] > v1) { v1 = lg[e]; e1 = e; }
                    int e2 = -1; float v2 = -3.0e38f;
#pragma unroll
                    for (int e = 0; e < 8; ++e) if (e != e1 && lg[e] > v2) { v2 = lg[e]; e2 = e; }
                    const float gb_ = 1.0f / (1.0f + __expf(v1 - v2)), ga_ = 1.0f - gb_;
                    const int i = row - cs;
                    rec[i * 6 + 0] = e1; rec[i * 6 + 1] = __hip_atomic_fetch_add(&lcnt[e1], 1, __ATOMIC_RELAXED, __HIP_MEMORY_SCOPE_WORKGROUP); rec[i * 6 + 2] = e2; rec[i * 6 + 3] = __hip_atomic_fetch_add(&lcnt[e2], 1, __ATOMIC_RELAXED, __HIP_MEMORY_SCOPE_WORKGROUP);
                    rec[i * 6 + 4] = __float_as_int(ga_); rec[i * 6 + 5] = __float_as_int(gb_);
                }
            }
        }
        if (do_route) {
            __syncthreads();
            if (tid < 8) lcnt[8 + tid] = (int)__hip_atomic_fetch_add(gcnt + 64 * tid, (unsigned)lcnt[tid], __ATOMIC_RELAXED, __HIP_MEMORY_SCOPE_AGENT);
            __syncthreads();
            for (int i = tid; i < ce - cs; i += 512) { Route rt; rt.sa = 0; rt.sb = 0;
                rt.ea = rec[i * 6 + 0]; rt.pa = lcnt[8 + rt.ea] + rec[i * 6 + 1]; rt.eb = rec[i * 6 + 2]; rt.pb = lcnt[8 + rt.eb] + rec[i * 6 + 3];
                rt.ga = __int_as_float(rec[i * 6 + 4]); rt.gb = __int_as_float(rec[i * 6 + 5]); route_out[cs + i] = rt; }
            __syncthreads();
        }
    }
}
__device__ __forceinline__ void moe_gather(const unsigned char* h2, unsigned char* hs, Route* route, unsigned* gcnt, int nrows, int gw, int ngw, int lane) {
    int off[8]; { int a = 0;
#pragma unroll
        for (int e = 0; e < 8; ++e) { off[e] = a; const int c = (int)__hip_atomic_load(gcnt + 64 * e, __ATOMIC_RELAXED, __HIP_MEMORY_SCOPE_AGENT); a += (c + 255) & ~255; } }
    u32x4 an; Route rn;
    if (gw < nrows) { rn = route[gw]; an = *(const u32x4*)(h2 + (size_t)gw * DM + 16 * lane); }
    for (int row = gw; row < nrows; row += ngw) {
        const Route rt = rn; const u32x4 a = an;
        if (row + ngw < nrows) { rn = route[row + ngw]; an = *(const u32x4*)(h2 + (size_t)(row + ngw) * DM + 16 * lane); }
        int oa = 0, ob = 0;
#pragma unroll
        for (int e = 0; e < 8; ++e) { oa = (rt.ea == e) ? off[e] : oa; ob = (rt.eb == e) ? off[e] : ob; }
        const int sa = oa + rt.pa, sb = ob + rt.pb;
        *(u32x4*)(hs + (size_t)sa * DM + 16 * lane) = a;
        *(u32x4*)(hs + (size_t)sb * DM + 16 * lane) = a;
        if (lane == 0) { route[row].sa = sa; route[row].sb = sb; }
    }
}
__device__ __forceinline__ void final_norm(float* x, const float* gain, const float* mod, const Route* route, const bf16_t* fbuf, int gw, int ngw, int lane) {
    for (int row = gw; row < TL; row += ngw) {
        const int mb = row >> 12; float* xr = x + (size_t)row * DM;
        const Route rt = route[row]; const float* g2 = mod + mb * 6144 + 5120;
        f32x4 v[4]; float s = 0.f;
#pragma unroll
        for (int j = 0; j < 4; ++j) { const int col = 4 * lane + 256 * j; v[j] = *(const f32x4*)(xr + col);
            const u32x2 fa = *(const u32x2*)(fbuf + (size_t)rt.sa * DM + col), fb = *(const u32x2*)(fbuf + (size_t)rt.sb * DM + col);
            const f32x4 gg = *(const f32x4*)(g2 + col);
            v[j][0] += gg[0] * (rt.ga * bf_lo(fa.x) + rt.gb * bf_lo(fb.x)); v[j][1] += gg[1] * (rt.ga * bf_hi(fa.x) + rt.gb * bf_hi(fb.x));
            v[j][2] += gg[2] * (rt.ga * bf_lo(fa.y) + rt.gb * bf_lo(fb.y)); v[j][3] += gg[3] * (rt.ga * bf_hi(fa.y) + rt.gb * bf_hi(fb.y));
            s += (v[j][0] * v[j][0] + v[j][1] * v[j][1]) + (v[j][2] * v[j][2] + v[j][3] * v[j][3]); }
        const float rstd = 1.0f / sqrtf(wave_sum(s) * (1.0f / DM) + NORM_EPS);
#pragma unroll
        for (int j = 0; j < 4; ++j) { const int col = 4 * lane + 256 * j; const f32x4 gn = *(const f32x4*)(gain + col); *(f32x4*)(xr + col) = v[j] * rstd * gn; }
    }
}
constexpr int NWAVES = 8;
constexpr int LDS_MISC = pg8::STAGE_BYTES + 2048, LDS_PTAB = LDS_MISC + 64;
constexpr int LDS_BYTES = pg8::STAGE_BYTES + 2048 + 1024;
static_assert(at::AT_A_LDS <= pg8::STAGE_BYTES && at::AT_C_LDS <= pg8::STAGE_BYTES + 2048 && at::R1_LDS <= pg8::STAGE_BYTES && at::R3_LDS <= pg8::STAGE_BYTES, "LDS");
constexpr int NPH = 11;
constexpr int N_PHASES = 1 + DEPTH * NPH + 1;

struct Args { const float* in[24]; float* out; unsigned char* ws; int ph_lo, ph_hi; };
static_assert(sizeof(Args) == 24 * 8 + 8 + 8 + 8, "Args has no padding");

__device__ __forceinline__ void* ldptr(LAS unsigned char* lds, int i) {
    const u32x2 v = *(const LAS u32x2*)(lds + LDS_PTAB + 8 * i);
    const unsigned lo = __builtin_amdgcn_readfirstlane(v.x), hi = __builtin_amdgcn_readfirstlane(v.y);
    GAS void* g = (GAS void*)(((unsigned long long)hi << 32) | lo);
    return (void*)g;
}
#define PIN(i) ((const float*)ldptr(lds, (i)))
#define PWS() ((unsigned char*)ldptr(lds, 25))
#define POUT() ((float*)ldptr(lds, 24))
__device__ __forceinline__ void range_item(int k, int r, LAS unsigned char* lds, unsigned char* ws, LAS float* scr, int lane) {
    if (k == 1 || k == 2 || k == 5) { const int l = (k == 5) ? 3 : k;
        cvt_mix(PIN(9) + (size_t)l * DM * DIN, PIN(15) + (size_t)l * 3 * 512 * DM, PIN(16) + (size_t)l * DM * DM, ws + WS_MIX + l * MIX_STRIDE, r, ((const float*)(ws + WS_TAB))[TAB_WSC + 2 * l], scr, lane); }
    else if (k == 0 || k == 4) { const int j = (k == 0) ? 0 : 1;
        cvt_ffn(PIN(17) + (size_t)j * DM * DFF, PIN(18) + (size_t)j * DM * DFF, PIN(19) + (size_t)j * DFF * DM, ws + WS_FD + j * FD_STRIDE, ws + WS_FD + j * FD_STRIDE + FD_W2, r, DENSE_F8, scr, lane); }
    else { const int j = (k == 3) ? 0 : 1, e = r / I_FE, rr = r % I_FE; const size_t eo = ((size_t)j * NEXP + e) * DM * DFF;
        cvt_ffn(PIN(21) + eo, PIN(22) + eo, PIN(23) + eo, ws + WS_W13 + (size_t)e * 2 * DFF * DM, ws + WS_W2 + (size_t)e * DM * DFF, rr, 1, scr, lane); }
}
__device__ __forceinline__ int range_base(int k) { return k == 0 ? 0 : k == 1 ? I_FE : k == 2 ? I_FE + I_MIX : k == 3 ? I_FE + 2 * I_MIX : k == 4 ? I_FE + 2 * I_MIX + NEXP * I_FE : k == 5 ? 2 * I_FE + 2 * I_MIX + NEXP * I_FE
                                                          : k == 6 ? 2 * I_FE + 3 * I_MIX + NEXP * I_FE : 2 * I_FE + 3 * I_MIX + 2 * NEXP * I_FE; }
__device__ __forceinline__ void bg_static(LAS unsigned char* lds, unsigned char* ws, int g0, int g1, int worker, int nworkers, int wave, int lane) {
    LAS float* scr = (LAS float*)lds + wave * (64 * 33);
    for (int g = g0 + worker; g < g1; g += nworkers) {
        int k = 0;
#pragma unroll
        for (int j = 1; j < N_RANGES; ++j) k += (g >= range_base(j)) ? 1 : 0;
        range_item(k, g - range_base(k), lds, ws, scr, lane);
    }
}
constexpr int WGM_MOE = 4;
constexpr int Q_B = 4, Q_F = 7, Q_G = 5, Q_I = 4, Q_J = 14;
#define TAIL_BOOK(nwg_in, quota, drain) const int tb_nwg = (nwg_in), tb_maxu = (tb_nwg + G - 1) / G, tb_nh = (tb_nwg % G == 0) ? G : tb_nwg - (tb_maxu - 1) * G, tb_nt = G - tb_nh; \
        const int tb_lim = range_base(kmax + 1), tb_g0 = gc; int tb_take = tb_nt * NWAVES * (quota); if (tb_take > tb_lim - gc) tb_take = tb_lim - gc; if (tb_take < 0) tb_take = 0; \
        const int tb_g1 = tb_g0 + tb_take; const int tb_e = (drain) >= 0 ? range_base((drain) + 1) : 0; const int tb_g2 = tb_e > tb_g1 ? tb_e : tb_g1; gc = tb_g2
#define TAIL_RUN() do { if (blk >= tb_nh && tb_take > 0) bg_static(lds, ws, tb_g0, tb_g1, (blk - tb_nh) * NWAVES + wave, tb_nt * NWAVES, wave, LANE()); \
        if (tb_g2 > tb_g1) bg_static(lds, ws, tb_g1, tb_g2, GW(), NGW(), wave, LANE()); } while (0)

__global__ void __launch_bounds__(NWAVES * 64, 2) mega(Args a) {
    extern __shared__ __attribute__((aligned(16))) unsigned char lds_raw[];
    LAS unsigned char* lds = (LAS unsigned char*)lds_raw;
    LAS unsigned char* const lds_k = lds;
#define LDSL() ({ LAS unsigned char* p_ = lds_k; asm volatile("" : "+s"(p_)); p_; })
    const int wave = __builtin_amdgcn_readfirstlane((int)threadIdx.x >> 6);
    const int G = gridDim.x, blk = blockIdx.x;
#define LANE0() ({ int t_; asm volatile("v_mbcnt_lo_u32_b32 %0, -1, 0\n\tv_mbcnt_hi_u32_b32 %0, -1, %0" : "=v"(t_)); t_; })
#define LANE() LANE0()
#define TID0() ((wave << 6) | LANE0())
#define TID() TID0()
    if (threadIdx.x == 0) {
        LAS unsigned long long* pt = (LAS unsigned long long*)(lds + LDS_PTAB);
#pragma unroll
        for (int i = 0; i < 24; ++i) pt[i] = (unsigned long long)a.in[i];
        pt[24] = (unsigned long long)a.out; pt[25] = (unsigned long long)a.ws;
        ((LAS unsigned*)(lds + LDS_MISC))[0] = 0u; ((LAS unsigned*)(lds + LDS_MISC))[1] = 0u; ((LAS unsigned*)(lds + LDS_MISC))[2] = 0u; ((LAS unsigned*)(lds + LDS_MISC))[3] = 0u;
    }
    __syncthreads();
#if MK_SINGLE
    (void)xcd_barrier_post((unsigned*)PWS() + CW_BAR, (volatile LAS unsigned*)(lds + LDS_MISC), TID());
#define GRID_BAR() do { XcdBarrier b_; b_.bar = (unsigned*)PWS() + CW_BAR; b_.x = 0; b_.st = (volatile LAS unsigned*)(lds_k + LDS_MISC); xcd_barrier(b_, TID()); } while (0)
#else
#define GRID_BAR() do { } while (0)
#endif
#if !MK_SINGLE
    const int lo = a.ph_lo, hi = a.ph_hi;
#endif
#ifndef PROBE_MASK
#define PROBE_MASK 0xffff
#endif
#define EN(k) (((PROBE_MASK) >> ((k) >= 100 ? (k) - 89 : (k))) & 1)
#if MK_SINGLE
#define IN(k) true
#else
#define IN(k) (lo <= (k) && (k) < hi)
#endif
#define SEAM(k) do { if (IN(k) && IN((k) + 1)) GRID_BAR(); } while (0)
#define LAUNDER_S(x) ({ int x_ = (x); asm volatile("" : "+s"(x_)); x_; })
#ifndef PROBE_DUP
#define PROBE_DUP 0
#endif
#define DUP(k) (1 + (((PROBE_DUP) >> (k)) & 1))
#define GW() (blk * NWAVES + wave)
#define NGW() (G * NWAVES)

    if (IN(0) && EN(100)) { LAS unsigned char* lds = LDSL();
        float* tab = (float*)(PWS() + WS_TAB);
        p0_mod(lds, PIN(1), PIN(3), PIN(4), PIN(5), tab + TAB_MOD, blk, G, TID());
        if (blk == G - 1) p0_tables(tab, PIN(13), PIN(11), PIN(12), TID());
        __syncthreads();
        const float rms0 = fmaxf(sample_rms(PIN(9), DM * DIN, (LAS float*)(lds + 32768), TID()), 1.0e-30f), qs0 = 127.0f / (I8_CLIP * rms0);
        if (blk == 0 && TID() == 0) { tab[TAB_WSC] = qs0; tab[TAB_WSC + 1] = 1.0f / qs0; }
        if (blk >= 1 && blk < DEPTH) { const float r = fmaxf(sample_rms(PIN(9) + (size_t)blk * DM * DIN, DM * DIN, (LAS float*)(lds + 32768), TID()), 1.0e-30f), q = 127.0f / (I8_CLIP * r);
            if (TID() == 0) { tab[TAB_WSC + 2 * blk] = q; tab[TAB_WSC + 2 * blk + 1] = 1.0f / q; } }
        {
            unsigned char* ws = PWS(); LAS float* scr = (LAS float*)lds + wave * (64 * 33); const int ln = LANE();
            for (int it = (G - 1 - blk) * NWAVES + wave; it < I_MIX; it += NGW()) cvt_mix(PIN(9), PIN(15), PIN(16), ws + WS_MIX, it, qs0, scr, ln);
        }
    }
    SEAM(0);

    int gc = 0;
    for (int l = 0; l < DEPTH; ++l) {
        const int pb = 1 + l * NPH;
        const bool moe = (l & 1) != 0, last = (l == DEPTH - 1), first = (l == 0);
        const int nrows = last ? TL : TT;
        const int kmax = l <= 1 ? 5 : 6;
        if (IN(pb + 0) && EN(0)) { LAS unsigned char* lds = LDSL();
            unsigned char* ws = PWS();
            __syncthreads();
            const bool comb = (l == 2);
            const float* modl = (const float*)(ws + WS_TAB) + TAB_MOD + (size_t)l * 9 * 6144;
            float* xL = POUT(); float* xc = (float*)(ws + WS_XC);
            for (int dup = 0; dup < (comb ? 1 : DUP(8)); ++dup) norm_rows(lds, first ? PIN(0) : xL, first ? PIN(2) : xc, xL, xc, PIN(6) + l * DM, modl, modl - 9 * 6144, 0, (bf16_t*)(ws + WS_H), 2, (float*)(ws + WS_RS), TT, comb ? 1 : 0,
                      (const Route*)(ws + WS_ROUTE), (const bf16_t*)(ws + WS_OCAT), nullptr, 0, nullptr, nullptr, blk, G, wave, LANE(), TID());
        }
        SEAM(pb + 0);
        { TAIL_BOOK(last ? (TL / 256) * (DIN / 256) + 64 : (TT / 256) * (DIN / 256), Q_B, -1);
        if (IN(pb + 1) && EN(1)) { LAS unsigned char* lds = LDSL();
            unsigned char* ws = PWS();
            pg8::Gemm g{(const bf16_t*)(ws + WS_H), (const bf16_t*)(ws + WS_MIX + l * MIX_STRIDE), DM / 2}; pg8::GSched S; S.init(last ? TL / 256 : TT / 256, DIN / 256, LAUNDER_S(G), LAUNDER_S(blk));
            if (last) { S.nx = 64; S.nwg += 64; S.xtab = 0xEDCB6542ull; }
            pg8::EpiProj E{(bf16_t*)(ws + WS_PROJ), (const float*)(ws + WS_TAB) + TAB_ROPE, (u32x2*)(ws + WS_GATE), (const float*)(ws + WS_RS), ((const float*)(ws + WS_TAB))[TAB_WSC + 2 * l + 1]};
            pg8::gemm_phase<pg8::EpiProj, pg8::GSched, true, true, 2>(lds, g, S, E, TID());
            TAIL_RUN();
        } }
        SEAM(pb + 1);
        if (IN(pb + 2) && EN(2)) { LAS unsigned char* lds = LDSL();
            unsigned char* ws = PWS(); const float* lg2 = (const float*)(ws + WS_TAB) + TAB_LG2 + l * 8;
            for (int dup = 0; dup < DUP(10); ++dup) at::ret_kv_phase(lds, (const bf16_t*)(ws + WS_PROJ), (bf16_t*)(ws + WS_Y), lg2, blk, G, TID());
        }
        SEAM(pb + 2);
        if (IN(pb + 3) && EN(3)) for (int dup = 0; dup < DUP(11); ++dup) { unsigned char* ws = PWS(); at::ret_scan((const bf16_t*)(ws + WS_Y), (bf16_t*)(ws + WS_H), (const float*)(ws + WS_TAB) + TAB_LG2 + l * 8, blk * 512 + TID(), G * 512); }
        SEAM(pb + 3);
        if (IN(pb + 4) && EN(4)) { LAS unsigned char* lds = LDSL();
            {
                unsigned char* ws = PWS(); const float* tab = (const float*)(ws + WS_TAB);
                const float lam = tab[TAB_LAM + 2 * l], oml = tab[TAB_LAM + 2 * l + 1]; const float* dn = PIN(14) + l * 128;
                for (int dup = 0; dup < DUP(0); ++dup) for (int r = blk; r < 1024; r += G) { const int rnd = r >> 8, bi = r & 255, bh = rnd * 8 + (bi & 7), qb = bi >> 3;
                    at::attnC_unit(lds, (const bf16_t*)(ws + WS_PROJ), (bf16_t*)(ws + WS_OCAT), dn, lam, oml, bh >> 2, bh & 3, qb, 1, TID()); }
                if (!last) for (int r = blk; r < 64; r += G) { const int bh = r >> 1, qb = r & 1;
                    at::attnC_unit(lds, (const bf16_t*)(ws + WS_PROJ), (bf16_t*)(ws + WS_OCAT), dn, lam, oml, bh >> 2, bh & 3, qb, 0, TID()); }
            }
            {
                unsigned char* ws = PWS(); const float* lg2 = (const float*)(ws + WS_TAB) + TAB_LG2 + l * 8;
                const int nR = last ? NB * 4 * 32 : NB * 4 * NCHK;
                for (int dup = 0; dup < DUP(3); ++dup) for (int r = blk; r < nR; r = (r + G < (nR / G) * G) ? r + G : (r < (nR / G) * G ? (nR / G) * G + ((blk + G - 64) % G) : nR)) { int bh, ci; if (last) { bh = r >> 5; ci = 2 + (r & 31); } else { bh = r / NCHK; ci = r % NCHK; }
                    at::ret_out_unit(lds, (const bf16_t*)(ws + WS_PROJ), (const bf16_t*)(ws + WS_H), (bf16_t*)(ws + WS_OCAT), lg2[bh & 3], lg2[4 + (bh & 3)], bh >> 2, bh & 3, ci, TID()); }
            }
            {
                unsigned char* ws = PWS(); const float* sink = PIN(10) + l * 8;
                for (int dup = 0; dup < DUP(13); ++dup) for (int r = blk; r < 1024; r += G) { const int bg = r >> 6, qb = r & 63; at::attnA_unit(lds, (const bf16_t*)(ws + WS_PROJ), (bf16_t*)(ws + WS_OCAT), sink, bg >> 1, bg & 1, qb, 1, TID()); }
                if (!last) for (int r = (blk + G - 128) % G; r < 64; r += G) { const int bg = r >> 2, qb = r & 3; at::attnA_unit(lds, (const bf16_t*)(ws + WS_PROJ), (bf16_t*)(ws + WS_OCAT), sink, bg >> 1, bg & 1, qb, 0, TID()); }
            }
        }
        SEAM(pb + 4);
#ifdef PROBE_XBAR
        for (int xb_ = 0; xb_ < PROBE_XBAR; ++xb_) GRID_BAR();
#endif
        { TAIL_BOOK((nrows / 256) * (DM / 256), Q_F, -1);
        if (IN(pb + 5) && EN(5)) { LAS unsigned char* lds = LDSL();
            unsigned char* ws = PWS();
            pg8::Gemm g{(const bf16_t*)(ws + WS_OCAT), (const bf16_t*)(ws + WS_MIX + l * MIX_STRIDE + MIX_WB), OCW}; pg8::GSched S; S.init(nrows / 256, DM / 256, LAUNDER_S(G), LAUNDER_S(blk));
            pg8::EpiMerge E{(bf16_t*)(ws + WS_Y), (const u32x2*)(ws + WS_GATE)};
            pg8::gemm_phase<pg8::EpiMerge, pg8::GSched, true, true>(lds, g, S, E, TID());
            TAIL_RUN();
        } }
        SEAM(pb + 5);
        { TAIL_BOOK((nrows / 256) * (DM / 256), Q_G, (l == 0 ? 0 : l == 1 ? 3 : l == 2 ? 4 : 6));
        if (IN(pb + 6) && EN(6)) { LAS unsigned char* lds = LDSL();
            unsigned char* ws = PWS(); float* xL = POUT(); float* xc = (float*)(ws + WS_XC);
            pg8::Gemm g{(const bf16_t*)(ws + WS_Y), (const bf16_t*)(ws + WS_MIX + l * MIX_STRIDE + MIX_WO), DM}; pg8::GSched S; S.init(nrows / 256, DM / 256, LAUNDER_S(G), LAUNDER_S(blk));
            pg8::EpiRes E{first ? PIN(0) : xL, first ? PIN(2) : xc, xL, xc, (const float*)(ws + WS_TAB) + TAB_MOD + (size_t)l * 9 * 6144, 2048, 1.0f};
            pg8::gemm_phase<pg8::EpiRes, pg8::GSched, true, true>(lds, g, S, E, TID());
            TAIL_RUN();
        } }
        SEAM(pb + 6);
        if (IN(pb + 7) && EN(7)) { LAS unsigned char* lds = LDSL();
            unsigned char* ws = PWS(); float* xL = POUT(); float* xc = (float*)(ws + WS_XC);
            const float* modl = (const float*)(ws + WS_TAB) + TAB_MOD + (size_t)l * 9 * 6144;
            for (int dup = 0; dup < (moe ? 1 : DUP(9)); ++dup) norm_rows(lds, xL, xc, xL, xc, PIN(7) + l * DM, modl, modl, 3072, (bf16_t*)(ws + WS_H), (moe || DENSE_F8) ? 1 : 0, nullptr, nrows, 0, (const Route*)(ws + WS_ROUTE), (const bf16_t*)(ws + WS_OCAT),
                      moe ? PIN(20) + (size_t)(l >> 1) * DM * NEXP : nullptr, moe ? 1 : 0, (Route*)(ws + WS_ROUTE), (unsigned*)ws + CW_MOE + (l >> 1) * 1024, blk, G, wave, LANE(), TID());
        }
        SEAM(pb + 7);
        if (!moe) {
            { TAIL_BOOK((nrows / 256) * (2 * DFF / 256), Q_I, -1);
            if (IN(pb + 9) && EN(9)) { LAS unsigned char* lds = LDSL();
                unsigned char* ws = PWS();
                pg8::Gemm g{(const bf16_t*)(ws + WS_H), (const bf16_t*)(ws + WS_FD + (l >> 1) * FD_STRIDE), DENSE_F8 ? DM / 2 : DM}; pg8::GSched S; S.init(nrows / 256, 2 * DFF / 256, LAUNDER_S(G), LAUNDER_S(blk));
                if constexpr (DENSE_F8) { pg8::EpiSwiglu E{ws + WS_PROJ}; pg8::gemm_phase<pg8::EpiSwiglu, pg8::GSched, true, true, 1>(lds, g, S, E, TID()); }
                else { pg8::EpiSwigluB E{(bf16_t*)(ws + WS_PROJ)}; pg8::gemm_phase<pg8::EpiSwigluB, pg8::GSched, true, true, 0>(lds, g, S, E, TID()); }
                TAIL_RUN();
            } }
            SEAM(pb + 9);
            { TAIL_BOOK((nrows / 256) * (DM / 256), Q_J, (l == 0 ? 1 : 5));
            if (IN(pb + 10) && EN(10)) { LAS unsigned char* lds = LDSL();
                unsigned char* ws = PWS(); float* xL = POUT(); float* xc = (float*)(ws + WS_XC);
                pg8::Gemm g{(const bf16_t*)(ws + WS_PROJ), (const bf16_t*)(ws + WS_FD + (l >> 1) * FD_STRIDE + FD_W2), DENSE_F8 ? DFF / 2 : DFF}; pg8::GSched S; S.init(nrows / 256, DM / 256, LAUNDER_S(G), LAUNDER_S(blk));
                pg8::EpiRes E{xL, xc, xL, xc, (const float*)(ws + WS_TAB) + TAB_MOD + (size_t)l * 9 * 6144, 5120, DENSE_F8 ? F8_INV2 : 1.0f};
                pg8::gemm_phase<pg8::EpiRes, pg8::GSched, true, true, DENSE_F8 ? 1 : 0>(lds, g, S, E, TID());
                TAIL_RUN();
            } }
            SEAM(pb + 10);
        } else {
            if (IN(pb + 8) && EN(8)) for (int dup = 0; dup < DUP(12); ++dup) { unsigned char* ws = PWS(); moe_gather(ws + WS_H, ws + WS_OCAT, (Route*)(ws + WS_ROUTE), (unsigned*)ws + CW_MOE + (l >> 1) * 1024, nrows, GW(), NGW(), LANE()); }
            SEAM(pb + 8);
            if (IN(pb + 9) && EN(9)) { LAS unsigned char* lds = LDSL();
                unsigned char* ws = PWS(); unsigned* gcnt = (unsigned*)ws + CW_MOE + (l >> 1) * 1024;
                pg8::GSched S; LAS int* tsl = (LAS int*)(lds + LDS_MISC + 512);
                if (TID() == 0) { int a0 = 0;
                    for (int e = 0; e < 8; ++e) { tsl[e] = a0; const int c = (int)__hip_atomic_load(gcnt + 64 * e, __ATOMIC_RELAXED, __HIP_MEMORY_SCOPE_AGENT); a0 += (c + 255) >> 8; }
                    tsl[8] = a0; }
                __syncthreads();
                S.ts = tsl; S.nM = __builtin_amdgcn_readfirstlane(tsl[8]); S.nN = 2 * DFF / 256; S.nwg = S.nM * S.nN; S.G = LAUNDER_S(G); S.c = LAUNDER_S(blk); S.wgm = WGM_MOE; S.nx = 0; S.xtab = 0; S.grouped = 1; S.bstride = (size_t)DFF * DM;
                pg8::Gemm g{(const bf16_t*)(ws + WS_OCAT), (const bf16_t*)(ws + WS_W13), DM / 2}; pg8::EpiSwiglu E{ws + WS_PROJ};
                pg8::gemm_phase<pg8::EpiSwiglu, pg8::GSched, true, true, 1>(lds, g, S, E, TID());
            }
            SEAM(pb + 9);
            if (IN(pb + 10) && EN(10)) { LAS unsigned char* lds = LDSL();
                unsigned char* ws = PWS(); unsigned* gcnt = (unsigned*)ws + CW_MOE + (l >> 1) * 1024;
                pg8::GSched S; LAS int* tsl = (LAS int*)(lds + LDS_MISC + 512);
                if (TID() == 0) { int a0 = 0;
                    for (int e = 0; e < 8; ++e) { tsl[e] = a0; const int c = (int)__hip_atomic_load(gcnt + 64 * e, __ATOMIC_RELAXED, __HIP_MEMORY_SCOPE_AGENT); a0 += (c + 255) >> 8; }
                    tsl[8] = a0; }
                __syncthreads();
                S.ts = tsl; S.nM = __builtin_amdgcn_readfirstlane(tsl[8]); S.nN = DM / 256; S.nwg = S.nM * S.nN; S.G = LAUNDER_S(G); S.c = LAUNDER_S(blk); S.wgm = WGM_MOE; S.nx = 0; S.xtab = 0; S.grouped = 1; S.bstride = (size_t)DM * DFF / 2;
                pg8::Gemm g{(const bf16_t*)(ws + WS_PROJ), (const bf16_t*)(ws + WS_W2), DFF / 2}; pg8::EpiBf16 E{(bf16_t*)(ws + WS_OCAT), DM, F8_INV2};
                pg8::gemm_phase<pg8::EpiBf16, pg8::GSched, true, true, 1>(lds, g, S, E, TID());
            }
            SEAM(pb + 10);
        }
    }
    if (IN(1 + DEPTH * NPH) && EN(101)) { LAS unsigned char* lds = LDSL(); unsigned char* ws = PWS();
        final_norm(POUT(), PIN(8), (const float*)(ws + WS_TAB) + TAB_MOD + (size_t)3 * 9 * 6144, (const Route*)(ws + WS_ROUTE), (const bf16_t*)(ws + WS_OCAT), GW(), NGW(), LANE()); }
#undef IN
#undef SEAM
}

extern "C" void kernel_launch(void* const* d_in, const int* in_sizes, int n_in, void* d_out, int out_size, void* d_ws, size_t ws_size, hipStream_t stream) {
    static int grid = 0;
    if (grid == 0) {
        if (n_in != 24 || out_size != TL * DM || ws_size < WS_END) { fprintf(stderr, "kernel_launch: unexpected shapes (n_in %d, out %d, ws %zu)\n", n_in, out_size, ws_size); grid = -1; return; }
        int dev = 0, cus = 0, per_cu = 0;
        if (hipGetDevice(&dev) != hipSuccess || hipDeviceGetAttribute(&cus, hipDeviceAttributeMultiprocessorCount, dev) != hipSuccess) { grid = -1; return; }
        if (hipFuncSetAttribute((const void*)mega, hipFuncAttributeMaxDynamicSharedMemorySize, LDS_BYTES) != hipSuccess) { fprintf(stderr, "kernel_launch: hipFuncSetAttribute failed\n"); grid = -1; return; }
        if (hipOccupancyMaxActiveBlocksPerMultiprocessor(&per_cu, (const void*)mega, NWAVES * 64, LDS_BYTES) != hipSuccess || per_cu < 1) { fprintf(stderr, "kernel_launch: occupancy query reports %d\n", per_cu); }
        (void)hipGetLastError();
        grid = cus;
    }
    if (grid < 0) return;
    if (hipMemsetAsync((char*)d_ws + WS_CTL, 0, CTL_ZERO_BYTES, stream) != hipSuccess) return;
    Args a{};
    for (int i = 0; i < 24; ++i) a.in[i] = (const float*)d_in[i];
    a.out = (float*)d_out; a.ws = (unsigned char*)d_ws;
#if MK_SINGLE
    a.ph_lo = 0; a.ph_hi = N_PHASES;
    hipLaunchKernelGGL(mega, dim3(grid), dim3(NWAVES * 64), LDS_BYTES, stream, a);
#else
    for (int p = 0; p < N_PHASES; ++p) {
        const int k = (p - 1) % NPH, l = (p - 1) / NPH;
        if (p >= 1 && p < 1 + DEPTH * NPH && k == 8 && !(l & 1)) continue;
        a.ph_lo = p; a.ph_hi = p + 1;
        hipLaunchKernelGGL(mega, dim3(grid), dim3(NWAVES * 64), LDS_BYTES, stream, a);
    }
#endif
}
```

```cpp
#include <hip/hip_runtime.h>
#include <cstdio>
#include <cstdint>

#ifndef MK_SINGLE
#define MK_SINGLE 1
#endif

#define LAS __attribute__((address_space(3)))
#define GAS __attribute__((address_space(1)))

typedef unsigned short bf16_t;
typedef short bf16x8 __attribute__((ext_vector_type(8)));
typedef short s16x4 __attribute__((ext_vector_type(4)));
typedef float f32x2 __attribute__((ext_vector_type(2)));
typedef float f32x4 __attribute__((ext_vector_type(4)));
typedef float f32x16 __attribute__((ext_vector_type(16)));
typedef unsigned u32x2 __attribute__((ext_vector_type(2)));
typedef unsigned u32x4 __attribute__((ext_vector_type(4)));
typedef int i32x4 __attribute__((ext_vector_type(4)));
typedef int i32x8 __attribute__((ext_vector_type(8)));
typedef __bf16 bf16x2_t __attribute__((ext_vector_type(2)));

constexpr int DM = 1024, NB = 8, SEQ = 4096, CTXL = 256, DEPTH = 4;
constexpr int TL = NB * SEQ;
constexpr int TC = NB * CTXL;
constexpr int TT = TL + TC;
constexpr int DIN = 6912, DFF = 2816, NEXP = 8, OCW = 1536;
constexpr int DINP = 3840;
constexpr int NMT = 136;
constexpr int C_QA = 0, C_KA = 512, C_VA = 640, C_QB = 768, C_KB = 1024, C_VB = 1280, C_GB = 1792, C_QD = 2304, C_KD = 2816, C_VD = 3328, C_GL = 3840;
constexpr float NORM_EPS = 1e-6f;
constexpr float SM_C2 = 0.125f * 1.4426950408889634f;
constexpr float LOG2E = 1.4426950408889634f;
constexpr int NCHK = 34;

__device__ __forceinline__ unsigned pk2(float lo, float hi) { f32x2 v = {lo, hi}; bf16x2_t b = __builtin_convertvector(v, bf16x2_t); return __builtin_bit_cast(unsigned, b); }
constexpr int DENSE_F8 = 0;
constexpr float F8_SH = 8.0f, F8_SW13 = 256.0f, F8_SU = 8.0f, F8_SW2 = 256.0f, F8_INV13 = 1.0f / (F8_SH * F8_SW13), F8_INV2 = 1.0f / (F8_SU * F8_SW2);
__device__ __forceinline__ unsigned pk4f8(float a, float b, float c, float d) {
    a = __builtin_amdgcn_fmed3f(a, -448.0f, 448.0f); b = __builtin_amdgcn_fmed3f(b, -448.0f, 448.0f); c = __builtin_amdgcn_fmed3f(c, -448.0f, 448.0f); d = __builtin_amdgcn_fmed3f(d, -448.0f, 448.0f);
    int w = __builtin_amdgcn_cvt_pk_fp8_f32(a, b, 0, false); w = __builtin_amdgcn_cvt_pk_fp8_f32(c, d, w, true); return (unsigned)w;
}
constexpr float I8_CLIP = 4.0f;
__device__ __forceinline__ unsigned pk4i8(float a, float b, float c, float d) {
    const float M = 12582912.0f;
    const unsigned ua = __float_as_uint(a + M), ub = __float_as_uint(b + M), uc = __float_as_uint(c + M), ud = __float_as_uint(d + M);
    return __builtin_amdgcn_perm(ub, ua, 0x0c0c0400u) | __builtin_amdgcn_perm(ud, uc, 0x04000c0cu);
}
__device__ __forceinline__ f32x4 acc_i2f(const f32x4& a) { return __builtin_convertvector(__builtin_bit_cast(i32x4, a), f32x4); }
__device__ __forceinline__ float wave_max(float v) {
#pragma unroll
    for (int o = 1; o < 64; o <<= 1) v = fmaxf(v, __shfl_xor(v, o));
    return v;
}
__device__ __forceinline__ float bf_lo(unsigned u) { return __uint_as_float(u << 16); }
__device__ __forceinline__ float bf_hi(unsigned u) { return __uint_as_float(u & 0xffff0000u); }
__device__ __forceinline__ float bf1(bf16_t u) { return __uint_as_float(((unsigned)u) << 16); }
__device__ __forceinline__ float wave_sum(float v) {
#pragma unroll
    for (int o = 1; o < 64; o <<= 1) v += __shfl_xor(v, o);
    return v;
}
__device__ __forceinline__ float fexp2(float x) { return __builtin_amdgcn_exp2f(x); }
__device__ __forceinline__ float sigmoidf_(float x) { return __builtin_amdgcn_rcpf(1.0f + __builtin_amdgcn_exp2f(-LOG2E * x)); }
__device__ __forceinline__ float siluf_(float x) { return x * __builtin_amdgcn_rcpf(1.0f + __builtin_amdgcn_exp2f(-LOG2E * x)); }
#define LDS_WAIT() asm volatile("s_waitcnt lgkmcnt(0)" ::: "memory")
#define VM_WAIT() asm volatile("s_waitcnt vmcnt(0)" ::: "memory")

namespace pg8 {
#define PG8_LAS __attribute__((address_space(3)))
constexpr int BM = 256, BK = 64, HALF = 128, HTB = HALF * BK * 2  , STAGE_BYTES = 8 * HTB, NXCD = 8, WGM = 8;

__host__ __device__ __forceinline__ int lds_byte(int r, int c) { const int st = (r >> 4) * 2 + (c >> 5), rr = r & 15, cc = c & 31, ob = rr * 64 + cc * 2; return st * 1024 + (ob ^ (((ob >> 9) & 1) << 5)); }
__host__ __device__ __forceinline__ void stage_rc(int b, int& R, int& C) { const int st = b / 1024, sb = b % 1024, swz = sb ^ (((sb >> 9) & 1) << 5); R = (st >> 1) * 16 + swz / 64; C = (st & 1) * 32 + (swz % 64) / 2; }
__host__ __device__ __forceinline__ int perm32(int rho) { const int n = rho >> 4, i = rho & 15; return 8 * (i >> 2) + 4 * n + (i & 3); }

struct Unit { int pm, pn; size_t bo; int ge; };
struct Gemm { const bf16_t* A; const bf16_t* Bt; int K; };

struct GSched {
    int nM, nN, nwg, G, c, wgm; int grouped; size_t bstride; const PG8_LAS int* ts;
    int nx; unsigned long long xtab;
    __device__ __forceinline__ void init(int nM_, int nN_, int G_, int c_, int wgm_ = 4) { nM = nM_; nN = nN_; nwg = nM * nN; G = G_; c = c_; wgm = wgm_; grouped = 0; bstride = 0; ts = nullptr; nx = 0; xtab = 0; }
    __device__ __forceinline__ bool next(int i, Unit& u) const {
        const long L = (long)i * G + c; if (L >= nwg) return false;
        const int nmain = nwg - nx;
        u.ge = 0; if (L >= nmain) { const int j = (int)L - nmain; u.pm = nM + (j >> 3); u.pn = (int)((xtab >> (4 * (j & 7))) & 15ull); u.bo = 0; return true; }
        int wgid = (int)L; { const int q = nmain / NXCD, r = nmain % NXCD, xcd = wgid % NXCD, off = wgid / NXCD; wgid = (xcd < r ? xcd * (q + 1) : r * (q + 1) + (xcd - r) * q) + off; }
        const int nig = wgm * nN, gid = wgid / nig, fm = gid * wgm, gsz = (nM - fm) < wgm ? (nM - fm) : wgm;
        u.pm = fm + ((wgid % nig) % gsz); u.pn = (wgid % nig) / gsz; u.bo = 0;
        if (grouped) { int e = 0;
#pragma unroll
            for (int j = 1; j < 8; ++j) e += (u.pm >= ts[j]) ? 1 : 0;
            e = __builtin_amdgcn_readfirstlane(e);
            u.bo = (size_t)e * bstride; u.ge = e; }
        return true;
    }
    __device__ __forceinline__ void a_ready(const Unit&) const {}
    __device__ __forceinline__ void done(const Unit&) const {}
};
#define ROT2(V, I, c, s) do { const float a_ = V[I] * (c) - V[I + 1] * (s), b_ = V[I + 1] * (c) + V[I] * (s); V[I] = a_; V[I + 1] = b_; } while (0)

struct EpiProj {
    static constexpr bool PERM = true, AFTER_DRAIN = false, KHOOK = false;
    bf16_t* O; const float* rope; u32x2* GB; const float* rs; float wsc;
    __device__ __forceinline__ void operator()(const f32x4 (&acc)[2][2][4][2], const Unit& u, int wr, int wc, int fr, int fq) const {
        const int pn = u.pn; const bool latent = u.pm < TL / 256;
        float rsc[2][4];
#pragma unroll
        for (int ai = 0; ai < 2; ++ai)
#pragma unroll
            for (int m = 0; m < 4; ++m) rsc[ai][m] = rs[u.pm * 256 + wr * 64 + fr + ai * 128 + m * 16] * wsc;
        if (pn >= 15) {
            const int gi = (pn - 15) >> 2, pnl = (pn - 15) & 3;
            u32x2* gp = GB + ((size_t)(((gi * NMT + u.pm) * 4 + pnl) * 8 + wr * 4 + wc) * 16) * 64 + fq * 16 + fr;
#pragma unroll
            for (int ai = 0; ai < 2; ++ai)
#pragma unroll
                for (int m = 0; m < 4; ++m)
#pragma unroll
                    for (int bj = 0; bj < 2; ++bj) { const f32x4 v0 = acc_i2f(acc[ai][bj][m][0]) * rsc[ai][m], v1 = acc_i2f(acc[ai][bj][m][1]) * rsc[ai][m];
#define SG_(x) ((unsigned)fminf(fmaxf(sigmoidf_(x) * 255.0f + 0.5f, 1.0f), 255.0f))
                        u32x2 w; w.x = SG_(v0[0]) | (SG_(v0[1]) << 8) | (SG_(v0[2]) << 16) | (SG_(v0[3]) << 24); w.y = SG_(v1[0]) | (SG_(v1[1]) << 8) | (SG_(v1[2]) << 16) | (SG_(v1[3]) << 24);
#undef SG_
                        __builtin_nontemporal_store(w, gp + (ai * 8 + m * 2 + bj) * 64); }
            return;
        }
        int rmask = 0; if (pn <= 1 || pn == 3 || pn == 4 || (pn >= 9 && pn <= 12)) rmask = 3; else if (pn == 2) rmask = 1;
        if (!latent) rmask = 0;
        const float sc = (pn == 4) ? 0.125f : SM_C2;
        const int row0 = u.pm * 256 + wr * 64 + fr, col0 = pn * 256 + wc * 32 + 8 * fq, axis = wc & 1;
#pragma unroll
        for (int ai = 0; ai < 2; ++ai)
#pragma unroll
            for (int m = 0; m < 4; ++m) {
                const int row = row0 + ai * 128 + m * 16;
                f32x4 cs0 = {1.f, 0.f, 1.f, 0.f}, cs1 = {1.f, 0.f, 1.f, 0.f};
                if (rmask) { const int pos = axis ? (row & 63) : ((row >> 6) & 63); const f32x4* tp = (const f32x4*)(rope + (pos * 16 + 4 * fq) * 2); cs0 = tp[0]; cs1 = tp[1]; }
                bf16_t* rowp = O + (size_t)row * DINP + col0;
#pragma unroll
                for (int bj = 0; bj < 2; ++bj) {
                    f32x4 v0 = acc_i2f(acc[ai][bj][m][0]) * rsc[ai][m], v1 = acc_i2f(acc[ai][bj][m][1]) * rsc[ai][m];
                    if ((rmask >> bj) & 1) { ROT2(v0, 0, cs0[0], cs0[1]); ROT2(v0, 2, cs0[2], cs0[3]); ROT2(v1, 0, cs1[0], cs1[1]); ROT2(v1, 2, cs1[2], cs1[3]); }
                    if (pn == 4 || pn <= 1 || pn == 9 || pn == 10) { v0 = v0 * sc; v1 = v1 * sc; }
                    u32x4 w; w.x = pk2(v0[0], v0[1]); w.y = pk2(v0[2], v0[3]); w.z = pk2(v1[0], v1[1]); w.w = pk2(v1[2], v1[3]);
                    __builtin_nontemporal_store(w, (u32x4*)(rowp + bj * 128));
                }
            }
    }
};

struct EpiMerge {
    static constexpr bool PERM = true, AFTER_DRAIN = false, KHOOK = true;
    bf16_t* Y; const u32x2* GB;
#define UB_(w, k) ((float)(((w) >> (8 * (k))) & 0xffu))
    __device__ __forceinline__ void khook(int t, f32x4 (&acc)[2][2][4][2], const Unit& u, int wr, int wc, int fr, int fq) const {
        const int gi = (t == 8) ? 0 : 1;
        const u32x2* ga = GB + ((size_t)(((gi * NMT + u.pm) * 4 + u.pn) * 8 + wr * 4 + wc) * 16) * 64 + fq * 16 + fr;
        const u32x2* gb = ga + (size_t)NMT * 4 * 8 * 16 * 64;
        u32x2 a[16], b[16];
#pragma unroll
        for (int j = 0; j < 16; ++j) { a[j] = ga[j * 64]; b[j] = gb[j * 64]; }
        __builtin_amdgcn_sched_barrier(0);
#pragma unroll
        for (int grp = 0; grp < 16; ++grp) { const int ai = grp >> 3, m = (grp >> 1) & 3, bj = grp & 1;
            f32x4 v0 = acc[ai][bj][m][0], v1 = acc[ai][bj][m][1];
#define MG_R(wa, wb, k) (UB_(wa, k) * __builtin_amdgcn_rcpf(UB_(wb, k)))
            v0[0] *= MG_R(a[grp].x, b[grp].x, 0); v0[1] *= MG_R(a[grp].x, b[grp].x, 1); v0[2] *= MG_R(a[grp].x, b[grp].x, 2); v0[3] *= MG_R(a[grp].x, b[grp].x, 3);
            v1[0] *= MG_R(a[grp].y, b[grp].y, 0); v1[1] *= MG_R(a[grp].y, b[grp].y, 1); v1[2] *= MG_R(a[grp].y, b[grp].y, 2); v1[3] *= MG_R(a[grp].y, b[grp].y, 3);
#undef MG_R
            acc[ai][bj][m][0] = v0; acc[ai][bj][m][1] = v1; }
        asm volatile("" ::: "memory"); __builtin_amdgcn_sched_barrier(0);
    }
    __device__ __forceinline__ void operator()(const f32x4 (&acc)[2][2][4][2], const Unit& u, int wr, int wc, int fr, int fq) const {
        const int row0 = u.pm * 256 + wr * 64 + fr, col0 = u.pn * 256 + wc * 32 + 8 * fq;
        const u32x2* gc = GB + ((size_t)(((2 * NMT + u.pm) * 4 + u.pn) * 8 + wr * 4 + wc) * 16) * 64 + fq * 16 + fr;
        u32x2 g[16];
#pragma unroll
        for (int j = 0; j < 16; ++j) g[j] = gc[j * 64];
        constexpr float q = 1.0f / 255.0f;
#pragma unroll
        for (int grp = 0; grp < 16; ++grp) { const int ai = grp >> 3, m = (grp >> 1) & 3, bj = grp & 1;
            const f32x4 v0 = acc[ai][bj][m][0] * q, v1 = acc[ai][bj][m][1] * q;
            u32x4 w; w.x = pk2(v0[0] * UB_(g[grp].x, 0), v0[1] * UB_(g[grp].x, 1)); w.y = pk2(v0[2] * UB_(g[grp].x, 2), v0[3] * UB_(g[grp].x, 3));
            w.z = pk2(v1[0] * UB_(g[grp].y, 0), v1[1] * UB_(g[grp].y, 1)); w.w = pk2(v1[2] * UB_(g[grp].y, 2), v1[3] * UB_(g[grp].y, 3));
            *(u32x4*)(Y + (size_t)(row0 + ai * 128 + m * 16) * DM + col0 + bj * 128) = w; }
    }
#undef UB_
};

struct EpiRes {
    static constexpr bool PERM = true, AFTER_DRAIN = false, KHOOK = false;
    const float* srcL; const float* srcC; float* dstL; float* dstC; const float* mod; int goff; float scl;
    __device__ __forceinline__ void operator()(const f32x4 (&acc)[2][2][4][2], const Unit& u, int wr, int wc, int fr, int fq) const {
        const bool latent = u.pm < TL / 256; const int mb = latent ? (u.pm >> 4) : 8;
        const float* g = mod + mb * 6144 + goff;
        const int rloc = (latent ? u.pm * 256 : u.pm * 256 - TL) + wr * 64 + fr, col0 = u.pn * 256 + wc * 32 + 8 * fq;
        const float* src = latent ? srcL : srcC; float* dst = latent ? dstL : dstC;
        f32x4 gv[2][2];
#pragma unroll
        for (int bj = 0; bj < 2; ++bj) { gv[bj][0] = *(const f32x4*)(g + col0 + bj * 128) * scl; gv[bj][1] = *(const f32x4*)(g + col0 + bj * 128 + 4) * scl; }
#pragma unroll
        for (int ai = 0; ai < 2; ++ai)
#pragma unroll
            for (int m = 0; m < 4; ++m) {
                const size_t off = (size_t)(rloc + ai * 128 + m * 16) * DM + col0;
#pragma unroll
                for (int bj = 0; bj < 2; ++bj) {
                    const f32x4 x0 = *(const f32x4*)(src + off + bj * 128), x1 = *(const f32x4*)(src + off + bj * 128 + 4);
                    *(f32x4*)(dst + off + bj * 128) = x0 + gv[bj][0] * acc[ai][bj][m][0];
                    *(f32x4*)(dst + off + bj * 128 + 4) = x1 + gv[bj][1] * acc[ai][bj][m][1];
                }
                if (m & 1) asm volatile("" ::: "memory");
            }
    }
};

template <bool OUT8>
struct EpiSwiglu {
    static constexpr bool PERM = true, AFTER_DRAIN = false, KHOOK = false;
    unsigned char* U; const float* rs; const float* wsc; int d3;
    __device__ __forceinline__ void operator()(const f32x4 (&acc)[2][2][4][2], const Unit& u, int wr, int wc, int fr, int fq) const {
        const int row0 = u.pm * 256 + wr * 64 + fr, col0 = u.pn * 128 + wc * 32 + 8 * fq;
        const float w1s = wsc[2 * u.ge], w3s = wsc[2 * u.ge + d3] * (OUT8 ? F8_SU : 1.0f);
#pragma unroll
        for (int ai = 0; ai < 2; ++ai)
#pragma unroll
            for (int m = 0; m < 4; ++m) {
                const int row = row0 + ai * 128 + m * 16; const float r = rs[row], ra = r * w1s, rb = r * w3s;
                const f32x4 a0 = acc_i2f(acc[ai][0][m][0]) * ra, a1 = acc_i2f(acc[ai][0][m][1]) * ra, b0 = acc_i2f(acc[ai][1][m][0]) * rb, b1 = acc_i2f(acc[ai][1][m][1]) * rb;
                if constexpr (OUT8) {
                    u32x2 w; w.x = pk4f8(siluf_(a0[0]) * b0[0], siluf_(a0[1]) * b0[1], siluf_(a0[2]) * b0[2], siluf_(a0[3]) * b0[3]);
                    w.y = pk4f8(siluf_(a1[0]) * b1[0], siluf_(a1[1]) * b1[1], siluf_(a1[2]) * b1[2], siluf_(a1[3]) * b1[3]);
                    *(u32x2*)(U + (size_t)row * DFF + col0) = w;
                } else {
                    u32x4 w; w.x = pk2(siluf_(a0[0]) * b0[0], siluf_(a0[1]) * b0[1]); w.y = pk2(siluf_(a0[2]) * b0[2], siluf_(a0[3]) * b0[3]);
                    w.z = pk2(siluf_(a1[0]) * b1[0], siluf_(a1[1]) * b1[1]); w.w = pk2(siluf_(a1[2]) * b1[2], siluf_(a1[3]) * b1[3]);
                    *(u32x4*)((bf16_t*)U + (size_t)row * DFF + col0) = w;
                }
            }
    }
};

struct EpiBf16 {
    static constexpr bool PERM = true, AFTER_DRAIN = false, KHOOK = false;
    bf16_t* O; int ldc; float scl;
    __device__ __forceinline__ void operator()(const f32x4 (&acc)[2][2][4][2], const Unit& u, int wr, int wc, int fr, int fq) const {
        const int row0 = u.pm * 256 + wr * 64 + fr, col0 = u.pn * 256 + wc * 32 + 8 * fq;
#pragma unroll
        for (int ai = 0; ai < 2; ++ai)
#pragma unroll
            for (int m = 0; m < 4; ++m) { bf16_t* rowp = O + (size_t)(row0 + ai * 128 + m * 16) * ldc + col0;
#pragma unroll
                for (int bj = 0; bj < 2; ++bj) { const f32x4 v0 = acc[ai][bj][m][0] * scl, v1 = acc[ai][bj][m][1] * scl;
                    u32x4 w; w.x = pk2(v0[0], v0[1]); w.y = pk2(v0[2], v0[3]); w.z = pk2(v1[0], v1[1]); w.w = pk2(v1[2], v1[3]);
                    *(u32x4*)(rowp + bj * 128) = w; } }
    }
};

template <class Epi, class Sched, bool ALIGN_EPI = false, bool SP2 = false, int MODE = 0>
__device__ __forceinline__ void gemm_phase(PG8_LAS unsigned char* lds, const Gemm g, const Sched& S, const Epi& E, int tid_in) {
    int tid = tid_in; asm volatile("" : "+v"(tid));
    const int wid = __builtin_amdgcn_readfirstlane(tid >> 6), lane = tid & 63, wr = wid >> 2, wc = wid & 3, fr = lane & 15, fq = lane >> 4;
    const int K = g.K, nt = K / BK;
    unsigned voffA[2], voffB[2];
#pragma unroll
    for (int i = 0; i < 2; ++i) { int R, C; stage_rc(tid * 16 + i * 8192, R, C); const int Rb = Epi::PERM ? ((R & ~31) + perm32(R & 31)) : R;
        voffA[i] = (unsigned)(R * K + C) * 2u; voffB[i] = (unsigned)(Rb * K + C) * 2u; }
    const size_t kstep = (size_t)(BK * 2);
    const size_t hstep = (size_t)HALF * K * 2;
    const size_t tstep = 2 * hstep;
    const unsigned ldsw = (unsigned)wid * 1024u;
    const int aoff = lds_byte(wr * 64 + fr, fq * 8), boff = lds_byte(wc * 32 + fr, fq * 8);
#define PG8_SA(b, h) (((b) * 2 + (h)) * HTB)
#define PG8_SB(b, h) ((4 + (b) * 2 + (h)) * HTB)
#define PG8_STAGE(bufoff, gbase, voff) do { _Pragma("unroll") for (int _i = 0; _i < 2; ++_i) \
        __builtin_amdgcn_global_load_lds((const unsigned*)((const char*)(gbase) + (voff)[_i]), (PG8_LAS unsigned*)(lds + (bufoff) + ldsw + _i * 8192), 16, 0, 0); } while (0)
#define PG8_LDA(dst, b, h) do { _Pragma("unroll") for (int m = 0; m < 4; ++m) _Pragma("unroll") for (int k = 0; k < 2; ++k) dst[m][k] = *(const PG8_LAS bf16x8*)(lds + PG8_SA(b, h) + aoff + m * 2048 + k * 1024); } while (0)
#define PG8_LDB(dst, b, h) do { _Pragma("unroll") for (int n = 0; n < 2; ++n) _Pragma("unroll") for (int k = 0; k < 2; ++k) dst[n][k] = *(const PG8_LAS bf16x8*)(lds + PG8_SB(b, h) + boff + n * 2048 + k * 1024); } while (0)
#define PG8_CAT(x) __builtin_shufflevector(__builtin_bit_cast(i32x4, (x)[0]), __builtin_bit_cast(i32x4, (x)[1]), 0, 1, 2, 3, 4, 5, 6, 7)
#define PG8_MMA(ai, bj, At, Bt) do { __builtin_amdgcn_s_setprio(1); _Pragma("unroll") for (int m = 0; m < 4; ++m) _Pragma("unroll") for (int n = 0; n < 2; ++n) { \
        if constexpr (MODE == 1) { const i32x8 b8_ = PG8_CAT(Bt[n]), a8_ = PG8_CAT(At[m]); asm volatile("v_mfma_f32_16x16x128_f8f6f4 %0, %1, %2, %0" : "+v"(acc[ai][bj][m][n]) : "v"(b8_), "v"(a8_)); } \
          \
        else if constexpr (MODE == 2) { _Pragma("unroll") for (int k = 0; k < 2; ++k) asm volatile("v_mfma_i32_16x16x64_i8 %0, %1, %2, %0" : "+v"(acc[ai][bj][m][n]) : "v"(Bt[n][k]), "v"(At[m][k])); } \
        else { _Pragma("unroll") for (int k = 0; k < 2; ++k) acc[ai][bj][m][n] = __builtin_amdgcn_mfma_f32_16x16x32_bf16(Bt[n][k], At[m][k], acc[ai][bj][m][n], 0, 0, 0); } } \
        __builtin_amdgcn_s_setprio(0); } while (0)
#define PG8_WAIT_V(n) asm volatile("s_waitcnt vmcnt(" #n ")" ::: "memory")
#define PG8_WAIT_L(n) asm volatile("s_waitcnt lgkmcnt(" #n ")" ::: "memory")
#define PG8_BAR __builtin_amdgcn_s_barrier()
#define PG8_SCHED __builtin_amdgcn_sched_barrier(0)
    Unit cur, nxt; int ui = 0;
    if (!S.next(0, cur)) return;
    f32x4 acc[2][2][4][2];
#pragma unroll
    for (int a = 0; a < 2; ++a)
#pragma unroll
        for (int b = 0; b < 2; ++b)
#pragma unroll
            for (int m = 0; m < 4; ++m)
#pragma unroll
                for (int n = 0; n < 2; ++n) acc[a][b][m][n] = (f32x4){0.f, 0.f, 0.f, 0.f};
    bf16x8 At[4][2], B0[2][2], B1[2][2];
    const char* cA = (const char*)g.A + (size_t)cur.pm * tstep; const char* cB = (const char*)g.Bt + cur.bo * 2 + (size_t)cur.pn * tstep;
    S.a_ready(cur);
    if constexpr (SP2) {
        PG8_STAGE(PG8_SB(0, 0), cB, voffB); PG8_STAGE(PG8_SB(0, 1), cB + hstep, voffB); PG8_STAGE(PG8_SA(0, 0), cA, voffA); PG8_STAGE(PG8_SA(0, 1), cA + hstep, voffA);
        if (wr == 1) PG8_BAR;
        PG8_WAIT_V(2); PG8_BAR;
        PG8_STAGE(PG8_SB(1, 0), cB + kstep, voffB); PG8_STAGE(PG8_SA(1, 0), cA + kstep, voffA); PG8_STAGE(PG8_SB(1, 1), cB + hstep + kstep, voffB);
        PG8_WAIT_V(6); PG8_BAR;
    } else {
        PG8_STAGE(PG8_SB(0, 0), cB, voffB); PG8_STAGE(PG8_SA(0, 0), cA, voffA); PG8_STAGE(PG8_SB(0, 1), cB + hstep, voffB); PG8_STAGE(PG8_SA(0, 1), cA + hstep, voffA);
        if (wr == 1) PG8_BAR;
        PG8_WAIT_V(4); PG8_BAR;
        PG8_STAGE(PG8_SB(1, 0), cB + kstep, voffB); PG8_STAGE(PG8_SA(1, 0), cA + kstep, voffA); PG8_STAGE(PG8_SB(1, 1), cB + hstep + kstep, voffB);
        PG8_WAIT_V(6); PG8_BAR;
    }
    for (;;) {
        const bool has_next = S.next(ui + 1, nxt);
        const char* nA = has_next ? (const char*)g.A + (size_t)nxt.pm * tstep : cA; const char* nB = has_next ? (const char*)g.Bt + nxt.bo * 2 + (size_t)nxt.pn * tstep : cB;
        for (int t = 0; t < nt; t += 2) {
            const bool last = (t == nt - 2);
            const char* a1 = cA + (size_t)(t + 1) * kstep;
            const char* a2 = last ? nA : cA + (size_t)(t + 2) * kstep; const char* b2 = last ? nB : cB + (size_t)(t + 2) * kstep;
            const char* a3 = a2 + kstep; const char* b3 = b2 + kstep;
            if (last && has_next) S.a_ready(nxt);
            if constexpr (Epi::KHOOK) { if (t == 8 || t == 16) E.khook(t, acc, cur, wr, wc, fr, fq); }
            if constexpr (SP2) {
            PG8_LDB(B0, 0, 0); PG8_LDB(B1, 0, 1); PG8_SCHED; PG8_LDA(At, 0, 0); PG8_STAGE(PG8_SA(1, 1), a1 + hstep, voffA);
            PG8_WAIT_V(8); PG8_WAIT_L(0); PG8_BAR; PG8_MMA(0, 0, At, B0); PG8_MMA(0, 1, At, B1); PG8_BAR; PG8_SCHED;
            PG8_LDA(At, 0, 1); PG8_STAGE(PG8_SB(0, 0), b2, voffB); PG8_STAGE(PG8_SB(0, 1), b2 + hstep, voffB); PG8_STAGE(PG8_SA(0, 0), a2, voffA);
            PG8_WAIT_V(8); PG8_WAIT_L(0); PG8_BAR; PG8_MMA(1, 0, At, B0); PG8_MMA(1, 1, At, B1); PG8_BAR; PG8_SCHED;
            PG8_LDB(B0, 1, 0); PG8_LDB(B1, 1, 1); PG8_SCHED; PG8_LDA(At, 1, 0); PG8_STAGE(PG8_SA(0, 1), a2 + hstep, voffA);
            PG8_WAIT_V(8); PG8_WAIT_L(0); PG8_BAR; PG8_MMA(0, 0, At, B0); PG8_MMA(0, 1, At, B1); PG8_BAR; PG8_SCHED;
            PG8_LDA(At, 1, 1); PG8_STAGE(PG8_SB(1, 0), b3, voffB); PG8_STAGE(PG8_SB(1, 1), b3 + hstep, voffB); PG8_STAGE(PG8_SA(1, 0), a3, voffA);
            PG8_WAIT_V(8); PG8_WAIT_L(0); PG8_BAR; PG8_MMA(1, 0, At, B0); PG8_MMA(1, 1, At, B1); PG8_BAR; PG8_SCHED;
            } else {
            PG8_LDB(B0, 0, 0); PG8_SCHED; PG8_LDA(At, 0, 0); PG8_STAGE(PG8_SA(1, 1), a1 + hstep, voffA);
            PG8_WAIT_L(8); PG8_BAR; PG8_WAIT_L(0); PG8_MMA(0, 0, At, B0); PG8_BAR; PG8_SCHED;
            PG8_LDB(B1, 0, 1); PG8_STAGE(PG8_SB(0, 0), b2, voffB);
            PG8_BAR; PG8_WAIT_L(0); PG8_MMA(0, 1, At, B1); PG8_BAR;
            PG8_LDA(At, 0, 1); PG8_STAGE(PG8_SA(0, 0), a2, voffA);
            PG8_BAR; PG8_WAIT_L(0); PG8_MMA(1, 0, At, B0); PG8_BAR; PG8_SCHED;
            PG8_STAGE(PG8_SB(0, 1), b2 + hstep, voffB);
            PG8_WAIT_V(6); PG8_BAR; PG8_MMA(1, 1, At, B1); PG8_BAR;
            PG8_LDB(B0, 1, 0); PG8_SCHED; PG8_LDA(At, 1, 0); PG8_STAGE(PG8_SA(0, 1), a2 + hstep, voffA);
            PG8_WAIT_L(8); PG8_BAR; PG8_WAIT_L(0); PG8_MMA(0, 0, At, B0); PG8_BAR; PG8_SCHED;
            PG8_LDB(B1, 1, 1); PG8_STAGE(PG8_SB(1, 0), b3, voffB);
            PG8_BAR; PG8_WAIT_L(0); PG8_MMA(0, 1, At, B1); PG8_BAR;
            PG8_LDA(At, 1, 1); PG8_STAGE(PG8_SA(1, 0), a3, voffA);
            PG8_BAR; PG8_WAIT_L(0); PG8_MMA(1, 0, At, B0); PG8_BAR; PG8_SCHED;
            PG8_STAGE(PG8_SB(1, 1), b3 + hstep, voffB);
            PG8_WAIT_V(6); PG8_BAR; PG8_MMA(1, 1, At, B1); PG8_BAR;
            }
        }
        if constexpr (MODE != 0) asm volatile("s_nop 15\n\ts_nop 15" ::: "memory");
        if constexpr (ALIGN_EPI) { if (wr == 0) PG8_BAR; }
        if constexpr (!Epi::AFTER_DRAIN) { int ln_; asm volatile("v_mbcnt_lo_u32_b32 %0, -1, 0\n\tv_mbcnt_hi_u32_b32 %0, -1, %0" : "=v"(ln_));
            E(acc, cur, wr, wc, ln_ & 15, ln_ >> 4); S.done(cur); }
        if (!has_next) break;
#pragma unroll
        for (int a = 0; a < 2; ++a)
#pragma unroll
            for (int b = 0; b < 2; ++b)
#pragma unroll
                for (int m = 0; m < 4; ++m)
#pragma unroll
                    for (int n = 0; n < 2; ++n) acc[a][b][m][n] = (f32x4){0.f, 0.f, 0.f, 0.f};
        cur = nxt; cA = nA; cB = nB; ++ui;
        if constexpr (ALIGN_EPI) { if (wr == 1) PG8_BAR; }
    }
    PG8_WAIT_V(0);
    if constexpr (!ALIGN_EPI) { if (wr == 0) PG8_BAR; }
    PG8_BAR;
    if constexpr (Epi::AFTER_DRAIN) { E.fused(acc, cur, wr, wc, fr, fq, lds, wid, lane); S.done(cur); }
#undef PG8_SA
#undef PG8_SB
#undef PG8_STAGE
#undef PG8_LDA
#undef PG8_LDB
#undef PG8_MMA
#undef PG8_CAT
#undef PG8_WAIT_V
#undef PG8_WAIT_L
#undef PG8_BAR
#undef PG8_SCHED
}
}
namespace at {
__device__ __forceinline__ int crow(int r, int hi) { return (r & 3) + 8 * (r >> 2) + 4 * hi; }
typedef short v4i16_t __attribute__((ext_vector_type(4)));
__device__ __forceinline__ s16x4 vtr(const LAS unsigned char* p) { return __builtin_bit_cast(s16x4, __builtin_amdgcn_ds_read_tr16_b64_v4i16((LAS v4i16_t*)p)); }
__device__ __forceinline__ bf16x8 cat8(s16x4 lo, s16x4 hi) { return (bf16x8){lo[0], lo[1], lo[2], lo[3], hi[0], hi[1], hi[2], hi[3]}; }
#define MFMA32(a, b, c) __builtin_amdgcn_mfma_f32_32x32x16_bf16((a), (b), (c), 0, 0, 0)
constexpr int KSTR = 144;
constexpr float NEG_BIG = -1.0e30f;

__device__ __forceinline__ bf16x8 tr_frag(const LAS unsigned char* tile, int vstr, int ks, int colb, int lane) {
    const int hi = lane >> 5, ql = (lane & 15) >> 2, blk = (lane >> 4) & 1, p = lane & 3;
    const LAS unsigned char* a = tile + (16 * ks + 4 * hi + ql) * vstr + (colb + 16 * blk + 4 * p) * 2;
    return cat8(vtr(a), vtr(a + 8 * vstr));
}

template <int N> __device__ __forceinline__ void wait_bar() { asm volatile("s_waitcnt vmcnt(%0) lgkmcnt(0)\n\ts_barrier" :: "n"(N) : "memory"); }
template <int DV, int NK> struct AtGeo { static constexpr int KB = 8192, VB = DV * 128, STAGE = NK * KB + VB, NP = (NK * 8 + DV / 8) / 8  , LDS = 3 * STAGE + 2048; };
__device__ __forceinline__ bf16x8 v_frag(const LAS unsigned char* Vt, int ks, int c, int lane) {
    const int hi = lane >> 5, ql = (lane & 15) >> 2, blk = (lane >> 4) & 1, p = lane & 3;
    const int ch = (4 * (c & 1) + 2 * blk + (p >> 1)) ^ ((ql & 2) << 1);
    const LAS unsigned char* a = Vt + (c >> 1) * 8192 + (16 * ks + 4 * hi + ql) * 128 + ch * 16 + 8 * (p & 1);
    return cat8(vtr(a), vtr(a + 1024));
}
template <int DV, int NK> struct AtCtx {
    LAS unsigned char* lds; LAS float* scr; bf16x8 qr[4]; f32x16 o[DV / 32]; f32x16 negm; float m, l; int lane, r32, hi, ksel, qpos, kpos0, nloc; bool exact0;
};
template <int DV, int NK, bool BAND, bool HAS_QK, bool HAS_PV, bool EX0>
__device__ __forceinline__ void at_step(AtCtx<DV, NK>& C, int t, int koff, int voff, const u32x4 (&pw)[4], u32x4 (&pn)[4]) {
    constexpr int KB = 8192, NC = DV / 32, NG = NC * 4  , EPG = 16 / NG  ;
    const LAS unsigned char* Kt = C.lds + koff + C.ksel * KB;
    const LAS unsigned char* Vt = C.lds + voff;
    const int lane = C.lane, r32 = C.r32, hi = C.hi;
    f32x16 s0, s1; bf16x8 vf[2][4];
    bool resc = false;
    if (HAS_QK) {
        bf16x8 kf[8];
#pragma unroll
        for (int d0 = 0; d0 < 4; ++d0) { const int ko = r32 * 128 + (((2 * d0 + hi) ^ ((r32 >> 1) & 7)) << 4);
            kf[2 * d0] = *(const LAS bf16x8*)(Kt + ko); kf[2 * d0 + 1] = *(const LAS bf16x8*)(Kt + 4096 + ko); }
        __builtin_amdgcn_sched_barrier(0);
        __builtin_amdgcn_s_setprio(1);
        s0 = MFMA32(kf[0], C.qr[0], C.negm); s1 = MFMA32(kf[1], C.qr[0], C.negm);
#pragma unroll
        for (int d0 = 1; d0 < 4; ++d0) { s0 = MFMA32(kf[2 * d0], C.qr[d0], s0); s1 = MFMA32(kf[2 * d0 + 1], C.qr[d0], s1); }
        __builtin_amdgcn_s_setprio(0);
        __builtin_amdgcn_sched_barrier(0);
    }
    if (HAS_PV) {
#pragma unroll
        for (int c = 0; c < 2; ++c)
#pragma unroll
            for (int ks = 0; ks < 4; ++ks) vf[c][ks] = v_frag(Vt, ks, c, lane);
        __builtin_amdgcn_sched_barrier(0);
    }
    if (HAS_QK) {
        if (BAND && t < C.nloc) {
            const int kb = C.kpos0 + 64 * t - C.qpos;
#pragma unroll
            for (int r = 0; r < 16; ++r) { const int d = kb + crow(r, hi); if (d > 128 || d < -128) s0[r] = NEG_BIG; if (d + 32 > 128 || d + 32 < -128) s1[r] = NEG_BIG; }
        }
        float mt = fmaxf(fmaxf(s0[0], s1[0]), s0[1]);
#pragma unroll
        for (int r = 2; r < 16; r += 2) mt = fmaxf(fmaxf(mt, s0[r]), s0[r + 1]);
#pragma unroll
        for (int r = 1; r < 16; r += 2) mt = fmaxf(fmaxf(mt, s1[r]), s1[(r + 1) & 15]);
        { const auto sw = __builtin_amdgcn_permlane32_swap(__float_as_uint(mt), __float_as_uint(mt), false, false); mt = fmaxf(__uint_as_float(sw[0]), __uint_as_float(sw[1])); }
        const float dl = (!HAS_PV && EX0) ? mt : ((mt > 8.0f) ? mt : 0.0f);
        resc = (!HAS_PV && EX0) ? true : __any(dl > 0.0f);
        if (resc) { const float f = (!HAS_PV && EX0) ? 1.0f : fexp2(-dl);     C.l *= f; C.m += dl; if (hi == 0) C.scr[r32] = f;
#pragma unroll
            for (int r = 0; r < 16; ++r) { s0[r] -= dl; s1[r] -= dl; C.negm[r] = -C.m; } }
        __builtin_amdgcn_sched_barrier(0);
    }
    {
        float ls = 0.f;
        __builtin_amdgcn_s_setprio(1);
#pragma unroll
        for (int g = 0; g < NG; ++g) {
            const int c = g >> 2, ks = g & 3;
            if (HAS_PV) {
                C.o[c] = MFMA32(__builtin_bit_cast(bf16x8, pw[ks]), vf[c & 1][ks], C.o[c]);
                if (ks == 3 && c + 2 < NC) {
#pragma unroll
                    for (int k2 = 0; k2 < 4; ++k2) vf[c & 1][k2] = v_frag(Vt, k2, c + 2, lane);
                }
            }
            if (HAS_QK) {
#pragma unroll
                for (int e = 0; e < EPG; ++e) { const int r = g * EPG + e;
                    s0[r] = fexp2(s0[r]); s1[r] = fexp2(s1[r]); ls += s0[r] + s1[r];
                    if (r & 1) { const unsigned w0 = pk2(s0[r - 1], s0[r]), w1 = pk2(s1[r - 1], s1[r]); pn[r >> 3][(r >> 1) & 3] = w0; pn[2 + (r >> 3)][(r >> 1) & 3] = w1; } }
            }
        }
        if (HAS_QK) { C.l += ls; asm volatile("" : "+v"(pn[0]), "+v"(pn[1]), "+v"(pn[2]), "+v"(pn[3]), "+v"(C.l)); }
        __builtin_amdgcn_s_setprio(0);
        if (HAS_QK && HAS_PV) {
#pragma unroll
            for (int g = 0; g < NG; ++g) { __builtin_amdgcn_sched_group_barrier(0x008, 1, 0); __builtin_amdgcn_sched_group_barrier(0x002, 6 * EPG, 0); if (g < (NC - 2) * 4) __builtin_amdgcn_sched_group_barrier(0x100, 2, 0); }
        }
        __builtin_amdgcn_sched_barrier(0);
    }
    if (resc) {
        LDS_WAIT();
#pragma unroll
        for (int j = 0; j < 4; ++j) { const f32x4 fv = *(const LAS f32x4*)(C.scr + 8 * j + 4 * hi);
#pragma unroll
            for (int c = 0; c < NC; ++c) { C.o[c][4 * j] *= fv[0]; C.o[c][4 * j + 1] *= fv[1]; C.o[c][4 * j + 2] *= fv[2]; C.o[c][4 * j + 3] *= fv[3]; } }
        LDS_WAIT();
    }
}
template <int DV, int NK, bool BAND, bool EX0>
__device__ __forceinline__ void attn_core(LAS unsigned char* lds, const bf16_t* __restrict__ proj, int NT, int nloc, int locrow0, int ctxrow0, int kcol, int vcol,
                                          const bf16_t* qp, int ksel, int qpos, int kpos0, float m_init, float l_init, f32x16 (&o)[DV / 32], float& l_out, int tid) {
    typedef AtGeo<DV, NK> Geo;
    constexpr int KB = Geo::KB, VB = Geo::VB, NPK = NK, NPV = DV / 64, NP = NPK + NPV;
    AtCtx<DV, NK> C;
    C.lds = lds; C.lane = tid & 63; C.r32 = C.lane & 31; C.hi = C.lane >> 5; C.ksel = ksel; C.qpos = qpos; C.kpos0 = kpos0; C.nloc = nloc;
    const int lane = C.lane; const int wid = __builtin_amdgcn_readfirstlane(tid >> 6);
    C.scr = (LAS float*)(lds + 3 * Geo::STAGE) + wid * 64;
#pragma unroll
    for (int d0 = 0; d0 < 4; ++d0) C.qr[d0] = *(const bf16x8*)(qp + d0 * 16 + C.hi * 8);
    unsigned ksoff[NPK], vsoff[NPV]; int kdoff[NPK], vdoff[NPV];
#pragma unroll
    for (int i = 0; i < NPK; ++i) { const int pc = wid + 8 * i, j = pc >> 3, key = 8 * (pc & 7) + (lane >> 3), ch = (lane & 7) ^ ((key >> 1) & 7);
        ksoff[i] = (unsigned)key * DINP + kcol + j * 64 + ch * 8; kdoff[i] = pc * 1024; }
#pragma unroll
    for (int i = 0; i < NPV; ++i) { const int pv = wid + 8 * i, cp = pv >> 3, key = 8 * (pv & 7) + (lane >> 3), ch = (lane & 7) ^ (((key >> 1) & 1) << 2);
        vsoff[i] = (unsigned)key * DINP + vcol + cp * 64 + ch * 8; vdoff[i] = 3 * NK * KB + pv * 1024; }
#define AT_ROW0(t) ((t) < nloc ? locrow0 + 64 * (t) : ctxrow0 + 64 * ((t) - nloc))
#define AT_DMA_K(t, s) do { const bf16_t* tb = proj + (size_t)AT_ROW0(t) * DINP; \
        _Pragma("unroll") for (int i = 0; i < NPK; ++i) __builtin_amdgcn_global_load_lds((const unsigned*)(tb + ksoff[i]), (LAS unsigned*)(lds + (s) * (NK * KB) + kdoff[i]), 16, 0, 0); } while (0)
#define AT_DMA_V(t, s) do { const bf16_t* tb = proj + (size_t)AT_ROW0(t) * DINP; \
        _Pragma("unroll") for (int i = 0; i < NPV; ++i) __builtin_amdgcn_global_load_lds((const unsigned*)(tb + vsoff[i]), (LAS unsigned*)(lds + (s) * VB + vdoff[i]), 16, 0, 0); } while (0)
    C.m = m_init; C.l = l_init; C.exact0 = EX0;
#pragma unroll
    for (int r = 0; r < 16; ++r) C.negm[r] = -m_init;
#pragma unroll
    for (int c = 0; c < DV / 32; ++c) C.o[c] = (f32x16){0.f};
    u32x4 pa[4], pb[4];
    AT_DMA_K(0, 0);
    AT_DMA_K(1, 1); AT_DMA_V(0, 0);
    wait_bar<NP>();
    if (2 < NT) AT_DMA_K(2, 2);
    AT_DMA_V(1, 1);
    at_step<DV, NK, BAND, true, false, EX0>(C, 0, 0, 0, pb, pa);
    int s1 = 1, s0 = 0;
    for (int t = 1; t < NT; ++t) {
        if (t + 1 < NT) wait_bar<NP>(); else wait_bar<NPV>();
        const int s2 = s1 == 2 ? 0 : s1 + 1;
        if (t + 2 < NT) AT_DMA_K(t + 2, s0);
        if (t + 1 < NT) AT_DMA_V(t + 1, s2);
        at_step<DV, NK, BAND, true, true, EX0>(C, t, s1 * (NK * KB), 3 * NK * KB + s0 * VB, pa, pb);
#pragma unroll
        for (int i_ = 0; i_ < 4; ++i_) pa[i_] = pb[i_];
        s0 = s1; s1 = s2;
    }
    wait_bar<0>();
    at_step<DV, NK, BAND, false, true, EX0>(C, NT, 0, 3 * NK * KB + s0 * VB, pa, pb);
    wait_bar<0>();
#undef AT_ROW0
#undef AT_DMA_K
#undef AT_DMA_V
#pragma unroll
    for (int c = 0; c < DV / 32; ++c) o[c] = C.o[c];
    l_out = C.l + __shfl_xor(C.l, 32);
}
template <int DV, int NK> struct AtGeoP { static constexpr int KT = NK * 8192, VT = DV * 128, VRING = 4 * KT, SCR = 4 * KT + 4 * VT, LDS = SCR + 2048; };
template <int DV, int NK, bool EX0>
__device__ __forceinline__ void attn_core_pair(LAS unsigned char* lds, const bf16_t* __restrict__ proj, int NT, int nloc, int locrow0, int ctxrow0, int kcol, int vcol,
                                               const bf16_t* qp, int ksel, float m_init, float l_init, f32x16 (&o)[DV / 32], float& l_out, int tid) {
    typedef AtGeoP<DV, NK> Geo;
    constexpr int KT = Geo::KT, VT = Geo::VT, VRING = Geo::VRING, NPK = NK, NPV = DV / 64;
    AtCtx<DV, NK> C;
    C.lds = lds; C.lane = tid & 63; C.r32 = C.lane & 31; C.hi = C.lane >> 5; C.ksel = ksel; C.qpos = 0; C.kpos0 = 0; C.nloc = nloc;
    const int lane = C.lane; const int wid = __builtin_amdgcn_readfirstlane(tid >> 6);
    C.scr = (LAS float*)(lds + Geo::SCR) + wid * 64;
#pragma unroll
    for (int d0 = 0; d0 < 4; ++d0) C.qr[d0] = *(const bf16x8*)(qp + d0 * 16 + C.hi * 8);
    unsigned ksoff[NPK], vsoff[NPV]; int kdoff[NPK], vdoff[NPV];
#pragma unroll
    for (int i = 0; i < NPK; ++i) { const int pc = wid + 8 * i, j = pc >> 3, key = 8 * (pc & 7) + (lane >> 3), ch = (lane & 7) ^ ((key >> 1) & 7);
        ksoff[i] = (unsigned)key * DINP + kcol + j * 64 + ch * 8; kdoff[i] = pc * 1024; }
#pragma unroll
    for (int i = 0; i < NPV; ++i) { const int pv = wid + 8 * i, cp = pv >> 3, key = 8 * (pv & 7) + (lane >> 3), ch = (lane & 7) ^ (((key >> 1) & 1) << 2);
        vsoff[i] = (unsigned)key * DINP + vcol + cp * 64 + ch * 8; vdoff[i] = VRING + pv * 1024; }
#define ATP_ROW0(t) ((t) < nloc ? locrow0 + 64 * (t) : ctxrow0 + 64 * ((t) - nloc))
#define ATP_OFF(t, T_) ((((t) >> 1) & 1) * 2 * (T_) + ((t) & 1) * (T_))
#define ATP_DMA_K(t) do { const bf16_t* tb = proj + (size_t)ATP_ROW0(t) * DINP; const int so_ = ATP_OFF(t, KT); \
        _Pragma("unroll") for (int i = 0; i < NPK; ++i) __builtin_amdgcn_global_load_lds((const unsigned*)(tb + ksoff[i]), (LAS unsigned*)(lds + so_ + kdoff[i]), 16, 0, 0); } while (0)
#define ATP_DMA_V(t) do { const bf16_t* tb = proj + (size_t)ATP_ROW0(t) * DINP; const int so_ = ATP_OFF(t, VT); \
        _Pragma("unroll") for (int i = 0; i < NPV; ++i) __builtin_amdgcn_global_load_lds((const unsigned*)(tb + vsoff[i]), (LAS unsigned*)(lds + so_ + vdoff[i]), 16, 0, 0); } while (0)
    C.m = m_init; C.l = l_init; C.exact0 = EX0;
#pragma unroll
    for (int r = 0; r < 16; ++r) C.negm[r] = -m_init;
#pragma unroll
    for (int c = 0; c < DV / 32; ++c) C.o[c] = (f32x16){0.f};
    u32x4 pa[4], pb[4];
    ATP_DMA_K(0); ATP_DMA_K(1); ATP_DMA_V(0);
    wait_bar<0>();
    if (2 < NT) { ATP_DMA_K(2); ATP_DMA_K(3); ATP_DMA_V(2); }
    ATP_DMA_V(1);
    at_step<DV, NK, false, true, false, EX0>(C, 0, ATP_OFF(0, KT), 0, pb, pa);
    at_step<DV, NK, false, true, true, EX0>(C, 1, ATP_OFF(1, KT), VRING + ATP_OFF(0, VT), pa, pb);
#pragma unroll
    for (int i_ = 0; i_ < 4; ++i_) pa[i_] = pb[i_];
    for (int t = 2; t < NT; t += 2) {
        wait_bar<0>();
        if (t + 2 < NT) { ATP_DMA_K(t + 2); ATP_DMA_K(t + 3); ATP_DMA_V(t + 2); }
        ATP_DMA_V(t + 1);
        at_step<DV, NK, false, true, true, EX0>(C, t, ATP_OFF(t, KT), VRING + ATP_OFF(t - 1, VT), pa, pb);
#pragma unroll
        for (int i_ = 0; i_ < 4; ++i_) pa[i_] = pb[i_];
        at_step<DV, NK, false, true, true, EX0>(C, t + 1, ATP_OFF(t + 1, KT), VRING + ATP_OFF(t, VT), pa, pb);
#pragma unroll
        for (int i_ = 0; i_ < 4; ++i_) pa[i_] = pb[i_];
    }
    wait_bar<0>();
    at_step<DV, NK, false, false, true, EX0>(C, NT, 0, VRING + ATP_OFF(NT - 1, VT), pa, pb);
    wait_bar<0>();
#undef ATP_ROW0
#undef ATP_OFF
#undef ATP_DMA_K
#undef ATP_DMA_V
#pragma unroll
    for (int c = 0; c < DV / 32; ++c) o[c] = C.o[c];
    l_out = C.l + __shfl_xor(C.l, 32);
}
template <int NC>
__device__ __forceinline__ void scale_rows(f32x16 (&o)[NC], float v, LAS float* scr, int r32, int hi) {
    LDS_WAIT();
    if (hi == 0) scr[r32] = v;
    LDS_WAIT();
#pragma unroll
    for (int j = 0; j < 4; ++j) { const f32x4 fv = *(const LAS f32x4*)(scr + 8 * j + 4 * hi);
#pragma unroll
        for (int c = 0; c < NC; ++c) { o[c][4 * j] *= fv[0]; o[c][4 * j + 1] *= fv[1]; o[c][4 * j + 2] *= fv[2]; o[c][4 * j + 3] *= fv[3]; } }
    LDS_WAIT();
}
constexpr int AT_A_LDS = AtGeo<64, 1>::LDS;
constexpr int AT_C_LDS = AtGeoP<128, 2>::LDS;

__device__ __forceinline__ void attnA_unit(LAS unsigned char* lds, const bf16_t* proj, bf16_t* ocat, const float* sink, int b, int g, int qb, int lat, int tid) {
    const int lane = tid & 63, r32 = lane & 31, hi = lane >> 5; const int wid = __builtin_amdgcn_readfirstlane(tid >> 6);
    const int head = g * 4 + (wid >> 1), qloc = qb * 64 + (wid & 1) * 32;
    const int qrow0 = (lat ? b * SEQ : TL + b * CTXL) + qloc;
    int nloc = 0, kt0 = 0;
    if (lat) { kt0 = qb - 2 < 0 ? 0 : qb - 2; const int kt1 = qb + 2 > 63 ? 63 : qb + 2; nloc = kt1 - kt0 + 1; }
    const int NT = nloc + 4;
    f32x16 o[2]; float l;
    attn_core<64, 1, true, false>(lds, proj, NT, nloc, b * SEQ + 64 * kt0, TL + b * CTXL, C_KA + g * 64, C_VA + g * 64,
                           proj + (size_t)(qrow0 + r32) * DINP + C_QA + head * 64, 0, qloc + r32, 64 * kt0, sink[head] * LOG2E, hi == 0 ? 1.0f : 0.0f, o, l, tid);
    LAS float* scr = (LAS float*)(lds + 3 * AtGeo<64, 1>::STAGE) + wid * 64;
    scale_rows<2>(o, __builtin_amdgcn_rcpf(l), scr, r32, hi);
    bf16_t* op = ocat + (size_t)qrow0 * OCW + head * 64 + r32;
#pragma unroll
    for (int r = 0; r < 16; ++r) { const int row = crow(r, hi);
#pragma unroll
        for (int c = 0; c < 2; ++c) op[(size_t)row * OCW + 32 * c] = (bf16_t)(pk2(o[c][r], 0.f) & 0xffffu); }
}

__device__ __forceinline__ void attnC_unit(LAS unsigned char* lds, const bf16_t* proj, bf16_t* ocat, const float* dgain, float lam, float oml, int b, int h, int qb, int lat, int tid) {
    const int lane = tid & 63, r32 = lane & 31, hi = lane >> 5; const int wid = __builtin_amdgcn_readfirstlane(tid >> 6);
    const int comp = wid >> 2, qloc = qb * 128 + (wid & 3) * 32;
    const int qrow0 = (lat ? b * SEQ : TL + b * CTXL) + qloc;
    const int nloc = lat ? 64 : 0, NT = nloc + 4;
    f32x16 o[4]; float l;
    attn_core_pair<128, 2, true>(lds, proj, NT, nloc, b * SEQ, TL + b * CTXL, C_KD + h * 128, C_VD + h * 128,
                           proj + (size_t)(qrow0 + r32) * DINP + C_QD + h * 128 + comp * 64, comp, 0.0f, 0.0f, o, l, tid);
    LAS float* scr = (LAS float*)(lds + AtGeoP<128, 2>::SCR) + wid * 64;
    scale_rows<4>(o, __builtin_amdgcn_rcpf(l), scr, r32, hi);
    LAS float* X = (LAS float*)lds + (wid & 3) * 4096;
    if (comp == 1) {
#pragma unroll
        for (int c = 0; c < 4; ++c)
#pragma unroll
            for (int r = 0; r < 16; ++r) X[(c * 16 + r) * 64 + lane] = o[c][r];
    }
    __syncthreads();
    if (comp == 0) {
        float ss[16];
#pragma unroll
        for (int r = 0; r < 16; ++r) ss[r] = 0.f;
#pragma unroll
        for (int c = 0; c < 4; ++c)
#pragma unroll
            for (int r = 0; r < 16; ++r) { const float v = o[c][r] - lam * X[(c * 16 + r) * 64 + lane]; o[c][r] = v; ss[r] += v * v; }
#pragma unroll
        for (int r = 0; r < 16; ++r) {
#pragma unroll
            for (int s = 1; s < 32; s <<= 1) ss[r] += __shfl_xor(ss[r], s);
            ss[r] = __builtin_amdgcn_rsqf(ss[r] * (1.0f / 128.0f) + NORM_EPS) * oml;
        }
        bf16_t* op = ocat + (size_t)qrow0 * OCW + 1024 + h * 128 + r32;
#pragma unroll
        for (int c = 0; c < 4; ++c) { const float gn = dgain[32 * c + r32];
#pragma unroll
            for (int r = 0; r < 16; ++r) op[(size_t)crow(r, hi) * OCW + 32 * c] = (bf16_t)(pk2(o[c][r] * ss[r] * gn, 0.f) & 0xffffu); }
    }
    __syncthreads();
}
__device__ __forceinline__ int chunk_row0(int b, int ci) { return ci < 2 ? TL + b * CTXL + ci * 128 : b * SEQ + (ci - 2) * 128; }
constexpr int RSTR = 192;
constexpr int VSTR128 = 320;
constexpr int R1_LDS = 2 * 128 * RSTR + 128 * VSTR128;
__device__ __forceinline__ void ret_kv_phase(LAS unsigned char* lds, const bf16_t* __restrict__ proj, bf16_t* kvT, const float* lg2, int blk, int G, int tid) {
    const int lane = tid & 63, hi = lane >> 5; const int wid = __builtin_amdgcn_readfirstlane(tid >> 6);
    LAS unsigned char* Kf = lds; LAS unsigned char* Kb = lds + 128 * RSTR; LAS unsigned char* Vt = lds + 2 * 128 * RSTR;
    constexpr int NU = NB * 4 * NCHK;
    int u = blk; if (u >= NU) return;
    u32x4 kreg[2], vreg[4];
#define R1_LOAD(uu) do { const int ci_ = (uu) % NCHK, bh_ = (uu) / NCHK, row0_ = chunk_row0(bh_ >> 2, ci_), h_ = bh_ & 3; \
        _Pragma("unroll") for (int i = 0; i < 2; ++i) { const int c = tid + 512 * i, k = c >> 3, ch = c & 7; kreg[i] = *(const u32x4*)(proj + (size_t)(row0_ + k) * DINP + C_KB + h_ * 64 + ch * 8); } \
        _Pragma("unroll") for (int i = 0; i < 4; ++i) { const int c = tid + 512 * i, k = c >> 4, ch = c & 15; vreg[i] = *(const u32x4*)(proj + (size_t)(row0_ + k) * DINP + C_VB + h_ * 128 + ch * 8); } } while (0)
    R1_LOAD(u);
    for (;;) {
        const int ci = u % NCHK, bh = u / NCHK, b = bh >> 2, h = bh & 3;
        const float lgf2 = lg2[h], lgb2 = lg2[4 + h];
#pragma unroll
        for (int i = 0; i < 2; ++i) { const int c = tid + 512 * i, k = c >> 3, ch = c & 7;
            const u32x4 v = kreg[i];
            const float wf = fexp2((float)(127 - k) * lgf2), wb = fexp2((float)k * lgb2);
            u32x4 a, d;
#pragma unroll
            for (int j = 0; j < 4; ++j) { const float x0 = bf_lo(v[j]), x1 = bf_hi(v[j]); a[j] = pk2(x0 * wf, x1 * wf); d[j] = pk2(x0 * wb, x1 * wb); }
            *(LAS u32x4*)(Kf + k * RSTR + ch * 16) = a; *(LAS u32x4*)(Kb + k * RSTR + ch * 16) = d; }
#pragma unroll
        for (int i = 0; i < 4; ++i) { const int c = tid + 512 * i, k = c >> 4, ch = c & 15; *(LAS u32x4*)(Vt + k * VSTR128 + ch * 16) = vreg[i]; }
        __syncthreads();
        const int un = u + G;
        if (un < NU) R1_LOAD(un);
        const int dir = wid >> 2, mt = (wid >> 1) & 1, nt0 = (wid & 1) * 2;
        const LAS unsigned char* Kt = dir ? Kb : Kf;
        f32x16 acc0 = (f32x16){0.f}, acc1 = (f32x16){0.f};
#pragma unroll
        for (int ks = 0; ks < 8; ++ks) {
            const bf16x8 af = tr_frag(Kt, RSTR, ks, 32 * mt, lane);
            acc0 = MFMA32(af, tr_frag(Vt, VSTR128, ks, 32 * nt0, lane), acc0);
            acc1 = MFMA32(af, tr_frag(Vt, VSTR128, ks, 32 * nt0 + 32, lane), acc1);
        }
        bf16_t* out = kvT + ((size_t)(((b * 4 + h) * NCHK + ci) * 2 + dir)) * 8192;
#pragma unroll
        for (int j = 0; j < 4; ++j) {
            u32x2 w0, w1; w0.x = pk2(acc0[4 * j], acc0[4 * j + 1]); w0.y = pk2(acc0[4 * j + 2], acc0[4 * j + 3]); w1.x = pk2(acc1[4 * j], acc1[4 * j + 1]); w1.y = pk2(acc1[4 * j + 2], acc1[4 * j + 3]);
            *(u32x2*)(out + (size_t)(32 * nt0 + (lane & 31)) * 64 + 32 * mt + 8 * j + 4 * hi) = w0;
            *(u32x2*)(out + (size_t)(32 * nt0 + 32 + (lane & 31)) * 64 + 32 * mt + 8 * j + 4 * hi) = w1;
        }
        __syncthreads();
        if (un >= NU) break;
        u = un;
    }
#undef R1_LOAD
}
__device__ __forceinline__ void ret_scan(const bf16_t* kvT, bf16_t* SpT, const float* lg2  , int gtid, int gthreads) {
    for (int q = gtid; q < 64 * 2048; q += gthreads) {
        const int combo = q >> 11, e4 = (q & 2047) * 4, dir = combo & 1, h = (combo >> 1) & 3, b = combo >> 3;
        const float g128 = fexp2(128.0f * lg2[dir * 4 + h]);
        f32x4 S = {0.f, 0.f, 0.f, 0.f};
        for (int s = 0; s < NCHK; ++s) {
            const int ci = dir ? (s == 0 ? 1 : (s == 1 ? 0 : 35 - s)) : s;
            const size_t off = ((size_t)(((b * 4 + h) * NCHK + ci) * 2 + dir)) * 8192 + e4;
            const u32x2 kw = *(const u32x2*)(kvT + off); const f32x4 kv = {bf_lo(kw.x), bf_hi(kw.x), bf_lo(kw.y), bf_hi(kw.y)};
            u32x2 w; w.x = pk2(S[0], S[1]); w.y = pk2(S[2], S[3]);
            *(u32x2*)(SpT + off) = w;
            S = S * g128 + kv;
        }
    }
}
constexpr int R3_K = 0, R3_V = 128 * KSTR, R3_SF = R3_V + 128 * VSTR128, R3_SB = R3_SF + 128 * KSTR, R3_X = R3_SB + 128 * KSTR, R3_SCR = R3_X + 1024, R3_LDS = R3_SCR + 2048;
__device__ __forceinline__ void ret_out_unit(LAS unsigned char* lds, const bf16_t* __restrict__ proj, const bf16_t* __restrict__ SpT, bf16_t* ocat, float lgf2, float lgb2, int b, int h, int ci, int tid) {
    const int lane = tid & 63, r32 = lane & 31, hi = lane >> 5; const int wid = __builtin_amdgcn_readfirstlane(tid >> 6);
    const int row0 = chunk_row0(b, ci), qs = wid & 3, dh = wid >> 2;
    const bf16_t* sp = SpT + ((size_t)(((b * 4 + h) * NCHK + ci) * 2)) * 8192;
#pragma unroll
    for (int i = 0; i < 2; ++i) { const int c = tid + 512 * i, k = c >> 3, ch = c & 7;
        *(LAS u32x4*)(lds + R3_K + k * KSTR + ch * 16) = *(const u32x4*)(proj + (size_t)(row0 + k) * DINP + C_KB + h * 64 + ch * 8);
        *(LAS u32x4*)(lds + R3_SF + k * KSTR + ch * 16) = *(const u32x4*)(sp + (size_t)k * 64 + ch * 8);
        *(LAS u32x4*)(lds + R3_SB + k * KSTR + ch * 16) = *(const u32x4*)(sp + 8192 + (size_t)k * 64 + ch * 8); }
#pragma unroll
    for (int i = 0; i < 4; ++i) { const int c = tid + 512 * i, k = c >> 4, ch = c & 15;
        *(LAS u32x4*)(lds + R3_V + k * VSTR128 + ch * 16) = *(const u32x4*)(proj + (size_t)(row0 + k) * DINP + C_VB + h * 128 + ch * 8); }
    bf16x8 qr[4];
    { const bf16_t* qp = proj + (size_t)(row0 + 32 * qs + r32) * DINP + C_QB + h * 64;
#pragma unroll
      for (int d0 = 0; d0 < 4; ++d0) qr[d0] = *(const bf16x8*)(qp + d0 * 16 + hi * 8); }
    bf16_t gt[2][16];
    { const bf16_t* gp0 = proj + (size_t)(row0 + 32 * qs) * DINP + C_GB + h * 128 + 64 * dh + r32;
#pragma unroll
      for (int r = 0; r < 16; ++r)
#pragma unroll
          for (int c = 0; c < 2; ++c) gt[c][r] = gp0[(size_t)crow(r, hi) * DINP + 32 * c]; }
    __syncthreads();
    f32x16 o[2];
#pragma unroll
    for (int c = 0; c < 2; ++c) {
        f32x16 tf = (f32x16){0.f}, tb = (f32x16){0.f};
        const int srow = 64 * dh + 32 * c + r32;
#pragma unroll
        for (int d0 = 0; d0 < 4; ++d0) {
            tf = MFMA32(qr[d0], *(const LAS bf16x8*)(lds + R3_SF + srow * KSTR + (16 * d0 + 8 * hi) * 2), tf);
            tb = MFMA32(qr[d0], *(const LAS bf16x8*)(lds + R3_SB + srow * KSTR + (16 * d0 + 8 * hi) * 2), tb);
        }
#pragma unroll
        for (int r = 0; r < 16; ++r) { const int cp = 32 * qs + crow(r, hi); o[c][r] = fexp2((float)(cp + 1) * lgf2) * tf[r] + fexp2((float)(128 - cp) * lgb2) * tb[r]; }
    }
    const int qpos = 32 * qs + r32;
#pragma unroll 1
    for (int kt = 0; kt < 4; ++kt) {
        f32x16 p = (f32x16){0.f};
#pragma unroll
        for (int d0 = 0; d0 < 4; ++d0) p = MFMA32(*(const LAS bf16x8*)(lds + R3_K + (32 * kt + r32) * KSTR + (16 * d0 + 8 * hi) * 2), qr[d0], p);
#pragma unroll
        for (int r = 0; r < 16; ++r) { const int d = qpos - (32 * kt + crow(r, hi));
            const float wf = d >= 0 ? fexp2((float)d * lgf2) : 0.f, wb = d <= 0 ? fexp2((float)(-d) * lgb2) : 0.f; p[r] *= (wf + wb); }
        u32x4 w0, w1;
        w0.x = pk2(p[0], p[1]); w0.y = pk2(p[2], p[3]); w0.z = pk2(p[4], p[5]); w0.w = pk2(p[6], p[7]);
        w1.x = pk2(p[8], p[9]); w1.y = pk2(p[10], p[11]); w1.z = pk2(p[12], p[13]); w1.w = pk2(p[14], p[15]);
        const bf16x8 pa = __builtin_bit_cast(bf16x8, w0), pb = __builtin_bit_cast(bf16x8, w1);
#pragma unroll
        for (int c = 0; c < 2; ++c) {
            o[c] = MFMA32(pa, tr_frag(lds + R3_V, VSTR128, 2 * kt, 64 * dh + 32 * c, lane), o[c]);
            o[c] = MFMA32(pb, tr_frag(lds + R3_V, VSTR128, 2 * kt + 1, 64 * dh + 32 * c, lane), o[c]);
        }
    }
    float ss[16];
#pragma unroll
    for (int r = 0; r < 16; ++r) { ss[r] = o[0][r] * o[0][r] + o[1][r] * o[1][r];
#pragma unroll
        for (int s = 1; s < 32; s <<= 1) ss[r] += __shfl_xor(ss[r], s); }
    LAS float* X = (LAS float*)(lds + R3_X);
    if (r32 == 0) {
#pragma unroll
        for (int r = 0; r < 16; ++r) X[dh * 128 + 32 * qs + crow(r, hi)] = ss[r];
    }
    __syncthreads();
    bf16_t* op = ocat + (size_t)(row0 + 32 * qs) * OCW + 512 + h * 128 + 64 * dh + r32;
#pragma unroll
    for (int r = 0; r < 16; ++r) { const int row = crow(r, hi);
        const float rstd = __builtin_amdgcn_rsqf((X[32 * qs + row] + X[128 + 32 * qs + row]) * (1.0f / 128.0f) + NORM_EPS);
#pragma unroll
        for (int c = 0; c < 2; ++c) { const float gte = bf1(gt[c][r]);
            op[(size_t)row * OCW + 32 * c] = (bf16_t)(pk2(o[c][r] * rstd * siluf_(gte), 0.f) & 0xffffu); } }
    __syncthreads();
}
#undef MFMA32
}
constexpr size_t MiB = 1u << 20;
constexpr size_t WS_CTL = 0, CTL_ZERO_BYTES = 128 * 1024;
constexpr int CW_BAR = 1024;
constexpr int CW_MOE = 8192;
constexpr int CW_CUR = 12288;
constexpr int CW_DEP = 20480;
constexpr int CW_DONE = 16384;
constexpr size_t WS_TAB = 1 * MiB;
constexpr int TAB_MOD = 0, TAB_ROPE = DEPTH * 9 * 6144, TAB_LAM = TAB_ROPE + 2048, TAB_LG2 = TAB_LAM + 8, TAB_WSC = TAB_LG2 + 32;
constexpr size_t WS_XC = 2 * MiB;
constexpr size_t WS_ROUTE = 10 * MiB;
constexpr size_t WS_RS = 11 * MiB + 256 * 1024;
constexpr size_t WS_RSS = 11 * MiB + 512 * 1024;
constexpr size_t WS_MIX = 12 * MiB, MIX_STRIDE = 19 * MiB;
constexpr size_t MIX_WB = 14 * MiB, MIX_WO = 17 * MiB;
constexpr size_t WS_FD = 88 * MiB, FD_STRIDE = 17 * MiB, FD_W2 = 11 * MiB;
constexpr size_t WS_W13 = 122 * MiB;
constexpr size_t WS_W2 = 210 * MiB;
constexpr size_t WS_H = 254 * MiB;
constexpr size_t WS_PROJ = 322 * MiB;
constexpr size_t WS_GATE = WS_PROJ + 256 * MiB;
constexpr size_t WS_OCAT = 782 * MiB;
constexpr size_t WS_Y = 884 * MiB;
constexpr size_t WS_END = 952 * MiB;
static_assert((size_t)DIN * DM * 2 <= MIX_WB && MIX_WB + (size_t)DM * OCW * 2 <= MIX_WO && MIX_WO + (size_t)DM * DM * 2 <= MIX_STRIDE && WS_MIX + DEPTH * MIX_STRIDE <= WS_FD, "ws map (mixer weights)");
static_assert((size_t)2 * DFF * DM * 2 <= FD_W2 && FD_W2 + (size_t)DM * DFF * 2 <= FD_STRIDE && WS_FD + 2 * FD_STRIDE <= WS_W13, "ws map (dense ffn weights)");
static_assert(WS_W13 + (size_t)NEXP * 2 * DFF * DM * 2 <= WS_W2 && WS_W2 + (size_t)NEXP * DM * DFF * 2 <= WS_H && WS_H + (size_t)TT * DM * 2 <= WS_PROJ, "ws map (moe weights, h)");
static_assert(WS_PROJ + (size_t)TT * DINP * 2 <= WS_GATE && WS_GATE + (size_t)3 * NMT * 4 * 8 * 16 * 64 * 16 <= WS_OCAT && WS_OCAT + (size_t)TT * OCW * 2 <= WS_Y && WS_Y + (size_t)TT * DM * 2 <= WS_END, "ws map (activations)");
constexpr int MOE_SLOTS = 2 * TT + NEXP * 256;
static_assert(WS_PROJ + (size_t)MOE_SLOTS * DFF * 2 <= WS_OCAT && WS_OCAT + (size_t)MOE_SLOTS * DM * 2 <= WS_END, "ws map (MoE overlays)");
static_assert((size_t)NB * 4 * NCHK * 2 * 8192 * 4 <= (size_t)TT * DM * 2 && (size_t)NB * 4 * NCHK * 2 * 8192 * 2 <= (size_t)TT * DM * 2, "ws map (retention overlays)");

#define XB_TMO      128
#define XB_XCNT(j)  (256  + 64 * (j))
#define XB_XSUB(j)  (1280 + 64 * (j))
#define XB_XGEN(j)  (2304 + 64 * (j))
#define XB_TOP      3328
#define XB_TOPGEN   3392
#define XCD_BAR_WORDS 3456
#define XB_SPIN_CAP (1u << 18)

__device__ __forceinline__ unsigned xb_ld(unsigned* p)              { return __hip_atomic_load(p, __ATOMIC_RELAXED, __HIP_MEMORY_SCOPE_AGENT); }
__device__ __forceinline__ unsigned xb_add(unsigned* p, unsigned v) { return __hip_atomic_fetch_add(p, v, __ATOMIC_RELAXED, __HIP_MEMORY_SCOPE_AGENT); }
__device__ __forceinline__ unsigned xb_xcc_id() { return (unsigned)__builtin_amdgcn_s_getreg((3 << 11) | 20) & 0xFu; }
#define XB_SPIN(cond, bar) do { unsigned _sp = 0; while (cond) { __builtin_amdgcn_s_sleep(1); \
    if ((++_sp & 255u) == 0u) { if (xb_ld(&(bar)[XB_TMO])) break; if (_sp > XB_SPIN_CAP) { atomicAdd(&(bar)[XB_TMO], 1u); break; } } } } while (0)

struct XcdBarrier {
    unsigned* bar; unsigned x;
    volatile LAS unsigned* st;
};
__device__ __forceinline__ XcdBarrier xcd_barrier_post(unsigned* bar, volatile LAS unsigned* st, int tid) {
    XcdBarrier b; b.bar = bar; b.x = xb_xcc_id(); b.st = st;
    if (tid == 0) (void)xb_add(&bar[XB_XCNT(b.x)], 1u);
    return b;
}
__device__ __forceinline__ void xcd_barrier_complete(unsigned* bar, unsigned x, unsigned& nloc, unsigned& nx) {
    const unsigned G = gridDim.x * gridDim.y * gridDim.z;
    unsigned sum, cnt, mine, sp = 0u;
    for (;;) {
        sum = 0u; cnt = 0u; mine = 0u;
#pragma unroll
        for (unsigned j = 0; j < 16; ++j) { const unsigned c = xb_ld(&bar[XB_XCNT(j)]); sum += c; cnt += (c > 0u) ? 1u : 0u; mine = (j == x) ? c : mine; }
        if (sum == G) break;
        __builtin_amdgcn_s_sleep(1);
        if ((++sp & 255u) == 0u) { if (xb_ld(&bar[XB_TMO])) break; if (sp > XB_SPIN_CAP) { atomicAdd(&bar[XB_TMO], 1u); break; } }
    }
    nloc = mine > 0u ? mine : 1u; nx = cnt > 0u ? cnt : 1u;
}
__device__ __forceinline__ void xcd_barrier(const XcdBarrier& b_in, int tid) {
    XcdBarrier b = b_in; b.x = xb_xcc_id();
    asm volatile("s_waitcnt vmcnt(0)" ::: "memory");
    __syncthreads();
    if (tid == 0) {
        unsigned* bar = b.bar; asm volatile("" : "+s"(bar));
        __builtin_amdgcn_s_waitcnt(0);
        unsigned nloc = b.st[0], nx = b.st[1];
        if (nloc == 0u) { xcd_barrier_complete(bar, b.x, nloc, nx); b.st[0] = nloc; b.st[1] = nx; }
        const unsigned old = xb_add(&bar[XB_XSUB(b.x)], 1u);
        const unsigned gen = old / nloc;
        if (old + 1u == (gen + 1u) * nloc) {
            __builtin_amdgcn_fence(__ATOMIC_RELEASE, "agent");
            asm volatile("s_waitcnt vmcnt(0)" ::: "memory");
            const unsigned og = xb_add(&bar[XB_TOP], 1u);
            const unsigned tg = og / nx;
            if (og + 1u == (tg + 1u) * nx) xb_add(&bar[XB_TOPGEN], 1u);
            else XB_SPIN(xb_ld(&bar[XB_TOPGEN]) == tg, bar);
            __builtin_amdgcn_fence(__ATOMIC_ACQUIRE, "agent");
            xb_add(&bar[XB_XGEN(b.x)], 1u);
            asm volatile("s_waitcnt vmcnt(0)" ::: "memory");
        } else {
            XB_SPIN(xb_ld(&bar[XB_XGEN(b.x)]) == gen, bar);
            __builtin_amdgcn_fence(__ATOMIC_ACQUIRE, "agent");
            asm volatile("s_waitcnt vmcnt(0)" ::: "memory");
        }
    }
    __syncthreads();
}
struct Route { int sa, sb; float ga, gb; int ea, pa, eb, pb; };

__device__ __forceinline__ void p0_mod(LAS unsigned char* lds, const float* c, const float* cctx, const float* wmod, const float* bmod, float* mod, int blk, int G, int tid) {
    LAS float* sc = (LAS float*)lds;
    LAS float* red = sc + 9 * 1024;
    for (int i = tid; i < 9 * 1024; i += 512) { const float v = i < 8192 ? c[i] : cctx[i - 8192]; sc[i] = siluf_(v); }
    __syncthreads();
    const int cq = tid & 31, kg = tid >> 5;
    for (int u = blk; u < DEPTH * 48; u += G) {
        const int l = u / 48, n = (u % 48) * 128 + 4 * cq;
        f32x4 acc[9];
#pragma unroll
        for (int r = 0; r < 9; ++r) acc[r] = (f32x4){0.f, 0.f, 0.f, 0.f};
        const float* wp = wmod + ((size_t)l * DM + kg * 64) * 6144 + n;
        for (int k0 = 0; k0 < 64; k0 += 16) {
            f32x4 w[16];
#pragma unroll
            for (int k = 0; k < 16; ++k) w[k] = *(const f32x4*)(wp + (size_t)(k0 + k) * 6144);
#pragma unroll
            for (int k = 0; k < 16; ++k)
#pragma unroll
                for (int r = 0; r < 9; ++r) acc[r] += w[k] * sc[r * 1024 + kg * 64 + k0 + k];
        }
#pragma unroll
        for (int r = 0; r < 9; ++r) *(LAS f32x4*)(red + ((kg * 32 + cq) * 9 + r) * 4) = acc[r];
        __syncthreads();
        if (tid < 32 * 9) { const int q = tid / 9, r = tid % 9; f32x4 s = {0.f, 0.f, 0.f, 0.f};
#pragma unroll
            for (int g = 0; g < 16; ++g) s += *(const LAS f32x4*)(red + ((g * 32 + q) * 9 + r) * 4);
            const int nn = (u % 48) * 128 + 4 * q;
            *(f32x4*)(mod + ((size_t)l * 9 + r) * 6144 + nn) = s + *(const f32x4*)(bmod + (size_t)l * 6144 + nn); }
        __syncthreads();
    }
}
__device__ __forceinline__ void p0_tables(float* tab, const float* dlam, const float* decf, const float* decb, int tid) {
    for (int i = tid; i < 1024; i += 512) { const int pos = i >> 4, f = i & 15;
        const float inv = 1.0f / powf(10000.0f, (float)f / 16.0f), ang = (float)pos * inv;
        tab[TAB_ROPE + 2 * i] = cosf(ang); tab[TAB_ROPE + 2 * i + 1] = sinf(ang); }
    if (tid < 4) { const float* lp = dlam + tid * 256; float s01 = 0.f, s23 = 0.f;
        for (int k = 0; k < 64; ++k) { s01 += lp[k] * lp[64 + k]; s23 += lp[128 + k] * lp[192 + k]; }
        const float li = 0.8f - 0.6f * expf(-0.3f * (float)tid);
        tab[TAB_LAM + 2 * tid] = expf(s01) - expf(s23) + li; tab[TAB_LAM + 2 * tid + 1] = 1.0f - li; }
    if (tid >= 64 && tid < 96) { const int i = tid - 64, l = i >> 3, dir = (i >> 2) & 1, h = i & 3;
        const float x = (dir ? decb : decf)[l * 4 + h];
        tab[TAB_LG2 + i] = -log1pf(expf(-x)) * LOG2E; }
}

__device__ __forceinline__ float sample_rms(const float* W, int n, LAS float* red, int tid) {
    const int stride = n / 16384 - 1; float s = 0.f; float v[32];
#pragma unroll
    for (int i = 0; i < 32; ++i) v[i] = W[(size_t)(tid * 32 + i) * stride];
#pragma unroll
    for (int i = 0; i < 32; ++i) s += v[i] * v[i];
    s = wave_sum(s);
    __syncthreads(); if ((tid & 63) == 0) red[tid >> 6] = s; __syncthreads();
    float t = 0.f;
#pragma unroll
    for (int w = 0; w < 8; ++w) t += red[w];
    __syncthreads();
    return sqrtf(t * (1.0f / 16384.0f));
}
__device__ __forceinline__ void cvt_item(const float* W, int ldw, int k0, int sc, bf16_t* WTrow0, int ldt, LAS float* scr, int lane) {
    float v[32];
#pragma unroll
    for (int i = 0; i < 32; ++i) v[i] = __builtin_nontemporal_load(W + (size_t)(k0 + 2 * i + (lane >> 5)) * ldw + sc);
#pragma unroll
    for (int i = 0; i < 32; ++i) scr[(2 * i + (lane >> 5)) * 33 + (lane & 31)] = v[i];
    LDS_WAIT(); asm volatile("" ::: "memory");
    const int c = lane & 7;
#pragma unroll
    for (int j = 0; j < 4; ++j) { const int n = (lane >> 3) + 8 * j; const LAS float* s = scr + (8 * c) * 33 + n;
        u32x4 o; o.x = pk2(s[0 * 33], s[1 * 33]); o.y = pk2(s[2 * 33], s[3 * 33]); o.z = pk2(s[4 * 33], s[5 * 33]); o.w = pk2(s[6 * 33], s[7 * 33]);
        *(u32x4*)(WTrow0 + (size_t)n * ldt + 8 * c) = o; }
    LDS_WAIT(); asm volatile("" ::: "memory");
}
template <bool I8>
__device__ __forceinline__ void cvt_item8(const float* W, int ldw, int k0, int sc, unsigned char* WTrow0, int ldt, float scale, LAS float* scr, int lane) {
    float v[32];
#pragma unroll
    for (int i = 0; i < 32; ++i) v[i] = __builtin_nontemporal_load(W + (size_t)(k0 + 2 * i + (lane >> 5)) * ldw + sc);
#pragma unroll
    for (int i = 0; i < 32; ++i) scr[(2 * i + (lane >> 5)) * 33 + (lane & 31)] = v[i] * scale;
    LDS_WAIT(); asm volatile("" ::: "memory");
    const int c = lane & 7;
#pragma unroll
    for (int j = 0; j < 4; ++j) { const int n = (lane >> 3) + 8 * j; const LAS float* s = scr + (8 * c) * 33 + n;
        u32x2 o;
        if constexpr (I8) {
#define CL_(x) __builtin_amdgcn_fmed3f((x), -127.0f, 127.0f)
            o.x = pk4i8(CL_(s[0 * 33]), CL_(s[1 * 33]), CL_(s[2 * 33]), CL_(s[3 * 33])); o.y = pk4i8(CL_(s[4 * 33]), CL_(s[5 * 33]), CL_(s[6 * 33]), CL_(s[7 * 33]));
#undef CL_
        } else { o.x = pk4f8(s[0 * 33], s[1 * 33], s[2 * 33], s[3 * 33]); o.y = pk4f8(s[4 * 33], s[5 * 33], s[6 * 33], s[7 * 33]); }
        *(u32x2*)(WTrow0 + (size_t)n * ldt + 8 * c) = o; }
    LDS_WAIT(); asm volatile("" ::: "memory");
}
__device__ __forceinline__ int win_src(int n) {
    const bool rp = (n < 640) || (n >= 768 && n < 1280) || (n >= 2304 && n < 3328);
    if (!rp) return n;
    const int p = n & 63, j = p >> 1, e = p & 1;
    return (n & ~63) + (j >> 4) * 32 + e * 16 + (j & 15);
}
constexpr int I_IN = 16 * 216, I_B = 3 * 8 * 32, I_O = 16 * 32, I_MIX = I_IN + I_B + I_O, I_F1 = 16 * 88, I_F2 = 44 * 32, I_FE = 2 * I_F1 + I_F2;
__device__ __forceinline__ void cvt_mix(const float* win, const float* wb, const float* wo, unsigned char* mixbase, int r, float qs_in, LAS float* scr, int lane) {
    bf16_t* WbT = (bf16_t*)(mixbase + MIX_WB); bf16_t* WoT = (bf16_t*)(mixbase + MIX_WO);
    if (r < I_IN) { const int kb = r / 216, nb = r % 216; cvt_item8<true>(win, DIN, 64 * kb, win_src(32 * nb + (lane & 31)), mixbase + (size_t)(32 * nb) * DM + 64 * kb, DM, qs_in, scr, lane); return; } r -= I_IN;
    if (r < I_B) { const int i = r / 256, q = r % 256, kb = q / 32, nb = q % 32;
        cvt_item(wb + (size_t)i * 512 * DM, DM, 64 * kb, 32 * nb + (lane & 31), WbT + (size_t)(32 * nb) * OCW + i * 512 + 64 * kb, OCW, scr, lane); return; } r -= I_B;
    { const int kb = r / 32, nb = r % 32; cvt_item(wo, DM, 64 * kb, 32 * nb + (lane & 31), WoT + (size_t)(32 * nb) * DM + 64 * kb, DM, scr, lane); }
}
__device__ __forceinline__ void cvt_ffn(const float* f1, const float* f3, const float* f2, unsigned char* w13, unsigned char* w2, int r, float qs1, float qs3, int f8dn, LAS float* scr, int lane) {
    if (r < 2 * I_F1) { const int which = r / I_F1, q = r % I_F1, kb = q / 88, nb = q % 88, j0 = 32 * nb;
        const int drow = (j0 >> 7) * 256 + which * 128 + (j0 & 127);
        cvt_item8<true>(which ? f3 : f1, DFF, 64 * kb, j0 + (lane & 31), w13 + (size_t)drow * DM + 64 * kb, DM, which ? qs3 : qs1, scr, lane);
        return; } r -= 2 * I_F1;
    { const int kb = r / 32, nb = r % 32;
        if (f8dn) cvt_item8<false>(f2, DM, 64 * kb, 32 * nb + (lane & 31), w2 + (size_t)(32 * nb) * DFF + 64 * kb, DFF, F8_SW2, scr, lane);
        else cvt_item(f2, DM, 64 * kb, 32 * nb + (lane & 31), (bf16_t*)w2 + (size_t)(32 * nb) * DFF + 64 * kb, DFF, scr, lane); }
}
constexpr int N_RANGES = 7;
__device__ __forceinline__ int range_items(int k) { return (k == 0 || k == 4) ? I_FE : (k == 3 || k == 6) ? NEXP * I_FE : I_MIX; }
__device__ __forceinline__ void range_item(int k, int r, LAS unsigned char* lds, unsigned char* ws, LAS float* scr, int lane);

__device__ __forceinline__ void norm_rows(LAS unsigned char* lds, const float* xinL, const float* xinC, float* xoutL, float* xoutC, const float* gain, const float* mod, const float* modc, int shoff,
                                          bf16_t* hout, int qmode, float* rsout, int nrows, int combine, const Route* route, const bf16_t* fbuf, const float* wrouter, int do_route, Route* route_out, unsigned* gcnt,
                                          int blk, int G, int wave, int lane, int tid) {
    LAS float* wr = (LAS float*)lds;
    LAS int* lcnt = (LAS int*)(lds + 32768);
    LAS int* rec = (LAS int*)(lds + 32768 + 64);
    if (do_route) { for (int i = tid; i < 8192; i += 512) wr[i] = wrouter[i]; }
    const int per = (nrows + G - 1) / G, r0 = blk * per, r1 = (r0 + per < nrows) ? r0 + per : nrows;
    for (int cs = r0; cs < r1; cs += 256) {
        const int ce = cs + 256 < r1 ? cs + 256 : r1;
        if (do_route) { if (tid < 8) lcnt[tid] = 0; __syncthreads(); }
        f32x4 vn[4];
#define NR_LOAD(rr) do { const float* xi_ = (rr) < TL ? xinL + (size_t)(rr) * DM : xinC + (size_t)((rr) - TL) * DM; \
            _Pragma("unroll") for (int j = 0; j < 4; ++j) vn[j] = *(const f32x4*)(xi_ + 4 * lane + 256 * j); } while (0)
        if (cs + wave < ce) NR_LOAD(cs + wave);
        for (int row = cs + wave; row < ce; row += 8) {
            const bool lat = row < TL; const int mb = lat ? (row >> 12) : 8;
            f32x4 v[4];
#pragma unroll
            for (int j = 0; j < 4; ++j) v[j] = vn[j];
            if (row + 8 < ce) NR_LOAD(row + 8);
            if (combine) {
                const Route rt = route[row]; const float* g2 = modc + mb * 6144 + 5120;
                float* xo = lat ? xoutL + (size_t)row * DM : xoutC + (size_t)(row - TL) * DM;
#pragma unroll
                for (int j = 0; j < 4; ++j) { const int col = 4 * lane + 256 * j;
                    const u32x2 fa = *(const u32x2*)(fbuf + (size_t)rt.sa * DM + col), fb = *(const u32x2*)(fbuf + (size_t)rt.sb * DM + col);
                    const f32x4 gg = *(const f32x4*)(g2 + col);
                    v[j][0] += gg[0] * (rt.ga * bf_lo(fa.x) + rt.gb * bf_lo(fb.x)); v[j][1] += gg[1] * (rt.ga * bf_hi(fa.x) + rt.gb * bf_hi(fb.x));
                    v[j][2] += gg[2] * (rt.ga * bf_lo(fa.y) + rt.gb * bf_lo(fb.y)); v[j][3] += gg[3] * (rt.ga * bf_hi(fa.y) + rt.gb * bf_hi(fb.y));
                    *(f32x4*)(xo + col) = v[j]; }
            }
            float s = 0.f;
#pragma unroll
            for (int j = 0; j < 4; ++j) s += (v[j][0] * v[j][0] + v[j][1] * v[j][1]) + (v[j][2] * v[j][2] + v[j][3] * v[j][3]);
            const float rstd = 1.0f / sqrtf(wave_sum(s) * (1.0f / DM) + NORM_EPS);
            const float* sh = mod + mb * 6144 + shoff; const float* scp = sh + 1024;
            float lg[8];
#pragma unroll
            for (int e = 0; e < 8; ++e) lg[e] = 0.f;
            float qs = 1.0f;
            if (qmode == 2) {
                float am = 0.f;
#pragma unroll
                for (int j = 0; j < 4; ++j) { const int col = 4 * lane + 256 * j;
                    const f32x4 gn = *(const f32x4*)(gain + col), s1 = *(const f32x4*)(scp + col), s0 = *(const f32x4*)(sh + col);
#pragma unroll
                    for (int k = 0; k < 4; ++k) am = fmaxf(am, fabsf(v[j][k] * rstd * gn[k] * (1.0f + s1[k]) + s0[k])); }
                am = fmaxf(wave_max(am), 1.0e-20f); qs = 127.0f / am;
                if (lane == 0) rsout[row] = am * (1.0f / 127.0f);
            }
#pragma unroll
            for (int j = 0; j < 4; ++j) { const int col = 4 * lane + 256 * j;
                const f32x4 gn = *(const f32x4*)(gain + col), s1 = *(const f32x4*)(scp + col), s0 = *(const f32x4*)(sh + col);
                f32x4 hv;
#pragma unroll
                for (int k = 0; k < 4; ++k) hv[k] = v[j][k] * rstd * gn[k] * (1.0f + s1[k]) + s0[k];
                if (qmode == 2) *(unsigned*)((unsigned char*)hout + (size_t)row * DM + col) = pk4i8(fminf(hv[0] * qs, 127.0f), fminf(hv[1] * qs, 127.0f), fminf(hv[2] * qs, 127.0f), fminf(hv[3] * qs, 127.0f));
                else if (qmode == 1) *(unsigned*)((unsigned char*)hout + (size_t)row * DM + col) = pk4f8(hv[0] * F8_SH, hv[1] * F8_SH, hv[2] * F8_SH, hv[3] * F8_SH);
                else { u32x2 w; w.x = pk2(hv[0], hv[1]); w.y = pk2(hv[2], hv[3]); *(u32x2*)(hout + (size_t)row * DM + col) = w; }
                if (do_route) {
#pragma unroll
                    for (int k = 0; k < 4; ++k) { const f32x4 wa = *(const LAS f32x4*)(wr + (col + k) * 8), wb = *(const LAS f32x4*)(wr + (col + k) * 8 + 4);
                        lg[0] += hv[k] * wa[0]; lg[1] += hv[k] * wa[1]; lg[2] += hv[k] * wa[2]; lg[3] += hv[k] * wa[3];
                        lg[4] += hv[k] * wb[0]; lg[5] += hv[k] * wb[1]; lg[6] += hv[k] * wb[2]; lg[7] += hv[k] * wb[3]; }
                }
            }
            if (do_route) {
#pragma unroll
                for (int e = 0; e < 8; ++e) lg[e] = wave_sum(lg[e]);
                if (lane == 0) {
                    int e1 = 0; float v1 = lg[0];
#pragma unroll
                    for (int e = 1; e < 8; ++e) if (lg[e] > v1) { v1 = lg[e]; e1 = e; }
                    int e2 = -1; float v2 = -3.0e38f;
#pragma unroll
                    for (int e = 0; e < 8; ++e) if (e != e1 && lg[e] > v2) { v2 = lg[e]; e2 = e; }
                    const float gb_ = 1.0f / (1.0f + __expf(v1 - v2)), ga_ = 1.0f - gb_;
                    const int i = row - cs;
                    rec[i * 6 + 0] = e1; rec[i * 6 + 1] = __hip_atomic_fetch_add(&lcnt[e1], 1, __ATOMIC_RELAXED, __HIP_MEMORY_SCOPE_WORKGROUP); rec[i * 6 + 2] = e2; rec[i * 6 + 3] = __hip_atomic_fetch_add(&lcnt[e2], 1, __ATOMIC_RELAXED, __HIP_MEMORY_SCOPE_WORKGROUP);
                    rec[i * 6 + 4] = __float_as_int(ga_); rec[i * 6 + 5] = __float_as_int(gb_);
                }
            }
        }
        if (do_route) {
            __syncthreads();
            if (tid < 8) lcnt[8 + tid] = (int)__hip_atomic_fetch_add(gcnt + 64 * tid, (unsigned)lcnt[tid], __ATOMIC_RELAXED, __HIP_MEMORY_SCOPE_AGENT);
            __syncthreads();
            for (int i = tid; i < ce - cs; i += 512) { Route rt; rt.sa = 0; rt.sb = 0;
                rt.ea = rec[i * 6 + 0]; rt.pa = lcnt[8 + rt.ea] + rec[i * 6 + 1]; rt.eb = rec[i * 6 + 2]; rt.pb = lcnt[8 + rt.eb] + rec[i * 6 + 3];
                rt.ga = __int_as_float(rec[i * 6 + 4]); rt.gb = __int_as_float(rec[i * 6 + 5]); route_out[cs + i] = rt; }
            __syncthreads();
        }
    }
}
__device__ __forceinline__ void moe_gather(const unsigned char* h2, unsigned char* hs, const float* rs, float* rss, Route* route, unsigned* gcnt, int nrows, int gw, int ngw, int lane) {
    int off[8]; { int a = 0;
#pragma unroll
        for (int e = 0; e < 8; ++e) { off[e] = a; const int c = (int)__hip_atomic_load(gcnt + 64 * e, __ATOMIC_RELAXED, __HIP_MEMORY_SCOPE_AGENT); a += (c + 255) & ~255; } }
    u32x4 an; Route rn;
    if (gw < nrows) { rn = route[gw]; an = *(const u32x4*)(h2 + (size_t)gw * DM + 16 * lane); }
    for (int row = gw; row < nrows; row += ngw) {
        const Route rt = rn; const u32x4 a = an;
        if (row + ngw < nrows) { rn = route[row + ngw]; an = *(const u32x4*)(h2 + (size_t)(row + ngw) * DM + 16 * lane); }
        int oa = 0, ob = 0;
#pragma unroll
        for (int e = 0; e < 8; ++e) { oa = (rt.ea == e) ? off[e] : oa; ob = (rt.eb == e) ? off[e] : ob; }
        const int sa = oa + rt.pa, sb = ob + rt.pb;
        *(u32x4*)(hs + (size_t)sa * DM + 16 * lane) = a;
        *(u32x4*)(hs + (size_t)sb * DM + 16 * lane) = a;
        if (lane == 0) { route[row].sa = sa; route[row].sb = sb; const float r = rs[row]; rss[sa] = r; rss[sb] = r; }
    }
}
__device__ __forceinline__ void final_norm(float* x, const float* gain, const float* mod, const Route* route, const bf16_t* fbuf, int gw, int ngw, int lane) {
    for (int row = gw; row < TL; row += ngw) {
        const int mb = row >> 12; float* xr = x + (size_t)row * DM;
        const Route rt = route[row]; const float* g2 = mod + mb * 6144 + 5120;
        f32x4 v[4]; float s = 0.f;
#pragma unroll
        for (int j = 0; j < 4; ++j) { const int col = 4 * lane + 256 * j; v[j] = *(const f32x4*)(xr + col);
            const u32x2 fa = *(const u32x2*)(fbuf + (size_t)rt.sa * DM + col), fb = *(const u32x2*)(fbuf + (size_t)rt.sb * DM + col);
            const f32x4 gg = *(const f32x4*)(g2 + col);
            v[j][0] += gg[0] * (rt.ga * bf_lo(fa.x) + rt.gb * bf_lo(fb.x)); v[j][1] += gg[1] * (rt.ga * bf_hi(fa.x) + rt.gb * bf_hi(fb.x));
            v[j][2] += gg[2] * (rt.ga * bf_lo(fa.y) + rt.gb * bf_lo(fb.y)); v[j][3] += gg[3] * (rt.ga * bf_hi(fa.y) + rt.gb * bf_hi(fb.y));
            s += (v[j][0] * v[j][0] + v[j][1] * v[j][1]) + (v[j][2] * v[j][2] + v[j][3] * v[j][3]); }
        const float rstd = 1.0f / sqrtf(wave_sum(s) * (1.0f / DM) + NORM_EPS);
#pragma unroll
        for (int j = 0; j < 4; ++j) { const int col = 4 * lane + 256 * j; const f32x4 gn = *(const f32x4*)(gain + col); *(f32x4*)(xr + col) = v[j] * rstd * gn; }
    }
}
constexpr int NWAVES = 8;
constexpr int LDS_MISC = pg8::STAGE_BYTES + 2048, LDS_PTAB = LDS_MISC + 64;
constexpr int LDS_BYTES = pg8::STAGE_BYTES + 2048 + 1024;
static_assert(at::AT_A_LDS <= pg8::STAGE_BYTES && at::AT_C_LDS <= pg8::STAGE_BYTES + 2048 && at::R1_LDS <= pg8::STAGE_BYTES && at::R3_LDS <= pg8::STAGE_BYTES, "LDS");
constexpr int NPH = 11;
constexpr int N_PHASES = 1 + DEPTH * NPH + 1;

struct Args { const float* in[24]; float* out; unsigned char* ws; int ph_lo, ph_hi; };
static_assert(sizeof(Args) == 24 * 8 + 8 + 8 + 8, "Args has no padding");

__device__ __forceinline__ void* ldptr(LAS unsigned char* lds, int i) {
    const u32x2 v = *(const LAS u32x2*)(lds + LDS_PTAB + 8 * i);
    const unsigned lo = __builtin_amdgcn_readfirstlane(v.x), hi = __builtin_amdgcn_readfirstlane(v.y);
    GAS void* g = (GAS void*)(((unsigned long long)hi << 32) | lo);
    return (void*)g;
}
#define PIN(i) ((const float*)ldptr(lds, (i)))
#define PWS() ((unsigned char*)ldptr(lds, 25))
#define POUT() ((float*)ldptr(lds, 24))
__device__ __forceinline__ void range_item(int k, int r, LAS unsigned char* lds, unsigned char* ws, LAS float* scr, int lane) {
    if (k == 1 || k == 2 || k == 5) { const int l = (k == 5) ? 3 : k;
        cvt_mix(PIN(9) + (size_t)l * DM * DIN, PIN(15) + (size_t)l * 3 * 512 * DM, PIN(16) + (size_t)l * DM * DM, ws + WS_MIX + l * MIX_STRIDE, r, ((const float*)(ws + WS_TAB))[TAB_WSC + 2 * l], scr, lane); }
    else if (k == 0 || k == 4) { const int j = (k == 0) ? 0 : 1;
        cvt_ffn(PIN(17) + (size_t)j * DM * DFF, PIN(18) + (size_t)j * DM * DFF, PIN(19) + (size_t)j * DFF * DM, ws + WS_FD + j * FD_STRIDE, ws + WS_FD + j * FD_STRIDE + FD_W2, r, ((const float*)(ws + WS_TAB))[TAB_WSC + 2 * (4 + j)], ((const float*)(ws + WS_TAB))[TAB_WSC + 2 * (6 + j)], DENSE_F8, scr, lane); }
    else { const int j = (k == 3) ? 0 : 1, e = r / I_FE, rr = r % I_FE; const size_t eo = ((size_t)j * NEXP + e) * DM * DFF;
        cvt_ffn(PIN(21) + eo, PIN(22) + eo, PIN(23) + eo, ws + WS_W13 + (size_t)e * 2 * DFF * DM, ws + WS_W2 + (size_t)e * DM * DFF, rr, ((const float*)(ws + WS_TAB))[TAB_WSC + 2 * (8 + j * 8 + e)], ((const float*)(ws + WS_TAB))[TAB_WSC + 2 * (24 + j * 8 + e)], 1, scr, lane); }
}
__device__ __forceinline__ int range_base(int k) { return k == 0 ? 0 : k == 1 ? I_FE : k == 2 ? I_FE + I_MIX : k == 3 ? I_FE + 2 * I_MIX : k == 4 ? I_FE + 2 * I_MIX + NEXP * I_FE : k == 5 ? 2 * I_FE + 2 * I_MIX + NEXP * I_FE
                                                          : k == 6 ? 2 * I_FE + 3 * I_MIX + NEXP * I_FE : 2 * I_FE + 3 * I_MIX + 2 * NEXP * I_FE; }
__device__ __forceinline__ void bg_static(LAS unsigned char* lds, unsigned char* ws, int g0, int g1, int worker, int nworkers, int wave, int lane) {
    LAS float* scr = (LAS float*)lds + wave * (64 * 33);
    for (int g = g0 + worker; g < g1; g += nworkers) {
        int k = 0;
#pragma unroll
        for (int j = 1; j < N_RANGES; ++j) k += (g >= range_base(j)) ? 1 : 0;
        range_item(k, g - range_base(k), lds, ws, scr, lane);
    }
}
constexpr int WGM_MOE = 4;
constexpr int Q_B = 4, Q_F = 7, Q_G = 5, Q_I = 4, Q_J = 14;
#define TAIL_BOOK(nwg_in, quota, drain) const int tb_nwg = (nwg_in), tb_maxu = (tb_nwg + G - 1) / G, tb_nh = (tb_nwg % G == 0) ? G : tb_nwg - (tb_maxu - 1) * G, tb_nt = G - tb_nh; \
        const int tb_lim = range_base(kmax + 1), tb_g0 = gc; int tb_take = tb_nt * NWAVES * (quota); if (tb_take > tb_lim - gc) tb_take = tb_lim - gc; if (tb_take < 0) tb_take = 0; \
        const int tb_g1 = tb_g0 + tb_take; const int tb_e = (drain) >= 0 ? range_base((drain) + 1) : 0; const int tb_g2 = tb_e > tb_g1 ? tb_e : tb_g1; gc = tb_g2
#define TAIL_RUN() do { if (blk >= tb_nh && tb_take > 0) bg_static(lds, ws, tb_g0, tb_g1, (blk - tb_nh) * NWAVES + wave, tb_nt * NWAVES, wave, LANE()); \
        if (tb_g2 > tb_g1) bg_static(lds, ws, tb_g1, tb_g2, GW(), NGW(), wave, LANE()); } while (0)

__global__ void __launch_bounds__(NWAVES * 64, 2) mega(Args a) {
    extern __shared__ __attribute__((aligned(16))) unsigned char lds_raw[];
    LAS unsigned char* lds = (LAS unsigned char*)lds_raw;
    LAS unsigned char* const lds_k = lds;
#define LDSL() ({ LAS unsigned char* p_ = lds_k; asm volatile("" : "+s"(p_)); p_; })
    const int wave = __builtin_amdgcn_readfirstlane((int)threadIdx.x >> 6);
    const int G = gridDim.x, blk = blockIdx.x;
#define LANE0() ({ int t_; asm volatile("v_mbcnt_lo_u32_b32 %0, -1, 0\n\tv_mbcnt_hi_u32_b32 %0, -1, %0" : "=v"(t_)); t_; })
#define LANE() LANE0()
#define TID0() ((wave << 6) | LANE0())
#define TID() TID0()
    if (threadIdx.x == 0) {
        LAS unsigned long long* pt = (LAS unsigned long long*)(lds + LDS_PTAB);
#pragma unroll
        for (int i = 0; i < 24; ++i) pt[i] = (unsigned long long)a.in[i];
        pt[24] = (unsigned long long)a.out; pt[25] = (unsigned long long)a.ws;
        ((LAS unsigned*)(lds + LDS_MISC))[0] = 0u; ((LAS unsigned*)(lds + LDS_MISC))[1] = 0u; ((LAS unsigned*)(lds + LDS_MISC))[2] = 0u; ((LAS unsigned*)(lds + LDS_MISC))[3] = 0u;
    }
    __syncthreads();
#if MK_SINGLE
    (void)xcd_barrier_post((unsigned*)PWS() + CW_BAR, (volatile LAS unsigned*)(lds + LDS_MISC), TID());
#define GRID_BAR() do { XcdBarrier b_; b_.bar = (unsigned*)PWS() + CW_BAR; b_.x = 0; b_.st = (volatile LAS unsigned*)(lds_k + LDS_MISC); xcd_barrier(b_, TID()); } while (0)
#else
#define GRID_BAR() do { } while (0)
#endif
#if !MK_SINGLE
    const int lo = a.ph_lo, hi = a.ph_hi;
#endif
#ifndef PROBE_MASK
#define PROBE_MASK 0xffff
#endif
#define EN(k) (((PROBE_MASK) >> ((k) >= 100 ? (k) - 89 : (k))) & 1)
#if MK_SINGLE
#define IN(k) true
#else
#define IN(k) (lo <= (k) && (k) < hi)
#endif
#define SEAM(k) do { if (IN(k) && IN((k) + 1)) GRID_BAR(); } while (0)
#define LAUNDER_S(x) ({ int x_ = (x); asm volatile("" : "+s"(x_)); x_; })
#ifndef PROBE_DUP
#define PROBE_DUP 0
#endif
#define DUP(k) (1 + (((PROBE_DUP) >> (k)) & 1))
#define GW() (blk * NWAVES + wave)
#define NGW() (G * NWAVES)

    if (IN(0) && EN(100)) { LAS unsigned char* lds = LDSL();
        float* tab = (float*)(PWS() + WS_TAB);
        p0_mod(lds, PIN(1), PIN(3), PIN(4), PIN(5), tab + TAB_MOD, blk, G, TID());
        if (blk == G - 1) p0_tables(tab, PIN(13), PIN(11), PIN(12), TID());
        __syncthreads();
        const float rms0 = fmaxf(sample_rms(PIN(9), DM * DIN, (LAS float*)(lds + 32768), TID()), 1.0e-30f), qs0 = 127.0f / (I8_CLIP * rms0);
        if (blk == 0 && TID() == 0) { tab[TAB_WSC] = qs0; tab[TAB_WSC + 1] = 1.0f / qs0; }
        if (blk >= 1 && blk < 40) {
            const float* W = blk < 4 ? PIN(9) + (size_t)blk * DM * DIN : blk < 6 ? PIN(17) + (size_t)(blk - 4) * DM * DFF : blk < 8 ? PIN(18) + (size_t)(blk - 6) * DM * DFF
                           : blk < 24 ? PIN(21) + (size_t)(blk - 8) * DM * DFF : PIN(22) + (size_t)(blk - 24) * DM * DFF;
            const float r = fmaxf(sample_rms(W, blk < 4 ? DM * DIN : DM * DFF, (LAS float*)(lds + 32768), TID()), 1.0e-30f), q = 127.0f / (I8_CLIP * r);
            if (TID() == 0) { tab[TAB_WSC + 2 * blk] = q; tab[TAB_WSC + 2 * blk + 1] = 1.0f / q; } }
        {
            unsigned char* ws = PWS(); LAS float* scr = (LAS float*)lds + wave * (64 * 33); const int ln = LANE();
            for (int it = (G - 1 - blk) * NWAVES + wave; it < I_MIX; it += NGW()) cvt_mix(PIN(9), PIN(15), PIN(16), ws + WS_MIX, it, qs0, scr, ln);
        }
    }
    SEAM(0);

    int gc = 0;
    for (int l = 0; l < DEPTH; ++l) {
        const int pb = 1 + l * NPH;
        const bool moe = (l & 1) != 0, last = (l == DEPTH - 1), first = (l == 0);
        const int nrows = last ? TL : TT;
        const int kmax = l <= 1 ? 5 : 6;
        if (IN(pb + 0) && EN(0)) { LAS unsigned char* lds = LDSL();
            unsigned char* ws = PWS();
            __syncthreads();
            const bool comb = (l == 2);
            const float* modl = (const float*)(ws + WS_TAB) + TAB_MOD + (size_t)l * 9 * 6144;
            float* xL = POUT(); float* xc = (float*)(ws + WS_XC);
            for (int dup = 0; dup < (comb ? 1 : DUP(8)); ++dup) norm_rows(lds, first ? PIN(0) : xL, first ? PIN(2) : xc, xL, xc, PIN(6) + l * DM, modl, modl - 9 * 6144, 0, (bf16_t*)(ws + WS_H), 2, (float*)(ws + WS_RS), TT, comb ? 1 : 0,
                      (const Route*)(ws + WS_ROUTE), (const bf16_t*)(ws + WS_OCAT), nullptr, 0, nullptr, nullptr, blk, G, wave, LANE(), TID());
        }
        SEAM(pb + 0);
        { TAIL_BOOK(last ? (TL / 256) * (DIN / 256) + 64 : (TT / 256) * (DIN / 256), Q_B, -1);
        if (IN(pb + 1) && EN(1)) { LAS unsigned char* lds = LDSL();
            unsigned char* ws = PWS();
            pg8::Gemm g{(const bf16_t*)(ws + WS_H), (const bf16_t*)(ws + WS_MIX + l * MIX_STRIDE), DM / 2}; pg8::GSched S; S.init(last ? TL / 256 : TT / 256, DIN / 256, LAUNDER_S(G), LAUNDER_S(blk));
            if (last) { S.nx = 64; S.nwg += 64; S.xtab = 0xEDCB6542ull; }
            pg8::EpiProj E{(bf16_t*)(ws + WS_PROJ), (const float*)(ws + WS_TAB) + TAB_ROPE, (u32x2*)(ws + WS_GATE), (const float*)(ws + WS_RS), ((const float*)(ws + WS_TAB))[TAB_WSC + 2 * l + 1]};
            pg8::gemm_phase<pg8::EpiProj, pg8::GSched, true, true, 2>(lds, g, S, E, TID());
            TAIL_RUN();
        } }
        SEAM(pb + 1);
        if (IN(pb + 2) && EN(2)) { LAS unsigned char* lds = LDSL();
            unsigned char* ws = PWS(); const float* lg2 = (const float*)(ws + WS_TAB) + TAB_LG2 + l * 8;
            for (int dup = 0; dup < DUP(10); ++dup) at::ret_kv_phase(lds, (const bf16_t*)(ws + WS_PROJ), (bf16_t*)(ws + WS_Y), lg2, blk, G, TID());
        }
        SEAM(pb + 2);
        if (IN(pb + 3) && EN(3)) for (int dup = 0; dup < DUP(11); ++dup) { unsigned char* ws = PWS(); at::ret_scan((const bf16_t*)(ws + WS_Y), (bf16_t*)(ws + WS_H), (const float*)(ws + WS_TAB) + TAB_LG2 + l * 8, blk * 512 + TID(), G * 512); }
        SEAM(pb + 3);
        if (IN(pb + 4) && EN(4)) { LAS unsigned char* lds = LDSL();
            {
                unsigned char* ws = PWS(); const float* tab = (const float*)(ws + WS_TAB);
                const float lam = tab[TAB_LAM + 2 * l], oml = tab[TAB_LAM + 2 * l + 1]; const float* dn = PIN(14) + l * 128;
                for (int dup = 0; dup < DUP(0); ++dup) for (int r = blk; r < 1024; r += G) { const int rnd = r >> 8, bi = r & 255, bh = rnd * 8 + (bi & 7), qb = bi >> 3;
                    at::attnC_unit(lds, (const bf16_t*)(ws + WS_PROJ), (bf16_t*)(ws + WS_OCAT), dn, lam, oml, bh >> 2, bh & 3, qb, 1, TID()); }
                if (!last) for (int r = blk; r < 64; r += G) { const int bh = r >> 1, qb = r & 1;
                    at::attnC_unit(lds, (const bf16_t*)(ws + WS_PROJ), (bf16_t*)(ws + WS_OCAT), dn, lam, oml, bh >> 2, bh & 3, qb, 0, TID()); }
            }
            {
                unsigned char* ws = PWS(); const float* lg2 = (const float*)(ws + WS_TAB) + TAB_LG2 + l * 8;
                const int nR = last ? NB * 4 * 32 : NB * 4 * NCHK;
                for (int dup = 0; dup < DUP(3); ++dup) for (int r = blk; r < nR; r = (r + G < (nR / G) * G) ? r + G : (r < (nR / G) * G ? (nR / G) * G + ((blk + G - 64) % G) : nR)) { int bh, ci; if (last) { bh = r >> 5; ci = 2 + (r & 31); } else { bh = r / NCHK; ci = r % NCHK; }
                    at::ret_out_unit(lds, (const bf16_t*)(ws + WS_PROJ), (const bf16_t*)(ws + WS_H), (bf16_t*)(ws + WS_OCAT), lg2[bh & 3], lg2[4 + (bh & 3)], bh >> 2, bh & 3, ci, TID()); }
            }
            {
                unsigned char* ws = PWS(); const float* sink = PIN(10) + l * 8;
                for (int dup = 0; dup < DUP(13); ++dup) for (int r = blk; r < 1024; r += G) { const int bg = r >> 6, qb = r & 63; at::attnA_unit(lds, (const bf16_t*)(ws + WS_PROJ), (bf16_t*)(ws + WS_OCAT), sink, bg >> 1, bg & 1, qb, 1, TID()); }
                if (!last) for (int r = (blk + G - 128) % G; r < 64; r += G) { const int bg = r >> 2, qb = r & 3; at::attnA_unit(lds, (const bf16_t*)(ws + WS_PROJ), (bf16_t*)(ws + WS_OCAT), sink, bg >> 1, bg & 1, qb, 0, TID()); }
            }
        }
        SEAM(pb + 4);
#ifdef PROBE_XBAR
        for (int xb_ = 0; xb_ < PROBE_XBAR; ++xb_) GRID_BAR();
#endif
        { TAIL_BOOK((nrows / 256) * (DM / 256), Q_F, -1);
        if (IN(pb + 5) && EN(5)) { LAS unsigned char* lds = LDSL();
            unsigned char* ws = PWS();
            pg8::Gemm g{(const bf16_t*)(ws + WS_OCAT), (const bf16_t*)(ws + WS_MIX + l * MIX_STRIDE + MIX_WB), OCW}; pg8::GSched S; S.init(nrows / 256, DM / 256, LAUNDER_S(G), LAUNDER_S(blk));
            pg8::EpiMerge E{(bf16_t*)(ws + WS_Y), (const u32x2*)(ws + WS_GATE)};
            pg8::gemm_phase<pg8::EpiMerge, pg8::GSched, true, true>(lds, g, S, E, TID());
            TAIL_RUN();
        } }
        SEAM(pb + 5);
        { TAIL_BOOK((nrows / 256) * (DM / 256), Q_G, (l == 0 ? 0 : l == 1 ? 3 : l == 2 ? 4 : 6));
        if (IN(pb + 6) && EN(6)) { LAS unsigned char* lds = LDSL();
            unsigned char* ws = PWS(); float* xL = POUT(); float* xc = (float*)(ws + WS_XC);
            pg8::Gemm g{(const bf16_t*)(ws + WS_Y), (const bf16_t*)(ws + WS_MIX + l * MIX_STRIDE + MIX_WO), DM}; pg8::GSched S; S.init(nrows / 256, DM / 256, LAUNDER_S(G), LAUNDER_S(blk));
            pg8::EpiRes E{first ? PIN(0) : xL, first ? PIN(2) : xc, xL, xc, (const float*)(ws + WS_TAB) + TAB_MOD + (size_t)l * 9 * 6144, 2048, 1.0f};
            pg8::gemm_phase<pg8::EpiRes, pg8::GSched, true, true>(lds, g, S, E, TID());
            TAIL_RUN();
        } }
        SEAM(pb + 6);
        if (IN(pb + 7) && EN(7)) { LAS unsigned char* lds = LDSL();
            unsigned char* ws = PWS(); float* xL = POUT(); float* xc = (float*)(ws + WS_XC);
            const float* modl = (const float*)(ws + WS_TAB) + TAB_MOD + (size_t)l * 9 * 6144;
            for (int dup = 0; dup < (moe ? 1 : DUP(9)); ++dup) norm_rows(lds, xL, xc, xL, xc, PIN(7) + l * DM, modl, modl, 3072, (bf16_t*)(ws + WS_H), 2, (float*)(ws + WS_RS), nrows, 0, (const Route*)(ws + WS_ROUTE), (const bf16_t*)(ws + WS_OCAT),
                      moe ? PIN(20) + (size_t)(l >> 1) * DM * NEXP : nullptr, moe ? 1 : 0, (Route*)(ws + WS_ROUTE), (unsigned*)ws + CW_MOE + (l >> 1) * 1024, blk, G, wave, LANE(), TID());
        }
        SEAM(pb + 7);
        if (!moe) {
            { TAIL_BOOK((nrows / 256) * (2 * DFF / 256), Q_I, -1);
            if (IN(pb + 9) && EN(9)) { LAS unsigned char* lds = LDSL();
                unsigned char* ws = PWS();
                pg8::Gemm g{(const bf16_t*)(ws + WS_H), (const bf16_t*)(ws + WS_FD + (l >> 1) * FD_STRIDE), DM / 2}; pg8::GSched S; S.init(nrows / 256, 2 * DFF / 256, LAUNDER_S(G), LAUNDER_S(blk));
                pg8::EpiSwiglu<DENSE_F8 != 0> E{ws + WS_PROJ, (const float*)(ws + WS_RS), (const float*)(ws + WS_TAB) + TAB_WSC + 2 * (4 + (l >> 1)) + 1, 4};
                pg8::gemm_phase<pg8::EpiSwiglu<DENSE_F8 != 0>, pg8::GSched, true, true, 2>(lds, g, S, E, TID());
                TAIL_RUN();
            } }
            SEAM(pb + 9);
            { TAIL_BOOK((nrows / 256) * (DM / 256), Q_J, (l == 0 ? 1 : 5));
            if (IN(pb + 10) && EN(10)) { LAS unsigned char* lds = LDSL();
                unsigned char* ws = PWS(); float* xL = POUT(); float* xc = (float*)(ws + WS_XC);
                pg8::Gemm g{(const bf16_t*)(ws + WS_PROJ), (const bf16_t*)(ws + WS_FD + (l >> 1) * FD_STRIDE + FD_W2), DENSE_F8 ? DFF / 2 : DFF}; pg8::GSched S; S.init(nrows / 256, DM / 256, LAUNDER_S(G), LAUNDER_S(blk));
                pg8::EpiRes E{xL, xc, xL, xc, (const float*)(ws + WS_TAB) + TAB_MOD + (size_t)l * 9 * 6144, 5120, DENSE_F8 ? F8_INV2 : 1.0f};
                pg8::gemm_phase<pg8::EpiRes, pg8::GSched, true, true, DENSE_F8 ? 1 : 0>(lds, g, S, E, TID());
                TAIL_RUN();
            } }
            SEAM(pb + 10);
        } else {
            if (IN(pb + 8) && EN(8)) for (int dup = 0; dup < DUP(12); ++dup) { unsigned char* ws = PWS(); moe_gather(ws + WS_H, ws + WS_OCAT, (const float*)(ws + WS_RS), (float*)(ws + WS_RSS), (Route*)(ws + WS_ROUTE), (unsigned*)ws + CW_MOE + (l >> 1) * 1024, nrows, GW(), NGW(), LANE()); }
            SEAM(pb + 8);
            if (IN(pb + 9) && EN(9)) { LAS unsigned char* lds = LDSL();
                unsigned char* ws = PWS(); unsigned* gcnt = (unsigned*)ws + CW_MOE + (l >> 1) * 1024;
                pg8::GSched S; LAS int* tsl = (LAS int*)(lds + LDS_MISC + 512);
                if (TID() == 0) { int a0 = 0;
                    for (int e = 0; e < 8; ++e) { tsl[e] = a0; const int c = (int)__hip_atomic_load(gcnt + 64 * e, __ATOMIC_RELAXED, __HIP_MEMORY_SCOPE_AGENT); a0 += (c + 255) >> 8; }
                    tsl[8] = a0; }
                __syncthreads();
                S.ts = tsl; S.nM = __builtin_amdgcn_readfirstlane(tsl[8]); S.nN = 2 * DFF / 256; S.nwg = S.nM * S.nN; S.G = LAUNDER_S(G); S.c = LAUNDER_S(blk); S.wgm = WGM_MOE; S.nx = 0; S.xtab = 0; S.grouped = 1; S.bstride = (size_t)DFF * DM;
                pg8::Gemm g{(const bf16_t*)(ws + WS_OCAT), (const bf16_t*)(ws + WS_W13), DM / 2};
                pg8::EpiSwiglu<true> E{ws + WS_PROJ, (const float*)(ws + WS_RSS), (const float*)(ws + WS_TAB) + TAB_WSC + 2 * (8 + (l >> 1) * 8) + 1, 32};
                pg8::gemm_phase<pg8::EpiSwiglu<true>, pg8::GSched, true, true, 2>(lds, g, S, E, TID());
            }
            SEAM(pb + 9);
            if (IN(pb + 10) && EN(10)) { LAS unsigned char* lds = LDSL();
                unsigned char* ws = PWS(); unsigned* gcnt = (unsigned*)ws + CW_MOE + (l >> 1) * 1024;
                pg8::GSched S; LAS int* tsl = (LAS int*)(lds + LDS_MISC + 512);
                if (TID() == 0) { int a0 = 0;
                    for (int e = 0; e < 8; ++e) { tsl[e] = a0; const int c = (int)__hip_atomic_load(gcnt + 64 * e, __ATOMIC_RELAXED, __HIP_MEMORY_SCOPE_AGENT); a0 += (c + 255) >> 8; }
                    tsl[8] = a0; }
                __syncthreads();
                S.ts = tsl; S.nM = __builtin_amdgcn_readfirstlane(tsl[8]); S.nN = DM / 256; S.nwg = S.nM * S.nN; S.G = LAUNDER_S(G); S.c = LAUNDER_S(blk); S.wgm = WGM_MOE; S.nx = 0; S.xtab = 0; S.grouped = 1; S.bstride = (size_t)DM * DFF / 2;
                pg8::Gemm g{(const bf16_t*)(ws + WS_PROJ), (const bf16_t*)(ws + WS_W2), DFF / 2}; pg8::EpiBf16 E{(bf16_t*)(ws + WS_OCAT), DM, F8_INV2};
                pg8::gemm_phase<pg8::EpiBf16, pg8::GSched, true, true, 1>(lds, g, S, E, TID());
            }
            SEAM(pb + 10);
        }
    }
    if (IN(1 + DEPTH * NPH) && EN(101)) { LAS unsigned char* lds = LDSL(); unsigned char* ws = PWS();
        final_norm(POUT(), PIN(8), (const float*)(ws + WS_TAB) + TAB_MOD + (size_t)3 * 9 * 6144, (const Route*)(ws + WS_ROUTE), (const bf16_t*)(ws + WS_OCAT), GW(), NGW(), LANE()); }
#undef IN
#undef SEAM
}

extern "C" void kernel_launch(void* const* d_in, const int* in_sizes, int n_in, void* d_out, int out_size, void* d_ws, size_t ws_size, hipStream_t stream) {
    static int grid = 0;
    if (grid == 0) {
        if (n_in != 24 || out_size != TL * DM || ws_size < WS_END) { fprintf(stderr, "kernel_launch: unexpected shapes (n_in %d, out %d, ws %zu)\n", n_in, out_size, ws_size); grid = -1; return; }
        int dev = 0, cus = 0, per_cu = 0;
        if (hipGetDevice(&dev) != hipSuccess || hipDeviceGetAttribute(&cus, hipDeviceAttributeMultiprocessorCount, dev) != hipSuccess) { grid = -1; return; }
        if (hipFuncSetAttribute((const void*)mega, hipFuncAttributeMaxDynamicSharedMemorySize, LDS_BYTES) != hipSuccess) { fprintf(stderr, "kernel_launch: hipFuncSetAttribute failed\n"); grid = -1; return; }
        if (hipOccupancyMaxActiveBlocksPerMultiprocessor(&per_cu, (const void*)mega, NWAVES * 64, LDS_BYTES) != hipSuccess || per_cu < 1) { fprintf(stderr, "kernel_launch: occupancy query reports %d\n", per_cu); }
        (void)hipGetLastError();
        grid = cus;
    }
    if (grid < 0) return;
    if (hipMemsetAsync((char*)d_ws + WS_CTL, 0, CTL_ZERO_BYTES, stream) != hipSuccess) return;
    Args a{};
    for (int i = 0; i < 24; ++i) a.in[i] = (const float*)d_in[i];
    a.out = (float*)d_out; a.ws = (unsigned char*)d_ws;
#if MK_SINGLE
    a.ph_lo = 0; a.ph_hi = N_PHASES;
    hipLaunchKernelGGL(mega, dim3(grid), dim3(NWAVES * 64), LDS_BYTES, stream, a);
#else
    for (int p = 0; p < N_PHASES; ++p) {
        const int k = (p - 1) % NPH, l = (p - 1) / NPH;
        if (p >= 1 && p < 1 + DEPTH * NPH && k == 8 && !(l & 1)) continue;
        a.ph_lo = p; a.ph_hi = p + 1;
        hipLaunchKernelGGL(mega, dim3(grid), dim3(NWAVES * 64), LDS_BYTES, stream, a);
    }
#endif
}
```

```cpp
#include <hip/hip_runtime.h>
#include <cstdio>
#include <cstdint>

#ifndef MK_SINGLE
#define MK_SINGLE 1
#endif

#define LAS __attribute__((address_space(3)))
#define GAS __attribute__((address_space(1)))

typedef unsigned short bf16_t;
typedef short bf16x8 __attribute__((ext_vector_type(8)));
typedef short s16x4 __attribute__((ext_vector_type(4)));
typedef float f32x2 __attribute__((ext_vector_type(2)));
typedef float f32x4 __attribute__((ext_vector_type(4)));
typedef float f32x16 __attribute__((ext_vector_type(16)));
typedef unsigned u32x2 __attribute__((ext_vector_type(2)));
typedef unsigned u32x4 __attribute__((ext_vector_type(4)));
typedef int i32x4 __attribute__((ext_vector_type(4)));
typedef int i32x8 __attribute__((ext_vector_type(8)));
typedef __bf16 bf16x2_t __attribute__((ext_vector_type(2)));

constexpr int DM = 1024, NB = 8, SEQ = 4096, CTXL = 256, DEPTH = 4;
constexpr int TL = NB * SEQ;
constexpr int TC = NB * CTXL;
constexpr int TT = TL + TC;
constexpr int DIN = 6912, DFF = 2816, NEXP = 8, OCW = 1536;
constexpr int DINP = 3840;
constexpr int NMT = 136;
constexpr int C_QA = 0, C_KA = 512, C_VA = 640, C_QB = 768, C_KB = 1024, C_VB = 1280, C_GB = 1792, C_QD = 2304, C_KD = 2816, C_VD = 3328, C_GL = 3840;
constexpr float NORM_EPS = 1e-6f;
constexpr float SM_C2 = 0.125f * 1.4426950408889634f;
constexpr float LOG2E = 1.4426950408889634f;
constexpr int NCHK = 34;

__device__ __forceinline__ unsigned pk2(float lo, float hi) { f32x2 v = {lo, hi}; bf16x2_t b = __builtin_convertvector(v, bf16x2_t); return __builtin_bit_cast(unsigned, b); }
constexpr int DENSE_F8 = 0;
constexpr float F8_SH = 8.0f, F8_SW13 = 256.0f, F8_SU = 8.0f, F8_SW2 = 256.0f, F8_INV13 = 1.0f / (F8_SH * F8_SW13), F8_INV2 = 1.0f / (F8_SU * F8_SW2);
__device__ __forceinline__ unsigned pk4f8(float a, float b, float c, float d) {
    a = __builtin_amdgcn_fmed3f(a, -448.0f, 448.0f); b = __builtin_amdgcn_fmed3f(b, -448.0f, 448.0f); c = __builtin_amdgcn_fmed3f(c, -448.0f, 448.0f); d = __builtin_amdgcn_fmed3f(d, -448.0f, 448.0f);
    int w = __builtin_amdgcn_cvt_pk_fp8_f32(a, b, 0, false); w = __builtin_amdgcn_cvt_pk_fp8_f32(c, d, w, true); return (unsigned)w;
}
constexpr float I8_CLIP = 4.0f;
__device__ __forceinline__ unsigned pk4i8(float a, float b, float c, float d) {
    const float M = 12582912.0f;
    const unsigned ua = __float_as_uint(a + M), ub = __float_as_uint(b + M), uc = __float_as_uint(c + M), ud = __float_as_uint(d + M);
    return __builtin_amdgcn_perm(ub, ua, 0x0c0c0400u) | __builtin_amdgcn_perm(ud, uc, 0x04000c0cu);
}
__device__ __forceinline__ f32x4 acc_i2f(const f32x4& a) { return __builtin_convertvector(__builtin_bit_cast(i32x4, a), f32x4); }
__device__ __forceinline__ float wave_max(float v) {
#pragma unroll
    for (int o = 1; o < 64; o <<= 1) v = fmaxf(v, __shfl_xor(v, o));
    return v;
}
__device__ __forceinline__ float bf_lo(unsigned u) { return __uint_as_float(u << 16); }
__device__ __forceinline__ float bf_hi(unsigned u) { return __uint_as_float(u & 0xffff0000u); }
__device__ __forceinline__ float bf1(bf16_t u) { return __uint_as_float(((unsigned)u) << 16); }
__device__ __forceinline__ float wave_sum(float v) {
#pragma unroll
    for (int o = 1; o < 64; o <<= 1) v += __shfl_xor(v, o);
    return v;
}
__device__ __forceinline__ float fexp2(float x) { return __builtin_amdgcn_exp2f(x); }
__device__ __forceinline__ float sigmoidf_(float x) { return __builtin_amdgcn_rcpf(1.0f + __builtin_amdgcn_exp2f(-LOG2E * x)); }
__device__ __forceinline__ float siluf_(float x) { return x * __builtin_amdgcn_rcpf(1.0f + __builtin_amdgcn_exp2f(-LOG2E * x)); }
#define LDS_WAIT() asm volatile("s_waitcnt lgkmcnt(0)" ::: "memory")
#define VM_WAIT() asm volatile("s_waitcnt vmcnt(0)" ::: "memory")

namespace pg8 {
#define PG8_LAS __attribute__((address_space(3)))
constexpr int BM = 256, BK = 64, HALF = 128, HTB = HALF * BK * 2  , STAGE_BYTES = 8 * HTB, NXCD = 8, WGM = 8;

__host__ __device__ __forceinline__ int lds_byte(int r, int c) { const int st = (r >> 4) * 2 + (c >> 5), rr = r & 15, cc = c & 31, ob = rr * 64 + cc * 2; return st * 1024 + (ob ^ (((ob >> 9) & 1) << 5)); }
__host__ __device__ __forceinline__ void stage_rc(int b, int& R, int& C) { const int st = b / 1024, sb = b % 1024, swz = sb ^ (((sb >> 9) & 1) << 5); R = (st >> 1) * 16 + swz / 64; C = (st & 1) * 32 + (swz % 64) / 2; }
__host__ __device__ __forceinline__ int perm32(int rho) { const int n = rho >> 4, i = rho & 15; return 8 * (i >> 2) + 4 * n + (i & 3); }

struct Unit { int pm, pn; size_t bo; int ge; };
struct Gemm { const bf16_t* A; const bf16_t* Bt; int K; };

struct GSched {
    int nM, nN, nwg, G, c, wgm; int grouped; size_t bstride; const PG8_LAS int* ts;
    int nx; unsigned long long xtab;
    __device__ __forceinline__ void init(int nM_, int nN_, int G_, int c_, int wgm_ = 4) { nM = nM_; nN = nN_; nwg = nM * nN; G = G_; c = c_; wgm = wgm_; grouped = 0; bstride = 0; ts = nullptr; nx = 0; xtab = 0; }
    __device__ __forceinline__ bool next(int i, Unit& u) const {
        const long L = (long)i * G + c; if (L >= nwg) return false;
        const int nmain = nwg - nx;
        u.ge = 0; if (L >= nmain) { const int j = (int)L - nmain; u.pm = nM + (j >> 3); u.pn = (int)((xtab >> (4 * (j & 7))) & 15ull); u.bo = 0; return true; }
        int wgid = (int)L; { const int q = nmain / NXCD, r = nmain % NXCD, xcd = wgid % NXCD, off = wgid / NXCD; wgid = (xcd < r ? xcd * (q + 1) : r * (q + 1) + (xcd - r) * q) + off; }
        const int nig = wgm * nN, gid = wgid / nig, fm = gid * wgm, gsz = (nM - fm) < wgm ? (nM - fm) : wgm;
        u.pm = fm + ((wgid % nig) % gsz); u.pn = (wgid % nig) / gsz; u.bo = 0;
        if (grouped) { int e = 0;
#pragma unroll
            for (int j = 1; j < 8; ++j) e += (u.pm >= ts[j]) ? 1 : 0;
            e = __builtin_amdgcn_readfirstlane(e);
            u.bo = (size_t)e * bstride; u.ge = e; }
        return true;
    }
    __device__ __forceinline__ void a_ready(const Unit&) const {}
    __device__ __forceinline__ void done(const Unit&) const {}
};
#define ROT2(V, I, c, s) do { const float a_ = V[I] * (c) - V[I + 1] * (s), b_ = V[I + 1] * (c) + V[I] * (s); V[I] = a_; V[I + 1] = b_; } while (0)

struct EpiProj {
    static constexpr bool PERM = true, AFTER_DRAIN = false, KHOOK = false;
    bf16_t* O; const float* rope; u32x2* GB; const float* rs; float wsc;
    __device__ __forceinline__ void operator()(const f32x4 (&acc)[2][2][4][2], const Unit& u, int wr, int wc, int fr, int fq) const {
        const int pn = u.pn; const bool latent = u.pm < TL / 256;
        float rsc[2][4];
#pragma unroll
        for (int ai = 0; ai < 2; ++ai)
#pragma unroll
            for (int m = 0; m < 4; ++m) rsc[ai][m] = rs[u.pm * 256 + wr * 64 + fr + ai * 128 + m * 16] * wsc;
        if (pn >= 15) {
            const int gi = (pn - 15) >> 2, pnl = (pn - 15) & 3;
            u32x2* gp = GB + ((size_t)(((gi * NMT + u.pm) * 4 + pnl) * 8 + wr * 4 + wc) * 16) * 64 + fq * 16 + fr;
#pragma unroll
            for (int ai = 0; ai < 2; ++ai)
#pragma unroll
                for (int m = 0; m < 4; ++m)
#pragma unroll
                    for (int bj = 0; bj < 2; ++bj) { const f32x4 v0 = acc_i2f(acc[ai][bj][m][0]) * rsc[ai][m], v1 = acc_i2f(acc[ai][bj][m][1]) * rsc[ai][m];
#define SG_(x) ((unsigned)fminf(fmaxf(sigmoidf_(x) * 255.0f + 0.5f, 1.0f), 255.0f))
                        u32x2 w; w.x = SG_(v0[0]) | (SG_(v0[1]) << 8) | (SG_(v0[2]) << 16) | (SG_(v0[3]) << 24); w.y = SG_(v1[0]) | (SG_(v1[1]) << 8) | (SG_(v1[2]) << 16) | (SG_(v1[3]) << 24);
#undef SG_
                        __builtin_nontemporal_store(w, gp + (ai * 8 + m * 2 + bj) * 64); }
            return;
        }
        int rmask = 0; if (pn <= 1 || pn == 3 || pn == 4 || (pn >= 9 && pn <= 12)) rmask = 3; else if (pn == 2) rmask = 1;
        if (!latent) rmask = 0;
        const float sc = (pn == 4) ? 0.125f : SM_C2;
        const int row0 = u.pm * 256 + wr * 64 + fr, col0 = pn * 256 + wc * 32 + 8 * fq, axis = wc & 1;
#pragma unroll
        for (int ai = 0; ai < 2; ++ai)
#pragma unroll
            for (int m = 0; m < 4; ++m) {
                const int row = row0 + ai * 128 + m * 16;
                f32x4 cs0 = {1.f, 0.f, 1.f, 0.f}, cs1 = {1.f, 0.f, 1.f, 0.f};
                if (rmask) { const int pos = axis ? (row & 63) : ((row >> 6) & 63); const f32x4* tp = (const f32x4*)(rope + (pos * 16 + 4 * fq) * 2); cs0 = tp[0]; cs1 = tp[1]; }
                bf16_t* rowp = O + (size_t)row * DINP + col0;
#pragma unroll
                for (int bj = 0; bj < 2; ++bj) {
                    f32x4 v0 = acc_i2f(acc[ai][bj][m][0]) * rsc[ai][m], v1 = acc_i2f(acc[ai][bj][m][1]) * rsc[ai][m];
                    if ((rmask >> bj) & 1) { ROT2(v0, 0, cs0[0], cs0[1]); ROT2(v0, 2, cs0[2], cs0[3]); ROT2(v1, 0, cs1[0], cs1[1]); ROT2(v1, 2, cs1[2], cs1[3]); }
                    if (pn == 4 || pn <= 1 || pn == 9 || pn == 10) { v0 = v0 * sc; v1 = v1 * sc; }
                    u32x4 w; w.x = pk2(v0[0], v0[1]); w.y = pk2(v0[2], v0[3]); w.z = pk2(v1[0], v1[1]); w.w = pk2(v1[2], v1[3]);
                    __builtin_nontemporal_store(w, (u32x4*)(rowp + bj * 128));
                }
            }
    }
};

struct EpiMerge {
    static constexpr bool PERM = true, AFTER_DRAIN = false, KHOOK = true;
    bf16_t* Y; const u32x2* GB;
#define UB_(w, k) ((float)(((w) >> (8 * (k))) & 0xffu))
    __device__ __forceinline__ void khook(int t, f32x4 (&acc)[2][2][4][2], const Unit& u, int wr, int wc, int fr, int fq) const {
        const int gi = (t == 8) ? 0 : 1;
        const u32x2* ga = GB + ((size_t)(((gi * NMT + u.pm) * 4 + u.pn) * 8 + wr * 4 + wc) * 16) * 64 + fq * 16 + fr;
        const u32x2* gb = ga + (size_t)NMT * 4 * 8 * 16 * 64;
        u32x2 a[16], b[16];
#pragma unroll
        for (int j = 0; j < 16; ++j) { a[j] = ga[j * 64]; b[j] = gb[j * 64]; }
        __builtin_amdgcn_sched_barrier(0);
#pragma unroll
        for (int grp = 0; grp < 16; ++grp) { const int ai = grp >> 3, m = (grp >> 1) & 3, bj = grp & 1;
            f32x4 v0 = acc[ai][bj][m][0], v1 = acc[ai][bj][m][1];
#define MG_R(wa, wb, k) (UB_(wa, k) * __builtin_amdgcn_rcpf(UB_(wb, k)))
            v0[0] *= MG_R(a[grp].x, b[grp].x, 0); v0[1] *= MG_R(a[grp].x, b[grp].x, 1); v0[2] *= MG_R(a[grp].x, b[grp].x, 2); v0[3] *= MG_R(a[grp].x, b[grp].x, 3);
            v1[0] *= MG_R(a[grp].y, b[grp].y, 0); v1[1] *= MG_R(a[grp].y, b[grp].y, 1); v1[2] *= MG_R(a[grp].y, b[grp].y, 2); v1[3] *= MG_R(a[grp].y, b[grp].y, 3);
#undef MG_R
            acc[ai][bj][m][0] = v0; acc[ai][bj][m][1] = v1; }
        asm volatile("" ::: "memory"); __builtin_amdgcn_sched_barrier(0);
    }
    __device__ __forceinline__ void operator()(const f32x4 (&acc)[2][2][4][2], const Unit& u, int wr, int wc, int fr, int fq) const {
        const int row0 = u.pm * 256 + wr * 64 + fr, col0 = u.pn * 256 + wc * 32 + 8 * fq;
        const u32x2* gc = GB + ((size_t)(((2 * NMT + u.pm) * 4 + u.pn) * 8 + wr * 4 + wc) * 16) * 64 + fq * 16 + fr;
        u32x2 g[16];
#pragma unroll
        for (int j = 0; j < 16; ++j) g[j] = gc[j * 64];
        constexpr float q = 1.0f / 255.0f;
#pragma unroll
        for (int grp = 0; grp < 16; ++grp) { const int ai = grp >> 3, m = (grp >> 1) & 3, bj = grp & 1;
            const f32x4 v0 = acc[ai][bj][m][0] * q, v1 = acc[ai][bj][m][1] * q;
            u32x4 w; w.x = pk2(v0[0] * UB_(g[grp].x, 0), v0[1] * UB_(g[grp].x, 1)); w.y = pk2(v0[2] * UB_(g[grp].x, 2), v0[3] * UB_(g[grp].x, 3));
            w.z = pk2(v1[0] * UB_(g[grp].y, 0), v1[1] * UB_(g[grp].y, 1)); w.w = pk2(v1[2] * UB_(g[grp].y, 2), v1[3] * UB_(g[grp].y, 3));
            *(u32x4*)(Y + (size_t)(row0 + ai * 128 + m * 16) * DM + col0 + bj * 128) = w; }
    }
#undef UB_
};

struct EpiRes {
    static constexpr bool PERM = true, AFTER_DRAIN = false, KHOOK = false;
    const void* srcL; const void* srcC; bf16_t* dstL; bf16_t* dstC; const float* mod; int goff; float scl; int src32;
    __device__ __forceinline__ void operator()(const f32x4 (&acc)[2][2][4][2], const Unit& u, int wr, int wc, int fr, int fq) const {
        const bool latent = u.pm < TL / 256; const int mb = latent ? (u.pm >> 4) : 8;
        const float* g = mod + mb * 6144 + goff;
        const int rloc = (latent ? u.pm * 256 : u.pm * 256 - TL) + wr * 64 + fr, col0 = u.pn * 256 + wc * 32 + 8 * fq;
        const void* src = latent ? srcL : srcC; bf16_t* dst = latent ? dstL : dstC;
        f32x4 gv[2][2];
#pragma unroll
        for (int bj = 0; bj < 2; ++bj) { gv[bj][0] = *(const f32x4*)(g + col0 + bj * 128) * scl; gv[bj][1] = *(const f32x4*)(g + col0 + bj * 128 + 4) * scl; }
#pragma unroll
        for (int ai = 0; ai < 2; ++ai)
#pragma unroll
            for (int m = 0; m < 4; ++m) {
                const size_t off = (size_t)(rloc + ai * 128 + m * 16) * DM + col0;
#pragma unroll
                for (int bj = 0; bj < 2; ++bj) {
                    f32x4 x0, x1;
                    if (src32) { x0 = *(const f32x4*)((const float*)src + off + bj * 128); x1 = *(const f32x4*)((const float*)src + off + bj * 128 + 4); }
                    else { const u32x4 t = *(const u32x4*)((const bf16_t*)src + off + bj * 128); x0 = (f32x4){bf_lo(t.x), bf_hi(t.x), bf_lo(t.y), bf_hi(t.y)}; x1 = (f32x4){bf_lo(t.z), bf_hi(t.z), bf_lo(t.w), bf_hi(t.w)}; }
                    x0 += gv[bj][0] * acc[ai][bj][m][0]; x1 += gv[bj][1] * acc[ai][bj][m][1];
                    u32x4 w; w.x = pk2(x0[0], x0[1]); w.y = pk2(x0[2], x0[3]); w.z = pk2(x1[0], x1[1]); w.w = pk2(x1[2], x1[3]);
                    *(u32x4*)(dst + off + bj * 128) = w;
                }
                if (m & 1) asm volatile("" ::: "memory");
            }
    }
};

template <bool OUT8>
struct EpiSwiglu {
    static constexpr bool PERM = true, AFTER_DRAIN = false, KHOOK = false;
    unsigned char* U; const float* rs; const float* wsc; int d3;
    __device__ __forceinline__ void operator()(const f32x4 (&acc)[2][2][4][2], const Unit& u, int wr, int wc, int fr, int fq) const {
        const int row0 = u.pm * 256 + wr * 64 + fr, col0 = u.pn * 128 + wc * 32 + 8 * fq;
        const float w1s = wsc[2 * u.ge], w3s = wsc[2 * u.ge + d3] * (OUT8 ? F8_SU : 1.0f);
#pragma unroll
        for (int ai = 0; ai < 2; ++ai)
#pragma unroll
            for (int m = 0; m < 4; ++m) {
                const int row = row0 + ai * 128 + m * 16; const float r = rs[row], ra = r * w1s, rb = r * w3s;
                const f32x4 a0 = acc_i2f(acc[ai][0][m][0]) * ra, a1 = acc_i2f(acc[ai][0][m][1]) * ra, b0 = acc_i2f(acc[ai][1][m][0]) * rb, b1 = acc_i2f(acc[ai][1][m][1]) * rb;
                if constexpr (OUT8) {
                    u32x2 w; w.x = pk4f8(siluf_(a0[0]) * b0[0], siluf_(a0[1]) * b0[1], siluf_(a0[2]) * b0[2], siluf_(a0[3]) * b0[3]);
                    w.y = pk4f8(siluf_(a1[0]) * b1[0], siluf_(a1[1]) * b1[1], siluf_(a1[2]) * b1[2], siluf_(a1[3]) * b1[3]);
                    *(u32x2*)(U + (size_t)row * DFF + col0) = w;
                } else {
                    u32x4 w; w.x = pk2(siluf_(a0[0]) * b0[0], siluf_(a0[1]) * b0[1]); w.y = pk2(siluf_(a0[2]) * b0[2], siluf_(a0[3]) * b0[3]);
                    w.z = pk2(siluf_(a1[0]) * b1[0], siluf_(a1[1]) * b1[1]); w.w = pk2(siluf_(a1[2]) * b1[2], siluf_(a1[3]) * b1[3]);
                    *(u32x4*)((bf16_t*)U + (size_t)row * DFF + col0) = w;
                }
            }
    }
};

struct EpiBf16 {
    static constexpr bool PERM = true, AFTER_DRAIN = false, KHOOK = false;
    bf16_t* O; int ldc; float scl;
    __device__ __forceinline__ void operator()(const f32x4 (&acc)[2][2][4][2], const Unit& u, int wr, int wc, int fr, int fq) const {
        const int row0 = u.pm * 256 + wr * 64 + fr, col0 = u.pn * 256 + wc * 32 + 8 * fq;
#pragma unroll
        for (int ai = 0; ai < 2; ++ai)
#pragma unroll
            for (int m = 0; m < 4; ++m) { bf16_t* rowp = O + (size_t)(row0 + ai * 128 + m * 16) * ldc + col0;
#pragma unroll
                for (int bj = 0; bj < 2; ++bj) { const f32x4 v0 = acc[ai][bj][m][0] * scl, v1 = acc[ai][bj][m][1] * scl;
                    u32x4 w; w.x = pk2(v0[0], v0[1]); w.y = pk2(v0[2], v0[3]); w.z = pk2(v1[0], v1[1]); w.w = pk2(v1[2], v1[3]);
                    *(u32x4*)(rowp + bj * 128) = w; } }
    }
};

template <class Epi, class Sched, bool ALIGN_EPI = false, bool SP2 = false, int MODE = 0>
__device__ __forceinline__ void gemm_phase(PG8_LAS unsigned char* lds, const Gemm g, const Sched& S, const Epi& E, int tid_in) {
    int tid = tid_in; asm volatile("" : "+v"(tid));
    const int wid = __builtin_amdgcn_readfirstlane(tid >> 6), lane = tid & 63, wr = wid >> 2, wc = wid & 3, fr = lane & 15, fq = lane >> 4;
    const int K = g.K, nt = K / BK;
    unsigned voffA[2], voffB[2];
#pragma unroll
    for (int i = 0; i < 2; ++i) { int R, C; stage_rc(tid * 16 + i * 8192, R, C); const int Rb = Epi::PERM ? ((R & ~31) + perm32(R & 31)) : R;
        voffA[i] = (unsigned)(R * K + C) * 2u; voffB[i] = (unsigned)(Rb * K + C) * 2u; }
    const size_t kstep = (size_t)(BK * 2);
    const size_t hstep = (size_t)HALF * K * 2;
    const size_t tstep = 2 * hstep;
    const unsigned ldsw = (unsigned)wid * 1024u;
    const int aoff = lds_byte(wr * 64 + fr, fq * 8), boff = lds_byte(wc * 32 + fr, fq * 8);
#define PG8_SA(b, h) (((b) * 2 + (h)) * HTB)
#define PG8_SB(b, h) ((4 + (b) * 2 + (h)) * HTB)
#define PG8_STAGE(bufoff, gbase, voff) do { _Pragma("unroll") for (int _i = 0; _i < 2; ++_i) \
        __builtin_amdgcn_global_load_lds((const unsigned*)((const char*)(gbase) + (voff)[_i]), (PG8_LAS unsigned*)(lds + (bufoff) + ldsw + _i * 8192), 16, 0, 0); } while (0)
#define PG8_LDA(dst, b, h) do { _Pragma("unroll") for (int m = 0; m < 4; ++m) _Pragma("unroll") for (int k = 0; k < 2; ++k) dst[m][k] = *(const PG8_LAS bf16x8*)(lds + PG8_SA(b, h) + aoff + m * 2048 + k * 1024); } while (0)
#define PG8_LDB(dst, b, h) do { _Pragma("unroll") for (int n = 0; n < 2; ++n) _Pragma("unroll") for (int k = 0; k < 2; ++k) dst[n][k] = *(const PG8_LAS bf16x8*)(lds + PG8_SB(b, h) + boff + n * 2048 + k * 1024); } while (0)
#define PG8_CAT(x) __builtin_shufflevector(__builtin_bit_cast(i32x4, (x)[0]), __builtin_bit_cast(i32x4, (x)[1]), 0, 1, 2, 3, 4, 5, 6, 7)
#define PG8_MMA(ai, bj, At, Bt) do { __builtin_amdgcn_s_setprio(1); _Pragma("unroll") for (int m = 0; m < 4; ++m) _Pragma("unroll") for (int n = 0; n < 2; ++n) { \
        if constexpr (MODE == 1) { const i32x8 b8_ = PG8_CAT(Bt[n]), a8_ = PG8_CAT(At[m]); asm volatile("v_mfma_f32_16x16x128_f8f6f4 %0, %1, %2, %0" : "+v"(acc[ai][bj][m][n]) : "v"(b8_), "v"(a8_)); } \
          \
        else if constexpr (MODE == 2) { _Pragma("unroll") for (int k = 0; k < 2; ++k) asm volatile("v_mfma_i32_16x16x64_i8 %0, %1, %2, %0" : "+v"(acc[ai][bj][m][n]) : "v"(Bt[n][k]), "v"(At[m][k])); } \
        else { _Pragma("unroll") for (int k = 0; k < 2; ++k) acc[ai][bj][m][n] = __builtin_amdgcn_mfma_f32_16x16x32_bf16(Bt[n][k], At[m][k], acc[ai][bj][m][n], 0, 0, 0); } } \
        __builtin_amdgcn_s_setprio(0); } while (0)
#define PG8_WAIT_V(n) asm volatile("s_waitcnt vmcnt(" #n ")" ::: "memory")
#define PG8_WAIT_L(n) asm volatile("s_waitcnt lgkmcnt(" #n ")" ::: "memory")
#define PG8_BAR __builtin_amdgcn_s_barrier()
#define PG8_SCHED __builtin_amdgcn_sched_barrier(0)
    Unit cur, nxt; int ui = 0;
    if (!S.next(0, cur)) return;
    f32x4 acc[2][2][4][2];
#pragma unroll
    for (int a = 0; a < 2; ++a)
#pragma unroll
        for (int b = 0; b < 2; ++b)
#pragma unroll
            for (int m = 0; m < 4; ++m)
#pragma unroll
                for (int n = 0; n < 2; ++n) acc[a][b][m][n] = (f32x4){0.f, 0.f, 0.f, 0.f};
    bf16x8 At[4][2], B0[2][2], B1[2][2];
    const char* cA = (const char*)g.A + (size_t)cur.pm * tstep; const char* cB = (const char*)g.Bt + cur.bo * 2 + (size_t)cur.pn * tstep;
    S.a_ready(cur);
    if constexpr (SP2) {
        PG8_STAGE(PG8_SB(0, 0), cB, voffB); PG8_STAGE(PG8_SB(0, 1), cB + hstep, voffB); PG8_STAGE(PG8_SA(0, 0), cA, voffA); PG8_STAGE(PG8_SA(0, 1), cA + hstep, voffA);
        if (wr == 1) PG8_BAR;
        PG8_WAIT_V(2); PG8_BAR;
        PG8_STAGE(PG8_SB(1, 0), cB + kstep, voffB); PG8_STAGE(PG8_SA(1, 0), cA + kstep, voffA); PG8_STAGE(PG8_SB(1, 1), cB + hstep + kstep, voffB);
        PG8_WAIT_V(6); PG8_BAR;
    } else {
        PG8_STAGE(PG8_SB(0, 0), cB, voffB); PG8_STAGE(PG8_SA(0, 0), cA, voffA); PG8_STAGE(PG8_SB(0, 1), cB + hstep, voffB); PG8_STAGE(PG8_SA(0, 1), cA + hstep, voffA);
        if (wr == 1) PG8_BAR;
        PG8_WAIT_V(4); PG8_BAR;
        PG8_STAGE(PG8_SB(1, 0), cB + kstep, voffB); PG8_STAGE(PG8_SA(1, 0), cA + kstep, voffA); PG8_STAGE(PG8_SB(1, 1), cB + hstep + kstep, voffB);
        PG8_WAIT_V(6); PG8_BAR;
    }
    for (;;) {
        const bool has_next = S.next(ui + 1, nxt);
        const char* nA = has_next ? (const char*)g.A + (size_t)nxt.pm * tstep : cA; const char* nB = has_next ? (const char*)g.Bt + nxt.bo * 2 + (size_t)nxt.pn * tstep : cB;
        for (int t = 0; t < nt; t += 2) {
            const bool last = (t == nt - 2);
            const char* a1 = cA + (size_t)(t + 1) * kstep;
            const char* a2 = last ? nA : cA + (size_t)(t + 2) * kstep; const char* b2 = last ? nB : cB + (size_t)(t + 2) * kstep;
            const char* a3 = a2 + kstep; const char* b3 = b2 + kstep;
            if (last && has_next) S.a_ready(nxt);
            if constexpr (Epi::KHOOK) { if (t == 8 || t == 16) E.khook(t, acc, cur, wr, wc, fr, fq); }
            if constexpr (SP2) {
            PG8_LDB(B0, 0, 0); PG8_LDB(B1, 0, 1); PG8_SCHED; PG8_LDA(At, 0, 0); PG8_STAGE(PG8_SA(1, 1), a1 + hstep, voffA);
            PG8_WAIT_V(8); PG8_WAIT_L(0); PG8_BAR; PG8_MMA(0, 0, At, B0); PG8_MMA(0, 1, At, B1); PG8_BAR; PG8_SCHED;
            PG8_LDA(At, 0, 1); PG8_STAGE(PG8_SB(0, 0), b2, voffB); PG8_STAGE(PG8_SB(0, 1), b2 + hstep, voffB); PG8_STAGE(PG8_SA(0, 0), a2, voffA);
            PG8_WAIT_V(8); PG8_WAIT_L(0); PG8_BAR; PG8_MMA(1, 0, At, B0); PG8_MMA(1, 1, At, B1); PG8_BAR; PG8_SCHED;
            PG8_LDB(B0, 1, 0); PG8_LDB(B1, 1, 1); PG8_SCHED; PG8_LDA(At, 1, 0); PG8_STAGE(PG8_SA(0, 1), a2 + hstep, voffA);
            PG8_WAIT_V(8); PG8_WAIT_L(0); PG8_BAR; PG8_MMA(0, 0, At, B0); PG8_MMA(0, 1, At, B1); PG8_BAR; PG8_SCHED;
            PG8_LDA(At, 1, 1); PG8_STAGE(PG8_SB(1, 0), b3, voffB); PG8_STAGE(PG8_SB(1, 1), b3 + hstep, voffB); PG8_STAGE(PG8_SA(1, 0), a3, voffA);
            PG8_WAIT_V(8); PG8_WAIT_L(0); PG8_BAR; PG8_MMA(1, 0, At, B0); PG8_MMA(1, 1, At, B1); PG8_BAR; PG8_SCHED;
            } else {
            PG8_LDB(B0, 0, 0); PG8_SCHED; PG8_LDA(At, 0, 0); PG8_STAGE(PG8_SA(1, 1), a1 + hstep, voffA);
            PG8_WAIT_L(8); PG8_BAR; PG8_WAIT_L(0); PG8_MMA(0, 0, At, B0); PG8_BAR; PG8_SCHED;
            PG8_LDB(B1, 0, 1); PG8_STAGE(PG8_SB(0, 0), b2, voffB);
            PG8_BAR; PG8_WAIT_L(0); PG8_MMA(0, 1, At, B1); PG8_BAR;
            PG8_LDA(At, 0, 1); PG8_STAGE(PG8_SA(0, 0), a2, voffA);
            PG8_BAR; PG8_WAIT_L(0); PG8_MMA(1, 0, At, B0); PG8_BAR; PG8_SCHED;
            PG8_STAGE(PG8_SB(0, 1), b2 + hstep, voffB);
            PG8_WAIT_V(6); PG8_BAR; PG8_MMA(1, 1, At, B1); PG8_BAR;
            PG8_LDB(B0, 1, 0); PG8_SCHED; PG8_LDA(At, 1, 0); PG8_STAGE(PG8_SA(0, 1), a2 + hstep, voffA);
            PG8_WAIT_L(8); PG8_BAR; PG8_WAIT_L(0); PG8_MMA(0, 0, At, B0); PG8_BAR; PG8_SCHED;
            PG8_LDB(B1, 1, 1); PG8_STAGE(PG8_SB(1, 0), b3, voffB);
            PG8_BAR; PG8_WAIT_L(0); PG8_MMA(0, 1, At, B1); PG8_BAR;
            PG8_LDA(At, 1, 1); PG8_STAGE(PG8_SA(1, 0), a3, voffA);
            PG8_BAR; PG8_WAIT_L(0); PG8_MMA(1, 0, At, B0); PG8_BAR; PG8_SCHED;
            PG8_STAGE(PG8_SB(1, 1), b3 + hstep, voffB);
            PG8_WAIT_V(6); PG8_BAR; PG8_MMA(1, 1, At, B1); PG8_BAR;
            }
        }
        if constexpr (MODE != 0) asm volatile("s_nop 15\n\ts_nop 15" ::: "memory");
        if constexpr (ALIGN_EPI) { if (wr == 0) PG8_BAR; }
        if constexpr (!Epi::AFTER_DRAIN) { int ln_; asm volatile("v_mbcnt_lo_u32_b32 %0, -1, 0\n\tv_mbcnt_hi_u32_b32 %0, -1, %0" : "=v"(ln_));
            E(acc, cur, wr, wc, ln_ & 15, ln_ >> 4); S.done(cur); }
        if (!has_next) break;
#pragma unroll
        for (int a = 0; a < 2; ++a)
#pragma unroll
            for (int b = 0; b < 2; ++b)
#pragma unroll
                for (int m = 0; m < 4; ++m)
#pragma unroll
                    for (int n = 0; n < 2; ++n) acc[a][b][m][n] = (f32x4){0.f, 0.f, 0.f, 0.f};
        cur = nxt; cA = nA; cB = nB; ++ui;
        if constexpr (ALIGN_EPI) { if (wr == 1) PG8_BAR; }
    }
    PG8_WAIT_V(0);
    if constexpr (!ALIGN_EPI) { if (wr == 0) PG8_BAR; }
    PG8_BAR;
    if constexpr (Epi::AFTER_DRAIN) { E.fused(acc, cur, wr, wc, fr, fq, lds, wid, lane); S.done(cur); }
#undef PG8_SA
#undef PG8_SB
#undef PG8_STAGE
#undef PG8_LDA
#undef PG8_LDB
#undef PG8_MMA
#undef PG8_CAT
#undef PG8_WAIT_V
#undef PG8_WAIT_L
#undef PG8_BAR
#undef PG8_SCHED
}
}
namespace at {
__device__ __forceinline__ int crow(int r, int hi) { return (r & 3) + 8 * (r >> 2) + 4 * hi; }
typedef short v4i16_t __attribute__((ext_vector_type(4)));
__device__ __forceinline__ s16x4 vtr(const LAS unsigned char* p) { return __builtin_bit_cast(s16x4, __builtin_amdgcn_ds_read_tr16_b64_v4i16((LAS v4i16_t*)p)); }
__device__ __forceinline__ bf16x8 cat8(s16x4 lo, s16x4 hi) { return (bf16x8){lo[0], lo[1], lo[2], lo[3], hi[0], hi[1], hi[2], hi[3]}; }
#define MFMA32(a, b, c) __builtin_amdgcn_mfma_f32_32x32x16_bf16((a), (b), (c), 0, 0, 0)
constexpr int KSTR = 144;
constexpr float NEG_BIG = -1.0e30f;

__device__ __forceinline__ bf16x8 tr_frag(const LAS unsigned char* tile, int vstr, int ks, int colb, int lane) {
    const int hi = lane >> 5, ql = (lane & 15) >> 2, blk = (lane >> 4) & 1, p = lane & 3;
    const LAS unsigned char* a = tile + (16 * ks + 4 * hi + ql) * vstr + (colb + 16 * blk + 4 * p) * 2;
    return cat8(vtr(a), vtr(a + 8 * vstr));
}

template <int N> __device__ __forceinline__ void wait_bar() { asm volatile("s_waitcnt vmcnt(%0) lgkmcnt(0)\n\ts_barrier" :: "n"(N) : "memory"); }
template <int DV, int NK> struct AtGeo { static constexpr int KB = 8192, VB = DV * 128, STAGE = NK * KB + VB, NP = (NK * 8 + DV / 8) / 8  , LDS = 3 * STAGE + 2048; };
__device__ __forceinline__ bf16x8 v_frag(const LAS unsigned char* Vt, int ks, int c, int lane) {
    const int hi = lane >> 5, ql = (lane & 15) >> 2, blk = (lane >> 4) & 1, p = lane & 3;
    const int ch = (4 * (c & 1) + 2 * blk + (p >> 1)) ^ ((ql & 2) << 1);
    const LAS unsigned char* a = Vt + (c >> 1) * 8192 + (16 * ks + 4 * hi + ql) * 128 + ch * 16 + 8 * (p & 1);
    return cat8(vtr(a), vtr(a + 1024));
}
template <int DV, int NK> struct AtCtx {
    LAS unsigned char* lds; LAS float* scr; bf16x8 qr[4]; f32x16 o[DV / 32]; f32x16 negm; float m, l; int lane, r32, hi, ksel, qpos, kpos0, nloc; bool exact0;
};
template <int DV, int NK, bool BAND, bool HAS_QK, bool HAS_PV, bool EX0>
__device__ __forceinline__ void at_step(AtCtx<DV, NK>& C, int t, int koff, int voff, const u32x4 (&pw)[4], u32x4 (&pn)[4]) {
    constexpr int KB = 8192, NC = DV / 32, NG = NC * 4  , EPG = 16 / NG  ;
    const LAS unsigned char* Kt = C.lds + koff + C.ksel * KB;
    const LAS unsigned char* Vt = C.lds + voff;
    const int lane = C.lane, r32 = C.r32, hi = C.hi;
    f32x16 s0, s1; bf16x8 vf[2][4];
    bool resc = false;
    if (HAS_QK) {
        bf16x8 kf[8];
#pragma unroll
        for (int d0 = 0; d0 < 4; ++d0) { const int ko = r32 * 128 + (((2 * d0 + hi) ^ ((r32 >> 1) & 7)) << 4);
            kf[2 * d0] = *(const LAS bf16x8*)(Kt + ko); kf[2 * d0 + 1] = *(const LAS bf16x8*)(Kt + 4096 + ko); }
        __builtin_amdgcn_sched_barrier(0);
        __builtin_amdgcn_s_setprio(1);
        s0 = MFMA32(kf[0], C.qr[0], C.negm); s1 = MFMA32(kf[1], C.qr[0], C.negm);
#pragma unroll
        for (int d0 = 1; d0 < 4; ++d0) { s0 = MFMA32(kf[2 * d0], C.qr[d0], s0); s1 = MFMA32(kf[2 * d0 + 1], C.qr[d0], s1); }
        __builtin_amdgcn_s_setprio(0);
        __builtin_amdgcn_sched_barrier(0);
    }
    if (HAS_PV) {
#pragma unroll
        for (int c = 0; c < 2; ++c)
#pragma unroll
            for (int ks = 0; ks < 4; ++ks) vf[c][ks] = v_frag(Vt, ks, c, lane);
        __builtin_amdgcn_sched_barrier(0);
    }
    if (HAS_QK) {
        if (BAND && t < C.nloc) {
            const int kb = C.kpos0 + 64 * t - C.qpos;
#pragma unroll
            for (int r = 0; r < 16; ++r) { const int d = kb + crow(r, hi); if (d > 128 || d < -128) s0[r] = NEG_BIG; if (d + 32 > 128 || d + 32 < -128) s1[r] = NEG_BIG; }
        }
        float mt = fmaxf(fmaxf(s0[0], s1[0]), s0[1]);
#pragma unroll
        for (int r = 2; r < 16; r += 2) mt = fmaxf(fmaxf(mt, s0[r]), s0[r + 1]);
#pragma unroll
        for (int r = 1; r < 16; r += 2) mt = fmaxf(fmaxf(mt, s1[r]), s1[(r + 1) & 15]);
        { const auto sw = __builtin_amdgcn_permlane32_swap(__float_as_uint(mt), __float_as_uint(mt), false, false); mt = fmaxf(__uint_as_float(sw[0]), __uint_as_float(sw[1])); }
        const float dl = (!HAS_PV && EX0) ? mt : ((mt > 8.0f) ? mt : 0.0f);
        resc = (!HAS_PV && EX0) ? true : __any(dl > 0.0f);
        if (resc) { const float f = (!HAS_PV && EX0) ? 1.0f : fexp2(-dl);     C.l *= f; C.m += dl; if (hi == 0) C.scr[r32] = f;
#pragma unroll
            for (int r = 0; r < 16; ++r) { s0[r] -= dl; s1[r] -= dl; C.negm[r] = -C.m; } }
        __builtin_amdgcn_sched_barrier(0);
    }
    {
        float ls = 0.f;
        __builtin_amdgcn_s_setprio(1);
#pragma unroll
        for (int g = 0; g < NG; ++g) {
            const int c = g >> 2, ks = g & 3;
            if (HAS_PV) {
                C.o[c] = MFMA32(__builtin_bit_cast(bf16x8, pw[ks]), vf[c & 1][ks], C.o[c]);
                if (ks == 3 && c + 2 < NC) {
#pragma unroll
                    for (int k2 = 0; k2 < 4; ++k2) vf[c & 1][k2] = v_frag(Vt, k2, c + 2, lane);
                }
            }
            if (HAS_QK) {
#pragma unroll
                for (int e = 0; e < EPG; ++e) { const int r = g * EPG + e;
                    s0[r] = fexp2(s0[r]); s1[r] = fexp2(s1[r]); ls += s0[r] + s1[r];
                    if (r & 1) { const unsigned w0 = pk2(s0[r - 1], s0[r]), w1 = pk2(s1[r - 1], s1[r]); pn[r >> 3][(r >> 1) & 3] = w0; pn[2 + (r >> 3)][(r >> 1) & 3] = w1; } }
            }
        }
        if (HAS_QK) { C.l += ls; asm volatile("" : "+v"(pn[0]), "+v"(pn[1]), "+v"(pn[2]), "+v"(pn[3]), "+v"(C.l)); }
        __builtin_amdgcn_s_setprio(0);
        if (HAS_QK && HAS_PV) {
#pragma unroll
            for (int g = 0; g < NG; ++g) { __builtin_amdgcn_sched_group_barrier(0x008, 1, 0); __builtin_amdgcn_sched_group_barrier(0x002, 6 * EPG, 0); if (g < (NC - 2) * 4) __builtin_amdgcn_sched_group_barrier(0x100, 2, 0); }
        }
        __builtin_amdgcn_sched_barrier(0);
    }
    if (resc) {
        LDS_WAIT();
#pragma unroll
        for (int j = 0; j < 4; ++j) { const f32x4 fv = *(const LAS f32x4*)(C.scr + 8 * j + 4 * hi);
#pragma unroll
            for (int c = 0; c < NC; ++c) { C.o[c][4 * j] *= fv[0]; C.o[c][4 * j + 1] *= fv[1]; C.o[c][4 * j + 2] *= fv[2]; C.o[c][4 * j + 3] *= fv[3]; } }
        LDS_WAIT();
    }
}
template <int DV, int NK, bool BAND, bool EX0>
__device__ __forceinline__ void attn_core(LAS unsigned char* lds, const bf16_t* __restrict__ proj, int NT, int nloc, int locrow0, int ctxrow0, int kcol, int vcol,
                                          const bf16_t* qp, int ksel, int qpos, int kpos0, float m_init, float l_init, f32x16 (&o)[DV / 32], float& l_out, int tid) {
    typedef AtGeo<DV, NK> Geo;
    constexpr int KB = Geo::KB, VB = Geo::VB, NPK = NK, NPV = DV / 64, NP = NPK + NPV;
    AtCtx<DV, NK> C;
    C.lds = lds; C.lane = tid & 63; C.r32 = C.lane & 31; C.hi = C.lane >> 5; C.ksel = ksel; C.qpos = qpos; C.kpos0 = kpos0; C.nloc = nloc;
    const int lane = C.lane; const int wid = __builtin_amdgcn_readfirstlane(tid >> 6);
    C.scr = (LAS float*)(lds + 3 * Geo::STAGE) + wid * 64;
#pragma unroll
    for (int d0 = 0; d0 < 4; ++d0) C.qr[d0] = *(const bf16x8*)(qp + d0 * 16 + C.hi * 8);
    unsigned ksoff[NPK], vsoff[NPV]; int kdoff[NPK], vdoff[NPV];
#pragma unroll
    for (int i = 0; i < NPK; ++i) { const int pc = wid + 8 * i, j = pc >> 3, key = 8 * (pc & 7) + (lane >> 3), ch = (lane & 7) ^ ((key >> 1) & 7);
        ksoff[i] = (unsigned)key * DINP + kcol + j * 64 + ch * 8; kdoff[i] = pc * 1024; }
#pragma unroll
    for (int i = 0; i < NPV; ++i) { const int pv = wid + 8 * i, cp = pv >> 3, key = 8 * (pv & 7) + (lane >> 3), ch = (lane & 7) ^ (((key >> 1) & 1) << 2);
        vsoff[i] = (unsigned)key * DINP + vcol + cp * 64 + ch * 8; vdoff[i] = 3 * NK * KB + pv * 1024; }
#define AT_ROW0(t) ((t) < nloc ? locrow0 + 64 * (t) : ctxrow0 + 64 * ((t) - nloc))
#define AT_DMA_K(t, s) do { const bf16_t* tb = proj + (size_t)AT_ROW0(t) * DINP; \
        _Pragma("unroll") for (int i = 0; i < NPK; ++i) __builtin_amdgcn_global_load_lds((const unsigned*)(tb + ksoff[i]), (LAS unsigned*)(lds + (s) * (NK * KB) + kdoff[i]), 16, 0, 0); } while (0)
#define AT_DMA_V(t, s) do { const bf16_t* tb = proj + (size_t)AT_ROW0(t) * DINP; \
        _Pragma("unroll") for (int i = 0; i < NPV; ++i) __builtin_amdgcn_global_load_lds((const unsigned*)(tb + vsoff[i]), (LAS unsigned*)(lds + (s) * VB + vdoff[i]), 16, 0, 0); } while (0)
    C.m = m_init; C.l = l_init; C.exact0 = EX0;
#pragma unroll
    for (int r = 0; r < 16; ++r) C.negm[r] = -m_init;
#pragma unroll
    for (int c = 0; c < DV / 32; ++c) C.o[c] = (f32x16){0.f};
    u32x4 pa[4], pb[4];
    AT_DMA_K(0, 0);
    AT_DMA_K(1, 1); AT_DMA_V(0, 0);
    wait_bar<NP>();
    if (2 < NT) AT_DMA_K(2, 2);
    AT_DMA_V(1, 1);
    at_step<DV, NK, BAND, true, false, EX0>(C, 0, 0, 0, pb, pa);
    int s1 = 1, s0 = 0;
    for (int t = 1; t < NT; ++t) {
        if (t + 1 < NT) wait_bar<NP>(); else wait_bar<NPV>();
        const int s2 = s1 == 2 ? 0 : s1 + 1;
        if (t + 2 < NT) AT_DMA_K(t + 2, s0);
        if (t + 1 < NT) AT_DMA_V(t + 1, s2);
        at_step<DV, NK, BAND, true, true, EX0>(C, t, s1 * (NK * KB), 3 * NK * KB + s0 * VB, pa, pb);
#pragma unroll
        for (int i_ = 0; i_ < 4; ++i_) pa[i_] = pb[i_];
        s0 = s1; s1 = s2;
    }
    wait_bar<0>();
    at_step<DV, NK, BAND, false, true, EX0>(C, NT, 0, 3 * NK * KB + s0 * VB, pa, pb);
    wait_bar<0>();
#undef AT_ROW0
#undef AT_DMA_K
#undef AT_DMA_V
#pragma unroll
    for (int c = 0; c < DV / 32; ++c) o[c] = C.o[c];
    l_out = C.l + __shfl_xor(C.l, 32);
}
template <int DV, int NK> struct AtGeoP { static constexpr int KT = NK * 8192, VT = DV * 128, VRING = 4 * KT, SCR = 4 * KT + 4 * VT, LDS = SCR + 2048; };
template <int DV, int NK, bool EX0>
__device__ __forceinline__ void attn_core_pair(LAS unsigned char* lds, const bf16_t* __restrict__ proj, int NT, int nloc, int locrow0, int ctxrow0, int kcol, int vcol,
                                               const bf16_t* qp, int ksel, float m_init, float l_init, f32x16 (&o)[DV / 32], float& l_out, int tid) {
    typedef AtGeoP<DV, NK> Geo;
    constexpr int KT = Geo::KT, VT = Geo::VT, VRING = Geo::VRING, NPK = NK, NPV = DV / 64;
    AtCtx<DV, NK> C;
    C.lds = lds; C.lane = tid & 63; C.r32 = C.lane & 31; C.hi = C.lane >> 5; C.ksel = ksel; C.qpos = 0; C.kpos0 = 0; C.nloc = nloc;
    const int lane = C.lane; const int wid = __builtin_amdgcn_readfirstlane(tid >> 6);
    C.scr = (LAS float*)(lds + Geo::SCR) + wid * 64;
#pragma unroll
    for (int d0 = 0; d0 < 4; ++d0) C.qr[d0] = *(const bf16x8*)(qp + d0 * 16 + C.hi * 8);
    unsigned ksoff[NPK], vsoff[NPV]; int kdoff[NPK], vdoff[NPV];
#pragma unroll
    for (int i = 0; i < NPK; ++i) { const int pc = wid + 8 * i, j = pc >> 3, key = 8 * (pc & 7) + (lane >> 3), ch = (lane & 7) ^ ((key >> 1) & 7);
        ksoff[i] = (unsigned)key * DINP + kcol + j * 64 + ch * 8; kdoff[i] = pc * 1024; }
#pragma unroll
    for (int i = 0; i < NPV; ++i) { const int pv = wid + 8 * i, cp = pv >> 3, key = 8 * (pv & 7) + (lane >> 3), ch = (lane & 7) ^ (((key >> 1) & 1) << 2);
        vsoff[i] = (unsigned)key * DINP + vcol + cp * 64 + ch * 8; vdoff[i] = VRING + pv * 1024; }
#define ATP_ROW0(t) ((t) < nloc ? locrow0 + 64 * (t) : ctxrow0 + 64 * ((t) - nloc))
#define ATP_OFF(t, T_) ((((t) >> 1) & 1) * 2 * (T_) + ((t) & 1) * (T_))
#define ATP_DMA_K(t) do { const bf16_t* tb = proj + (size_t)ATP_ROW0(t) * DINP; const int so_ = ATP_OFF(t, KT); \
        _Pragma("unroll") for (int i = 0; i < NPK; ++i) __builtin_amdgcn_global_load_lds((const unsigned*)(tb + ksoff[i]), (LAS unsigned*)(lds + so_ + kdoff[i]), 16, 0, 0); } while (0)
#define ATP_DMA_V(t) do { const bf16_t* tb = proj + (size_t)ATP_ROW0(t) * DINP; const int so_ = ATP_OFF(t, VT); \
        _Pragma("unroll") for (int i = 0; i < NPV; ++i) __builtin_amdgcn_global_load_lds((const unsigned*)(tb + vsoff[i]), (LAS unsigned*)(lds + so_ + vdoff[i]), 16, 0, 0); } while (0)
    C.m = m_init; C.l = l_init; C.exact0 = EX0;
#pragma unroll
    for (int r = 0; r < 16; ++r) C.negm[r] = -m_init;
#pragma unroll
    for (int c = 0; c < DV / 32; ++c) C.o[c] = (f32x16){0.f};
    u32x4 pa[4], pb[4];
    ATP_DMA_K(0); ATP_DMA_K(1); ATP_DMA_V(0);
    wait_bar<0>();
    if (2 < NT) { ATP_DMA_K(2); ATP_DMA_K(3); ATP_DMA_V(2); }
    ATP_DMA_V(1);
    at_step<DV, NK, false, true, false, EX0>(C, 0, ATP_OFF(0, KT), 0, pb, pa);
    at_step<DV, NK, false, true, true, EX0>(C, 1, ATP_OFF(1, KT), VRING + ATP_OFF(0, VT), pa, pb);
#pragma unroll
    for (int i_ = 0; i_ < 4; ++i_) pa[i_] = pb[i_];
    for (int t = 2; t < NT; t += 2) {
        wait_bar<0>();
        if (t + 2 < NT) { ATP_DMA_K(t + 2); ATP_DMA_K(t + 3); ATP_DMA_V(t + 2); }
        ATP_DMA_V(t + 1);
        at_step<DV, NK, false, true, true, EX0>(C, t, ATP_OFF(t, KT), VRING + ATP_OFF(t - 1, VT), pa, pb);
#pragma unroll
        for (int i_ = 0; i_ < 4; ++i_) pa[i_] = pb[i_];
        at_step<DV, NK, false, true, true, EX0>(C, t + 1, ATP_OFF(t + 1, KT), VRING + ATP_OFF(t, VT), pa, pb);
#pragma unroll
        for (int i_ = 0; i_ < 4; ++i_) pa[i_] = pb[i_];
    }
    wait_bar<0>();
    at_step<DV, NK, false, false, true, EX0>(C, NT, 0, VRING + ATP_OFF(NT - 1, VT), pa, pb);
    wait_bar<0>();
#undef ATP_ROW0
#undef ATP_OFF
#undef ATP_DMA_K
#undef ATP_DMA_V
#pragma unroll
    for (int c = 0; c < DV / 32; ++c) o[c] = C.o[c];
    l_out = C.l + __shfl_xor(C.l, 32);
}
template <int NC>
__device__ __forceinline__ void scale_rows(f32x16 (&o)[NC], float v, LAS float* scr, int r32, int hi) {
    LDS_WAIT();
    if (hi == 0) scr[r32] = v;
    LDS_WAIT();
#pragma unroll
    for (int j = 0; j < 4; ++j) { const f32x4 fv = *(const LAS f32x4*)(scr + 8 * j + 4 * hi);
#pragma unroll
        for (int c = 0; c < NC; ++c) { o[c][4 * j] *= fv[0]; o[c][4 * j + 1] *= fv[1]; o[c][4 * j + 2] *= fv[2]; o[c][4 * j + 3] *= fv[3]; } }
    LDS_WAIT();
}
constexpr int AT_A_LDS = AtGeo<64, 1>::LDS;
constexpr int AT_C_LDS = AtGeoP<128, 2>::LDS;

__device__ __forceinline__ void attnA_unit(LAS unsigned char* lds, const bf16_t* proj, bf16_t* ocat, const float* sink, int b, int g, int qb, int lat, int tid) {
    const int lane = tid & 63, r32 = lane & 31, hi = lane >> 5; const int wid = __builtin_amdgcn_readfirstlane(tid >> 6);
    const int head = g * 4 + (wid >> 1), qloc = qb * 64 + (wid & 1) * 32;
    const int qrow0 = (lat ? b * SEQ : TL + b * CTXL) + qloc;
    int nloc = 0, kt0 = 0;
    if (lat) { kt0 = qb - 2 < 0 ? 0 : qb - 2; const int kt1 = qb + 2 > 63 ? 63 : qb + 2; nloc = kt1 - kt0 + 1; }
    const int NT = nloc + 4;
    f32x16 o[2]; float l;
    attn_core<64, 1, true, false>(lds, proj, NT, nloc, b * SEQ + 64 * kt0, TL + b * CTXL, C_KA + g * 64, C_VA + g * 64,
                           proj + (size_t)(qrow0 + r32) * DINP + C_QA + head * 64, 0, qloc + r32, 64 * kt0, sink[head] * LOG2E, hi == 0 ? 1.0f : 0.0f, o, l, tid);
    LAS float* scr = (LAS float*)(lds + 3 * AtGeo<64, 1>::STAGE) + wid * 64;
    scale_rows<2>(o, __builtin_amdgcn_rcpf(l), scr, r32, hi);
    bf16_t* op = ocat + (size_t)qrow0 * OCW + head * 64 + r32;
#pragma unroll
    for (int r = 0; r < 16; ++r) { const int row = crow(r, hi);
#pragma unroll
        for (int c = 0; c < 2; ++c) op[(size_t)row * OCW + 32 * c] = (bf16_t)(pk2(o[c][r], 0.f) & 0xffffu); }
}

__device__ __forceinline__ void attnC_unit(LAS unsigned char* lds, const bf16_t* proj, bf16_t* ocat, const float* dgain, float lam, float oml, int b, int h, int qb, int lat, int tid) {
    const int lane = tid & 63, r32 = lane & 31, hi = lane >> 5; const int wid = __builtin_amdgcn_readfirstlane(tid >> 6);
    const int comp = wid >> 2, qloc = qb * 128 + (wid & 3) * 32;
    const int qrow0 = (lat ? b * SEQ : TL + b * CTXL) + qloc;
    const int nloc = lat ? 64 : 0, NT = nloc + 4;
    f32x16 o[4]; float l;
    attn_core_pair<128, 2, true>(lds, proj, NT, nloc, b * SEQ, TL + b * CTXL, C_KD + h * 128, C_VD + h * 128,
                           proj + (size_t)(qrow0 + r32) * DINP + C_QD + h * 128 + comp * 64, comp, 0.0f, 0.0f, o, l, tid);
    LAS float* scr = (LAS float*)(lds + AtGeoP<128, 2>::SCR) + wid * 64;
    scale_rows<4>(o, __builtin_amdgcn_rcpf(l), scr, r32, hi);
    LAS float* X = (LAS float*)lds + (wid & 3) * 4096;
    if (comp == 1) {
#pragma unroll
        for (int c = 0; c < 4; ++c)
#pragma unroll
            for (int r = 0; r < 16; ++r) X[(c * 16 + r) * 64 + lane] = o[c][r];
    }
    __syncthreads();
    if (comp == 0) {
        float ss[16];
#pragma unroll
        for (int r = 0; r < 16; ++r) ss[r] = 0.f;
#pragma unroll
        for (int c = 0; c < 4; ++c)
#pragma unroll
            for (int r = 0; r < 16; ++r) { const float v = o[c][r] - lam * X[(c * 16 + r) * 64 + lane]; o[c][r] = v; ss[r] += v * v; }
#pragma unroll
        for (int r = 0; r < 16; ++r) {
#pragma unroll
            for (int s = 1; s < 32; s <<= 1) ss[r] += __shfl_xor(ss[r], s);
            ss[r] = __builtin_amdgcn_rsqf(ss[r] * (1.0f / 128.0f) + NORM_EPS) * oml;
        }
        bf16_t* op = ocat + (size_t)qrow0 * OCW + 1024 + h * 128 + r32;
#pragma unroll
        for (int c = 0; c < 4; ++c) { const float gn = dgain[32 * c + r32];
#pragma unroll
            for (int r = 0; r < 16; ++r) op[(size_t)crow(r, hi) * OCW + 32 * c] = (bf16_t)(pk2(o[c][r] * ss[r] * gn, 0.f) & 0xffffu); }
    }
    __syncthreads();
}
__device__ __forceinline__ int chunk_row0(int b, int ci) { return ci < 2 ? TL + b * CTXL + ci * 128 : b * SEQ + (ci - 2) * 128; }
constexpr int RSTR = 192;
constexpr int VSTR128 = 320;
constexpr int R1_LDS = 2 * 128 * RSTR + 128 * VSTR128;
__device__ __forceinline__ void ret_kv_phase(LAS unsigned char* lds, const bf16_t* __restrict__ proj, bf16_t* kvT, const float* lg2, int blk, int G, int tid) {
    const int lane = tid & 63, hi = lane >> 5; const int wid = __builtin_amdgcn_readfirstlane(tid >> 6);
    LAS unsigned char* Kf = lds; LAS unsigned char* Kb = lds + 128 * RSTR; LAS unsigned char* Vt = lds + 2 * 128 * RSTR;
    constexpr int NU = NB * 4 * NCHK;
    int u = blk; if (u >= NU) return;
    u32x4 kreg[2], vreg[4];
#define R1_LOAD(uu) do { const int ci_ = (uu) % NCHK, bh_ = (uu) / NCHK, row0_ = chunk_row0(bh_ >> 2, ci_), h_ = bh_ & 3; \
        _Pragma("unroll") for (int i = 0; i < 2; ++i) { const int c = tid + 512 * i, k = c >> 3, ch = c & 7; kreg[i] = *(const u32x4*)(proj + (size_t)(row0_ + k) * DINP + C_KB + h_ * 64 + ch * 8); } \
        _Pragma("unroll") for (int i = 0; i < 4; ++i) { const int c = tid + 512 * i, k = c >> 4, ch = c & 15; vreg[i] = *(const u32x4*)(proj + (size_t)(row0_ + k) * DINP + C_VB + h_ * 128 + ch * 8); } } while (0)
    R1_LOAD(u);
    for (;;) {
        const int ci = u % NCHK, bh = u / NCHK, b = bh >> 2, h = bh & 3;
        const float lgf2 = lg2[h], lgb2 = lg2[4 + h];
#pragma unroll
        for (int i = 0; i < 2; ++i) { const int c = tid + 512 * i, k = c >> 3, ch = c & 7;
            const u32x4 v = kreg[i];
            const float wf = fexp2((float)(127 - k) * lgf2), wb = fexp2((float)k * lgb2);
            u32x4 a, d;
#pragma unroll
            for (int j = 0; j < 4; ++j) { const float x0 = bf_lo(v[j]), x1 = bf_hi(v[j]); a[j] = pk2(x0 * wf, x1 * wf); d[j] = pk2(x0 * wb, x1 * wb); }
            *(LAS u32x4*)(Kf + k * RSTR + ch * 16) = a; *(LAS u32x4*)(Kb + k * RSTR + ch * 16) = d; }
#pragma unroll
        for (int i = 0; i < 4; ++i) { const int c = tid + 512 * i, k = c >> 4, ch = c & 15; *(LAS u32x4*)(Vt + k * VSTR128 + ch * 16) = vreg[i]; }
        __syncthreads();
        const int un = u + G;
        if (un < NU) R1_LOAD(un);
        const int dir = wid >> 2, mt = (wid >> 1) & 1, nt0 = (wid & 1) * 2;
        const LAS unsigned char* Kt = dir ? Kb : Kf;
        f32x16 acc0 = (f32x16){0.f}, acc1 = (f32x16){0.f};
#pragma unroll
        for (int ks = 0; ks < 8; ++ks) {
            const bf16x8 af = tr_frag(Kt, RSTR, ks, 32 * mt, lane);
            acc0 = MFMA32(af, tr_frag(Vt, VSTR128, ks, 32 * nt0, lane), acc0);
            acc1 = MFMA32(af, tr_frag(Vt, VSTR128, ks, 32 * nt0 + 32, lane), acc1);
        }
        bf16_t* out = kvT + ((size_t)(((b * 4 + h) * NCHK + ci) * 2 + dir)) * 8192;
#pragma unroll
        for (int j = 0; j < 4; ++j) {
            u32x2 w0, w1; w0.x = pk2(acc0[4 * j], acc0[4 * j + 1]); w0.y = pk2(acc0[4 * j + 2], acc0[4 * j + 3]); w1.x = pk2(acc1[4 * j], acc1[4 * j + 1]); w1.y = pk2(acc1[4 * j + 2], acc1[4 * j + 3]);
            *(u32x2*)(out + (size_t)(32 * nt0 + (lane & 31)) * 64 + 32 * mt + 8 * j + 4 * hi) = w0;
            *(u32x2*)(out + (size_t)(32 * nt0 + 32 + (lane & 31)) * 64 + 32 * mt + 8 * j + 4 * hi) = w1;
        }
        __syncthreads();
        if (un >= NU) break;
        u = un;
    }
#undef R1_LOAD
}
__device__ __forceinline__ void ret_scan(const bf16_t* kvT, bf16_t* SpT, const float* lg2  , int gtid, int gthreads) {
    for (int q = gtid; q < 64 * 2048; q += gthreads) {
        const int combo = q >> 11, e4 = (q & 2047) * 4, dir = combo & 1, h = (combo >> 1) & 3, b = combo >> 3;
        const float g128 = fexp2(128.0f * lg2[dir * 4 + h]);
        f32x4 S = {0.f, 0.f, 0.f, 0.f};
        for (int s = 0; s < NCHK; ++s) {
            const int ci = dir ? (s == 0 ? 1 : (s == 1 ? 0 : 35 - s)) : s;
            const size_t off = ((size_t)(((b * 4 + h) * NCHK + ci) * 2 + dir)) * 8192 + e4;
            const u32x2 kw = *(const u32x2*)(kvT + off); const f32x4 kv = {bf_lo(kw.x), bf_hi(kw.x), bf_lo(kw.y), bf_hi(kw.y)};
            u32x2 w; w.x = pk2(S[0], S[1]); w.y = pk2(S[2], S[3]);
            *(u32x2*)(SpT + off) = w;
            S = S * g128 + kv;
        }
    }
}
constexpr int R3_K = 0, R3_V = 128 * KSTR, R3_SF = R3_V + 128 * VSTR128, R3_SB = R3_SF + 128 * KSTR, R3_X = R3_SB + 128 * KSTR, R3_SCR = R3_X + 1024, R3_LDS = R3_SCR + 2048;
__device__ __forceinline__ void ret_out_unit(LAS unsigned char* lds, const bf16_t* __restrict__ proj, const bf16_t* __restrict__ SpT, bf16_t* ocat, float lgf2, float lgb2, int b, int h, int ci, int tid) {
    const int lane = tid & 63, r32 = lane & 31, hi = lane >> 5; const int wid = __builtin_amdgcn_readfirstlane(tid >> 6);
    const int row0 = chunk_row0(b, ci), qs = wid & 3, dh = wid >> 2;
    const bf16_t* sp = SpT + ((size_t)(((b * 4 + h) * NCHK + ci) * 2)) * 8192;
#pragma unroll
    for (int i = 0; i < 2; ++i) { const int c = tid + 512 * i, k = c >> 3, ch = c & 7;
        *(LAS u32x4*)(lds + R3_K + k * KSTR + ch * 16) = *(const u32x4*)(proj + (size_t)(row0 + k) * DINP + C_KB + h * 64 + ch * 8);
        *(LAS u32x4*)(lds + R3_SF + k * KSTR + ch * 16) = *(const u32x4*)(sp + (size_t)k * 64 + ch * 8);
        *(LAS u32x4*)(lds + R3_SB + k * KSTR + ch * 16) = *(const u32x4*)(sp + 8192 + (size_t)k * 64 + ch * 8); }
#pragma unroll
    for (int i = 0; i < 4; ++i) { const int c = tid + 512 * i, k = c >> 4, ch = c & 15;
        *(LAS u32x4*)(lds + R3_V + k * VSTR128 + ch * 16) = *(const u32x4*)(proj + (size_t)(row0 + k) * DINP + C_VB + h * 128 + ch * 8); }
    bf16x8 qr[4];
    { const bf16_t* qp = proj + (size_t)(row0 + 32 * qs + r32) * DINP + C_QB + h * 64;
#pragma unroll
      for (int d0 = 0; d0 < 4; ++d0) qr[d0] = *(const bf16x8*)(qp + d0 * 16 + hi * 8); }
    bf16_t gt[2][16];
    { const bf16_t* gp0 = proj + (size_t)(row0 + 32 * qs) * DINP + C_GB + h * 128 + 64 * dh + r32;
#pragma unroll
      for (int r = 0; r < 16; ++r)
#pragma unroll
          for (int c = 0; c < 2; ++c) gt[c][r] = gp0[(size_t)crow(r, hi) * DINP + 32 * c]; }
    __syncthreads();
    f32x16 o[2];
#pragma unroll
    for (int c = 0; c < 2; ++c) {
        f32x16 tf = (f32x16){0.f}, tb = (f32x16){0.f};
        const int srow = 64 * dh + 32 * c + r32;
#pragma unroll
        for (int d0 = 0; d0 < 4; ++d0) {
            tf = MFMA32(qr[d0], *(const LAS bf16x8*)(lds + R3_SF + srow * KSTR + (16 * d0 + 8 * hi) * 2), tf);
            tb = MFMA32(qr[d0], *(const LAS bf16x8*)(lds + R3_SB + srow * KSTR + (16 * d0 + 8 * hi) * 2), tb);
        }
#pragma unroll
        for (int r = 0; r < 16; ++r) { const int cp = 32 * qs + crow(r, hi); o[c][r] = fexp2((float)(cp + 1) * lgf2) * tf[r] + fexp2((float)(128 - cp) * lgb2) * tb[r]; }
    }
    const int qpos = 32 * qs + r32;
#pragma unroll 1
    for (int kt = 0; kt < 4; ++kt) {
        f32x16 p = (f32x16){0.f};
#pragma unroll
        for (int d0 = 0; d0 < 4; ++d0) p = MFMA32(*(const LAS bf16x8*)(lds + R3_K + (32 * kt + r32) * KSTR + (16 * d0 + 8 * hi) * 2), qr[d0], p);
#pragma unroll
        for (int r = 0; r < 16; ++r) { const int d = qpos - (32 * kt + crow(r, hi));
            const float wf = d >= 0 ? fexp2((float)d * lgf2) : 0.f, wb = d <= 0 ? fexp2((float)(-d) * lgb2) : 0.f; p[r] *= (wf + wb); }
        u32x4 w0, w1;
        w0.x = pk2(p[0], p[1]); w0.y = pk2(p[2], p[3]); w0.z = pk2(p[4], p[5]); w0.w = pk2(p[6], p[7]);
        w1.x = pk2(p[8], p[9]); w1.y = pk2(p[10], p[11]); w1.z = pk2(p[12], p[13]); w1.w = pk2(p[14], p[15]);
        const bf16x8 pa = __builtin_bit_cast(bf16x8, w0), pb = __builtin_bit_cast(bf16x8, w1);
#pragma unroll
        for (int c = 0; c < 2; ++c) {
            o[c] = MFMA32(pa, tr_frag(lds + R3_V, VSTR128, 2 * kt, 64 * dh + 32 * c, lane), o[c]);
            o[c] = MFMA32(pb, tr_frag(lds + R3_V, VSTR128, 2 * kt + 1, 64 * dh + 32 * c, lane), o[c]);
        }
    }
    float ss[16];
#pragma unroll
    for (int r = 0; r < 16; ++r) { ss[r] = o[0][r] * o[0][r] + o[1][r] * o[1][r];
#pragma unroll
        for (int s = 1; s < 32; s <<= 1) ss[r] += __shfl_xor(ss[r], s); }
    LAS float* X = (LAS float*)(lds + R3_X);
    if (r32 == 0) {
#pragma unroll
        for (int r = 0; r < 16; ++r) X[dh * 128 + 32 * qs + crow(r, hi)] = ss[r];
    }
    __syncthreads();
    bf16_t* op = ocat + (size_t)(row0 + 32 * qs) * OCW + 512 + h * 128 + 64 * dh + r32;
#pragma unroll
    for (int r = 0; r < 16; ++r) { const int row = crow(r, hi);
        const float rstd = __builtin_amdgcn_rsqf((X[32 * qs + row] + X[128 + 32 * qs + row]) * (1.0f / 128.0f) + NORM_EPS);
#pragma unroll
        for (int c = 0; c < 2; ++c) { const float gte = bf1(gt[c][r]);
            op[(size_t)row * OCW + 32 * c] = (bf16_t)(pk2(o[c][r] * rstd * siluf_(gte), 0.f) & 0xffffu); } }
    __syncthreads();
}
#undef MFMA32
}
constexpr size_t MiB = 1u << 20;
constexpr size_t WS_CTL = 0, CTL_ZERO_BYTES = 128 * 1024;
constexpr int CW_BAR = 1024;
constexpr int CW_MOE = 8192;
constexpr int CW_CUR = 12288;
constexpr int CW_DEP = 20480;
constexpr int CW_DONE = 16384;
constexpr size_t WS_TAB = 1 * MiB;
constexpr int TAB_MOD = 0, TAB_ROPE = DEPTH * 9 * 6144, TAB_LAM = TAB_ROPE + 2048, TAB_LG2 = TAB_LAM + 8, TAB_WSC = TAB_LG2 + 32;
constexpr size_t WS_XC = 2 * MiB;
constexpr size_t WS_ROUTE = 10 * MiB;
constexpr size_t WS_RS = 11 * MiB + 256 * 1024;
constexpr size_t WS_RSS = 11 * MiB + 512 * 1024;
constexpr size_t WS_MIX = 12 * MiB, MIX_STRIDE = 19 * MiB;
constexpr size_t MIX_WB = 14 * MiB, MIX_WO = 17 * MiB;
constexpr size_t WS_FD = 88 * MiB, FD_STRIDE = 17 * MiB, FD_W2 = 11 * MiB;
constexpr size_t WS_W13 = 122 * MiB;
constexpr size_t WS_W2 = 166 * MiB;
constexpr size_t WS_XB = 188 * MiB;
constexpr size_t WS_H = 254 * MiB;
constexpr size_t WS_PROJ = 322 * MiB;
constexpr size_t WS_GATE = WS_PROJ + 256 * MiB;
constexpr size_t WS_OCAT = 782 * MiB;
constexpr size_t WS_Y = 884 * MiB;
constexpr size_t WS_END = 952 * MiB;
static_assert((size_t)DIN * DM * 2 <= MIX_WB && MIX_WB + (size_t)DM * OCW * 2 <= MIX_WO && MIX_WO + (size_t)DM * DM * 2 <= MIX_STRIDE && WS_MIX + DEPTH * MIX_STRIDE <= WS_FD, "ws map (mixer weights)");
static_assert((size_t)2 * DFF * DM * 2 <= FD_W2 && FD_W2 + (size_t)DM * DFF * 2 <= FD_STRIDE && WS_FD + 2 * FD_STRIDE <= WS_W13, "ws map (dense ffn weights)");
static_assert(WS_W13 + (size_t)NEXP * 2 * DFF * DM <= WS_W2 && WS_W2 + (size_t)NEXP * DM * DFF <= WS_XB && WS_XB + (size_t)TL * DM * 2 <= WS_H && WS_H + (size_t)TT * DM * 2 <= WS_PROJ, "ws map (moe weights, x, h)");
static_assert(WS_PROJ + (size_t)TT * DINP * 2 <= WS_GATE && WS_GATE + (size_t)3 * NMT * 4 * 8 * 16 * 64 * 16 <= WS_OCAT && WS_OCAT + (size_t)TT * OCW * 2 <= WS_Y && WS_Y + (size_t)TT * DM * 2 <= WS_END, "ws map (activations)");
constexpr int MOE_SLOTS = 2 * TT + NEXP * 256;
static_assert(WS_PROJ + (size_t)MOE_SLOTS * DFF * 2 <= WS_OCAT && WS_OCAT + (size_t)MOE_SLOTS * DM * 2 <= WS_END, "ws map (MoE overlays)");
static_assert((size_t)NB * 4 * NCHK * 2 * 8192 * 4 <= (size_t)TT * DM * 2 && (size_t)NB * 4 * NCHK * 2 * 8192 * 2 <= (size_t)TT * DM * 2, "ws map (retention overlays)");

#define XB_TMO      128
#define XB_XCNT(j)  (256  + 64 * (j))
#define XB_XSUB(j)  (1280 + 64 * (j))
#define XB_XGEN(j)  (2304 + 64 * (j))
#define XB_TOP      3328
#define XB_TOPGEN   3392
#define XCD_BAR_WORDS 3456
#define XB_SPIN_CAP (1u << 18)

__device__ __forceinline__ unsigned xb_ld(unsigned* p)              { return __hip_atomic_load(p, __ATOMIC_RELAXED, __HIP_MEMORY_SCOPE_AGENT); }
__device__ __forceinline__ unsigned xb_add(unsigned* p, unsigned v) { return __hip_atomic_fetch_add(p, v, __ATOMIC_RELAXED, __HIP_MEMORY_SCOPE_AGENT); }
__device__ __forceinline__ unsigned xb_xcc_id() { return (unsigned)__builtin_amdgcn_s_getreg((3 << 11) | 20) & 0xFu; }
#define XB_SPIN(cond, bar) do { unsigned _sp = 0; while (cond) { __builtin_amdgcn_s_sleep(1); \
    if ((++_sp & 255u) == 0u) { if (xb_ld(&(bar)[XB_TMO])) break; if (_sp > XB_SPIN_CAP) { atomicAdd(&(bar)[XB_TMO], 1u); break; } } } } while (0)

struct XcdBarrier {
    unsigned* bar; unsigned x;
    volatile LAS unsigned* st;
};
__device__ __forceinline__ XcdBarrier xcd_barrier_post(unsigned* bar, volatile LAS unsigned* st, int tid) {
    XcdBarrier b; b.bar = bar; b.x = xb_xcc_id(); b.st = st;
    if (tid == 0) (void)xb_add(&bar[XB_XCNT(b.x)], 1u);
    return b;
}
__device__ __forceinline__ void xcd_barrier_complete(unsigned* bar, unsigned x, unsigned& nloc, unsigned& nx) {
    const unsigned G = gridDim.x * gridDim.y * gridDim.z;
    unsigned sum, cnt, mine, sp = 0u;
    for (;;) {
        sum = 0u; cnt = 0u; mine = 0u;
#pragma unroll
        for (unsigned j = 0; j < 16; ++j) { const unsigned c = xb_ld(&bar[XB_XCNT(j)]); sum += c; cnt += (c > 0u) ? 1u : 0u; mine = (j == x) ? c : mine; }
        if (sum == G) break;
        __builtin_amdgcn_s_sleep(1);
        if ((++sp & 255u) == 0u) { if (xb_ld(&bar[XB_TMO])) break; if (sp > XB_SPIN_CAP) { atomicAdd(&bar[XB_TMO], 1u); break; } }
    }
    nloc = mine > 0u ? mine : 1u; nx = cnt > 0u ? cnt : 1u;
}
__device__ __forceinline__ void xcd_barrier(const XcdBarrier& b_in, int tid) {
    XcdBarrier b = b_in; b.x = xb_xcc_id();
    asm volatile("s_waitcnt vmcnt(0)" ::: "memory");
    __syncthreads();
    if (tid == 0) {
        unsigned* bar = b.bar; asm volatile("" : "+s"(bar));
        __builtin_amdgcn_s_waitcnt(0);
        unsigned nloc = b.st[0], nx = b.st[1];
        if (nloc == 0u) { xcd_barrier_complete(bar, b.x, nloc, nx); b.st[0] = nloc; b.st[1] = nx; }
        const unsigned old = xb_add(&bar[XB_XSUB(b.x)], 1u);
        const unsigned gen = old / nloc;
        if (old + 1u == (gen + 1u) * nloc) {
            __builtin_amdgcn_fence(__ATOMIC_RELEASE, "agent");
            asm volatile("s_waitcnt vmcnt(0)" ::: "memory");
            const unsigned og = xb_add(&bar[XB_TOP], 1u);
            const unsigned tg = og / nx;
            if (og + 1u == (tg + 1u) * nx) xb_add(&bar[XB_TOPGEN], 1u);
            else XB_SPIN(xb_ld(&bar[XB_TOPGEN]) == tg, bar);
            __builtin_amdgcn_fence(__ATOMIC_ACQUIRE, "agent");
            xb_add(&bar[XB_XGEN(b.x)], 1u);
            asm volatile("s_waitcnt vmcnt(0)" ::: "memory");
        } else {
            XB_SPIN(xb_ld(&bar[XB_XGEN(b.x)]) == gen, bar);
            __builtin_amdgcn_fence(__ATOMIC_ACQUIRE, "agent");
            asm volatile("s_waitcnt vmcnt(0)" ::: "memory");
        }
    }
    __syncthreads();
}
struct Route { int sa, sb; float ga, gb; int ea, pa, eb, pb; };

__device__ __forceinline__ void p0_mod(LAS unsigned char* lds, const float* c, const float* cctx, const float* wmod, const float* bmod, float* mod, int blk, int G, int tid) {
    LAS float* sc = (LAS float*)lds;
    LAS float* red = sc + 9 * 1024;
    for (int i = tid; i < 9 * 1024; i += 512) { const float v = i < 8192 ? c[i] : cctx[i - 8192]; sc[i] = siluf_(v); }
    __syncthreads();
    const int cq = tid & 31, kg = tid >> 5;
    for (int u = blk; u < DEPTH * 48; u += G) {
        const int l = u / 48, n = (u % 48) * 128 + 4 * cq;
        f32x4 acc[9];
#pragma unroll
        for (int r = 0; r < 9; ++r) acc[r] = (f32x4){0.f, 0.f, 0.f, 0.f};
        const float* wp = wmod + ((size_t)l * DM + kg * 64) * 6144 + n;
        for (int k0 = 0; k0 < 64; k0 += 16) {
            f32x4 w[16];
#pragma unroll
            for (int k = 0; k < 16; ++k) w[k] = *(const f32x4*)(wp + (size_t)(k0 + k) * 6144);
#pragma unroll
            for (int k = 0; k < 16; ++k)
#pragma unroll
                for (int r = 0; r < 9; ++r) acc[r] += w[k] * sc[r * 1024 + kg * 64 + k0 + k];
        }
#pragma unroll
        for (int r = 0; r < 9; ++r) *(LAS f32x4*)(red + ((kg * 32 + cq) * 9 + r) * 4) = acc[r];
        __syncthreads();
        if (tid < 32 * 9) { const int q = tid / 9, r = tid % 9; f32x4 s = {0.f, 0.f, 0.f, 0.f};
#pragma unroll
            for (int g = 0; g < 16; ++g) s += *(const LAS f32x4*)(red + ((g * 32 + q) * 9 + r) * 4);
            const int nn = (u % 48) * 128 + 4 * q;
            *(f32x4*)(mod + ((size_t)l * 9 + r) * 6144 + nn) = s + *(const f32x4*)(bmod + (size_t)l * 6144 + nn); }
        __syncthreads();
    }
}
__device__ __forceinline__ void p0_tables(float* tab, const float* dlam, const float* decf, const float* decb, int tid) {
    for (int i = tid; i < 1024; i += 512) { const int pos = i >> 4, f = i & 15;
        const float inv = 1.0f / powf(10000.0f, (float)f / 16.0f), ang = (float)pos * inv;
        tab[TAB_ROPE + 2 * i] = cosf(ang); tab[TAB_ROPE + 2 * i + 1] = sinf(ang); }
    if (tid < 4) { const float* lp = dlam + tid * 256; float s01 = 0.f, s23 = 0.f;
        for (int k = 0; k < 64; ++k) { s01 += lp[k] * lp[64 + k]; s23 += lp[128 + k] * lp[192 + k]; }
        const float li = 0.8f - 0.6f * expf(-0.3f * (float)tid);
        tab[TAB_LAM + 2 * tid] = expf(s01) - expf(s23) + li; tab[TAB_LAM + 2 * tid + 1] = 1.0f - li; }
    if (tid >= 64 && tid < 96) { const int i = tid - 64, l = i >> 3, dir = (i >> 2) & 1, h = i & 3;
        const float x = (dir ? decb : decf)[l * 4 + h];
        tab[TAB_LG2 + i] = -log1pf(expf(-x)) * LOG2E; }
}

__device__ __forceinline__ float sample_rms(const float* W, int n, LAS float* red, int tid) {
    const int stride = n / 16384 - 1; float s = 0.f; float v[32];
#pragma unroll
    for (int i = 0; i < 32; ++i) v[i] = W[(size_t)(tid * 32 + i) * stride];
#pragma unroll
    for (int i = 0; i < 32; ++i) s += v[i] * v[i];
    s = wave_sum(s);
    __syncthreads(); if ((tid & 63) == 0) red[tid >> 6] = s; __syncthreads();
    float t = 0.f;
#pragma unroll
    for (int w = 0; w < 8; ++w) t += red[w];
    __syncthreads();
    return sqrtf(t * (1.0f / 16384.0f));
}
__device__ __forceinline__ void cvt_item(const float* W, int ldw, int k0, int sc, bf16_t* WTrow0, int ldt, LAS float* scr, int lane) {
    float v[32];
#pragma unroll
    for (int i = 0; i < 32; ++i) v[i] = __builtin_nontemporal_load(W + (size_t)(k0 + 2 * i + (lane >> 5)) * ldw + sc);
#pragma unroll
    for (int i = 0; i < 32; ++i) scr[(2 * i + (lane >> 5)) * 33 + (lane & 31)] = v[i];
    LDS_WAIT(); asm volatile("" ::: "memory");
    const int c = lane & 7;
#pragma unroll
    for (int j = 0; j < 4; ++j) { const int n = (lane >> 3) + 8 * j; const LAS float* s = scr + (8 * c) * 33 + n;
        u32x4 o; o.x = pk2(s[0 * 33], s[1 * 33]); o.y = pk2(s[2 * 33], s[3 * 33]); o.z = pk2(s[4 * 33], s[5 * 33]); o.w = pk2(s[6 * 33], s[7 * 33]);
        *(u32x4*)(WTrow0 + (size_t)n * ldt + 8 * c) = o; }
    LDS_WAIT(); asm volatile("" ::: "memory");
}
template <bool I8>
__device__ __forceinline__ void cvt_item8(const float* W, int ldw, int k0, int sc, unsigned char* WTrow0, int ldt, float scale, LAS float* scr, int lane) {
    float v[32];
#pragma unroll
    for (int i = 0; i < 32; ++i) v[i] = __builtin_nontemporal_load(W + (size_t)(k0 + 2 * i + (lane >> 5)) * ldw + sc);
#pragma unroll
    for (int i = 0; i < 32; ++i) scr[(2 * i + (lane >> 5)) * 33 + (lane & 31)] = v[i] * scale;
    LDS_WAIT(); asm volatile("" ::: "memory");
    const int c = lane & 7;
#pragma unroll
    for (int j = 0; j < 4; ++j) { const int n = (lane >> 3) + 8 * j; const LAS float* s = scr + (8 * c) * 33 + n;
        u32x2 o;
        if constexpr (I8) {
#define CL_(x) __builtin_amdgcn_fmed3f((x), -127.0f, 127.0f)
            o.x = pk4i8(CL_(s[0 * 33]), CL_(s[1 * 33]), CL_(s[2 * 33]), CL_(s[3 * 33])); o.y = pk4i8(CL_(s[4 * 33]), CL_(s[5 * 33]), CL_(s[6 * 33]), CL_(s[7 * 33]));
#undef CL_
        } else { o.x = pk4f8(s[0 * 33], s[1 * 33], s[2 * 33], s[3 * 33]); o.y = pk4f8(s[4 * 33], s[5 * 33], s[6 * 33], s[7 * 33]); }
        *(u32x2*)(WTrow0 + (size_t)n * ldt + 8 * c) = o; }
    LDS_WAIT(); asm volatile("" ::: "memory");
}
__device__ __forceinline__ int win_src(int n) {
    const bool rp = (n < 640) || (n >= 768 && n < 1280) || (n >= 2304 && n < 3328);
    if (!rp) return n;
    const int p = n & 63, j = p >> 1, e = p & 1;
    return (n & ~63) + (j >> 4) * 32 + e * 16 + (j & 15);
}
constexpr int I_IN = 16 * 216, I_B = 3 * 8 * 32, I_O = 16 * 32, I_MIX = I_IN + I_B + I_O, I_F1 = 16 * 88, I_F2 = 44 * 32, I_FE = 2 * I_F1 + I_F2;
__device__ __forceinline__ void cvt_mix(const float* win, const float* wb, const float* wo, unsigned char* mixbase, int r, float qs_in, LAS float* scr, int lane) {
    bf16_t* WbT = (bf16_t*)(mixbase + MIX_WB); bf16_t* WoT = (bf16_t*)(mixbase + MIX_WO);
    if (r < I_IN) { const int kb = r / 216, nb = r % 216; cvt_item8<true>(win, DIN, 64 * kb, win_src(32 * nb + (lane & 31)), mixbase + (size_t)(32 * nb) * DM + 64 * kb, DM, qs_in, scr, lane); return; } r -= I_IN;
    if (r < I_B) { const int i = r / 256, q = r % 256, kb = q / 32, nb = q % 32;
        cvt_item(wb + (size_t)i * 512 * DM, DM, 64 * kb, 32 * nb + (lane & 31), WbT + (size_t)(32 * nb) * OCW + i * 512 + 64 * kb, OCW, scr, lane); return; } r -= I_B;
    { const int kb = r / 32, nb = r % 32; cvt_item(wo, DM, 64 * kb, 32 * nb + (lane & 31), WoT + (size_t)(32 * nb) * DM + 64 * kb, DM, scr, lane); }
}
__device__ __forceinline__ void cvt_ffn(const float* f1, const float* f3, const float* f2, unsigned char* w13, unsigned char* w2, int r, float qs1, float qs3, int f8dn, LAS float* scr, int lane) {
    if (r < 2 * I_F1) { const int which = r / I_F1, q = r % I_F1, kb = q / 88, nb = q % 88, j0 = 32 * nb;
        const int drow = (j0 >> 7) * 256 + which * 128 + (j0 & 127);
        cvt_item8<true>(which ? f3 : f1, DFF, 64 * kb, j0 + (lane & 31), w13 + (size_t)drow * DM + 64 * kb, DM, which ? qs3 : qs1, scr, lane);
        return; } r -= 2 * I_F1;
    { const int kb = r / 32, nb = r % 32;
        if (f8dn) cvt_item8<false>(f2, DM, 64 * kb, 32 * nb + (lane & 31), w2 + (size_t)(32 * nb) * DFF + 64 * kb, DFF, F8_SW2, scr, lane);
        else cvt_item(f2, DM, 64 * kb, 32 * nb + (lane & 31), (bf16_t*)w2 + (size_t)(32 * nb) * DFF + 64 * kb, DFF, scr, lane); }
}
constexpr int N_RANGES = 7;
__device__ __forceinline__ int range_items(int k) { return (k == 0 || k == 4) ? I_FE : (k == 3 || k == 6) ? NEXP * I_FE : I_MIX; }
__device__ __forceinline__ void range_item(int k, int r, LAS unsigned char* lds, unsigned char* ws, LAS float* scr, int lane);

__device__ __forceinline__ void norm_rows(LAS unsigned char* lds, const void* xinL, const void* xinC, int in32, bf16_t* xoutL, bf16_t* xoutC, const float* gain, const float* mod, const float* modc, int shoff,
                                          bf16_t* hout, int qmode, float* rsout, int nrows, int combine, const Route* route, const bf16_t* fbuf, const float* wrouter, int do_route, Route* route_out, unsigned* gcnt,
                                          int blk, int G, int wave, int lane, int tid) {
    LAS float* wr = (LAS float*)lds;
    LAS int* lcnt = (LAS int*)(lds + 32768);
    LAS int* rec = (LAS int*)(lds + 32768 + 64);
    if (do_route) { for (int i = tid; i < 8192; i += 512) wr[i] = wrouter[i]; }
    const int per = (nrows + G - 1) / G, r0 = blk * per, r1 = (r0 + per < nrows) ? r0 + per : nrows;
    for (int cs = r0; cs < r1; cs += 256) {
        const int ce = cs + 256 < r1 ? cs + 256 : r1;
        if (do_route) { if (tid < 8) lcnt[tid] = 0; __syncthreads(); }
        u32x4 vn[4];
#define NR_LOAD(rr) do { const size_t ro_ = (rr) < TL ? (size_t)(rr) * DM : (size_t)((rr) - TL) * DM; const void* xb_ = (rr) < TL ? xinL : xinC; \
            if (in32) { _Pragma("unroll") for (int j = 0; j < 4; ++j) vn[j] = *(const u32x4*)((const float*)xb_ + ro_ + 4 * lane + 256 * j); } \
            else { _Pragma("unroll") for (int j = 0; j < 4; ++j) { const u32x2 t_ = *(const u32x2*)((const bf16_t*)xb_ + ro_ + 4 * lane + 256 * j); vn[j].x = t_.x; vn[j].y = t_.y; } } } while (0)
        if (cs + wave < ce) NR_LOAD(cs + wave);
        for (int row = cs + wave; row < ce; row += 8) {
            const bool lat = row < TL; const int mb = lat ? (row >> 12) : 8;
            f32x4 v[4];
#pragma unroll
            for (int j = 0; j < 4; ++j) v[j] = in32 ? __builtin_bit_cast(f32x4, vn[j]) : (f32x4){bf_lo(vn[j].x), bf_hi(vn[j].x), bf_lo(vn[j].y), bf_hi(vn[j].y)};
            if (row + 8 < ce) NR_LOAD(row + 8);
            if (combine) {
                const Route rt = route[row]; const float* g2 = modc + mb * 6144 + 5120;
                bf16_t* xo = lat ? xoutL + (size_t)row * DM : xoutC + (size_t)(row - TL) * DM;
#pragma unroll
                for (int j = 0; j < 4; ++j) { const int col = 4 * lane + 256 * j;
                    const u32x2 fa = *(const u32x2*)(fbuf + (size_t)rt.sa * DM + col), fb = *(const u32x2*)(fbuf + (size_t)rt.sb * DM + col);
                    const f32x4 gg = *(const f32x4*)(g2 + col);
                    v[j][0] += gg[0] * (rt.ga * bf_lo(fa.x) + rt.gb * bf_lo(fb.x)); v[j][1] += gg[1] * (rt.ga * bf_hi(fa.x) + rt.gb * bf_hi(fb.x));
                    v[j][2] += gg[2] * (rt.ga * bf_lo(fa.y) + rt.gb * bf_lo(fb.y)); v[j][3] += gg[3] * (rt.ga * bf_hi(fa.y) + rt.gb * bf_hi(fb.y));
                    u32x2 w_; w_.x = pk2(v[j][0], v[j][1]); w_.y = pk2(v[j][2], v[j][3]); *(u32x2*)(xo + col) = w_;
                    v[j] = (f32x4){bf_lo(w_.x), bf_hi(w_.x), bf_lo(w_.y), bf_hi(w_.y)}; }
            }
            float s = 0.f;
#pragma unroll
            for (int j = 0; j < 4; ++j) s += (v[j][0] * v[j][0] + v[j][1] * v[j][1]) + (v[j][2] * v[j][2] + v[j][3] * v[j][3]);
            const float rstd = 1.0f / sqrtf(wave_sum(s) * (1.0f / DM) + NORM_EPS);
            const float* sh = mod + mb * 6144 + shoff; const float* scp = sh + 1024;
            float lg[8];
#pragma unroll
            for (int e = 0; e < 8; ++e) lg[e] = 0.f;
            float qs = 1.0f;
            if (qmode == 2) {
                float am = 0.f;
#pragma unroll
                for (int j = 0; j < 4; ++j) { const int col = 4 * lane + 256 * j;
                    const f32x4 gn = *(const f32x4*)(gain + col), s1 = *(const f32x4*)(scp + col), s0 = *(const f32x4*)(sh + col);
#pragma unroll
                    for (int k = 0; k < 4; ++k) am = fmaxf(am, fabsf(v[j][k] * rstd * gn[k] * (1.0f + s1[k]) + s0[k])); }
                am = fmaxf(wave_max(am), 1.0e-20f); qs = 127.0f / am;
                if (lane == 0) rsout[row] = am * (1.0f / 127.0f);
            }
#pragma unroll
            for (int j = 0; j < 4; ++j) { const int col = 4 * lane + 256 * j;
                const f32x4 gn = *(const f32x4*)(gain + col), s1 = *(const f32x4*)(scp + col), s0 = *(const f32x4*)(sh + col);
                f32x4 hv;
#pragma unroll
                for (int k = 0; k < 4; ++k) hv[k] = v[j][k] * rstd * gn[k] * (1.0f + s1[k]) + s0[k];
                if (qmode == 2) *(unsigned*)((unsigned char*)hout + (size_t)row * DM + col) = pk4i8(fminf(hv[0] * qs, 127.0f), fminf(hv[1] * qs, 127.0f), fminf(hv[2] * qs, 127.0f), fminf(hv[3] * qs, 127.0f));
                else if (qmode == 1) *(unsigned*)((unsigned char*)hout + (size_t)row * DM + col) = pk4f8(hv[0] * F8_SH, hv[1] * F8_SH, hv[2] * F8_SH, hv[3] * F8_SH);
                else { u32x2 w; w.x = pk2(hv[0], hv[1]); w.y = pk2(hv[2], hv[3]); *(u32x2*)(hout + (size_t)row * DM + col) = w; }
                if (do_route) {
#pragma unroll
                    for (int k = 0; k < 4; ++k) { const f32x4 wa = *(const LAS f32x4*)(wr + (col + k) * 8), wb = *(const LAS f32x4*)(wr + (col + k) * 8 + 4);
                        lg[0] += hv[k] * wa[0]; lg[1] += hv[k] * wa[1]; lg[2] += hv[k] * wa[2]; lg[3] += hv[k] * wa[3];
                        lg[4] += hv[k] * wb[0]; lg[5] += hv[k] * wb[1]; lg[6] += hv[k] * wb[2]; lg[7] += hv[k] * wb[3]; }
                }
            }
            if (do_route) {
#pragma unroll
                for (int e = 0; e < 8; ++e) lg[e] = wave_sum(lg[e]);
                if (lane == 0) {
                    int e1 = 0; float v1 = lg[0];
#pragma unroll
                    for (int e = 1; e < 8; ++e) if (lg[e] > v1) { v1 = lg[e]; e1 = e; }
                    int e2 = -1; float v2 = -3.0e38f;
#pragma unroll
                    for (int e = 0; e < 8; ++e) if (e != e1 && lg[e] > v2) { v2 = lg[e]; e2 = e; }
                    const float gb_ = 1.0f / (1.0f + __expf(v1 - v2)), ga_ = 1.0f - gb_;
                    const int i = row - cs;
                    rec[i * 6 + 0] = e1; rec[i * 6 + 1] = __hip_atomic_fetch_add(&lcnt[e1], 1, __ATOMIC_RELAXED, __HIP_MEMORY_SCOPE_WORKGROUP); rec[i * 6 + 2] = e2; rec[i * 6 + 3] = __hip_atomic_fetch_add(&lcnt[e2], 1, __ATOMIC_RELAXED, __HIP_MEMORY_SCOPE_WORKGROUP);
                    rec[i * 6 + 4] = __float_as_int(ga_); rec[i * 6 + 5] = __float_as_int(gb_);
                }
            }
        }
        if (do_route) {
            __syncthreads();
            if (tid < 8) lcnt[8 + tid] = (int)__hip_atomic_fetch_add(gcnt + 64 * tid, (unsigned)lcnt[tid], __ATOMIC_RELAXED, __HIP_MEMORY_SCOPE_AGENT);
            __syncthreads();
            for (int i = tid; i < ce - cs; i += 512) { Route rt; rt.sa = 0; rt.sb = 0;
                rt.ea = rec[i * 6 + 0]; rt.pa = lcnt[8 + rt.ea] + rec[i * 6 + 1]; rt.eb = rec[i * 6 + 2]; rt.pb = lcnt[8 + rt.eb] + rec[i * 6 + 3];
                rt.ga = __int_as_float(rec[i * 6 + 4]); rt.gb = __int_as_float(rec[i * 6 + 5]); route_out[cs + i] = rt; }
            __syncthreads();
        }
    }
}
__device__ __forceinline__ void moe_gather(const unsigned char* h2, unsigned char* hs, const float* rs, float* rss, Route* route, unsigned* gcnt, int nrows, int gw, int ngw, int lane) {
    int off[8]; { int a = 0;
#pragma unroll
        for (int e = 0; e < 8; ++e) { off[e] = a; const int c = (int)__hip_atomic_load(gcnt + 64 * e, __ATOMIC_RELAXED, __HIP_MEMORY_SCOPE_AGENT); a += (c + 255) & ~255; } }
    u32x4 an; Route rn;
    if (gw < nrows) { rn = route[gw]; an = *(const u32x4*)(h2 + (size_t)gw * DM + 16 * lane); }
    for (int row = gw; row < nrows; row += ngw) {
        const Route rt = rn; const u32x4 a = an;
        if (row + ngw < nrows) { rn = route[row + ngw]; an = *(const u32x4*)(h2 + (size_t)(row + ngw) * DM + 16 * lane); }
        int oa = 0, ob = 0;
#pragma unroll
        for (int e = 0; e < 8; ++e) { oa = (rt.ea == e) ? off[e] : oa; ob = (rt.eb == e) ? off[e] : ob; }
        const int sa = oa + rt.pa, sb = ob + rt.pb;
        *(u32x4*)(hs + (size_t)sa * DM + 16 * lane) = a;
        *(u32x4*)(hs + (size_t)sb * DM + 16 * lane) = a;
        if (lane == 0) { route[row].sa = sa; route[row].sb = sb; const float r = rs[row]; rss[sa] = r; rss[sb] = r; }
    }
}
__device__ __forceinline__ void final_norm(const bf16_t* x, float* out, const float* gain, const float* mod, const Route* route, const bf16_t* fbuf, int gw, int ngw, int lane) {
    for (int row = gw; row < TL; row += ngw) {
        const int mb = row >> 12; const bf16_t* xr = x + (size_t)row * DM; float* orow = out + (size_t)row * DM;
        const Route rt = route[row]; const float* g2 = mod + mb * 6144 + 5120;
        f32x4 v[4]; float s = 0.f;
#pragma unroll
        for (int j = 0; j < 4; ++j) { const int col = 4 * lane + 256 * j; { const u32x2 t = *(const u32x2*)(xr + col); v[j] = (f32x4){bf_lo(t.x), bf_hi(t.x), bf_lo(t.y), bf_hi(t.y)}; }
            const u32x2 fa = *(const u32x2*)(fbuf + (size_t)rt.sa * DM + col), fb = *(const u32x2*)(fbuf + (size_t)rt.sb * DM + col);
            const f32x4 gg = *(const f32x4*)(g2 + col);
            v[j][0] += gg[0] * (rt.ga * bf_lo(fa.x) + rt.gb * bf_lo(fb.x)); v[j][1] += gg[1] * (rt.ga * bf_hi(fa.x) + rt.gb * bf_hi(fb.x));
            v[j][2] += gg[2] * (rt.ga * bf_lo(fa.y) + rt.gb * bf_lo(fb.y)); v[j][3] += gg[3] * (rt.ga * bf_hi(fa.y) + rt.gb * bf_hi(fb.y));
            s += (v[j][0] * v[j][0] + v[j][1] * v[j][1]) + (v[j][2] * v[j][2] + v[j][3] * v[j][3]); }
        const float rstd = 1.0f / sqrtf(wave_sum(s) * (1.0f / DM) + NORM_EPS);
#pragma unroll
        for (int j = 0; j < 4; ++j) { const int col = 4 * lane + 256 * j; const f32x4 gn = *(const f32x4*)(gain + col); *(f32x4*)(orow + col) = v[j] * rstd * gn; }
    }
}
constexpr int NWAVES = 8;
constexpr int LDS_MISC = pg8::STAGE_BYTES + 2048, LDS_PTAB = LDS_MISC + 64;
constexpr int LDS_BYTES = pg8::STAGE_BYTES + 2048 + 1024;
static_assert(at::AT_A_LDS <= pg8::STAGE_BYTES && at::AT_C_LDS <= pg8::STAGE_BYTES + 2048 && at::R1_LDS <= pg8::STAGE_BYTES && at::R3_LDS <= pg8::STAGE_BYTES, "LDS");
constexpr int NPH = 11;
constexpr int N_PHASES = 1 + DEPTH * NPH + 1;

struct Args { const float* in[24]; float* out; unsigned char* ws; int ph_lo, ph_hi; };
static_assert(sizeof(Args) == 24 * 8 + 8 + 8 + 8, "Args has no padding");

__device__ __forceinline__ void* ldptr(LAS unsigned char* lds, int i) {
    const u32x2 v = *(const LAS u32x2*)(lds + LDS_PTAB + 8 * i);
    const unsigned lo = __builtin_amdgcn_readfirstlane(v.x), hi = __builtin_amdgcn_readfirstlane(v.y);
    GAS void* g = (GAS void*)(((unsigned long long)hi << 32) | lo);
    return (void*)g;
}
#define PIN(i) ((const float*)ldptr(lds, (i)))
#define PWS() ((unsigned char*)ldptr(lds, 25))
#define POUT() ((float*)ldptr(lds, 24))
__device__ __forceinline__ void range_item(int k, int r, LAS unsigned char* lds, unsigned char* ws, LAS float* scr, int lane) {
    if (k == 1 || k == 2 || k == 5) { const int l = (k == 5) ? 3 : k;
        cvt_mix(PIN(9) + (size_t)l * DM * DIN, PIN(15) + (size_t)l * 3 * 512 * DM, PIN(16) + (size_t)l * DM * DM, ws + WS_MIX + l * MIX_STRIDE, r, ((const float*)(ws + WS_TAB))[TAB_WSC + 2 * l], scr, lane); }
    else if (k == 0 || k == 4) { const int j = (k == 0) ? 0 : 1;
        cvt_ffn(PIN(17) + (size_t)j * DM * DFF, PIN(18) + (size_t)j * DM * DFF, PIN(19) + (size_t)j * DFF * DM, ws + WS_FD + j * FD_STRIDE, ws + WS_FD + j * FD_STRIDE + FD_W2, r, ((const float*)(ws + WS_TAB))[TAB_WSC + 2 * (4 + j)], ((const float*)(ws + WS_TAB))[TAB_WSC + 2 * (6 + j)], DENSE_F8, scr, lane); }
    else { const int j = (k == 3) ? 0 : 1, e = r / I_FE, rr = r % I_FE; const size_t eo = ((size_t)j * NEXP + e) * DM * DFF;
        cvt_ffn(PIN(21) + eo, PIN(22) + eo, PIN(23) + eo, ws + WS_W13 + (size_t)e * 2 * DFF * DM, ws + WS_W2 + (size_t)e * DM * DFF, rr, ((const float*)(ws + WS_TAB))[TAB_WSC + 2 * (8 + j * 8 + e)], ((const float*)(ws + WS_TAB))[TAB_WSC + 2 * (24 + j * 8 + e)], 1, scr, lane); }
}
__device__ __forceinline__ int range_base(int k) { return k == 0 ? 0 : k == 1 ? I_FE : k == 2 ? I_FE + I_MIX : k == 3 ? I_FE + 2 * I_MIX : k == 4 ? I_FE + 2 * I_MIX + NEXP * I_FE : k == 5 ? 2 * I_FE + 2 * I_MIX + NEXP * I_FE
                                                          : k == 6 ? 2 * I_FE + 3 * I_MIX + NEXP * I_FE : 2 * I_FE + 3 * I_MIX + 2 * NEXP * I_FE; }
__device__ __forceinline__ void bg_static(LAS unsigned char* lds, unsigned char* ws, int g0, int g1, int worker, int nworkers, int wave, int lane) {
    LAS float* scr = (LAS float*)lds + wave * (64 * 33);
    for (int g = g0 + worker; g < g1; g += nworkers) {
        int k = 0;
#pragma unroll
        for (int j = 1; j < N_RANGES; ++j) k += (g >= range_base(j)) ? 1 : 0;
        range_item(k, g - range_base(k), lds, ws, scr, lane);
    }
}
constexpr int WGM_MOE = 4;
constexpr int Q_B = 2, Q_F = 7, Q_G = 5, Q_I = 2, Q_J = 14;
#define TAIL_BOOK(nwg_in, quota, drain) const int tb_nwg = (nwg_in), tb_maxu = (tb_nwg + G - 1) / G, tb_nh = (tb_nwg % G == 0) ? G : tb_nwg - (tb_maxu - 1) * G, tb_nt = G - tb_nh; \
        const int tb_lim = range_base(kmax + 1), tb_g0 = gc; int tb_take = tb_nt * NWAVES * (quota); if (tb_take > tb_lim - gc) tb_take = tb_lim - gc; if (tb_take < 0) tb_take = 0; \
        const int tb_g1 = tb_g0 + tb_take; const int tb_e = (drain) >= 0 ? range_base((drain) + 1) : 0; const int tb_g2 = tb_e > tb_g1 ? tb_e : tb_g1; gc = tb_g2
#define TAIL_RUN() do { if (blk >= tb_nh && tb_take > 0) bg_static(lds, ws, tb_g0, tb_g1, (blk - tb_nh) * NWAVES + wave, tb_nt * NWAVES, wave, LANE()); \
        if (tb_g2 > tb_g1) bg_static(lds, ws, tb_g1, tb_g2, GW(), NGW(), wave, LANE()); } while (0)

__global__ void __launch_bounds__(NWAVES * 64, 2) mega(Args a) {
    extern __shared__ __attribute__((aligned(16))) unsigned char lds_raw[];
    LAS unsigned char* lds = (LAS unsigned char*)lds_raw;
    LAS unsigned char* const lds_k = lds;
#define LDSL() ({ LAS unsigned char* p_ = lds_k; asm volatile("" : "+s"(p_)); p_; })
    const int wave = __builtin_amdgcn_readfirstlane((int)threadIdx.x >> 6);
    const int G = gridDim.x, blk = blockIdx.x;
#define LANE0() ({ int t_; asm volatile("v_mbcnt_lo_u32_b32 %0, -1, 0\n\tv_mbcnt_hi_u32_b32 %0, -1, %0" : "=v"(t_)); t_; })
#define LANE() LANE0()
#define TID0() ((wave << 6) | LANE0())
#define TID() TID0()
    if (threadIdx.x == 0) {
        LAS unsigned long long* pt = (LAS unsigned long long*)(lds + LDS_PTAB);
#pragma unroll
        for (int i = 0; i < 24; ++i) pt[i] = (unsigned long long)a.in[i];
        pt[24] = (unsigned long long)a.out; pt[25] = (unsigned long long)a.ws;
        ((LAS unsigned*)(lds + LDS_MISC))[0] = 0u; ((LAS unsigned*)(lds + LDS_MISC))[1] = 0u; ((LAS unsigned*)(lds + LDS_MISC))[2] = 0u; ((LAS unsigned*)(lds + LDS_MISC))[3] = 0u;
    }
    __syncthreads();
#if MK_SINGLE
    (void)xcd_barrier_post((unsigned*)PWS() + CW_BAR, (volatile LAS unsigned*)(lds + LDS_MISC), TID());
#define GRID_BAR() do { XcdBarrier b_; b_.bar = (unsigned*)PWS() + CW_BAR; b_.x = 0; b_.st = (volatile LAS unsigned*)(lds_k + LDS_MISC); xcd_barrier(b_, TID()); } while (0)
#else
#define GRID_BAR() do { } while (0)
#endif
#if !MK_SINGLE
    const int lo = a.ph_lo, hi = a.ph_hi;
#endif
#ifndef PROBE_MASK
#define PROBE_MASK 0xffff
#endif
#define EN(k) (((PROBE_MASK) >> ((k) >= 100 ? (k) - 89 : (k))) & 1)
#if MK_SINGLE
#define IN(k) true
#else
#define IN(k) (lo <= (k) && (k) < hi)
#endif
#define SEAM(k) do { if (IN(k) && IN((k) + 1)) GRID_BAR(); } while (0)
#define LAUNDER_S(x) ({ int x_ = (x); asm volatile("" : "+s"(x_)); x_; })
#ifndef PROBE_DUP
#define PROBE_DUP 0
#endif
#define DUP(k) (1 + (((PROBE_DUP) >> (k)) & 1))
#define GW() (blk * NWAVES + wave)
#define NGW() (G * NWAVES)

    if (IN(0) && EN(100)) { LAS unsigned char* lds = LDSL();
        float* tab = (float*)(PWS() + WS_TAB);
        p0_mod(lds, PIN(1), PIN(3), PIN(4), PIN(5), tab + TAB_MOD, blk, G, TID());
        if (blk == G - 1) p0_tables(tab, PIN(13), PIN(11), PIN(12), TID());
        __syncthreads();
        const float rms0 = fmaxf(sample_rms(PIN(9), DM * DIN, (LAS float*)(lds + 32768), TID()), 1.0e-30f), qs0 = 127.0f / (I8_CLIP * rms0);
        if (blk == 0 && TID() == 0) { tab[TAB_WSC] = qs0; tab[TAB_WSC + 1] = 1.0f / qs0; }
        if (blk >= 1 && blk < 40) {
            const float* W = blk < 4 ? PIN(9) + (size_t)blk * DM * DIN : blk < 6 ? PIN(17) + (size_t)(blk - 4) * DM * DFF : blk < 8 ? PIN(18) + (size_t)(blk - 6) * DM * DFF
                           : blk < 24 ? PIN(21) + (size_t)(blk - 8) * DM * DFF : PIN(22) + (size_t)(blk - 24) * DM * DFF;
            const float r = fmaxf(sample_rms(W, blk < 4 ? DM * DIN : DM * DFF, (LAS float*)(lds + 32768), TID()), 1.0e-30f), q = 127.0f / (I8_CLIP * r);
            if (TID() == 0) { tab[TAB_WSC + 2 * blk] = q; tab[TAB_WSC + 2 * blk + 1] = 1.0f / q; } }
        {
            unsigned char* ws = PWS(); LAS float* scr = (LAS float*)lds + wave * (64 * 33); const int ln = LANE();
            for (int it = (G - 1 - blk) * NWAVES + wave; it < I_MIX; it += NGW()) cvt_mix(PIN(9), PIN(15), PIN(16), ws + WS_MIX, it, qs0, scr, ln);
        }
    }
    SEAM(0);

    int gc = 0;
    for (int l = 0; l < DEPTH; ++l) {
        const int pb = 1 + l * NPH;
        const bool moe = (l & 1) != 0, last = (l == DEPTH - 1), first = (l == 0);
        const int nrows = last ? TL : TT;
        const int kmax = l <= 1 ? 5 : 6;
        if (IN(pb + 0) && EN(0)) { LAS unsigned char* lds = LDSL();
            unsigned char* ws = PWS();
            __syncthreads();
            const bool comb = (l == 2);
            const float* modl = (const float*)(ws + WS_TAB) + TAB_MOD + (size_t)l * 9 * 6144;
            bf16_t* xL = (bf16_t*)(ws + WS_XB); bf16_t* xc = (bf16_t*)(ws + WS_XC);
            for (int dup = 0; dup < (comb ? 1 : DUP(8)); ++dup) norm_rows(lds, first ? (const void*)PIN(0) : (const void*)xL, first ? (const void*)PIN(2) : (const void*)xc, first ? 1 : 0, xL, xc, PIN(6) + l * DM, modl, modl - 9 * 6144, 0, (bf16_t*)(ws + WS_H), 2, (float*)(ws + WS_RS), TT, comb ? 1 : 0,
                      (const Route*)(ws + WS_ROUTE), (const bf16_t*)(ws + WS_OCAT), nullptr, 0, nullptr, nullptr, blk, G, wave, LANE(), TID());
        }
        SEAM(pb + 0);
        { TAIL_BOOK(last ? (TL / 256) * (DIN / 256) + 64 : (TT / 256) * (DIN / 256), Q_B, -1);
        if (IN(pb + 1) && EN(1)) { LAS unsigned char* lds = LDSL();
            unsigned char* ws = PWS();
            pg8::Gemm g{(const bf16_t*)(ws + WS_H), (const bf16_t*)(ws + WS_MIX + l * MIX_STRIDE), DM / 2}; pg8::GSched S; S.init(last ? TL / 256 : TT / 256, DIN / 256, LAUNDER_S(G), LAUNDER_S(blk));
            if (last) { S.nx = 64; S.nwg += 64; S.xtab = 0xEDCB6542ull; }
            pg8::EpiProj E{(bf16_t*)(ws + WS_PROJ), (const float*)(ws + WS_TAB) + TAB_ROPE, (u32x2*)(ws + WS_GATE), (const float*)(ws + WS_RS), ((const float*)(ws + WS_TAB))[TAB_WSC + 2 * l + 1]};
            pg8::gemm_phase<pg8::EpiProj, pg8::GSched, true, true, 2>(lds, g, S, E, TID());
            TAIL_RUN();
        } }
        SEAM(pb + 1);
        if (IN(pb + 2) && EN(2)) { LAS unsigned char* lds = LDSL();
            unsigned char* ws = PWS(); const float* lg2 = (const float*)(ws + WS_TAB) + TAB_LG2 + l * 8;
            for (int dup = 0; dup < DUP(10); ++dup) at::ret_kv_phase(lds, (const bf16_t*)(ws + WS_PROJ), (bf16_t*)(ws + WS_Y), lg2, blk, G, TID());
        }
        SEAM(pb + 2);
        if (IN(pb + 3) && EN(3)) for (int dup = 0; dup < DUP(11); ++dup) { unsigned char* ws = PWS(); at::ret_scan((const bf16_t*)(ws + WS_Y), (bf16_t*)(ws + WS_H), (const float*)(ws + WS_TAB) + TAB_LG2 + l * 8, blk * 512 + TID(), G * 512); }
        SEAM(pb + 3);
        if (IN(pb + 4) && EN(4)) { LAS unsigned char* lds = LDSL();
            {
                unsigned char* ws = PWS(); const float* tab = (const float*)(ws + WS_TAB);
                const float lam = tab[TAB_LAM + 2 * l], oml = tab[TAB_LAM + 2 * l + 1]; const float* dn = PIN(14) + l * 128;
                for (int dup = 0; dup < DUP(0); ++dup) for (int r = blk; r < 1024; r += G) { const int rnd = r >> 8, bi = r & 255, bh = rnd * 8 + (bi & 7), qb = bi >> 3;
                    at::attnC_unit(lds, (const bf16_t*)(ws + WS_PROJ), (bf16_t*)(ws + WS_OCAT), dn, lam, oml, bh >> 2, bh & 3, qb, 1, TID()); }
                if (!last) for (int r = blk; r < 64; r += G) { const int bh = r >> 1, qb = r & 1;
                    at::attnC_unit(lds, (const bf16_t*)(ws + WS_PROJ), (bf16_t*)(ws + WS_OCAT), dn, lam, oml, bh >> 2, bh & 3, qb, 0, TID()); }
            }
            {
                unsigned char* ws = PWS(); const float* lg2 = (const float*)(ws + WS_TAB) + TAB_LG2 + l * 8;
                const int nR = last ? NB * 4 * 32 : NB * 4 * NCHK;
                for (int dup = 0; dup < DUP(3); ++dup) for (int r = blk; r < nR; r = (r + G < (nR / G) * G) ? r + G : (r < (nR / G) * G ? (nR / G) * G + ((blk + G - 64) % G) : nR)) { int bh, ci; if (last) { bh = r >> 5; ci = 2 + (r & 31); } else { bh = r / NCHK; ci = r % NCHK; }
                    at::ret_out_unit(lds, (const bf16_t*)(ws + WS_PROJ), (const bf16_t*)(ws + WS_H), (bf16_t*)(ws + WS_OCAT), lg2[bh & 3], lg2[4 + (bh & 3)], bh >> 2, bh & 3, ci, TID()); }
            }
            {
                unsigned char* ws = PWS(); const float* sink = PIN(10) + l * 8;
                for (int dup = 0; dup < DUP(13); ++dup) for (int r = blk; r < 1024; r += G) { const int bg = r >> 6, qb = r & 63; at::attnA_unit(lds, (const bf16_t*)(ws + WS_PROJ), (bf16_t*)(ws + WS_OCAT), sink, bg >> 1, bg & 1, qb, 1, TID()); }
                if (!last) for (int r = (blk + G - 128) % G; r < 64; r += G) { const int bg = r >> 2, qb = r & 3; at::attnA_unit(lds, (const bf16_t*)(ws + WS_PROJ), (bf16_t*)(ws + WS_OCAT), sink, bg >> 1, bg & 1, qb, 0, TID()); }
            }
        }
        SEAM(pb + 4);
#ifdef PROBE_XBAR
        for (int xb_ = 0; xb_ < PROBE_XBAR; ++xb_) GRID_BAR();
#endif
        { TAIL_BOOK((nrows / 256) * (DM / 256), Q_F, -1);
        if (IN(pb + 5) && EN(5)) { LAS unsigned char* lds = LDSL();
            unsigned char* ws = PWS();
            pg8::Gemm g{(const bf16_t*)(ws + WS_OCAT), (const bf16_t*)(ws + WS_MIX + l * MIX_STRIDE + MIX_WB), OCW}; pg8::GSched S; S.init(nrows / 256, DM / 256, LAUNDER_S(G), LAUNDER_S(blk));
            pg8::EpiMerge E{(bf16_t*)(ws + WS_Y), (const u32x2*)(ws + WS_GATE)};
            pg8::gemm_phase<pg8::EpiMerge, pg8::GSched, true, true>(lds, g, S, E, TID());
            TAIL_RUN();
        } }
        SEAM(pb + 5);
        { TAIL_BOOK((nrows / 256) * (DM / 256), Q_G, (l == 0 ? 0 : l == 1 ? 3 : l == 2 ? 4 : 6));
        if (IN(pb + 6) && EN(6)) { LAS unsigned char* lds = LDSL();
            unsigned char* ws = PWS(); bf16_t* xL = (bf16_t*)(ws + WS_XB); bf16_t* xc = (bf16_t*)(ws + WS_XC);
            pg8::Gemm g{(const bf16_t*)(ws + WS_Y), (const bf16_t*)(ws + WS_MIX + l * MIX_STRIDE + MIX_WO), DM}; pg8::GSched S; S.init(nrows / 256, DM / 256, LAUNDER_S(G), LAUNDER_S(blk));
            pg8::EpiRes E{first ? (const void*)PIN(0) : (const void*)xL, first ? (const void*)PIN(2) : (const void*)xc, xL, xc, (const float*)(ws + WS_TAB) + TAB_MOD + (size_t)l * 9 * 6144, 2048, 1.0f, first ? 1 : 0};
            pg8::gemm_phase<pg8::EpiRes, pg8::GSched, true, true>(lds, g, S, E, TID());
            TAIL_RUN();
        } }
        SEAM(pb + 6);
        if (IN(pb + 7) && EN(7)) { LAS unsigned char* lds = LDSL();
            unsigned char* ws = PWS(); bf16_t* xL = (bf16_t*)(ws + WS_XB); bf16_t* xc = (bf16_t*)(ws + WS_XC);
            const float* modl = (const float*)(ws + WS_TAB) + TAB_MOD + (size_t)l * 9 * 6144;
            for (int dup = 0; dup < (moe ? 1 : DUP(9)); ++dup) norm_rows(lds, xL, xc, 0, xL, xc, PIN(7) + l * DM, modl, modl, 3072, (bf16_t*)(ws + WS_H), 2, (float*)(ws + WS_RS), nrows, 0, (const Route*)(ws + WS_ROUTE), (const bf16_t*)(ws + WS_OCAT),
                      moe ? PIN(20) + (size_t)(l >> 1) * DM * NEXP : nullptr, moe ? 1 : 0, (Route*)(ws + WS_ROUTE), (unsigned*)ws + CW_MOE + (l >> 1) * 1024, blk, G, wave, LANE(), TID());
        }
        SEAM(pb + 7);
        if (!moe) {
            { TAIL_BOOK((nrows / 256) * (2 * DFF / 256), Q_I, -1);
            if (IN(pb + 9) && EN(9)) { LAS unsigned char* lds = LDSL();
                unsigned char* ws = PWS();
                pg8::Gemm g{(const bf16_t*)(ws + WS_H), (const bf16_t*)(ws + WS_FD + (l >> 1) * FD_STRIDE), DM / 2}; pg8::GSched S; S.init(nrows / 256, 2 * DFF / 256, LAUNDER_S(G), LAUNDER_S(blk));
                pg8::EpiSwiglu<DENSE_F8 != 0> E{ws + WS_PROJ, (const float*)(ws + WS_RS), (const float*)(ws + WS_TAB) + TAB_WSC + 2 * (4 + (l >> 1)) + 1, 4};
                pg8::gemm_phase<pg8::EpiSwiglu<DENSE_F8 != 0>, pg8::GSched, true, true, 2>(lds, g, S, E, TID());
                TAIL_RUN();
            } }
            SEAM(pb + 9);
            { TAIL_BOOK((nrows / 256) * (DM / 256), Q_J, (l == 0 ? 1 : 5));
            if (IN(pb + 10) && EN(10)) { LAS unsigned char* lds = LDSL();
                unsigned char* ws = PWS(); bf16_t* xL = (bf16_t*)(ws + WS_XB); bf16_t* xc = (bf16_t*)(ws + WS_XC);
                pg8::Gemm g{(const bf16_t*)(ws + WS_PROJ), (const bf16_t*)(ws + WS_FD + (l >> 1) * FD_STRIDE + FD_W2), DENSE_F8 ? DFF / 2 : DFF}; pg8::GSched S; S.init(nrows / 256, DM / 256, LAUNDER_S(G), LAUNDER_S(blk));
                pg8::EpiRes E{xL, xc, xL, xc, (const float*)(ws + WS_TAB) + TAB_MOD + (size_t)l * 9 * 6144, 5120, DENSE_F8 ? F8_INV2 : 1.0f, 0};
                pg8::gemm_phase<pg8::EpiRes, pg8::GSched, true, true, DENSE_F8 ? 1 : 0>(lds, g, S, E, TID());
                TAIL_RUN();
            } }
            SEAM(pb + 10);
        } else {
            if (IN(pb + 8) && EN(8)) for (int dup = 0; dup < DUP(12); ++dup) { unsigned char* ws = PWS(); moe_gather(ws + WS_H, ws + WS_OCAT, (const float*)(ws + WS_RS), (float*)(ws + WS_RSS), (Route*)(ws + WS_ROUTE), (unsigned*)ws + CW_MOE + (l >> 1) * 1024, nrows, GW(), NGW(), LANE()); }
            SEAM(pb + 8);
            if (IN(pb + 9) && EN(9)) { LAS unsigned char* lds = LDSL();
                unsigned char* ws = PWS(); unsigned* gcnt = (unsigned*)ws + CW_MOE + (l >> 1) * 1024;
                pg8::GSched S; LAS int* tsl = (LAS int*)(lds + LDS_MISC + 512);
                if (TID() == 0) { int a0 = 0;
                    for (int e = 0; e < 8; ++e) { tsl[e] = a0; const int c = (int)__hip_atomic_load(gcnt + 64 * e, __ATOMIC_RELAXED, __HIP_MEMORY_SCOPE_AGENT); a0 += (c + 255) >> 8; }
                    tsl[8] = a0; }
                __syncthreads();
                S.ts = tsl; S.nM = __builtin_amdgcn_readfirstlane(tsl[8]); S.nN = 2 * DFF / 256; S.nwg = S.nM * S.nN; S.G = LAUNDER_S(G); S.c = LAUNDER_S(blk); S.wgm = WGM_MOE; S.nx = 0; S.xtab = 0; S.grouped = 1; S.bstride = (size_t)DFF * DM;
                pg8::Gemm g{(const bf16_t*)(ws + WS_OCAT), (const bf16_t*)(ws + WS_W13), DM / 2};
                pg8::EpiSwiglu<true> E{ws + WS_PROJ, (const float*)(ws + WS_RSS), (const float*)(ws + WS_TAB) + TAB_WSC + 2 * (8 + (l >> 1) * 8) + 1, 32};
                pg8::gemm_phase<pg8::EpiSwiglu<true>, pg8::GSched, true, true, 2>(lds, g, S, E, TID());
            }
            SEAM(pb + 9);
            if (IN(pb + 10) && EN(10)) { LAS unsigned char* lds = LDSL();
                unsigned char* ws = PWS(); unsigned* gcnt = (unsigned*)ws + CW_MOE + (l >> 1) * 1024;
                pg8::GSched S; LAS int* tsl = (LAS int*)(lds + LDS_MISC + 512);
                if (TID() == 0) { int a0 = 0;
                    for (int e = 0; e < 8; ++e) { tsl[e] = a0; const int c = (int)__hip_atomic_load(gcnt + 64 * e, __ATOMIC_RELAXED, __HIP_MEMORY_SCOPE_AGENT); a0 += (c + 255) >> 8; }
                    tsl[8] = a0; }
                __syncthreads();
                S.ts = tsl; S.nM = __builtin_amdgcn_readfirstlane(tsl[8]); S.nN = DM / 256; S.nwg = S.nM * S.nN; S.G = LAUNDER_S(G); S.c = LAUNDER_S(blk); S.wgm = WGM_MOE; S.nx = 0; S.xtab = 0; S.grouped = 1; S.bstride = (size_t)DM * DFF / 2;
                pg8::Gemm g{(const bf16_t*)(ws + WS_PROJ), (const bf16_t*)(ws + WS_W2), DFF / 2}; pg8::EpiBf16 E{(bf16_t*)(ws + WS_OCAT), DM, F8_INV2};
                pg8::gemm_phase<pg8::EpiBf16, pg8::GSched, true, true, 1>(lds, g, S, E, TID());
            }
            SEAM(pb + 10);
        }
    }
    if (IN(1 + DEPTH * NPH) && EN(101)) { LAS unsigned char* lds = LDSL(); unsigned char* ws = PWS();
        final_norm((const bf16_t*)(ws + WS_XB), POUT(), PIN(8), (const float*)(ws + WS_TAB) + TAB_MOD + (size_t)3 * 9 * 6144, (const Route*)(ws + WS_ROUTE), (const bf16_t*)(ws + WS_OCAT), GW(), NGW(), LANE()); }
#undef IN
#undef SEAM
}

extern "C" void kernel_launch(void* const* d_in, const int* in_sizes, int n_in, void* d_out, int out_size, void* d_ws, size_t ws_size, hipStream_t stream) {
    static int grid = 0;
    if (grid == 0) {
        if (n_in != 24 || out_size != TL * DM || ws_size < WS_END) { fprintf(stderr, "kernel_launch: unexpected shapes (n_in %d, out %d, ws %zu)\n", n_in, out_size, ws_size); grid = -1; return; }
        int dev = 0, cus = 0, per_cu = 0;
        if (hipGetDevice(&dev) != hipSuccess || hipDeviceGetAttribute(&cus, hipDeviceAttributeMultiprocessorCount, dev) != hipSuccess) { grid = -1; return; }
        if (hipFuncSetAttribute((const void*)mega, hipFuncAttributeMaxDynamicSharedMemorySize, LDS_BYTES) != hipSuccess) { fprintf(stderr, "kernel_launch: hipFuncSetAttribute failed\n"); grid = -1; return; }
        if (hipOccupancyMaxActiveBlocksPerMultiprocessor(&per_cu, (const void*)mega, NWAVES * 64, LDS_BYTES) != hipSuccess || per_cu < 1) { fprintf(stderr, "kernel_launch: occupancy query reports %d\n", per_cu); }
        (void)hipGetLastError();
        grid = cus;
    }
    if (grid < 0) return;
    if (hipMemsetAsync((char*)d_ws + WS_CTL, 0, CTL_ZERO_BYTES, stream) != hipSuccess) return;
    Args a{};
    for (int i = 0; i < 24; ++i) a.in[i] = (const float*)d_in[i];
    a.out = (float*)d_out; a.ws = (unsigned char*)d_ws;
#if MK_SINGLE
    a.ph_lo = 0; a.ph_hi = N_PHASES;
    hipLaunchKernelGGL(mega, dim3(grid), dim3(NWAVES * 64), LDS_BYTES, stream, a);
#else
    for (int p = 0; p < N_PHASES; ++p) {
        const int k = (p - 1) % NPH, l = (p - 1) / NPH;
        if (p >= 1 && p < 1 + DEPTH * NPH && k == 8 && !(l & 1)) continue;
        a.ph_lo = p; a.ph_hi = p + 1;
        hipLaunchKernelGGL(mega, dim3(grid), dim3(NWAVES * 64), LDS_BYTES, stream, a);
    }
#endif
}
```

```cpp
#include <hip/hip_runtime.h>
#include <cstdio>
#include <cstdint>

#ifndef MK_SINGLE
#define MK_SINGLE 1
#endif

#define LAS __attribute__((address_space(3)))
#define GAS __attribute__((address_space(1)))

typedef unsigned short bf16_t;
typedef short bf16x8 __attribute__((ext_vector_type(8)));
typedef short s16x4 __attribute__((ext_vector_type(4)));
typedef float f32x2 __attribute__((ext_vector_type(2)));
typedef float f32x4 __attribute__((ext_vector_type(4)));
typedef float f32x16 __attribute__((ext_vector_type(16)));
typedef unsigned u32x2 __attribute__((ext_vector_type(2)));
typedef unsigned u32x4 __attribute__((ext_vector_type(4)));
typedef int i32x4 __attribute__((ext_vector_type(4)));
typedef int i32x8 __attribute__((ext_vector_type(8)));
typedef __bf16 bf16x2_t __attribute__((ext_vector_type(2)));

constexpr int DM = 1024, NB = 8, SEQ = 4096, CTXL = 256, DEPTH = 4;
constexpr int TL = NB * SEQ;
constexpr int TC = NB * CTXL;
constexpr int TT = TL + TC;
constexpr int DIN = 6912, DFF = 2816, NEXP = 8, OCW = 1536;
constexpr int DINP = 3840;
constexpr int NMT = 136;
constexpr int C_QA = 0, C_KA = 512, C_VA = 640, C_QB = 768, C_KB = 1024, C_VB = 1280, C_GB = 1792, C_QD = 2304, C_KD = 2816, C_VD = 3328, C_GL = 3840;
constexpr float NORM_EPS = 1e-6f;
constexpr float SM_C2 = 0.125f * 1.4426950408889634f;
constexpr float LOG2E = 1.4426950408889634f;
constexpr int NCHK = 34;

__device__ __forceinline__ unsigned pk2(float lo, float hi) { f32x2 v = {lo, hi}; bf16x2_t b = __builtin_convertvector(v, bf16x2_t); return __builtin_bit_cast(unsigned, b); }
constexpr int DENSE_F8 = 0;
constexpr float F8_SH = 8.0f, F8_SW13 = 256.0f, F8_SU = 8.0f, F8_SW2 = 256.0f, F8_INV13 = 1.0f / (F8_SH * F8_SW13), F8_INV2 = 1.0f / (F8_SU * F8_SW2);
__device__ __forceinline__ unsigned pk4f8(float a, float b, float c, float d) {
    a = __builtin_amdgcn_fmed3f(a, -448.0f, 448.0f); b = __builtin_amdgcn_fmed3f(b, -448.0f, 448.0f); c = __builtin_amdgcn_fmed3f(c, -448.0f, 448.0f); d = __builtin_amdgcn_fmed3f(d, -448.0f, 448.0f);
    int w = __builtin_amdgcn_cvt_pk_fp8_f32(a, b, 0, false); w = __builtin_amdgcn_cvt_pk_fp8_f32(c, d, w, true); return (unsigned)w;
}
constexpr float I8_CLIP = 4.0f;
__device__ __forceinline__ unsigned pk4i8(float a, float b, float c, float d) {
    const float M = 12582912.0f;
    const unsigned ua = __float_as_uint(a + M), ub = __float_as_uint(b + M), uc = __float_as_uint(c + M), ud = __float_as_uint(d + M);
    return __builtin_amdgcn_perm(ub, ua, 0x0c0c0400u) | __builtin_amdgcn_perm(ud, uc, 0x04000c0cu);
}
__device__ __forceinline__ f32x4 acc_i2f(const f32x4& a) { return __builtin_convertvector(__builtin_bit_cast(i32x4, a), f32x4); }
__device__ __forceinline__ float wave_max(float v) {
#pragma unroll
    for (int o = 1; o < 64; o <<= 1) v = fmaxf(v, __shfl_xor(v, o));
    return v;
}
__device__ __forceinline__ float bf_lo(unsigned u) { return __uint_as_float(u << 16); }
__device__ __forceinline__ float bf_hi(unsigned u) { return __uint_as_float(u & 0xffff0000u); }
__device__ __forceinline__ float bf1(bf16_t u) { return __uint_as_float(((unsigned)u) << 16); }
__device__ __forceinline__ float wave_sum(float v) {
#pragma unroll
    for (int o = 1; o < 64; o <<= 1) v += __shfl_xor(v, o);
    return v;
}
__device__ __forceinline__ float fexp2(float x) { return __builtin_amdgcn_exp2f(x); }
__device__ __forceinline__ float sigmoidf_(float x) { return __builtin_amdgcn_rcpf(1.0f + __builtin_amdgcn_exp2f(-LOG2E * x)); }
__device__ __forceinline__ float siluf_(float x) { return x * __builtin_amdgcn_rcpf(1.0f + __builtin_amdgcn_exp2f(-LOG2E * x)); }
#define LDS_WAIT() asm volatile("s_waitcnt lgkmcnt(0)" ::: "memory")
#define VM_WAIT() asm volatile("s_waitcnt vmcnt(0)" ::: "memory")

namespace pg8 {
#define PG8_LAS __attribute__((address_space(3)))
constexpr int BM = 256, BK = 64, HALF = 128, HTB = HALF * BK * 2  , STAGE_BYTES = 8 * HTB, NXCD = 8, WGM = 8;

__host__ __device__ __forceinline__ int lds_byte(int r, int c) { const int st = (r >> 4) * 2 + (c >> 5), rr = r & 15, cc = c & 31, ob = rr * 64 + cc * 2; return st * 1024 + (ob ^ (((ob >> 9) & 1) << 5)); }
__host__ __device__ __forceinline__ void stage_rc(int b, int& R, int& C) { const int st = b / 1024, sb = b % 1024, swz = sb ^ (((sb >> 9) & 1) << 5); R = (st >> 1) * 16 + swz / 64; C = (st & 1) * 32 + (swz % 64) / 2; }
__host__ __device__ __forceinline__ int perm32(int rho) { const int n = rho >> 4, i = rho & 15; return 8 * (i >> 2) + 4 * n + (i & 3); }

struct Unit { int pm, pn; size_t bo; int ge; };
struct Gemm { const bf16_t* A; const bf16_t* Bt; int K; };

struct GSched {
    int nM, nN, nwg, G, c, wgm; int grouped; size_t bstride; const PG8_LAS int* ts;
    int nx; unsigned long long xtab;
    __device__ __forceinline__ void init(int nM_, int nN_, int G_, int c_, int wgm_ = 4) { nM = nM_; nN = nN_; nwg = nM * nN; G = G_; c = c_; wgm = wgm_; grouped = 0; bstride = 0; ts = nullptr; nx = 0; xtab = 0; }
    __device__ __forceinline__ bool next(int i, Unit& u) const {
        const long L = (long)i * G + c; if (L >= nwg) return false;
        const int nmain = nwg - nx;
        u.ge = 0; if (L >= nmain) { const int j = (int)L - nmain; u.pm = nM + (j >> 3); u.pn = (int)((xtab >> (4 * (j & 7))) & 15ull); u.bo = 0; return true; }
        int wgid = (int)L; { const int q = nmain / NXCD, r = nmain % NXCD, xcd = wgid % NXCD, off = wgid / NXCD; wgid = (xcd < r ? xcd * (q + 1) : r * (q + 1) + (xcd - r) * q) + off; }
        const int nig = wgm * nN, gid = wgid / nig, fm = gid * wgm, gsz = (nM - fm) < wgm ? (nM - fm) : wgm;
        u.pm = fm + ((wgid % nig) % gsz); u.pn = (wgid % nig) / gsz; u.bo = 0;
        if (grouped) { int e = 0;
#pragma unroll
            for (int j = 1; j < 8; ++j) e += (u.pm >= ts[j]) ? 1 : 0;
            e = __builtin_amdgcn_readfirstlane(e);
            u.bo = (size_t)e * bstride; u.ge = e; }
        return true;
    }
    __device__ __forceinline__ void a_ready(const Unit&) const {}
    __device__ __forceinline__ void done(const Unit&) const {}
};
#define ROT2(V, I, c, s) do { const float a_ = V[I] * (c) - V[I + 1] * (s), b_ = V[I + 1] * (c) + V[I] * (s); V[I] = a_; V[I + 1] = b_; } while (0)

struct EpiProj {
    static constexpr bool PERM = true, AFTER_DRAIN = false, KHOOK = false;
    bf16_t* O; const float* rope; u32x2* GB; const float* rs; float wsc;
    __device__ __forceinline__ void operator()(const f32x4 (&acc)[2][2][4][2], const Unit& u, int wr, int wc, int fr, int fq) const {
        const int pn = u.pn; const bool latent = u.pm < TL / 256;
        float rsc[2][4];
#pragma unroll
        for (int ai = 0; ai < 2; ++ai)
#pragma unroll
            for (int m = 0; m < 4; ++m) rsc[ai][m] = rs[u.pm * 256 + wr * 64 + fr + ai * 128 + m * 16] * wsc;
        if (pn >= 15) {
            const int gi = (pn - 15) >> 2, pnl = (pn - 15) & 3;
            u32x2* gp = GB + ((size_t)(((gi * NMT + u.pm) * 4 + pnl) * 8 + wr * 4 + wc) * 16) * 64 + fq * 16 + fr;
#pragma unroll
            for (int ai = 0; ai < 2; ++ai)
#pragma unroll
                for (int m = 0; m < 4; ++m)
#pragma unroll
                    for (int bj = 0; bj < 2; ++bj) { const f32x4 v0 = acc_i2f(acc[ai][bj][m][0]) * rsc[ai][m], v1 = acc_i2f(acc[ai][bj][m][1]) * rsc[ai][m];
#define SG_(x) ((unsigned)fminf(fmaxf(sigmoidf_(x) * 255.0f + 0.5f, 1.0f), 255.0f))
                        u32x2 w; w.x = SG_(v0[0]) | (SG_(v0[1]) << 8) | (SG_(v0[2]) << 16) | (SG_(v0[3]) << 24); w.y = SG_(v1[0]) | (SG_(v1[1]) << 8) | (SG_(v1[2]) << 16) | (SG_(v1[3]) << 24);
#undef SG_
                        __builtin_nontemporal_store(w, gp + (ai * 8 + m * 2 + bj) * 64); }
            return;
        }
        int rmask = 0; if (pn <= 1 || pn == 3 || pn == 4 || (pn >= 9 && pn <= 12)) rmask = 3; else if (pn == 2) rmask = 1;
        if (!latent) rmask = 0;
        const float sc = (pn == 4) ? 0.125f : SM_C2;
        const int row0 = u.pm * 256 + wr * 64 + fr, col0 = pn * 256 + wc * 32 + 8 * fq, axis = wc & 1;
#pragma unroll
        for (int ai = 0; ai < 2; ++ai)
#pragma unroll
            for (int m = 0; m < 4; ++m) {
                const int row = row0 + ai * 128 + m * 16;
                f32x4 cs0 = {1.f, 0.f, 1.f, 0.f}, cs1 = {1.f, 0.f, 1.f, 0.f};
                if (rmask) { const int pos = axis ? (row & 63) : ((row >> 6) & 63); const f32x4* tp = (const f32x4*)(rope + (pos * 16 + 4 * fq) * 2); cs0 = tp[0]; cs1 = tp[1]; }
                bf16_t* rowp = O + (size_t)row * DINP + col0;
#pragma unroll
                for (int bj = 0; bj < 2; ++bj) {
                    f32x4 v0 = acc_i2f(acc[ai][bj][m][0]) * rsc[ai][m], v1 = acc_i2f(acc[ai][bj][m][1]) * rsc[ai][m];
                    if ((rmask >> bj) & 1) { ROT2(v0, 0, cs0[0], cs0[1]); ROT2(v0, 2, cs0[2], cs0[3]); ROT2(v1, 0, cs1[0], cs1[1]); ROT2(v1, 2, cs1[2], cs1[3]); }
                    if (pn == 4 || pn <= 1 || pn == 9 || pn == 10) { v0 = v0 * sc; v1 = v1 * sc; }
                    u32x4 w; w.x = pk2(v0[0], v0[1]); w.y = pk2(v0[2], v0[3]); w.z = pk2(v1[0], v1[1]); w.w = pk2(v1[2], v1[3]);
                    __builtin_nontemporal_store(w, (u32x4*)(rowp + bj * 128));
                }
            }
    }
};

struct EpiMerge {
    static constexpr bool PERM = true, AFTER_DRAIN = false, KHOOK = true;
    bf16_t* Y; const u32x2* GB;
#define UB_(w, k) ((float)(((w) >> (8 * (k))) & 0xffu))
    __device__ __forceinline__ void khook(int t, f32x4 (&acc)[2][2][4][2], const Unit& u, int wr, int wc, int fr, int fq) const {
        const int gi = (t == 8) ? 0 : 1;
        const u32x2* ga = GB + ((size_t)(((gi * NMT + u.pm) * 4 + u.pn) * 8 + wr * 4 + wc) * 16) * 64 + fq * 16 + fr;
        const u32x2* gb = ga + (size_t)NMT * 4 * 8 * 16 * 64;
        u32x2 a[16], b[16];
#pragma unroll
        for (int j = 0; j < 16; ++j) { a[j] = ga[j * 64]; b[j] = gb[j * 64]; }
        __builtin_amdgcn_sched_barrier(0);
#pragma unroll
        for (int grp = 0; grp < 16; ++grp) { const int ai = grp >> 3, m = (grp >> 1) & 3, bj = grp & 1;
            f32x4 v0 = acc[ai][bj][m][0], v1 = acc[ai][bj][m][1];
#define MG_R(wa, wb, k) (UB_(wa, k) * __builtin_amdgcn_rcpf(UB_(wb, k)))
            v0[0] *= MG_R(a[grp].x, b[grp].x, 0); v0[1] *= MG_R(a[grp].x, b[grp].x, 1); v0[2] *= MG_R(a[grp].x, b[grp].x, 2); v0[3] *= MG_R(a[grp].x, b[grp].x, 3);
            v1[0] *= MG_R(a[grp].y, b[grp].y, 0); v1[1] *= MG_R(a[grp].y, b[grp].y, 1); v1[2] *= MG_R(a[grp].y, b[grp].y, 2); v1[3] *= MG_R(a[grp].y, b[grp].y, 3);
#undef MG_R
            acc[ai][bj][m][0] = v0; acc[ai][bj][m][1] = v1; }
        asm volatile("" ::: "memory"); __builtin_amdgcn_sched_barrier(0);
    }
    __device__ __forceinline__ void operator()(const f32x4 (&acc)[2][2][4][2], const Unit& u, int wr, int wc, int fr, int fq) const {
        const int row0 = u.pm * 256 + wr * 64 + fr, col0 = u.pn * 256 + wc * 32 + 8 * fq;
        const u32x2* gc = GB + ((size_t)(((2 * NMT + u.pm) * 4 + u.pn) * 8 + wr * 4 + wc) * 16) * 64 + fq * 16 + fr;
        u32x2 g[16];
#pragma unroll
        for (int j = 0; j < 16; ++j) g[j] = gc[j * 64];
        constexpr float q = 1.0f / 255.0f;
#pragma unroll
        for (int grp = 0; grp < 16; ++grp) { const int ai = grp >> 3, m = (grp >> 1) & 3, bj = grp & 1;
            const f32x4 v0 = acc[ai][bj][m][0] * q, v1 = acc[ai][bj][m][1] * q;
            u32x4 w; w.x = pk2(v0[0] * UB_(g[grp].x, 0), v0[1] * UB_(g[grp].x, 1)); w.y = pk2(v0[2] * UB_(g[grp].x, 2), v0[3] * UB_(g[grp].x, 3));
            w.z = pk2(v1[0] * UB_(g[grp].y, 0), v1[1] * UB_(g[grp].y, 1)); w.w = pk2(v1[2] * UB_(g[grp].y, 2), v1[3] * UB_(g[grp].y, 3));
            *(u32x4*)(Y + (size_t)(row0 + ai * 128 + m * 16) * DM + col0 + bj * 128) = w; }
    }
#undef UB_
};

struct EpiRes {
    static constexpr bool PERM = true, AFTER_DRAIN = false, KHOOK = false;
    const void* srcL; const void* srcC; bf16_t* dstL; bf16_t* dstC; const float* mod; int goff; float scl; int src32;
    __device__ __forceinline__ void operator()(const f32x4 (&acc)[2][2][4][2], const Unit& u, int wr, int wc, int fr, int fq) const {
        const bool latent = u.pm < TL / 256; const int mb = latent ? (u.pm >> 4) : 8;
        const float* g = mod + mb * 6144 + goff;
        const int rloc = (latent ? u.pm * 256 : u.pm * 256 - TL) + wr * 64 + fr, col0 = u.pn * 256 + wc * 32 + 8 * fq;
        const void* src = latent ? srcL : srcC; bf16_t* dst = latent ? dstL : dstC;
        f32x4 gv[2][2];
#pragma unroll
        for (int bj = 0; bj < 2; ++bj) { gv[bj][0] = *(const f32x4*)(g + col0 + bj * 128) * scl; gv[bj][1] = *(const f32x4*)(g + col0 + bj * 128 + 4) * scl; }
#pragma unroll
        for (int ai = 0; ai < 2; ++ai)
#pragma unroll
            for (int m = 0; m < 4; ++m) {
                const size_t off = (size_t)(rloc + ai * 128 + m * 16) * DM + col0;
#pragma unroll
                for (int bj = 0; bj < 2; ++bj) {
                    f32x4 x0, x1;
                    if (src32) { x0 = *(const f32x4*)((const float*)src + off + bj * 128); x1 = *(const f32x4*)((const float*)src + off + bj * 128 + 4); }
                    else { const u32x4 t = *(const u32x4*)((const bf16_t*)src + off + bj * 128); x0 = (f32x4){bf_lo(t.x), bf_hi(t.x), bf_lo(t.y), bf_hi(t.y)}; x1 = (f32x4){bf_lo(t.z), bf_hi(t.z), bf_lo(t.w), bf_hi(t.w)}; }
                    x0 += gv[bj][0] * acc[ai][bj][m][0]; x1 += gv[bj][1] * acc[ai][bj][m][1];
                    u32x4 w; w.x = pk2(x0[0], x0[1]); w.y = pk2(x0[2], x0[3]); w.z = pk2(x1[0], x1[1]); w.w = pk2(x1[2], x1[3]);
                    *(u32x4*)(dst + off + bj * 128) = w;
                }
                if (m & 1) asm volatile("" ::: "memory");
            }
    }
};

template <bool OUT8>
struct EpiSwiglu {
    static constexpr bool PERM = true, AFTER_DRAIN = false, KHOOK = false;
    unsigned char* U; const float* rs; const float* wsc; int d3;
    __device__ __forceinline__ void operator()(const f32x4 (&acc)[2][2][4][2], const Unit& u, int wr, int wc, int fr, int fq) const {
        const int row0 = u.pm * 256 + wr * 64 + fr, col0 = u.pn * 128 + wc * 32 + 8 * fq;
        const float w1s = wsc[2 * u.ge], w3s = wsc[2 * u.ge + d3] * (OUT8 ? F8_SU : 1.0f);
#pragma unroll
        for (int ai = 0; ai < 2; ++ai)
#pragma unroll
            for (int m = 0; m < 4; ++m) {
                const int row = row0 + ai * 128 + m * 16; const float r = rs[row], ra = r * w1s, rb = r * w3s;
                const f32x4 a0 = acc_i2f(acc[ai][0][m][0]) * ra, a1 = acc_i2f(acc[ai][0][m][1]) * ra, b0 = acc_i2f(acc[ai][1][m][0]) * rb, b1 = acc_i2f(acc[ai][1][m][1]) * rb;
                if constexpr (OUT8) {
                    u32x2 w; w.x = pk4f8(siluf_(a0[0]) * b0[0], siluf_(a0[1]) * b0[1], siluf_(a0[2]) * b0[2], siluf_(a0[3]) * b0[3]);
                    w.y = pk4f8(siluf_(a1[0]) * b1[0], siluf_(a1[1]) * b1[1], siluf_(a1[2]) * b1[2], siluf_(a1[3]) * b1[3]);
                    *(u32x2*)(U + (size_t)row * DFF + col0) = w;
                } else {
                    u32x4 w; w.x = pk2(siluf_(a0[0]) * b0[0], siluf_(a0[1]) * b0[1]); w.y = pk2(siluf_(a0[2]) * b0[2], siluf_(a0[3]) * b0[3]);
                    w.z = pk2(siluf_(a1[0]) * b1[0], siluf_(a1[1]) * b1[1]); w.w = pk2(siluf_(a1[2]) * b1[2], siluf_(a1[3]) * b1[3]);
                    *(u32x4*)((bf16_t*)U + (size_t)row * DFF + col0) = w;
                }
            }
    }
};

struct EpiBf16 {
    static constexpr bool PERM = true, AFTER_DRAIN = false, KHOOK = false;
    bf16_t* O; int ldc; float scl;
    __device__ __forceinline__ void operator()(const f32x4 (&acc)[2][2][4][2], const Unit& u, int wr, int wc, int fr, int fq) const {
        const int row0 = u.pm * 256 + wr * 64 + fr, col0 = u.pn * 256 + wc * 32 + 8 * fq;
#pragma unroll
        for (int ai = 0; ai < 2; ++ai)
#pragma unroll
            for (int m = 0; m < 4; ++m) { bf16_t* rowp = O + (size_t)(row0 + ai * 128 + m * 16) * ldc + col0;
#pragma unroll
                for (int bj = 0; bj < 2; ++bj) { const f32x4 v0 = acc[ai][bj][m][0] * scl, v1 = acc[ai][bj][m][1] * scl;
                    u32x4 w; w.x = pk2(v0[0], v0[1]); w.y = pk2(v0[2], v0[3]); w.z = pk2(v1[0], v1[1]); w.w = pk2(v1[2], v1[3]);
                    *(u32x4*)(rowp + bj * 128) = w; } }
    }
};

template <class Epi, class Sched, bool ALIGN_EPI = false, bool SP2 = false, int MODE = 0>
__device__ __forceinline__ void gemm_phase(PG8_LAS unsigned char* lds, const Gemm g, const Sched& S, const Epi& E, int tid_in) {
    int tid = tid_in; asm volatile("" : "+v"(tid));
    const int wid = __builtin_amdgcn_readfirstlane(tid >> 6), lane = tid & 63, wr = wid >> 2, wc = wid & 3, fr = lane & 15, fq = lane >> 4;
    const int K = g.K, nt = K / BK;
    unsigned voffA[2], voffB[2];
#pragma unroll
    for (int i = 0; i < 2; ++i) { int R, C; stage_rc(tid * 16 + i * 8192, R, C); const int Rb = Epi::PERM ? ((R & ~31) + perm32(R & 31)) : R;
        voffA[i] = (unsigned)(R * K + C) * 2u; voffB[i] = (unsigned)(Rb * K + C) * 2u; }
    const size_t kstep = (size_t)(BK * 2);
    const size_t hstep = (size_t)HALF * K * 2;
    const size_t tstep = 2 * hstep;
    const unsigned ldsw = (unsigned)wid * 1024u;
    const int aoff = lds_byte(wr * 64 + fr, fq * 8), boff = lds_byte(wc * 32 + fr, fq * 8);
#define PG8_SA(b, h) (((b) * 2 + (h)) * HTB)
#define PG8_SB(b, h) ((4 + (b) * 2 + (h)) * HTB)
#define PG8_STAGE(bufoff, gbase, voff) do { _Pragma("unroll") for (int _i = 0; _i < 2; ++_i) \
        __builtin_amdgcn_global_load_lds((const unsigned*)((const char*)(gbase) + (voff)[_i]), (PG8_LAS unsigned*)(lds + (bufoff) + ldsw + _i * 8192), 16, 0, 0); } while (0)
#define PG8_LDA(dst, b, h) do { _Pragma("unroll") for (int m = 0; m < 4; ++m) _Pragma("unroll") for (int k = 0; k < 2; ++k) dst[m][k] = *(const PG8_LAS bf16x8*)(lds + PG8_SA(b, h) + aoff + m * 2048 + k * 1024); } while (0)
#define PG8_LDB(dst, b, h) do { _Pragma("unroll") for (int n = 0; n < 2; ++n) _Pragma("unroll") for (int k = 0; k < 2; ++k) dst[n][k] = *(const PG8_LAS bf16x8*)(lds + PG8_SB(b, h) + boff + n * 2048 + k * 1024); } while (0)
#define PG8_CAT(x) __builtin_shufflevector(__builtin_bit_cast(i32x4, (x)[0]), __builtin_bit_cast(i32x4, (x)[1]), 0, 1, 2, 3, 4, 5, 6, 7)
#define PG8_MMA(ai, bj, At, Bt) do { __builtin_amdgcn_s_setprio(1); _Pragma("unroll") for (int m = 0; m < 4; ++m) _Pragma("unroll") for (int n = 0; n < 2; ++n) { \
        if constexpr (MODE == 1) { const i32x8 b8_ = PG8_CAT(Bt[n]), a8_ = PG8_CAT(At[m]); asm volatile("v_mfma_f32_16x16x128_f8f6f4 %0, %1, %2, %0" : "+v"(acc[ai][bj][m][n]) : "v"(b8_), "v"(a8_)); } \
          \
        else if constexpr (MODE == 2) { _Pragma("unroll") for (int k = 0; k < 2; ++k) asm volatile("v_mfma_i32_16x16x64_i8 %0, %1, %2, %0" : "+v"(acc[ai][bj][m][n]) : "v"(Bt[n][k]), "v"(At[m][k])); } \
        else { _Pragma("unroll") for (int k = 0; k < 2; ++k) acc[ai][bj][m][n] = __builtin_amdgcn_mfma_f32_16x16x32_bf16(Bt[n][k], At[m][k], acc[ai][bj][m][n], 0, 0, 0); } } \
        __builtin_amdgcn_s_setprio(0); } while (0)
#define PG8_WAIT_V(n) asm volatile("s_waitcnt vmcnt(" #n ")" ::: "memory")
#define PG8_WAIT_L(n) asm volatile("s_waitcnt lgkmcnt(" #n ")" ::: "memory")
#define PG8_BAR __builtin_amdgcn_s_barrier()
#define PG8_SCHED __builtin_amdgcn_sched_barrier(0)
    Unit cur, nxt; int ui = 0;
    if (!S.next(0, cur)) return;
    f32x4 acc[2][2][4][2];
#pragma unroll
    for (int a = 0; a < 2; ++a)
#pragma unroll
        for (int b = 0; b < 2; ++b)
#pragma unroll
            for (int m = 0; m < 4; ++m)
#pragma unroll
                for (int n = 0; n < 2; ++n) acc[a][b][m][n] = (f32x4){0.f, 0.f, 0.f, 0.f};
    bf16x8 At[4][2], B0[2][2], B1[2][2];
    const char* cA = (const char*)g.A + (size_t)cur.pm * tstep; const char* cB = (const char*)g.Bt + cur.bo * 2 + (size_t)cur.pn * tstep;
    S.a_ready(cur);
    if constexpr (SP2) {
        PG8_STAGE(PG8_SB(0, 0), cB, voffB); PG8_STAGE(PG8_SB(0, 1), cB + hstep, voffB); PG8_STAGE(PG8_SA(0, 0), cA, voffA); PG8_STAGE(PG8_SA(0, 1), cA + hstep, voffA);
        if (wr == 1) PG8_BAR;
        PG8_WAIT_V(2); PG8_BAR;
        PG8_STAGE(PG8_SB(1, 0), cB + kstep, voffB); PG8_STAGE(PG8_SA(1, 0), cA + kstep, voffA); PG8_STAGE(PG8_SB(1, 1), cB + hstep + kstep, voffB);
        PG8_WAIT_V(6); PG8_BAR;
    } else {
        PG8_STAGE(PG8_SB(0, 0), cB, voffB); PG8_STAGE(PG8_SA(0, 0), cA, voffA); PG8_STAGE(PG8_SB(0, 1), cB + hstep, voffB); PG8_STAGE(PG8_SA(0, 1), cA + hstep, voffA);
        if (wr == 1) PG8_BAR;
        PG8_WAIT_V(4); PG8_BAR;
        PG8_STAGE(PG8_SB(1, 0), cB + kstep, voffB); PG8_STAGE(PG8_SA(1, 0), cA + kstep, voffA); PG8_STAGE(PG8_SB(1, 1), cB + hstep + kstep, voffB);
        PG8_WAIT_V(6); PG8_BAR;
    }
    for (;;) {
        const bool has_next = S.next(ui + 1, nxt);
        const char* nA = has_next ? (const char*)g.A + (size_t)nxt.pm * tstep : cA; const char* nB = has_next ? (const char*)g.Bt + nxt.bo * 2 + (size_t)nxt.pn * tstep : cB;
        for (int t = 0; t < nt; t += 2) {
            const bool last = (t == nt - 2);
            const char* a1 = cA + (size_t)(t + 1) * kstep;
            const char* a2 = last ? nA : cA + (size_t)(t + 2) * kstep; const char* b2 = last ? nB : cB + (size_t)(t + 2) * kstep;
            const char* a3 = a2 + kstep; const char* b3 = b2 + kstep;
            if (last && has_next) S.a_ready(nxt);
            if constexpr (Epi::KHOOK) { if (t == 8 || t == 16) E.khook(t, acc, cur, wr, wc, fr, fq); }
            if constexpr (SP2) {
            PG8_LDB(B0, 0, 0); PG8_LDB(B1, 0, 1); PG8_SCHED; PG8_LDA(At, 0, 0); PG8_STAGE(PG8_SA(1, 1), a1 + hstep, voffA);
            PG8_WAIT_V(8); PG8_WAIT_L(0); PG8_BAR; PG8_MMA(0, 0, At, B0); PG8_MMA(0, 1, At, B1); PG8_BAR; PG8_SCHED;
            PG8_LDA(At, 0, 1); PG8_STAGE(PG8_SB(0, 0), b2, voffB); PG8_STAGE(PG8_SB(0, 1), b2 + hstep, voffB); PG8_STAGE(PG8_SA(0, 0), a2, voffA);
            PG8_WAIT_V(8); PG8_WAIT_L(0); PG8_BAR; PG8_MMA(1, 0, At, B0); PG8_MMA(1, 1, At, B1); PG8_BAR; PG8_SCHED;
            PG8_LDB(B0, 1, 0); PG8_LDB(B1, 1, 1); PG8_SCHED; PG8_LDA(At, 1, 0); PG8_STAGE(PG8_SA(0, 1), a2 + hstep, voffA);
            PG8_WAIT_V(8); PG8_WAIT_L(0); PG8_BAR; PG8_MMA(0, 0, At, B0); PG8_MMA(0, 1, At, B1); PG8_BAR; PG8_SCHED;
            PG8_LDA(At, 1, 1); PG8_STAGE(PG8_SB(1, 0), b3, voffB); PG8_STAGE(PG8_SB(1, 1), b3 + hstep, voffB); PG8_STAGE(PG8_SA(1, 0), a3, voffA);
            PG8_WAIT_V(8); PG8_WAIT_L(0); PG8_BAR; PG8_MMA(1, 0, At, B0); PG8_MMA(1, 1, At, B1); PG8_BAR; PG8_SCHED;
            } else {
            PG8_LDB(B0, 0, 0); PG8_SCHED; PG8_LDA(At, 0, 0); PG8_STAGE(PG8_SA(1, 1), a1 + hstep, voffA);
            PG8_WAIT_L(8); PG8_BAR; PG8_WAIT_L(0); PG8_MMA(0, 0, At, B0); PG8_BAR; PG8_SCHED;
            PG8_LDB(B1, 0, 1); PG8_STAGE(PG8_SB(0, 0), b2, voffB);
            PG8_BAR; PG8_WAIT_L(0); PG8_MMA(0, 1, At, B1); PG8_BAR;
            PG8_LDA(At, 0, 1); PG8_STAGE(PG8_SA(0, 0), a2, voffA);
            PG8_BAR; PG8_WAIT_L(0); PG8_MMA(1, 0, At, B0); PG8_BAR; PG8_SCHED;
            PG8_STAGE(PG8_SB(0, 1), b2 + hstep, voffB);
            PG8_WAIT_V(6); PG8_BAR; PG8_MMA(1, 1, At, B1); PG8_BAR;
            PG8_LDB(B0, 1, 0); PG8_SCHED; PG8_LDA(At, 1, 0); PG8_STAGE(PG8_SA(0, 1), a2 + hstep, voffA);
            PG8_WAIT_L(8); PG8_BAR; PG8_WAIT_L(0); PG8_MMA(0, 0, At, B0); PG8_BAR; PG8_SCHED;
            PG8_LDB(B1, 1, 1); PG8_STAGE(PG8_SB(1, 0), b3, voffB);
            PG8_BAR; PG8_WAIT_L(0); PG8_MMA(0, 1, At, B1); PG8_BAR;
            PG8_LDA(At, 1, 1); PG8_STAGE(PG8_SA(1, 0), a3, voffA);
            PG8_BAR; PG8_WAIT_L(0); PG8_MMA(1, 0, At, B0); PG8_BAR; PG8_SCHED;
            PG8_STAGE(PG8_SB(1, 1), b3 + hstep, voffB);
            PG8_WAIT_V(6); PG8_BAR; PG8_MMA(1, 1, At, B1); PG8_BAR;
            }
        }
        if constexpr (MODE != 0) asm volatile("s_nop 15\n\ts_nop 15" ::: "memory");
        if constexpr (ALIGN_EPI) { if (wr == 0) PG8_BAR; }
        if constexpr (!Epi::AFTER_DRAIN) { int ln_; asm volatile("v_mbcnt_lo_u32_b32 %0, -1, 0\n\tv_mbcnt_hi_u32_b32 %0, -1, %0" : "=v"(ln_));
            E(acc, cur, wr, wc, ln_ & 15, ln_ >> 4); S.done(cur); }
        if (!has_next) break;
#pragma unroll
        for (int a = 0; a < 2; ++a)
#pragma unroll
            for (int b = 0; b < 2; ++b)
#pragma unroll
                for (int m = 0; m < 4; ++m)
#pragma unroll
                    for (int n = 0; n < 2; ++n) acc[a][b][m][n] = (f32x4){0.f, 0.f, 0.f, 0.f};
        cur = nxt; cA = nA; cB = nB; ++ui;
        if constexpr (ALIGN_EPI) { if (wr == 1) PG8_BAR; }
    }
    PG8_WAIT_V(0);
    if constexpr (!ALIGN_EPI) { if (wr == 0) PG8_BAR; }
    PG8_BAR;
    if constexpr (Epi::AFTER_DRAIN) { E.fused(acc, cur, wr, wc, fr, fq, lds, wid, lane); S.done(cur); }
#undef PG8_SA
#undef PG8_SB
#undef PG8_STAGE
#undef PG8_LDA
#undef PG8_LDB
#undef PG8_MMA
#undef PG8_CAT
#undef PG8_WAIT_V
#undef PG8_WAIT_L
#undef PG8_BAR
#undef PG8_SCHED
}
}
namespace at {
__device__ __forceinline__ int crow(int r, int hi) { return (r & 3) + 8 * (r >> 2) + 4 * hi; }
typedef short v4i16_t __attribute__((ext_vector_type(4)));
__device__ __forceinline__ s16x4 vtr(const LAS unsigned char* p) { return __builtin_bit_cast(s16x4, __builtin_amdgcn_ds_read_tr16_b64_v4i16((LAS v4i16_t*)p)); }
__device__ __forceinline__ bf16x8 cat8(s16x4 lo, s16x4 hi) { return (bf16x8){lo[0], lo[1], lo[2], lo[3], hi[0], hi[1], hi[2], hi[3]}; }
#define MFMA32(a, b, c) __builtin_amdgcn_mfma_f32_32x32x16_bf16((a), (b), (c), 0, 0, 0)
constexpr int KSTR = 144;
constexpr float NEG_BIG = -1.0e30f;

__device__ __forceinline__ bf16x8 tr_frag(const LAS unsigned char* tile, int vstr, int ks, int colb, int lane) {
    const int hi = lane >> 5, ql = (lane & 15) >> 2, blk = (lane >> 4) & 1, p = lane & 3;
    const LAS unsigned char* a = tile + (16 * ks + 4 * hi + ql) * vstr + (colb + 16 * blk + 4 * p) * 2;
    return cat8(vtr(a), vtr(a + 8 * vstr));
}

template <int N> __device__ __forceinline__ void wait_bar() { asm volatile("s_waitcnt vmcnt(%0) lgkmcnt(0)\n\ts_barrier" :: "n"(N) : "memory"); }
template <int DV, int NK> struct AtGeo { static constexpr int KB = 8192, VB = DV * 128, STAGE = NK * KB + VB, NP = (NK * 8 + DV / 8) / 8  , LDS = 3 * STAGE + 2048; };
__device__ __forceinline__ bf16x8 v_frag(const LAS unsigned char* Vt, int ks, int c, int lane) {
    const int hi = lane >> 5, ql = (lane & 15) >> 2, blk = (lane >> 4) & 1, p = lane & 3;
    const int ch = (4 * (c & 1) + 2 * blk + (p >> 1)) ^ ((ql & 2) << 1);
    const LAS unsigned char* a = Vt + (c >> 1) * 8192 + (16 * ks + 4 * hi + ql) * 128 + ch * 16 + 8 * (p & 1);
    return cat8(vtr(a), vtr(a + 1024));
}
template <int DV, int NK> struct AtCtx {
    LAS unsigned char* lds; LAS float* scr; bf16x8 qr[4]; f32x16 o[DV / 32]; f32x16 negm; float m, l; int lane, r32, hi, ksel, qpos, kpos0, nloc; bool exact0;
};
template <int DV, int NK, bool BAND, bool HAS_QK, bool HAS_PV, bool EX0>
__device__ __forceinline__ void at_step(AtCtx<DV, NK>& C, int t, int koff, int voff, const u32x4 (&pw)[4], u32x4 (&pn)[4]) {
    constexpr int KB = 8192, NC = DV / 32, NG = NC * 4  , EPG = 16 / NG  ;
    const LAS unsigned char* Kt = C.lds + koff + C.ksel * KB;
    const LAS unsigned char* Vt = C.lds + voff;
    const int lane = C.lane, r32 = C.r32, hi = C.hi;
    f32x16 s0, s1; bf16x8 vf[2][4];
    bool resc = false;
    if (HAS_QK) {
        bf16x8 kf[8];
#pragma unroll
        for (int d0 = 0; d0 < 4; ++d0) { const int ko = r32 * 128 + (((2 * d0 + hi) ^ ((r32 >> 1) & 7)) << 4);
            kf[2 * d0] = *(const LAS bf16x8*)(Kt + ko); kf[2 * d0 + 1] = *(const LAS bf16x8*)(Kt + 4096 + ko); }
        __builtin_amdgcn_sched_barrier(0);
        __builtin_amdgcn_s_setprio(1);
        s0 = MFMA32(kf[0], C.qr[0], C.negm); s1 = MFMA32(kf[1], C.qr[0], C.negm);
#pragma unroll
        for (int d0 = 1; d0 < 4; ++d0) { s0 = MFMA32(kf[2 * d0], C.qr[d0], s0); s1 = MFMA32(kf[2 * d0 + 1], C.qr[d0], s1); }
        __builtin_amdgcn_s_setprio(0);
        __builtin_amdgcn_sched_barrier(0);
    }
    if (HAS_PV) {
#pragma unroll
        for (int c = 0; c < 2; ++c)
#pragma unroll
            for (int ks = 0; ks < 4; ++ks) vf[c][ks] = v_frag(Vt, ks, c, lane);
        __builtin_amdgcn_sched_barrier(0);
    }
    if (HAS_QK) {
        if (BAND && t < C.nloc) {
            const int kb = C.kpos0 + 64 * t - C.qpos;
#pragma unroll
            for (int r = 0; r < 16; ++r) { const int d = kb + crow(r, hi); if (d > 128 || d < -128) s0[r] = NEG_BIG; if (d + 32 > 128 || d + 32 < -128) s1[r] = NEG_BIG; }
        }
        float mt = fmaxf(fmaxf(s0[0], s1[0]), s0[1]);
#pragma unroll
        for (int r = 2; r < 16; r += 2) mt = fmaxf(fmaxf(mt, s0[r]), s0[r + 1]);
#pragma unroll
        for (int r = 1; r < 16; r += 2) mt = fmaxf(fmaxf(mt, s1[r]), s1[(r + 1) & 15]);
        { const auto sw = __builtin_amdgcn_permlane32_swap(__float_as_uint(mt), __float_as_uint(mt), false, false); mt = fmaxf(__uint_as_float(sw[0]), __uint_as_float(sw[1])); }
        const float dl = (!HAS_PV && EX0) ? mt : ((mt > 8.0f) ? mt : 0.0f);
        resc = (!HAS_PV && EX0) ? true : __any(dl > 0.0f);
        if (resc) { const float f = (!HAS_PV && EX0) ? 1.0f : fexp2(-dl);     C.l *= f; C.m += dl; if (hi == 0) C.scr[r32] = f;
#pragma unroll
            for (int r = 0; r < 16; ++r) { s0[r] -= dl; s1[r] -= dl; C.negm[r] = -C.m; } }
        __builtin_amdgcn_sched_barrier(0);
    }
    {
        float ls = 0.f;
        __builtin_amdgcn_s_setprio(1);
#pragma unroll
        for (int g = 0; g < NG; ++g) {
            const int c = g >> 2, ks = g & 3;
            if (HAS_PV) {
                C.o[c] = MFMA32(__builtin_bit_cast(bf16x8, pw[ks]), vf[c & 1][ks], C.o[c]);
                if (ks == 3 && c + 2 < NC) {
#pragma unroll
                    for (int k2 = 0; k2 < 4; ++k2) vf[c & 1][k2] = v_frag(Vt, k2, c + 2, lane);
                }
            }
            if (HAS_QK) {
#pragma unroll
                for (int e = 0; e < EPG; ++e) { const int r = g * EPG + e;
                    s0[r] = fexp2(s0[r]); s1[r] = fexp2(s1[r]); ls += s0[r] + s1[r];
                    if (r & 1) { const unsigned w0 = pk2(s0[r - 1], s0[r]), w1 = pk2(s1[r - 1], s1[r]); pn[r >> 3][(r >> 1) & 3] = w0; pn[2 + (r >> 3)][(r >> 1) & 3] = w1; } }
            }
        }
        if (HAS_QK) { C.l += ls; asm volatile("" : "+v"(pn[0]), "+v"(pn[1]), "+v"(pn[2]), "+v"(pn[3]), "+v"(C.l)); }
        __builtin_amdgcn_s_setprio(0);
        if (HAS_QK && HAS_PV) {
#pragma unroll
            for (int g = 0; g < NG; ++g) { __builtin_amdgcn_sched_group_barrier(0x008, 1, 0); __builtin_amdgcn_sched_group_barrier(0x002, 6 * EPG, 0); if (g < (NC - 2) * 4) __builtin_amdgcn_sched_group_barrier(0x100, 2, 0); }
        }
        __builtin_amdgcn_sched_barrier(0);
    }
    if (resc) {
        LDS_WAIT();
#pragma unroll
        for (int j = 0; j < 4; ++j) { const f32x4 fv = *(const LAS f32x4*)(C.scr + 8 * j + 4 * hi);
#pragma unroll
            for (int c = 0; c < NC; ++c) { C.o[c][4 * j] *= fv[0]; C.o[c][4 * j + 1] *= fv[1]; C.o[c][4 * j + 2] *= fv[2]; C.o[c][4 * j + 3] *= fv[3]; } }
        LDS_WAIT();
    }
}
template <int DV, int NK, bool BAND, bool EX0>
__device__ __forceinline__ void attn_core(LAS unsigned char* lds, const bf16_t* __restrict__ proj, int NT, int nloc, int locrow0, int ctxrow0, int kcol, int vcol,
                                          const bf16_t* qp, int ksel, int qpos, int kpos0, float m_init, float l_init, f32x16 (&o)[DV / 32], float& l_out, int tid) {
    typedef AtGeo<DV, NK> Geo;
    constexpr int KB = Geo::KB, VB = Geo::VB, NPK = NK, NPV = DV / 64, NP = NPK + NPV;
    AtCtx<DV, NK> C;
    C.lds = lds; C.lane = tid & 63; C.r32 = C.lane & 31; C.hi = C.lane >> 5; C.ksel = ksel; C.qpos = qpos; C.kpos0 = kpos0; C.nloc = nloc;
    const int lane = C.lane; const int wid = __builtin_amdgcn_readfirstlane(tid >> 6);
    C.scr = (LAS float*)(lds + 3 * Geo::STAGE) + wid * 64;
#pragma unroll
    for (int d0 = 0; d0 < 4; ++d0) C.qr[d0] = *(const bf16x8*)(qp + d0 * 16 + C.hi * 8);
    unsigned ksoff[NPK], vsoff[NPV]; int kdoff[NPK], vdoff[NPV];
#pragma unroll
    for (int i = 0; i < NPK; ++i) { const int pc = wid + 8 * i, j = pc >> 3, key = 8 * (pc & 7) + (lane >> 3), ch = (lane & 7) ^ ((key >> 1) & 7);
        ksoff[i] = (unsigned)key * DINP + kcol + j * 64 + ch * 8; kdoff[i] = pc * 1024; }
#pragma unroll
    for (int i = 0; i < NPV; ++i) { const int pv = wid + 8 * i, cp = pv >> 3, key = 8 * (pv & 7) + (lane >> 3), ch = (lane & 7) ^ (((key >> 1) & 1) << 2);
        vsoff[i] = (unsigned)key * DINP + vcol + cp * 64 + ch * 8; vdoff[i] = 3 * NK * KB + pv * 1024; }
#define AT_ROW0(t) ((t) < nloc ? locrow0 + 64 * (t) : ctxrow0 + 64 * ((t) - nloc))
#define AT_DMA_K(t, s) do { const bf16_t* tb = proj + (size_t)AT_ROW0(t) * DINP; \
        _Pragma("unroll") for (int i = 0; i < NPK; ++i) __builtin_amdgcn_global_load_lds((const unsigned*)(tb + ksoff[i]), (LAS unsigned*)(lds + (s) * (NK * KB) + kdoff[i]), 16, 0, 0); } while (0)
#define AT_DMA_V(t, s) do { const bf16_t* tb = proj + (size_t)AT_ROW0(t) * DINP; \
        _Pragma("unroll") for (int i = 0; i < NPV; ++i) __builtin_amdgcn_global_load_lds((const unsigned*)(tb + vsoff[i]), (LAS unsigned*)(lds + (s) * VB + vdoff[i]), 16, 0, 0); } while (0)
    C.m = m_init; C.l = l_init; C.exact0 = EX0;
#pragma unroll
    for (int r = 0; r < 16; ++r) C.negm[r] = -m_init;
#pragma unroll
    for (int c = 0; c < DV / 32; ++c) C.o[c] = (f32x16){0.f};
    u32x4 pa[4], pb[4];
    AT_DMA_K(0, 0);
    AT_DMA_K(1, 1); AT_DMA_V(0, 0);
    wait_bar<NP>();
    if (2 < NT) AT_DMA_K(2, 2);
    AT_DMA_V(1, 1);
    at_step<DV, NK, BAND, true, false, EX0>(C, 0, 0, 0, pb, pa);
    int s1 = 1, s0 = 0;
    for (int t = 1; t < NT; ++t) {
        if (t + 1 < NT) wait_bar<NP>(); else wait_bar<NPV>();
        const int s2 = s1 == 2 ? 0 : s1 + 1;
        if (t + 2 < NT) AT_DMA_K(t + 2, s0);
        if (t + 1 < NT) AT_DMA_V(t + 1, s2);
        at_step<DV, NK, BAND, true, true, EX0>(C, t, s1 * (NK * KB), 3 * NK * KB + s0 * VB, pa, pb);
#pragma unroll
        for (int i_ = 0; i_ < 4; ++i_) pa[i_] = pb[i_];
        s0 = s1; s1 = s2;
    }
    wait_bar<0>();
    at_step<DV, NK, BAND, false, true, EX0>(C, NT, 0, 3 * NK * KB + s0 * VB, pa, pb);
    wait_bar<0>();
#undef AT_ROW0
#undef AT_DMA_K
#undef AT_DMA_V
#pragma unroll
    for (int c = 0; c < DV / 32; ++c) o[c] = C.o[c];
    l_out = C.l + __shfl_xor(C.l, 32);
}
template <int DV, int NK> struct AtGeoP { static constexpr int KT = NK * 8192, VT = DV * 128, VRING = 4 * KT, SCR = 4 * KT + 4 * VT, LDS = SCR + 2048; };
template <int DV, int NK, bool EX0>
__device__ __forceinline__ void attn_core_pair(LAS unsigned char* lds, const bf16_t* __restrict__ proj, int NT, int nloc, int locrow0, int ctxrow0, int kcol, int vcol,
                                               const bf16_t* qp, int ksel, float m_init, float l_init, f32x16 (&o)[DV / 32], float& l_out, int tid) {
    typedef AtGeoP<DV, NK> Geo;
    constexpr int KT = Geo::KT, VT = Geo::VT, VRING = Geo::VRING, NPK = NK, NPV = DV / 64;
    AtCtx<DV, NK> C;
    C.lds = lds; C.lane = tid & 63; C.r32 = C.lane & 31; C.hi = C.lane >> 5; C.ksel = ksel; C.qpos = 0; C.kpos0 = 0; C.nloc = nloc;
    const int lane = C.lane; const int wid = __builtin_amdgcn_readfirstlane(tid >> 6);
    C.scr = (LAS float*)(lds + Geo::SCR) + wid * 64;
#pragma unroll
    for (int d0 = 0; d0 < 4; ++d0) C.qr[d0] = *(const bf16x8*)(qp + d0 * 16 + C.hi * 8);
    unsigned ksoff[NPK], vsoff[NPV]; int kdoff[NPK], vdoff[NPV];
#pragma unroll
    for (int i = 0; i < NPK; ++i) { const int pc = wid + 8 * i, j = pc >> 3, key = 8 * (pc & 7) + (lane >> 3), ch = (lane & 7) ^ ((key >> 1) & 7);
        ksoff[i] = (unsigned)key * DINP + kcol + j * 64 + ch * 8; kdoff[i] = pc * 1024; }
#pragma unroll
    for (int i = 0; i < NPV; ++i) { const int pv = wid + 8 * i, cp = pv >> 3, key = 8 * (pv & 7) + (lane >> 3), ch = (lane & 7) ^ (((key >> 1) & 1) << 2);
        vsoff[i] = (unsigned)key * DINP + vcol + cp * 64 + ch * 8; vdoff[i] = VRING + pv * 1024; }
#define ATP_ROW0(t) ((t) < nloc ? locrow0 + 64 * (t) : ctxrow0 + 64 * ((t) - nloc))
#define ATP_OFF(t, T_) ((((t) >> 1) & 1) * 2 * (T_) + ((t) & 1) * (T_))
#define ATP_DMA_K(t) do { const bf16_t* tb = proj + (size_t)ATP_ROW0(t) * DINP; const int so_ = ATP_OFF(t, KT); \
        _Pragma("unroll") for (int i = 0; i < NPK; ++i) __builtin_amdgcn_global_load_lds((const unsigned*)(tb + ksoff[i]), (LAS unsigned*)(lds + so_ + kdoff[i]), 16, 0, 0); } while (0)
#define ATP_DMA_V(t) do { const bf16_t* tb = proj + (size_t)ATP_ROW0(t) * DINP; const int so_ = ATP_OFF(t, VT); \
        _Pragma("unroll") for (int i = 0; i < NPV; ++i) __builtin_amdgcn_global_load_lds((const unsigned*)(tb + vsoff[i]), (LAS unsigned*)(lds + so_ + vdoff[i]), 16, 0, 0); } while (0)
    C.m = m_init; C.l = l_init; C.exact0 = EX0;
#pragma unroll
    for (int r = 0; r < 16; ++r) C.negm[r] = -m_init;
#pragma unroll
    for (int c = 0; c < DV / 32; ++c) C.o[c] = (f32x16){0.f};
    u32x4 pa[4], pb[4];
    ATP_DMA_K(0); ATP_DMA_K(1); ATP_DMA_V(0);
    wait_bar<0>();
    if (2 < NT) { ATP_DMA_K(2); ATP_DMA_K(3); ATP_DMA_V(2); }
    ATP_DMA_V(1);
    at_step<DV, NK, false, true, false, EX0>(C, 0, ATP_OFF(0, KT), 0, pb, pa);
    at_step<DV, NK, false, true, true, EX0>(C, 1, ATP_OFF(1, KT), VRING + ATP_OFF(0, VT), pa, pb);
#pragma unroll
    for (int i_ = 0; i_ < 4; ++i_) pa[i_] = pb[i_];
    for (int t = 2; t < NT; t += 2) {
        wait_bar<0>();
        if (t + 2 < NT) { ATP_DMA_K(t + 2); ATP_DMA_K(t + 3); ATP_DMA_V(t + 2); }
        ATP_DMA_V(t + 1);
        at_step<DV, NK, false, true, true, EX0>(C, t, ATP_OFF(t, KT), VRING + ATP_OFF(t - 1, VT), pa, pb);
#pragma unroll
        for (int i_ = 0; i_ < 4; ++i_) pa[i_] = pb[i_];
        at_step<DV, NK, false, true, true, EX0>(C, t + 1, ATP_OFF(t + 1, KT), VRING + ATP_OFF(t, VT), pa, pb);
#pragma unroll
        for (int i_ = 0; i_ < 4; ++i_) pa[i_] = pb[i_];
    }
    wait_bar<0>();
    at_step<DV, NK, false, false, true, EX0>(C, NT, 0, VRING + ATP_OFF(NT - 1, VT), pa, pb);
    wait_bar<0>();
#undef ATP_ROW0
#undef ATP_OFF
#undef ATP_DMA_K
#undef ATP_DMA_V
#pragma unroll
    for (int c = 0; c < DV / 32; ++c) o[c] = C.o[c];
    l_out = C.l + __shfl_xor(C.l, 32);
}
template <int NC>
__device__ __forceinline__ void scale_rows(f32x16 (&o)[NC], float v, LAS float* scr, int r32, int hi) {
    LDS_WAIT();
    if (hi == 0) scr[r32] = v;
    LDS_WAIT();
#pragma unroll
    for (int j = 0; j < 4; ++j) { const f32x4 fv = *(const LAS f32x4*)(scr + 8 * j + 4 * hi);
#pragma unroll
        for (int c = 0; c < NC; ++c) { o[c][4 * j] *= fv[0]; o[c][4 * j + 1] *= fv[1]; o[c][4 * j + 2] *= fv[2]; o[c][4 * j + 3] *= fv[3]; } }
    LDS_WAIT();
}
constexpr int AT_A_LDS = AtGeo<64, 1>::LDS;
constexpr int AT_C_LDS = AtGeoP<128, 2>::LDS;

__device__ __forceinline__ void attnA_unit(LAS unsigned char* lds, const bf16_t* proj, bf16_t* ocat, const float* sink, int b, int g, int qb, int lat, int tid) {
    const int lane = tid & 63, r32 = lane & 31, hi = lane >> 5; const int wid = __builtin_amdgcn_readfirstlane(tid >> 6);
    const int head = g * 4 + (wid >> 1), qloc = qb * 64 + (wid & 1) * 32;
    const int qrow0 = (lat ? b * SEQ : TL + b * CTXL) + qloc;
    int nloc = 0, kt0 = 0;
    if (lat) { kt0 = qb - 2 < 0 ? 0 : qb - 2; const int kt1 = qb + 2 > 63 ? 63 : qb + 2; nloc = kt1 - kt0 + 1; }
    const int NT = nloc + 4;
    f32x16 o[2]; float l;
    attn_core<64, 1, true, false>(lds, proj, NT, nloc, b * SEQ + 64 * kt0, TL + b * CTXL, C_KA + g * 64, C_VA + g * 64,
                           proj + (size_t)(qrow0 + r32) * DINP + C_QA + head * 64, 0, qloc + r32, 64 * kt0, sink[head] * LOG2E, hi == 0 ? 1.0f : 0.0f, o, l, tid);
    LAS float* scr = (LAS float*)(lds + 3 * AtGeo<64, 1>::STAGE) + wid * 64;
    scale_rows<2>(o, __builtin_amdgcn_rcpf(l), scr, r32, hi);
    bf16_t* op = ocat + (size_t)qrow0 * OCW + head * 64 + r32;
#pragma unroll
    for (int r = 0; r < 16; ++r) { const int row = crow(r, hi);
#pragma unroll
        for (int c = 0; c < 2; ++c) op[(size_t)row * OCW + 32 * c] = (bf16_t)(pk2(o[c][r], 0.f) & 0xffffu); }
}

__device__ __forceinline__ void attnC_unit(LAS unsigned char* lds, const bf16_t* proj, bf16_t* ocat, const float* dgain, float lam, float oml, int b, int h, int qb, int lat, int tid) {
    const int lane = tid & 63, r32 = lane & 31, hi = lane >> 5; const int wid = __builtin_amdgcn_readfirstlane(tid >> 6);
    const int comp = wid >> 2, qloc = qb * 128 + (wid & 3) * 32;
    const int qrow0 = (lat ? b * SEQ : TL + b * CTXL) + qloc;
    const int nloc = lat ? 64 : 0, NT = nloc + 4;
    f32x16 o[4]; float l;
    attn_core_pair<128, 2, true>(lds, proj, NT, nloc, b * SEQ, TL + b * CTXL, C_KD + h * 128, C_VD + h * 128,
                           proj + (size_t)(qrow0 + r32) * DINP + C_QD + h * 128 + comp * 64, comp, 0.0f, 0.0f, o, l, tid);
    LAS float* scr = (LAS float*)(lds + AtGeoP<128, 2>::SCR) + wid * 64;
    scale_rows<4>(o, __builtin_amdgcn_rcpf(l), scr, r32, hi);
    LAS float* X = (LAS float*)lds + (wid & 3) * 4096;
    if (comp == 1) {
#pragma unroll
        for (int c = 0; c < 4; ++c)
#pragma unroll
            for (int r = 0; r < 16; ++r) X[(c * 16 + r) * 64 + lane] = o[c][r];
    }
    __syncthreads();
    if (comp == 0) {
        float ss[16];
#pragma unroll
        for (int r = 0; r < 16; ++r) ss[r] = 0.f;
#pragma unroll
        for (int c = 0; c < 4; ++c)
#pragma unroll
            for (int r = 0; r < 16; ++r) { const float v = o[c][r] - lam * X[(c * 16 + r) * 64 + lane]; o[c][r] = v; ss[r] += v * v; }
#pragma unroll
        for (int r = 0; r < 16; ++r) {
#pragma unroll
            for (int s = 1; s < 32; s <<= 1) ss[r] += __shfl_xor(ss[r], s);
            ss[r] = __builtin_amdgcn_rsqf(ss[r] * (1.0f / 128.0f) + NORM_EPS) * oml;
        }
        bf16_t* op = ocat + (size_t)qrow0 * OCW + 1024 + h * 128 + r32;
#pragma unroll
        for (int c = 0; c < 4; ++c) { const float gn = dgain[32 * c + r32];
#pragma unroll
            for (int r = 0; r < 16; ++r) op[(size_t)crow(r, hi) * OCW + 32 * c] = (bf16_t)(pk2(o[c][r] * ss[r] * gn, 0.f) & 0xffffu); }
    }
    __syncthreads();
}
__device__ __forceinline__ int chunk_row0(int b, int ci) { return ci < 2 ? TL + b * CTXL + ci * 128 : b * SEQ + (ci - 2) * 128; }
constexpr int RSTR = 192;
constexpr int VSTR128 = 320;
constexpr int R1_LDS = 2 * 128 * RSTR + 128 * VSTR128;
__device__ __forceinline__ void ret_kv_phase(LAS unsigned char* lds, const bf16_t* __restrict__ proj, bf16_t* kvT, const float* lg2, int blk, int G, int tid) {
    const int lane = tid & 63, hi = lane >> 5; const int wid = __builtin_amdgcn_readfirstlane(tid >> 6);
    LAS unsigned char* Kf = lds; LAS unsigned char* Kb = lds + 128 * RSTR; LAS unsigned char* Vt = lds + 2 * 128 * RSTR;
    constexpr int NU = NB * 4 * NCHK;
    int u = blk; if (u >= NU) return;
    u32x4 kreg[2], vreg[4];
#define R1_LOAD(uu) do { const int ci_ = (uu) % NCHK, bh_ = (uu) / NCHK, row0_ = chunk_row0(bh_ >> 2, ci_), h_ = bh_ & 3; \
        _Pragma("unroll") for (int i = 0; i < 2; ++i) { const int c = tid + 512 * i, k = c >> 3, ch = c & 7; kreg[i] = *(const u32x4*)(proj + (size_t)(row0_ + k) * DINP + C_KB + h_ * 64 + ch * 8); } \
        _Pragma("unroll") for (int i = 0; i < 4; ++i) { const int c = tid + 512 * i, k = c >> 4, ch = c & 15; vreg[i] = *(const u32x4*)(proj + (size_t)(row0_ + k) * DINP + C_VB + h_ * 128 + ch * 8); } } while (0)
    R1_LOAD(u);
    for (;;) {
        const int ci = u % NCHK, bh = u / NCHK, b = bh >> 2, h = bh & 3;
        const float lgf2 = lg2[h], lgb2 = lg2[4 + h];
#pragma unroll
        for (int i = 0; i < 2; ++i) { const int c = tid + 512 * i, k = c >> 3, ch = c & 7;
            const u32x4 v = kreg[i];
            const float wf = fexp2((float)(127 - k) * lgf2), wb = fexp2((float)k * lgb2);
            u32x4 a, d;
#pragma unroll
            for (int j = 0; j < 4; ++j) { const float x0 = bf_lo(v[j]), x1 = bf_hi(v[j]); a[j] = pk2(x0 * wf, x1 * wf); d[j] = pk2(x0 * wb, x1 * wb); }
            *(LAS u32x4*)(Kf + k * RSTR + ch * 16) = a; *(LAS u32x4*)(Kb + k * RSTR + ch * 16) = d; }
#pragma unroll
        for (int i = 0; i < 4; ++i) { const int c = tid + 512 * i, k = c >> 4, ch = c & 15; *(LAS u32x4*)(Vt + k * VSTR128 + ch * 16) = vreg[i]; }
        __syncthreads();
        const int un = u + G;
        if (un < NU) R1_LOAD(un);
        const int dir = wid >> 2, mt = (wid >> 1) & 1, nt0 = (wid & 1) * 2;
        const LAS unsigned char* Kt = dir ? Kb : Kf;
        f32x16 acc0 = (f32x16){0.f}, acc1 = (f32x16){0.f};
#pragma unroll
        for (int ks = 0; ks < 8; ++ks) {
            const bf16x8 af = tr_frag(Kt, RSTR, ks, 32 * mt, lane);
            acc0 = MFMA32(af, tr_frag(Vt, VSTR128, ks, 32 * nt0, lane), acc0);
            acc1 = MFMA32(af, tr_frag(Vt, VSTR128, ks, 32 * nt0 + 32, lane), acc1);
        }
        bf16_t* out = kvT + ((size_t)(((b * 4 + h) * NCHK + ci) * 2 + dir)) * 8192;
#pragma unroll
        for (int j = 0; j < 4; ++j) {
            u32x2 w0, w1; w0.x = pk2(acc0[4 * j], acc0[4 * j + 1]); w0.y = pk2(acc0[4 * j + 2], acc0[4 * j + 3]); w1.x = pk2(acc1[4 * j], acc1[4 * j + 1]); w1.y = pk2(acc1[4 * j + 2], acc1[4 * j + 3]);
            *(u32x2*)(out + (size_t)(32 * nt0 + (lane & 31)) * 64 + 32 * mt + 8 * j + 4 * hi) = w0;
            *(u32x2*)(out + (size_t)(32 * nt0 + 32 + (lane & 31)) * 64 + 32 * mt + 8 * j + 4 * hi) = w1;
        }
        __syncthreads();
        if (un >= NU) break;
        u = un;
    }
#undef R1_LOAD
}
__device__ __forceinline__ void ret_scan(const bf16_t* kvT, bf16_t* SpT, const float* lg2  , int gtid, int gthreads) {
    for (int q = gtid; q < 64 * 2048; q += gthreads) {
        const int combo = q >> 11, e4 = (q & 2047) * 4, dir = combo & 1, h = (combo >> 1) & 3, b = combo >> 3;
        const float g128 = fexp2(128.0f * lg2[dir * 4 + h]);
        f32x4 S = {0.f, 0.f, 0.f, 0.f};
        for (int s = 0; s < NCHK; ++s) {
            const int ci = dir ? (s == 0 ? 1 : (s == 1 ? 0 : 35 - s)) : s;
            const size_t off = ((size_t)(((b * 4 + h) * NCHK + ci) * 2 + dir)) * 8192 + e4;
            const u32x2 kw = *(const u32x2*)(kvT + off); const f32x4 kv = {bf_lo(kw.x), bf_hi(kw.x), bf_lo(kw.y), bf_hi(kw.y)};
            u32x2 w; w.x = pk2(S[0], S[1]); w.y = pk2(S[2], S[3]);
            *(u32x2*)(SpT + off) = w;
            S = S * g128 + kv;
        }
    }
}
constexpr int R3_K = 0, R3_V = 128 * KSTR, R3_SF = R3_V + 128 * VSTR128, R3_SB = R3_SF + 128 * KSTR, R3_X = R3_SB + 128 * KSTR, R3_SCR = R3_X + 1024, R3_LDS = R3_SCR + 2048;
__device__ __forceinline__ void ret_out_unit(LAS unsigned char* lds, const bf16_t* __restrict__ proj, const bf16_t* __restrict__ SpT, bf16_t* ocat, float lgf2, float lgb2, int b, int h, int ci, int tid) {
    const int lane = tid & 63, r32 = lane & 31, hi = lane >> 5; const int wid = __builtin_amdgcn_readfirstlane(tid >> 6);
    const int row0 = chunk_row0(b, ci), qs = wid & 3, dh = wid >> 2;
    const bf16_t* sp = SpT + ((size_t)(((b * 4 + h) * NCHK + ci) * 2)) * 8192;
#pragma unroll
    for (int i = 0; i < 2; ++i) { const int c = tid + 512 * i, k = c >> 3, ch = c & 7;
        *(LAS u32x4*)(lds + R3_K + k * KSTR + ch * 16) = *(const u32x4*)(proj + (size_t)(row0 + k) * DINP + C_KB + h * 64 + ch * 8);
        *(LAS u32x4*)(lds + R3_SF + k * KSTR + ch * 16) = *(const u32x4*)(sp + (size_t)k * 64 + ch * 8);
        *(LAS u32x4*)(lds + R3_SB + k * KSTR + ch * 16) = *(const u32x4*)(sp + 8192 + (size_t)k * 64 + ch * 8); }
#pragma unroll
    for (int i = 0; i < 4; ++i) { const int c = tid + 512 * i, k = c >> 4, ch = c & 15;
        *(LAS u32x4*)(lds + R3_V + k * VSTR128 + ch * 16) = *(const u32x4*)(proj + (size_t)(row0 + k) * DINP + C_VB + h * 128 + ch * 8); }
    bf16x8 qr[4];
    { const bf16_t* qp = proj + (size_t)(row0 + 32 * qs + r32) * DINP + C_QB + h * 64;
#pragma unroll
      for (int d0 = 0; d0 < 4; ++d0) qr[d0] = *(const bf16x8*)(qp + d0 * 16 + hi * 8); }
    bf16_t gt[2][16];
    { const bf16_t* gp0 = proj + (size_t)(row0 + 32 * qs) * DINP + C_GB + h * 128 + 64 * dh + r32;
#pragma unroll
      for (int r = 0; r < 16; ++r)
#pragma unroll
          for (int c = 0; c < 2; ++c) gt[c][r] = gp0[(size_t)crow(r, hi) * DINP + 32 * c]; }
    __syncthreads();
    f32x16 o[2];
#pragma unroll
    for (int c = 0; c < 2; ++c) {
        f32x16 tf = (f32x16){0.f}, tb = (f32x16){0.f};
        const int srow = 64 * dh + 32 * c + r32;
#pragma unroll
        for (int d0 = 0; d0 < 4; ++d0) {
            tf = MFMA32(qr[d0], *(const LAS bf16x8*)(lds + R3_SF + srow * KSTR + (16 * d0 + 8 * hi) * 2), tf);
            tb = MFMA32(qr[d0], *(const LAS bf16x8*)(lds + R3_SB + srow * KSTR + (16 * d0 + 8 * hi) * 2), tb);
        }
#pragma unroll
        for (int r = 0; r < 16; ++r) { const int cp = 32 * qs + crow(r, hi); o[c][r] = fexp2((float)(cp + 1) * lgf2) * tf[r] + fexp2((float)(128 - cp) * lgb2) * tb[r]; }
    }
    const int qpos = 32 * qs + r32;
#pragma unroll 1
    for (int kt = 0; kt < 4; ++kt) {
        f32x16 p = (f32x16){0.f};
#pragma unroll
        for (int d0 = 0; d0 < 4; ++d0) p = MFMA32(*(const LAS bf16x8*)(lds + R3_K + (32 * kt + r32) * KSTR + (16 * d0 + 8 * hi) * 2), qr[d0], p);
#pragma unroll
        for (int r = 0; r < 16; ++r) { const int d = qpos - (32 * kt + crow(r, hi));
            const float wf = d >= 0 ? fexp2((float)d * lgf2) : 0.f, wb = d <= 0 ? fexp2((float)(-d) * lgb2) : 0.f; p[r] *= (wf + wb); }
        u32x4 w0, w1;
        w0.x = pk2(p[0], p[1]); w0.y = pk2(p[2], p[3]); w0.z = pk2(p[4], p[5]); w0.w = pk2(p[6], p[7]);
        w1.x = pk2(p[8], p[9]); w1.y = pk2(p[10], p[11]); w1.z = pk2(p[12], p[13]); w1.w = pk2(p[14], p[15]);
        const bf16x8 pa = __builtin_bit_cast(bf16x8, w0), pb = __builtin_bit_cast(bf16x8, w1);
#pragma unroll
        for (int c = 0; c < 2; ++c) {
            o[c] = MFMA32(pa, tr_frag(lds + R3_V, VSTR128, 2 * kt, 64 * dh + 32 * c, lane), o[c]);
            o[c] = MFMA32(pb, tr_frag(lds + R3_V, VSTR128, 2 * kt + 1, 64 * dh + 32 * c, lane), o[c]);
        }
    }
    float ss[16];
#pragma unroll
    for (int r = 0; r < 16; ++r) { ss[r] = o[0][r] * o[0][r] + o[1][r] * o[1][r];
#pragma unroll
        for (int s = 1; s < 32; s <<= 1) ss[r] += __shfl_xor(ss[r], s); }
    LAS float* X = (LAS float*)(lds + R3_X);
    if (r32 == 0) {
#pragma unroll
        for (int r = 0; r < 16; ++r) X[dh * 128 + 32 * qs + crow(r, hi)] = ss[r];
    }
    __syncthreads();
    bf16_t* op = ocat + (size_t)(row0 + 32 * qs) * OCW + 512 + h * 128 + 64 * dh + r32;
#pragma unroll
    for (int r = 0; r < 16; ++r) { const int row = crow(r, hi);
        const float rstd = __builtin_amdgcn_rsqf((X[32 * qs + row] + X[128 + 32 * qs + row]) * (1.0f / 128.0f) + NORM_EPS);
#pragma unroll
        for (int c = 0; c < 2; ++c) { const float gte = bf1(gt[c][r]);
            op[(size_t)row * OCW + 32 * c] = (bf16_t)(pk2(o[c][r] * rstd * siluf_(gte), 0.f) & 0xffffu); } }
    __syncthreads();
}
#undef MFMA32
}
constexpr size_t MiB = 1u << 20;
constexpr size_t WS_CTL = 0, CTL_ZERO_BYTES = 128 * 1024;
constexpr int CW_BAR = 1024;
constexpr int CW_MOE = 8192;
constexpr int CW_CUR = 12288;
constexpr int CW_DEP = 20480;
constexpr int CW_DONE = 16384;
constexpr size_t WS_TAB = 1 * MiB;
constexpr int TAB_MOD = 0, TAB_ROPE = DEPTH * 9 * 6144, TAB_LAM = TAB_ROPE + 2048, TAB_LG2 = TAB_LAM + 8, TAB_WSC = TAB_LG2 + 32;
constexpr size_t WS_XC = 2 * MiB;
constexpr size_t WS_ROUTE = 10 * MiB;
constexpr size_t WS_RS = 11 * MiB + 256 * 1024;
constexpr size_t WS_RSS = 11 * MiB + 512 * 1024;
constexpr size_t WS_MIX = 12 * MiB, MIX_STRIDE = 19 * MiB;
constexpr size_t MIX_WB = 14 * MiB, MIX_WO = 17 * MiB;
constexpr size_t WS_FD = 88 * MiB, FD_STRIDE = 17 * MiB, FD_W2 = 11 * MiB;
constexpr size_t WS_W13 = 122 * MiB;
constexpr size_t WS_W2 = 166 * MiB;
constexpr size_t WS_XB = 188 * MiB;
constexpr size_t WS_H = 254 * MiB;
constexpr size_t WS_PROJ = 322 * MiB;
constexpr size_t WS_GATE = WS_PROJ + 256 * MiB;
constexpr size_t WS_OCAT = 782 * MiB;
constexpr size_t WS_Y = 884 * MiB;
constexpr size_t WS_END = 952 * MiB;
static_assert((size_t)DIN * DM * 2 <= MIX_WB && MIX_WB + (size_t)DM * OCW * 2 <= MIX_WO && MIX_WO + (size_t)DM * DM * 2 <= MIX_STRIDE && WS_MIX + DEPTH * MIX_STRIDE <= WS_FD, "ws map (mixer weights)");
static_assert((size_t)2 * DFF * DM * 2 <= FD_W2 && FD_W2 + (size_t)DM * DFF * 2 <= FD_STRIDE && WS_FD + 2 * FD_STRIDE <= WS_W13, "ws map (dense ffn weights)");
static_assert(WS_W13 + (size_t)NEXP * 2 * DFF * DM <= WS_W2 && WS_W2 + (size_t)NEXP * DM * DFF <= WS_XB && WS_XB + (size_t)TL * DM * 2 <= WS_H && WS_H + (size_t)TT * DM * 2 <= WS_PROJ, "ws map (moe weights, x, h)");
static_assert(WS_PROJ + (size_t)TT * DINP * 2 <= WS_GATE && WS_GATE + (size_t)3 * NMT * 4 * 8 * 16 * 64 * 16 <= WS_OCAT && WS_OCAT + (size_t)TT * OCW * 2 <= WS_Y && WS_Y + (size_t)TT * DM * 2 <= WS_END, "ws map (activations)");
constexpr int MOE_SLOTS = 2 * TT + NEXP * 256;
static_assert(WS_PROJ + (size_t)MOE_SLOTS * DFF * 2 <= WS_OCAT && WS_OCAT + (size_t)MOE_SLOTS * DM * 2 <= WS_END, "ws map (MoE overlays)");
static_assert((size_t)NB * 4 * NCHK * 2 * 8192 * 4 <= (size_t)TT * DM * 2 && (size_t)NB * 4 * NCHK * 2 * 8192 * 2 <= (size_t)TT * DM * 2, "ws map (retention overlays)");

#define XB_TMO      128
#define XB_XCNT(j)  (256  + 64 * (j))
#define XB_XSUB(j)  (1280 + 64 * (j))
#define XB_XGEN(j)  (2304 + 64 * (j))
#define XB_TOP      3328
#define XB_TOPGEN   3392
#define XCD_BAR_WORDS 3456
#define XB_SPIN_CAP (1u << 18)

__device__ __forceinline__ unsigned xb_ld(unsigned* p)              { return __hip_atomic_load(p, __ATOMIC_RELAXED, __HIP_MEMORY_SCOPE_AGENT); }
__device__ __forceinline__ unsigned xb_add(unsigned* p, unsigned v) { return __hip_atomic_fetch_add(p, v, __ATOMIC_RELAXED, __HIP_MEMORY_SCOPE_AGENT); }
__device__ __forceinline__ unsigned xb_xcc_id() { return (unsigned)__builtin_amdgcn_s_getreg((3 << 11) | 20) & 0xFu; }
#define XB_SPIN(cond, bar) do { unsigned _sp = 0; while (cond) { __builtin_amdgcn_s_sleep(1); \
    if ((++_sp & 255u) == 0u) { if (xb_ld(&(bar)[XB_TMO])) break; if (_sp > XB_SPIN_CAP) { atomicAdd(&(bar)[XB_TMO], 1u); break; } } } } while (0)

struct XcdBarrier {
    unsigned* bar; unsigned x;
    volatile LAS unsigned* st;
};
__device__ __forceinline__ XcdBarrier xcd_barrier_post(unsigned* bar, volatile LAS unsigned* st, int tid) {
    XcdBarrier b; b.bar = bar; b.x = xb_xcc_id(); b.st = st;
    if (tid == 0) (void)xb_add(&bar[XB_XCNT(b.x)], 1u);
    return b;
}
__device__ __forceinline__ void xcd_barrier_complete(unsigned* bar, unsigned x, unsigned& nloc, unsigned& nx) {
    const unsigned G = gridDim.x * gridDim.y * gridDim.z;
    unsigned sum, cnt, mine, sp = 0u;
    for (;;) {
        sum = 0u; cnt = 0u; mine = 0u;
#pragma unroll
        for (unsigned j = 0; j < 16; ++j) { const unsigned c = xb_ld(&bar[XB_XCNT(j)]); sum += c; cnt += (c > 0u) ? 1u : 0u; mine = (j == x) ? c : mine; }
        if (sum == G) break;
        __builtin_amdgcn_s_sleep(1);
        if ((++sp & 255u) == 0u) { if (xb_ld(&bar[XB_TMO])) break; if (sp > XB_SPIN_CAP) { atomicAdd(&bar[XB_TMO], 1u); break; } }
    }
    nloc = mine > 0u ? mine : 1u; nx = cnt > 0u ? cnt : 1u;
}
__device__ __forceinline__ void xcd_barrier(const XcdBarrier& b_in, int tid) {
    XcdBarrier b = b_in; b.x = xb_xcc_id();
    asm volatile("s_waitcnt vmcnt(0)" ::: "memory");
    __syncthreads();
    if (tid == 0) {
        unsigned* bar = b.bar; asm volatile("" : "+s"(bar));
        __builtin_amdgcn_s_waitcnt(0);
        unsigned nloc = b.st[0], nx = b.st[1];
        if (nloc == 0u) { xcd_barrier_complete(bar, b.x, nloc, nx); b.st[0] = nloc; b.st[1] = nx; }
        const unsigned old = xb_add(&bar[XB_XSUB(b.x)], 1u);
        const unsigned gen = old / nloc;
        if (old + 1u == (gen + 1u) * nloc) {
            __builtin_amdgcn_fence(__ATOMIC_RELEASE, "agent");
            asm volatile("s_waitcnt vmcnt(0)" ::: "memory");
            const unsigned og = xb_add(&bar[XB_TOP], 1u);
            const unsigned tg = og / nx;
            if (og + 1u == (tg + 1u) * nx) xb_add(&bar[XB_TOPGEN], 1u);
            else XB_SPIN(xb_ld(&bar[XB_TOPGEN]) == tg, bar);
            __builtin_amdgcn_fence(__ATOMIC_ACQUIRE, "agent");
            xb_add(&bar[XB_XGEN(b.x)], 1u);
            asm volatile("s_waitcnt vmcnt(0)" ::: "memory");
        } else {
            XB_SPIN(xb_ld(&bar[XB_XGEN(b.x)]) == gen, bar);
            __builtin_amdgcn_fence(__ATOMIC_ACQUIRE, "agent");
            asm volatile("s_waitcnt vmcnt(0)" ::: "memory");
        }
    }
    __syncthreads();
}
struct Route { int sa, sb; float ga, gb; int ea, pa, eb, pb; };

__device__ __forceinline__ void p0_mod(LAS unsigned char* lds, const float* c, const float* cctx, const float* wmod, const float* bmod, float* mod, int blk, int G, int tid) {
    LAS float* sc = (LAS float*)lds;
    LAS float* red = sc + 9 * 1024;
    for (int i = tid; i < 9 * 1024; i += 512) { const float v = i < 8192 ? c[i] : cctx[i - 8192]; sc[i] = siluf_(v); }
    __syncthreads();
    const int cq = tid & 31, kg = tid >> 5;
    for (int u = blk; u < DEPTH * 48; u += G) {
        const int l = u / 48, n = (u % 48) * 128 + 4 * cq;
        f32x4 acc[9];
#pragma unroll
        for (int r = 0; r < 9; ++r) acc[r] = (f32x4){0.f, 0.f, 0.f, 0.f};
        const float* wp = wmod + ((size_t)l * DM + kg * 64) * 6144 + n;
        for (int k0 = 0; k0 < 64; k0 += 16) {
            f32x4 w[16];
#pragma unroll
            for (int k = 0; k < 16; ++k) w[k] = *(const f32x4*)(wp + (size_t)(k0 + k) * 6144);
#pragma unroll
            for (int k = 0; k < 16; ++k)
#pragma unroll
                for (int r = 0; r < 9; ++r) acc[r] += w[k] * sc[r * 1024 + kg * 64 + k0 + k];
        }
#pragma unroll
        for (int r = 0; r < 9; ++r) *(LAS f32x4*)(red + ((kg * 32 + cq) * 9 + r) * 4) = acc[r];
        __syncthreads();
        if (tid < 32 * 9) { const int q = tid / 9, r = tid % 9; f32x4 s = {0.f, 0.f, 0.f, 0.f};
#pragma unroll
            for (int g = 0; g < 16; ++g) s += *(const LAS f32x4*)(red + ((g * 32 + q) * 9 + r) * 4);
            const int nn = (u % 48) * 128 + 4 * q;
            *(f32x4*)(mod + ((size_t)l * 9 + r) * 6144 + nn) = s + *(const f32x4*)(bmod + (size_t)l * 6144 + nn); }
        __syncthreads();
    }
}
__device__ __forceinline__ void p0_tables(float* tab, const float* dlam, const float* decf, const float* decb, int tid) {
    for (int i = tid; i < 1024; i += 512) { const int pos = i >> 4, f = i & 15;
        const float inv = 1.0f / powf(10000.0f, (float)f / 16.0f), ang = (float)pos * inv;
        tab[TAB_ROPE + 2 * i] = cosf(ang); tab[TAB_ROPE + 2 * i + 1] = sinf(ang); }
    if (tid < 4) { const float* lp = dlam + tid * 256; float s01 = 0.f, s23 = 0.f;
        for (int k = 0; k < 64; ++k) { s01 += lp[k] * lp[64 + k]; s23 += lp[128 + k] * lp[192 + k]; }
        const float li = 0.8f - 0.6f * expf(-0.3f * (float)tid);
        tab[TAB_LAM + 2 * tid] = expf(s01) - expf(s23) + li; tab[TAB_LAM + 2 * tid + 1] = 1.0f - li; }
    if (tid >= 64 && tid < 96) { const int i = tid - 64, l = i >> 3, dir = (i >> 2) & 1, h = i & 3;
        const float x = (dir ? decb : decf)[l * 4 + h];
        tab[TAB_LG2 + i] = -log1pf(expf(-x)) * LOG2E; }
}

__device__ __forceinline__ float sample_rms(const float* W, int n, LAS float* red, int tid) {
    const int stride = n / 16384 - 1; float s = 0.f; float v[32];
#pragma unroll
    for (int i = 0; i < 32; ++i) v[i] = W[(size_t)(tid * 32 + i) * stride];
#pragma unroll
    for (int i = 0; i < 32; ++i) s += v[i] * v[i];
    s = wave_sum(s);
    __syncthreads(); if ((tid & 63) == 0) red[tid >> 6] = s; __syncthreads();
    float t = 0.f;
#pragma unroll
    for (int w = 0; w < 8; ++w) t += red[w];
    __syncthreads();
    return sqrtf(t * (1.0f / 16384.0f));
}
struct CvtD { const float* src; unsigned char* dst; int ldw; int mode; float scale; };
__device__ __forceinline__ CvtD cvt_desc(const float* W, int ldw, int k0, int sc, unsigned char* WTrow0  , int ldt_bytes, int mode, float scale, int lane) {
    const int n = lane & 31, hi = lane >> 5; CvtD d;
    d.src = W + (size_t)(k0 + 32 * hi) * ldw + sc; d.ldw = ldw; d.mode = mode; d.scale = scale;
    d.dst = WTrow0 + (size_t)n * ldt_bytes + 32 * hi * (mode == 0 ? 2 : 1); return d;
}
__device__ __forceinline__ void cvt_load(const CvtD& d, float (&v)[32]) {
#pragma unroll
    for (int i = 0; i < 32; ++i) v[i] = __builtin_nontemporal_load(d.src + (size_t)i * d.ldw);
}
__device__ __forceinline__ void cvt_store(const CvtD& d, const float (&v)[32]) {
    if (d.mode == 0) {
#pragma unroll
        for (int q = 0; q < 4; ++q) { u32x4 o; o.x = pk2(v[8 * q], v[8 * q + 1]); o.y = pk2(v[8 * q + 2], v[8 * q + 3]); o.z = pk2(v[8 * q + 4], v[8 * q + 5]); o.w = pk2(v[8 * q + 6], v[8 * q + 7]);
            *(u32x4*)(d.dst + 16 * q) = o; }
    } else if (d.mode == 1) { const float sc = d.scale;
#pragma unroll
        for (int q = 0; q < 2; ++q) { u32x4 o;
#define F4_(b) pk4f8(v[b] * sc, v[(b) + 1] * sc, v[(b) + 2] * sc, v[(b) + 3] * sc)
            o.x = F4_(16 * q); o.y = F4_(16 * q + 4); o.z = F4_(16 * q + 8); o.w = F4_(16 * q + 12);
#undef F4_
            *(u32x4*)(d.dst + 16 * q) = o; }
    } else { const float sc = d.scale;
#pragma unroll
        for (int q = 0; q < 2; ++q) { u32x4 o;
#define CL_(x) __builtin_amdgcn_fmed3f((x) * sc, -127.0f, 127.0f)
#define I4_(b) pk4i8(CL_(v[b]), CL_(v[(b) + 1]), CL_(v[(b) + 2]), CL_(v[(b) + 3]))
            o.x = I4_(16 * q); o.y = I4_(16 * q + 4); o.z = I4_(16 * q + 8); o.w = I4_(16 * q + 12);
#undef I4_
#undef CL_
            *(u32x4*)(d.dst + 16 * q) = o; }
    }
}
__device__ __forceinline__ int win_src(int n) {
    const bool rp = (n < 640) || (n >= 768 && n < 1280) || (n >= 2304 && n < 3328);
    if (!rp) return n;
    const int p = n & 63, j = p >> 1, e = p & 1;
    return (n & ~63) + (j >> 4) * 32 + e * 16 + (j & 15);
}
constexpr int I_IN = 16 * 216, I_B = 3 * 8 * 32, I_O = 16 * 32, I_MIX = I_IN + I_B + I_O, I_F1 = 16 * 88, I_F2 = 44 * 32, I_FE = 2 * I_F1 + I_F2;
__device__ __forceinline__ CvtD mix_desc(const float* win, const float* wb, const float* wo, unsigned char* mixbase, int r, float qs_in, int lane) {
    if (r < I_IN) { const int kb = r / 216, nb = r % 216; return cvt_desc(win, DIN, 64 * kb, win_src(32 * nb + (lane & 31)), mixbase + (size_t)(32 * nb) * DM + 64 * kb, DM, 2, qs_in, lane); } r -= I_IN;
    if (r < I_B) { const int i = r / 256, q = r % 256, kb = q / 32, nb = q % 32;
        return cvt_desc(wb + (size_t)i * 512 * DM, DM, 64 * kb, 32 * nb + (lane & 31), mixbase + MIX_WB + ((size_t)(32 * nb) * OCW + i * 512 + 64 * kb) * 2, OCW * 2, 0, 1.0f, lane); } r -= I_B;
    { const int kb = r / 32, nb = r % 32; return cvt_desc(wo, DM, 64 * kb, 32 * nb + (lane & 31), mixbase + MIX_WO + ((size_t)(32 * nb) * DM + 64 * kb) * 2, DM * 2, 0, 1.0f, lane); }
}
__device__ __forceinline__ CvtD ffn_desc(const float* f1, const float* f3, const float* f2, unsigned char* w13, unsigned char* w2, int r, float qs1, float qs3, int f8dn, int lane) {
    if (r < 2 * I_F1) { const int which = r / I_F1, q = r % I_F1, kb = q / 88, nb = q % 88, j0 = 32 * nb;
        const int drow = (j0 >> 7) * 256 + which * 128 + (j0 & 127);
        return cvt_desc(which ? f3 : f1, DFF, 64 * kb, j0 + (lane & 31), w13 + (size_t)drow * DM + 64 * kb, DM, 2, which ? qs3 : qs1, lane); } r -= 2 * I_F1;
    { const int kb = r / 32, nb = r % 32;
        if (f8dn) return cvt_desc(f2, DM, 64 * kb, 32 * nb + (lane & 31), w2 + (size_t)(32 * nb) * DFF + 64 * kb, DFF, 1, F8_SW2, lane);
        return cvt_desc(f2, DM, 64 * kb, 32 * nb + (lane & 31), w2 + ((size_t)(32 * nb) * DFF + 64 * kb) * 2, DFF * 2, 0, 1.0f, lane); }
}
constexpr int N_RANGES = 7;
__device__ __forceinline__ int range_items(int k) { return (k == 0 || k == 4) ? I_FE : (k == 3 || k == 6) ? NEXP * I_FE : I_MIX; }
__device__ __forceinline__ CvtD range_desc(int k, int r, LAS unsigned char* lds, unsigned char* ws, int lane);

__device__ __forceinline__ void norm_rows(LAS unsigned char* lds, const void* xinL, const void* xinC, int in32, bf16_t* xoutL, bf16_t* xoutC, const float* gain, const float* mod, const float* modc, int shoff,
                                          bf16_t* hout, int qmode, float* rsout, int nrows, int combine, const Route* route, const bf16_t* fbuf, const float* wrouter, int do_route, Route* route_out, unsigned* gcnt,
                                          int blk, int G, int wave, int lane, int tid) {
    LAS float* wr = (LAS float*)lds;
    LAS int* lcnt = (LAS int*)(lds + 32768);
    LAS int* rec = (LAS int*)(lds + 32768 + 64);
    if (do_route) { for (int i = tid; i < 8192; i += 512) wr[i] = wrouter[i]; }
    const int per = (nrows + G - 1) / G, r0 = blk * per, r1 = (r0 + per < nrows) ? r0 + per : nrows;
    for (int cs = r0; cs < r1; cs += 256) {
        const int ce = cs + 256 < r1 ? cs + 256 : r1;
        if (do_route) { if (tid < 8) lcnt[tid] = 0; __syncthreads(); }
        u32x4 vn[4];
#define NR_LOAD(rr) do { const size_t ro_ = (rr) < TL ? (size_t)(rr) * DM : (size_t)((rr) - TL) * DM; const void* xb_ = (rr) < TL ? xinL : xinC; \
            if (in32) { _Pragma("unroll") for (int j = 0; j < 4; ++j) vn[j] = *(const u32x4*)((const float*)xb_ + ro_ + 4 * lane + 256 * j); } \
            else { _Pragma("unroll") for (int j = 0; j < 4; ++j) { const u32x2 t_ = *(const u32x2*)((const bf16_t*)xb_ + ro_ + 4 * lane + 256 * j); vn[j].x = t_.x; vn[j].y = t_.y; } } } while (0)
        if (cs + wave < ce) NR_LOAD(cs + wave);
        for (int row = cs + wave; row < ce; row += 8) {
            const bool lat = row < TL; const int mb = lat ? (row >> 12) : 8;
            f32x4 v[4];
#pragma unroll
            for (int j = 0; j < 4; ++j) v[j] = in32 ? __builtin_bit_cast(f32x4, vn[j]) : (f32x4){bf_lo(vn[j].x), bf_hi(vn[j].x), bf_lo(vn[j].y), bf_hi(vn[j].y)};
            if (row + 8 < ce) NR_LOAD(row + 8);
            if (combine) {
                const Route rt = route[row]; const float* g2 = modc + mb * 6144 + 5120;
                bf16_t* xo = lat ? xoutL + (size_t)row * DM : xoutC + (size_t)(row - TL) * DM;
#pragma unroll
                for (int j = 0; j < 4; ++j) { const int col = 4 * lane + 256 * j;
                    const u32x2 fa = *(const u32x2*)(fbuf + (size_t)rt.sa * DM + col), fb = *(const u32x2*)(fbuf + (size_t)rt.sb * DM + col);
                    const f32x4 gg = *(const f32x4*)(g2 + col);
                    v[j][0] += gg[0] * (rt.ga * bf_lo(fa.x) + rt.gb * bf_lo(fb.x)); v[j][1] += gg[1] * (rt.ga * bf_hi(fa.x) + rt.gb * bf_hi(fb.x));
                    v[j][2] += gg[2] * (rt.ga * bf_lo(fa.y) + rt.gb * bf_lo(fb.y)); v[j][3] += gg[3] * (rt.ga * bf_hi(fa.y) + rt.gb * bf_hi(fb.y));
                    u32x2 w_; w_.x = pk2(v[j][0], v[j][1]); w_.y = pk2(v[j][2], v[j][3]); *(u32x2*)(xo + col) = w_;
                    v[j] = (f32x4){bf_lo(w_.x), bf_hi(w_.x), bf_lo(w_.y), bf_hi(w_.y)}; }
            }
            float s = 0.f;
#pragma unroll
            for (int j = 0; j < 4; ++j) s += (v[j][0] * v[j][0] + v[j][1] * v[j][1]) + (v[j][2] * v[j][2] + v[j][3] * v[j][3]);
            const float rstd = 1.0f / sqrtf(wave_sum(s) * (1.0f / DM) + NORM_EPS);
            const float* sh = mod + mb * 6144 + shoff; const float* scp = sh + 1024;
            float lg[8];
#pragma unroll
            for (int e = 0; e < 8; ++e) lg[e] = 0.f;
            float qs = 1.0f;
            if (qmode == 2) {
                float am = 0.f;
#pragma unroll
                for (int j = 0; j < 4; ++j) { const int col = 4 * lane + 256 * j;
                    const f32x4 gn = *(const f32x4*)(gain + col), s1 = *(const f32x4*)(scp + col), s0 = *(const f32x4*)(sh + col);
#pragma unroll
                    for (int k = 0; k < 4; ++k) am = fmaxf(am, fabsf(v[j][k] * rstd * gn[k] * (1.0f + s1[k]) + s0[k])); }
                am = fmaxf(wave_max(am), 1.0e-20f); qs = 127.0f / am;
                if (lane == 0) rsout[row] = am * (1.0f / 127.0f);
            }
#pragma unroll
            for (int j = 0; j < 4; ++j) { const int col = 4 * lane + 256 * j;
                const f32x4 gn = *(const f32x4*)(gain + col), s1 = *(const f32x4*)(scp + col), s0 = *(const f32x4*)(sh + col);
                f32x4 hv;
#pragma unroll
                for (int k = 0; k < 4; ++k) hv[k] = v[j][k] * rstd * gn[k] * (1.0f + s1[k]) + s0[k];
                if (qmode == 2) *(unsigned*)((unsigned char*)hout + (size_t)row * DM + col) = pk4i8(fminf(hv[0] * qs, 127.0f), fminf(hv[1] * qs, 127.0f), fminf(hv[2] * qs, 127.0f), fminf(hv[3] * qs, 127.0f));
                else if (qmode == 1) *(unsigned*)((unsigned char*)hout + (size_t)row * DM + col) = pk4f8(hv[0] * F8_SH, hv[1] * F8_SH, hv[2] * F8_SH, hv[3] * F8_SH);
                else { u32x2 w; w.x = pk2(hv[0], hv[1]); w.y = pk2(hv[2], hv[3]); *(u32x2*)(hout + (size_t)row * DM + col) = w; }
                if (do_route) {
#pragma unroll
                    for (int k = 0; k < 4; ++k) { const f32x4 wa = *(const LAS f32x4*)(wr + (col + k) * 8), wb = *(const LAS f32x4*)(wr + (col + k) * 8 + 4);
                        lg[0] += hv[k] * wa[0]; lg[1] += hv[k] * wa[1]; lg[2] += hv[k] * wa[2]; lg[3] += hv[k] * wa[3];
                        lg[4] += hv[k] * wb[0]; lg[5] += hv[k] * wb[1]; lg[6] += hv[k] * wb[2]; lg[7] += hv[k] * wb[3]; }
                }
            }
            if (do_route) {
#pragma unroll
                for (int e = 0; e < 8; ++e) lg[e] = wave_sum(lg[e]);
                if (lane == 0) {
                    int e1 = 0; float v1 = lg[0];
#pragma unroll
                    for (int e = 1; e < 8; ++e) if (lg[e] > v1) { v1 = lg[e]; e1 = e; }
                    int e2 = -1; float v2 = -3.0e38f;
#pragma unroll
                    for (int e = 0; e < 8; ++e) if (e != e1 && lg[e] > v2) { v2 = lg[e]; e2 = e; }
                    const float gb_ = 1.0f / (1.0f + __expf(v1 - v2)), ga_ = 1.0f - gb_;
                    const int i = row - cs;
                    rec[i * 6 + 0] = e1; rec[i * 6 + 1] = __hip_atomic_fetch_add(&lcnt[e1], 1, __ATOMIC_RELAXED, __HIP_MEMORY_SCOPE_WORKGROUP); rec[i * 6 + 2] = e2; rec[i * 6 + 3] = __hip_atomic_fetch_add(&lcnt[e2], 1, __ATOMIC_RELAXED, __HIP_MEMORY_SCOPE_WORKGROUP);
                    rec[i * 6 + 4] = __float_as_int(ga_); rec[i * 6 + 5] = __float_as_int(gb_);
                }
            }
        }
        if (do_route) {
            __syncthreads();
            if (tid < 8) lcnt[8 + tid] = (int)__hip_atomic_fetch_add(gcnt + 64 * tid, (unsigned)lcnt[tid], __ATOMIC_RELAXED, __HIP_MEMORY_SCOPE_AGENT);
            __syncthreads();
            for (int i = tid; i < ce - cs; i += 512) { Route rt; rt.sa = 0; rt.sb = 0;
                rt.ea = rec[i * 6 + 0]; rt.pa = lcnt[8 + rt.ea] + rec[i * 6 + 1]; rt.eb = rec[i * 6 + 2]; rt.pb = lcnt[8 + rt.eb] + rec[i * 6 + 3];
                rt.ga = __int_as_float(rec[i * 6 + 4]); rt.gb = __int_as_float(rec[i * 6 + 5]); route_out[cs + i] = rt; }
            __syncthreads();
        }
    }
}
__device__ __forceinline__ void moe_gather(const unsigned char* h2, unsigned char* hs, const float* rs, float* rss, Route* route, unsigned* gcnt, int nrows, int gw, int ngw, int lane) {
    int off[8]; { int a = 0;
#pragma unroll
        for (int e = 0; e < 8; ++e) { off[e] = a; const int c = (int)__hip_atomic_load(gcnt + 64 * e, __ATOMIC_RELAXED, __HIP_MEMORY_SCOPE_AGENT); a += (c + 255) & ~255; } }
    u32x4 an; Route rn;
    if (gw < nrows) { rn = route[gw]; an = *(const u32x4*)(h2 + (size_t)gw * DM + 16 * lane); }
    for (int row = gw; row < nrows; row += ngw) {
        const Route rt = rn; const u32x4 a = an;
        if (row + ngw < nrows) { rn = route[row + ngw]; an = *(const u32x4*)(h2 + (size_t)(row + ngw) * DM + 16 * lane); }
        int oa = 0, ob = 0;
#pragma unroll
        for (int e = 0; e < 8; ++e) { oa = (rt.ea == e) ? off[e] : oa; ob = (rt.eb == e) ? off[e] : ob; }
        const int sa = oa + rt.pa, sb = ob + rt.pb;
        *(u32x4*)(hs + (size_t)sa * DM + 16 * lane) = a;
        *(u32x4*)(hs + (size_t)sb * DM + 16 * lane) = a;
        if (lane == 0) { route[row].sa = sa; route[row].sb = sb; const float r = rs[row]; rss[sa] = r; rss[sb] = r; }
    }
}
__device__ __forceinline__ void final_norm(const bf16_t* x, float* out, const float* gain, const float* mod, const Route* route, const bf16_t* fbuf, int gw, int ngw, int lane) {
    for (int row = gw; row < TL; row += ngw) {
        const int mb = row >> 12; const bf16_t* xr = x + (size_t)row * DM; float* orow = out + (size_t)row * DM;
        const Route rt = route[row]; const float* g2 = mod + mb * 6144 + 5120;
        f32x4 v[4]; float s = 0.f;
#pragma unroll
        for (int j = 0; j < 4; ++j) { const int col = 4 * lane + 256 * j; { const u32x2 t = *(const u32x2*)(xr + col); v[j] = (f32x4){bf_lo(t.x), bf_hi(t.x), bf_lo(t.y), bf_hi(t.y)}; }
            const u32x2 fa = *(const u32x2*)(fbuf + (size_t)rt.sa * DM + col), fb = *(const u32x2*)(fbuf + (size_t)rt.sb * DM + col);
            const f32x4 gg = *(const f32x4*)(g2 + col);
            v[j][0] += gg[0] * (rt.ga * bf_lo(fa.x) + rt.gb * bf_lo(fb.x)); v[j][1] += gg[1] * (rt.ga * bf_hi(fa.x) + rt.gb * bf_hi(fb.x));
            v[j][2] += gg[2] * (rt.ga * bf_lo(fa.y) + rt.gb * bf_lo(fb.y)); v[j][3] += gg[3] * (rt.ga * bf_hi(fa.y) + rt.gb * bf_hi(fb.y));
            s += (v[j][0] * v[j][0] + v[j][1] * v[j][1]) + (v[j][2] * v[j][2] + v[j][3] * v[j][3]); }
        const float rstd = 1.0f / sqrtf(wave_sum(s) * (1.0f / DM) + NORM_EPS);
#pragma unroll
        for (int j = 0; j < 4; ++j) { const int col = 4 * lane + 256 * j; const f32x4 gn = *(const f32x4*)(gain + col); *(f32x4*)(orow + col) = v[j] * rstd * gn; }
    }
}
constexpr int NWAVES = 8;
constexpr int LDS_MISC = pg8::STAGE_BYTES + 2048, LDS_PTAB = LDS_MISC + 64;
constexpr int LDS_BYTES = pg8::STAGE_BYTES + 2048 + 1024;
static_assert(at::AT_A_LDS <= pg8::STAGE_BYTES && at::AT_C_LDS <= pg8::STAGE_BYTES + 2048 && at::R1_LDS <= pg8::STAGE_BYTES && at::R3_LDS <= pg8::STAGE_BYTES, "LDS");
constexpr int NPH = 11;
constexpr int N_PHASES = 1 + DEPTH * NPH + 1;

struct Args { const float* in[24]; float* out; unsigned char* ws; int ph_lo, ph_hi; };
static_assert(sizeof(Args) == 24 * 8 + 8 + 8 + 8, "Args has no padding");

__device__ __forceinline__ void* ldptr(LAS unsigned char* lds, int i) {
    const u32x2 v = *(const LAS u32x2*)(lds + LDS_PTAB + 8 * i);
    const unsigned lo = __builtin_amdgcn_readfirstlane(v.x), hi = __builtin_amdgcn_readfirstlane(v.y);
    GAS void* g = (GAS void*)(((unsigned long long)hi << 32) | lo);
    return (void*)g;
}
#define PIN(i) ((const float*)ldptr(lds, (i)))
#define PWS() ((unsigned char*)ldptr(lds, 25))
#define POUT() ((float*)ldptr(lds, 24))
__device__ __forceinline__ CvtD range_desc(int k, int r, LAS unsigned char* lds, unsigned char* ws, int lane) {
    const float* wsc = (const float*)(ws + WS_TAB) + TAB_WSC;
    if (k == 1 || k == 2 || k == 5) { const int l = (k == 5) ? 3 : k;
        return mix_desc(PIN(9) + (size_t)l * DM * DIN, PIN(15) + (size_t)l * 3 * 512 * DM, PIN(16) + (size_t)l * DM * DM, ws + WS_MIX + l * MIX_STRIDE, r, wsc[2 * l], lane); }
    if (k == 0 || k == 4) { const int j = (k == 0) ? 0 : 1;
        return ffn_desc(PIN(17) + (size_t)j * DM * DFF, PIN(18) + (size_t)j * DM * DFF, PIN(19) + (size_t)j * DFF * DM, ws + WS_FD + j * FD_STRIDE, ws + WS_FD + j * FD_STRIDE + FD_W2, r, wsc[2 * (4 + j)], wsc[2 * (6 + j)], DENSE_F8, lane); }
    { const int j = (k == 3) ? 0 : 1, e = r / I_FE, rr = r % I_FE; const size_t eo = ((size_t)j * NEXP + e) * DM * DFF;
        return ffn_desc(PIN(21) + eo, PIN(22) + eo, PIN(23) + eo, ws + WS_W13 + (size_t)e * 2 * DFF * DM, ws + WS_W2 + (size_t)e * DM * DFF, rr, wsc[2 * (8 + j * 8 + e)], wsc[2 * (24 + j * 8 + e)], 1, lane); }
}
__device__ __forceinline__ int range_base(int k) { return k == 0 ? 0 : k == 1 ? I_FE : k == 2 ? I_FE + I_MIX : k == 3 ? I_FE + 2 * I_MIX : k == 4 ? I_FE + 2 * I_MIX + NEXP * I_FE : k == 5 ? 2 * I_FE + 2 * I_MIX + NEXP * I_FE
                                                          : k == 6 ? 2 * I_FE + 3 * I_MIX + NEXP * I_FE : 2 * I_FE + 3 * I_MIX + 2 * NEXP * I_FE; }
__device__ __forceinline__ int range_of(int g) { int k = 0;
#pragma unroll
    for (int j = 1; j < N_RANGES; ++j) k += (g >= range_base(j)) ? 1 : 0;
    return k; }
__device__ __forceinline__ void bg_static(LAS unsigned char* lds, unsigned char* ws, int g0, int g1, int worker, int nworkers, int wave, int lane) {
    for (int g = g0 + worker; g < g1; g += 2 * nworkers) {
        const int gb = g + nworkers; const bool two = gb < g1;
        const int ka = range_of(g), kb = range_of(two ? gb : g);
        const CvtD da = range_desc(ka, g - range_base(ka), lds, ws, lane), db = range_desc(kb, (two ? gb : g) - range_base(kb), lds, ws, lane);
        float va[32], vb[32];
        cvt_load(da, va); if (two) cvt_load(db, vb);
        cvt_store(da, va); if (two) cvt_store(db, vb);
    }
}
constexpr int WGM_MOE = 4;
constexpr int Q_B = 2, Q_F = 7, Q_G = 5, Q_I = 2, Q_J = 14;
#define TAIL_BOOK(nwg_in, quota, drain) const int tb_nwg = (nwg_in), tb_maxu = (tb_nwg + G - 1) / G, tb_nh = (tb_nwg % G == 0) ? G : tb_nwg - (tb_maxu - 1) * G, tb_nt = G - tb_nh; \
        const int tb_lim = range_base(kmax + 1), tb_g0 = gc; int tb_take = tb_nt * NWAVES * (quota); if (tb_take > tb_lim - gc) tb_take = tb_lim - gc; if (tb_take < 0) tb_take = 0; \
        const int tb_g1 = tb_g0 + tb_take; const int tb_e = (drain) >= 0 ? range_base((drain) + 1) : 0; const int tb_g2 = tb_e > tb_g1 ? tb_e : tb_g1; gc = tb_g2
#define TAIL_RUN() do { if (blk >= tb_nh && tb_take > 0) bg_static(lds, ws, tb_g0, tb_g1, (blk - tb_nh) * NWAVES + wave, tb_nt * NWAVES, wave, LANE()); \
        if (tb_g2 > tb_g1) bg_static(lds, ws, tb_g1, tb_g2, GW(), NGW(), wave, LANE()); } while (0)

__global__ void __launch_bounds__(NWAVES * 64, 2) mega(Args a) {
    extern __shared__ __attribute__((aligned(16))) unsigned char lds_raw[];
    LAS unsigned char* lds = (LAS unsigned char*)lds_raw;
    LAS unsigned char* const lds_k = lds;
#define LDSL() ({ LAS unsigned char* p_ = lds_k; asm volatile("" : "+s"(p_)); p_; })
    const int wave = __builtin_amdgcn_readfirstlane((int)threadIdx.x >> 6);
    const int G = gridDim.x, blk = blockIdx.x;
#define LANE0() ({ int t_; asm volatile("v_mbcnt_lo_u32_b32 %0, -1, 0\n\tv_mbcnt_hi_u32_b32 %0, -1, %0" : "=v"(t_)); t_; })
#define LANE() LANE0()
#define TID0() ((wave << 6) | LANE0())
#define TID() TID0()
    if (threadIdx.x == 0) {
        LAS unsigned long long* pt = (LAS unsigned long long*)(lds + LDS_PTAB);
#pragma unroll
        for (int i = 0; i < 24; ++i) pt[i] = (unsigned long long)a.in[i];
        pt[24] = (unsigned long long)a.out; pt[25] = (unsigned long long)a.ws;
        ((LAS unsigned*)(lds + LDS_MISC))[0] = 0u; ((LAS unsigned*)(lds + LDS_MISC))[1] = 0u; ((LAS unsigned*)(lds + LDS_MISC))[2] = 0u; ((LAS unsigned*)(lds + LDS_MISC))[3] = 0u;
    }
    __syncthreads();
#if MK_SINGLE
    (void)xcd_barrier_post((unsigned*)PWS() + CW_BAR, (volatile LAS unsigned*)(lds + LDS_MISC), TID());
#define GRID_BAR() do { XcdBarrier b_; b_.bar = (unsigned*)PWS() + CW_BAR; b_.x = 0; b_.st = (volatile LAS unsigned*)(lds_k + LDS_MISC); xcd_barrier(b_, TID()); } while (0)
#else
#define GRID_BAR() do { } while (0)
#endif
#if !MK_SINGLE
    const int lo = a.ph_lo, hi = a.ph_hi;
#endif
#ifndef PROBE_MASK
#define PROBE_MASK 0xffff
#endif
#define EN(k) (((PROBE_MASK) >> ((k) >= 100 ? (k) - 89 : (k))) & 1)
#if MK_SINGLE
#define IN(k) true
#else
#define IN(k) (lo <= (k) && (k) < hi)
#endif
#define SEAM(k) do { if (IN(k) && IN((k) + 1)) GRID_BAR(); } while (0)
#define LAUNDER_S(x) ({ int x_ = (x); asm volatile("" : "+s"(x_)); x_; })
#ifndef PROBE_DUP
#define PROBE_DUP 0
#endif
#define DUP(k) (1 + (((PROBE_DUP) >> (k)) & 1))
#define GW() (blk * NWAVES + wave)
#define NGW() (G * NWAVES)

    if (IN(0) && EN(100)) { LAS unsigned char* lds = LDSL();
        float* tab = (float*)(PWS() + WS_TAB);
        p0_mod(lds, PIN(1), PIN(3), PIN(4), PIN(5), tab + TAB_MOD, blk, G, TID());
        if (blk == G - 1) p0_tables(tab, PIN(13), PIN(11), PIN(12), TID());
        __syncthreads();
        const float rms0 = fmaxf(sample_rms(PIN(9), DM * DIN, (LAS float*)(lds + 32768), TID()), 1.0e-30f), qs0 = 127.0f / (I8_CLIP * rms0);
        if (blk == 0 && TID() == 0) { tab[TAB_WSC] = qs0; tab[TAB_WSC + 1] = 1.0f / qs0; }
        if (blk >= 1 && blk < 40) {
            const float* W = blk < 4 ? PIN(9) + (size_t)blk * DM * DIN : blk < 6 ? PIN(17) + (size_t)(blk - 4) * DM * DFF : blk < 8 ? PIN(18) + (size_t)(blk - 6) * DM * DFF
                           : blk < 24 ? PIN(21) + (size_t)(blk - 8) * DM * DFF : PIN(22) + (size_t)(blk - 24) * DM * DFF;
            const float r = fmaxf(sample_rms(W, blk < 4 ? DM * DIN : DM * DFF, (LAS float*)(lds + 32768), TID()), 1.0e-30f), q = 127.0f / (I8_CLIP * r);
            if (TID() == 0) { tab[TAB_WSC + 2 * blk] = q; tab[TAB_WSC + 2 * blk + 1] = 1.0f / q; } }
        {
            unsigned char* ws = PWS(); const int ln = LANE();
            for (int it = (G - 1 - blk) * NWAVES + wave; it < I_MIX; it += 2 * NGW()) { const int ib = it + NGW(); const bool two = ib < I_MIX;
                const CvtD da = mix_desc(PIN(9), PIN(15), PIN(16), ws + WS_MIX, it, qs0, ln), db = mix_desc(PIN(9), PIN(15), PIN(16), ws + WS_MIX, two ? ib : it, qs0, ln);
                float va[32], vb[32];
                cvt_load(da, va); if (two) cvt_load(db, vb);
                cvt_store(da, va); if (two) cvt_store(db, vb); }
        }
    }
    SEAM(0);

    int gc = 0;
    for (int l = 0; l < DEPTH; ++l) {
        const int pb = 1 + l * NPH;
        const bool moe = (l & 1) != 0, last = (l == DEPTH - 1), first = (l == 0);
        const int nrows = last ? TL : TT;
        const int kmax = l <= 1 ? 5 : 6;
        if (IN(pb + 0) && EN(0)) { LAS unsigned char* lds = LDSL();
            unsigned char* ws = PWS();
            __syncthreads();
            const bool comb = (l == 2);
            const float* modl = (const float*)(ws + WS_TAB) + TAB_MOD + (size_t)l * 9 * 6144;
            bf16_t* xL = (bf16_t*)(ws + WS_XB); bf16_t* xc = (bf16_t*)(ws + WS_XC);
            for (int dup = 0; dup < (comb ? 1 : DUP(8)); ++dup) norm_rows(lds, first ? (const void*)PIN(0) : (const void*)xL, first ? (const void*)PIN(2) : (const void*)xc, first ? 1 : 0, xL, xc, PIN(6) + l * DM, modl, modl - 9 * 6144, 0, (bf16_t*)(ws + WS_H), 2, (float*)(ws + WS_RS), TT, comb ? 1 : 0,
                      (const Route*)(ws + WS_ROUTE), (const bf16_t*)(ws + WS_OCAT), nullptr, 0, nullptr, nullptr, blk, G, wave, LANE(), TID());
        }
        SEAM(pb + 0);
        { TAIL_BOOK(last ? (TL / 256) * (DIN / 256) + 64 : (TT / 256) * (DIN / 256), Q_B, -1);
        if (IN(pb + 1) && EN(1)) { LAS unsigned char* lds = LDSL();
            unsigned char* ws = PWS();
            pg8::Gemm g{(const bf16_t*)(ws + WS_H), (const bf16_t*)(ws + WS_MIX + l * MIX_STRIDE), DM / 2}; pg8::GSched S; S.init(last ? TL / 256 : TT / 256, DIN / 256, LAUNDER_S(G), LAUNDER_S(blk));
            if (last) { S.nx = 64; S.nwg += 64; S.xtab = 0xEDCB6542ull; }
            pg8::EpiProj E{(bf16_t*)(ws + WS_PROJ), (const float*)(ws + WS_TAB) + TAB_ROPE, (u32x2*)(ws + WS_GATE), (const float*)(ws + WS_RS), ((const float*)(ws + WS_TAB))[TAB_WSC + 2 * l + 1]};
            pg8::gemm_phase<pg8::EpiProj, pg8::GSched, true, true, 2>(lds, g, S, E, TID());
            TAIL_RUN();
        } }
        SEAM(pb + 1);
        if (IN(pb + 2) && EN(2)) { LAS unsigned char* lds = LDSL();
            unsigned char* ws = PWS(); const float* lg2 = (const float*)(ws + WS_TAB) + TAB_LG2 + l * 8;
            for (int dup = 0; dup < DUP(10); ++dup) at::ret_kv_phase(lds, (const bf16_t*)(ws + WS_PROJ), (bf16_t*)(ws + WS_Y), lg2, blk, G, TID());
        }
        SEAM(pb + 2);
        if (IN(pb + 3) && EN(3)) for (int dup = 0; dup < DUP(11); ++dup) { unsigned char* ws = PWS(); at::ret_scan((const bf16_t*)(ws + WS_Y), (bf16_t*)(ws + WS_H), (const float*)(ws + WS_TAB) + TAB_LG2 + l * 8, blk * 512 + TID(), G * 512); }
        SEAM(pb + 3);
        if (IN(pb + 4) && EN(4)) { LAS unsigned char* lds = LDSL();
            {
                unsigned char* ws = PWS(); const float* tab = (const float*)(ws + WS_TAB);
                const float lam = tab[TAB_LAM + 2 * l], oml = tab[TAB_LAM + 2 * l + 1]; const float* dn = PIN(14) + l * 128;
                for (int dup = 0; dup < DUP(0); ++dup) for (int r = blk; r < 1024; r += G) { const int rnd = r >> 8, bi = r & 255, bh = rnd * 8 + (bi & 7), qb = bi >> 3;
                    at::attnC_unit(lds, (const bf16_t*)(ws + WS_PROJ), (bf16_t*)(ws + WS_OCAT), dn, lam, oml, bh >> 2, bh & 3, qb, 1, TID()); }
                if (!last) for (int r = blk; r < 64; r += G) { const int bh = r >> 1, qb = r & 1;
                    at::attnC_unit(lds, (const bf16_t*)(ws + WS_PROJ), (bf16_t*)(ws + WS_OCAT), dn, lam, oml, bh >> 2, bh & 3, qb, 0, TID()); }
            }
            {
                unsigned char* ws = PWS(); const float* lg2 = (const float*)(ws + WS_TAB) + TAB_LG2 + l * 8;
                const int nR = last ? NB * 4 * 32 : NB * 4 * NCHK;
                for (int dup = 0; dup < DUP(3); ++dup) for (int r = blk; r < nR; r = (r + G < (nR / G) * G) ? r + G : (r < (nR / G) * G ? (nR / G) * G + ((blk + G - 64) % G) : nR)) { int bh, ci; if (last) { bh = r >> 5; ci = 2 + (r & 31); } else { bh = r / NCHK; ci = r % NCHK; }
                    at::ret_out_unit(lds, (const bf16_t*)(ws + WS_PROJ), (const bf16_t*)(ws + WS_H), (bf16_t*)(ws + WS_OCAT), lg2[bh & 3], lg2[4 + (bh & 3)], bh >> 2, bh & 3, ci, TID()); }
            }
            {
                unsigned char* ws = PWS(); const float* sink = PIN(10) + l * 8;
                for (int dup = 0; dup < DUP(13); ++dup) for (int r = blk; r < 1024; r += G) { const int bg = r >> 6, qb = r & 63; at::attnA_unit(lds, (const bf16_t*)(ws + WS_PROJ), (bf16_t*)(ws + WS_OCAT), sink, bg >> 1, bg & 1, qb, 1, TID()); }
                if (!last) for (int r = (blk + G - 128) % G; r < 64; r += G) { const int bg = r >> 2, qb = r & 3; at::attnA_unit(lds, (const bf16_t*)(ws + WS_PROJ), (bf16_t*)(ws + WS_OCAT), sink, bg >> 1, bg & 1, qb, 0, TID()); }
            }
        }
        SEAM(pb + 4);
#ifdef PROBE_XBAR
        for (int xb_ = 0; xb_ < PROBE_XBAR; ++xb_) GRID_BAR();
#endif
        { TAIL_BOOK((nrows / 256) * (DM / 256), Q_F, -1);
        if (IN(pb + 5) && EN(5)) { LAS unsigned char* lds = LDSL();
            unsigned char* ws = PWS();
            pg8::Gemm g{(const bf16_t*)(ws + WS_OCAT), (const bf16_t*)(ws + WS_MIX + l * MIX_STRIDE + MIX_WB), OCW}; pg8::GSched S; S.init(nrows / 256, DM / 256, LAUNDER_S(G), LAUNDER_S(blk));
            pg8::EpiMerge E{(bf16_t*)(ws + WS_Y), (const u32x2*)(ws + WS_GATE)};
            pg8::gemm_phase<pg8::EpiMerge, pg8::GSched, true, true>(lds, g, S, E, TID());
            TAIL_RUN();
        } }
        SEAM(pb + 5);
        { TAIL_BOOK((nrows / 256) * (DM / 256), Q_G, (l == 0 ? 0 : l == 1 ? 3 : l == 2 ? 4 : 6));
        if (IN(pb + 6) && EN(6)) { LAS unsigned char* lds = LDSL();
            unsigned char* ws = PWS(); bf16_t* xL = (bf16_t*)(ws + WS_XB); bf16_t* xc = (bf16_t*)(ws + WS_XC);
            pg8::Gemm g{(const bf16_t*)(ws + WS_Y), (const bf16_t*)(ws + WS_MIX + l * MIX_STRIDE + MIX_WO), DM}; pg8::GSched S; S.init(nrows / 256, DM / 256, LAUNDER_S(G), LAUNDER_S(blk));
            pg8::EpiRes E{first ? (const void*)PIN(0) : (const void*)xL, first ? (const void*)PIN(2) : (const void*)xc, xL, xc, (const float*)(ws + WS_TAB) + TAB_MOD + (size_t)l * 9 * 6144, 2048, 1.0f, first ? 1 : 0};
            pg8::gemm_phase<pg8::EpiRes, pg8::GSched, true, true>(lds, g, S, E, TID());
            TAIL_RUN();
        } }
        SEAM(pb + 6);
        if (IN(pb + 7) && EN(7)) { LAS unsigned char* lds = LDSL();
            unsigned char* ws = PWS(); bf16_t* xL = (bf16_t*)(ws + WS_XB); bf16_t* xc = (bf16_t*)(ws + WS_XC);
            const float* modl = (const float*)(ws + WS_TAB) + TAB_MOD + (size_t)l * 9 * 6144;
            for (int dup = 0; dup < (moe ? 1 : DUP(9)); ++dup) norm_rows(lds, xL, xc, 0, xL, xc, PIN(7) + l * DM, modl, modl, 3072, (bf16_t*)(ws + WS_H), 2, (float*)(ws + WS_RS), nrows, 0, (const Route*)(ws + WS_ROUTE), (const bf16_t*)(ws + WS_OCAT),
                      moe ? PIN(20) + (size_t)(l >> 1) * DM * NEXP : nullptr, moe ? 1 : 0, (Route*)(ws + WS_ROUTE), (unsigned*)ws + CW_MOE + (l >> 1) * 1024, blk, G, wave, LANE(), TID());
        }
        SEAM(pb + 7);
        if (!moe) {
            { TAIL_BOOK((nrows / 256) * (2 * DFF / 256), Q_I, -1);
            if (IN(pb + 9) && EN(9)) { LAS unsigned char* lds = LDSL();
                unsigned char* ws = PWS();
                pg8::Gemm g{(const bf16_t*)(ws + WS_H), (const bf16_t*)(ws + WS_FD + (l >> 1) * FD_STRIDE), DM / 2}; pg8::GSched S; S.init(nrows / 256, 2 * DFF / 256, LAUNDER_S(G), LAUNDER_S(blk));
                pg8::EpiSwiglu<DENSE_F8 != 0> E{ws + WS_PROJ, (const float*)(ws + WS_RS), (const float*)(ws + WS_TAB) + TAB_WSC + 2 * (4 + (l >> 1)) + 1, 4};
                pg8::gemm_phase<pg8::EpiSwiglu<DENSE_F8 != 0>, pg8::GSched, true, true, 2>(lds, g, S, E, TID());
                TAIL_RUN();
            } }
            SEAM(pb + 9);
            { TAIL_BOOK((nrows / 256) * (DM / 256), Q_J, (l == 0 ? 1 : 5));
            if (IN(pb + 10) && EN(10)) { LAS unsigned char* lds = LDSL();
                unsigned char* ws = PWS(); bf16_t* xL = (bf16_t*)(ws + WS_XB); bf16_t* xc = (bf16_t*)(ws + WS_XC);
                pg8::Gemm g{(const bf16_t*)(ws + WS_PROJ), (const bf16_t*)(ws + WS_FD + (l >> 1) * FD_STRIDE + FD_W2), DENSE_F8 ? DFF / 2 : DFF}; pg8::GSched S; S.init(nrows / 256, DM / 256, LAUNDER_S(G), LAUNDER_S(blk));
                pg8::EpiRes E{xL, xc, xL, xc, (const float*)(ws + WS_TAB) + TAB_MOD + (size_t)l * 9 * 6144, 5120, DENSE_F8 ? F8_INV2 : 1.0f, 0};
                pg8::gemm_phase<pg8::EpiRes, pg8::GSched, true, true, DENSE_F8 ? 1 : 0>(lds, g, S, E, TID());
                TAIL_RUN();
            } }
            SEAM(pb + 10);
        } else {
            if (IN(pb + 8) && EN(8)) for (int dup = 0; dup < DUP(12); ++dup) { unsigned char* ws = PWS(); moe_gather(ws + WS_H, ws + WS_OCAT, (const float*)(ws + WS_RS), (float*)(ws + WS_RSS), (Route*)(ws + WS_ROUTE), (unsigned*)ws + CW_MOE + (l >> 1) * 1024, nrows, GW(), NGW(), LANE()); }
            SEAM(pb + 8);
            if (IN(pb + 9) && EN(9)) { LAS unsigned char* lds = LDSL();
                unsigned char* ws = PWS(); unsigned* gcnt = (unsigned*)ws + CW_MOE + (l >> 1) * 1024;
                pg8::GSched S; LAS int* tsl = (LAS int*)(lds + LDS_MISC + 512);
                if (TID() == 0) { int a0 = 0;
                    for (int e = 0; e < 8; ++e) { tsl[e] = a0; const int c = (int)__hip_atomic_load(gcnt + 64 * e, __ATOMIC_RELAXED, __HIP_MEMORY_SCOPE_AGENT); a0 += (c + 255) >> 8; }
                    tsl[8] = a0; }
                __syncthreads();
                S.ts = tsl; S.nM = __builtin_amdgcn_readfirstlane(tsl[8]); S.nN = 2 * DFF / 256; S.nwg = S.nM * S.nN; S.G = LAUNDER_S(G); S.c = LAUNDER_S(blk); S.wgm = WGM_MOE; S.nx = 0; S.xtab = 0; S.grouped = 1; S.bstride = (size_t)DFF * DM;
                pg8::Gemm g{(const bf16_t*)(ws + WS_OCAT), (const bf16_t*)(ws + WS_W13), DM / 2};
                pg8::EpiSwiglu<true> E{ws + WS_PROJ, (const float*)(ws + WS_RSS), (const float*)(ws + WS_TAB) + TAB_WSC + 2 * (8 + (l >> 1) * 8) + 1, 32};
                pg8::gemm_phase<pg8::EpiSwiglu<true>, pg8::GSched, true, true, 2>(lds, g, S, E, TID());
            }
            SEAM(pb + 9);
            if (IN(pb + 10) && EN(10)) { LAS unsigned char* lds = LDSL();
                unsigned char* ws = PWS(); unsigned* gcnt = (unsigned*)ws + CW_MOE + (l >> 1) * 1024;
                pg8::GSched S; LAS int* tsl = (LAS int*)(lds + LDS_MISC + 512);
                if (TID() == 0) { int a0 = 0;
                    for (int e = 0; e < 8; ++e) { tsl[e] = a0; const int c = (int)__hip_atomic_load(gcnt + 64 * e, __ATOMIC_RELAXED, __HIP_MEMORY_SCOPE_AGENT); a0 += (c + 255) >> 8; }
                    tsl[8] = a0; }
                __syncthreads();
                S.ts = tsl; S.nM = __builtin_amdgcn_readfirstlane(tsl[8]); S.nN = DM / 256; S.nwg = S.nM * S.nN; S.G = LAUNDER_S(G); S.c = LAUNDER_S(blk); S.wgm = WGM_MOE; S.nx = 0; S.xtab = 0; S.grouped = 1; S.bstride = (size_t)DM * DFF / 2;
                pg8::Gemm g{(const bf16_t*)(ws + WS_PROJ), (const bf16_t*)(ws + WS_W2), DFF / 2}; pg8::EpiBf16 E{(bf16_t*)(ws + WS_OCAT), DM, F8_INV2};
                pg8::gemm_phase<pg8::EpiBf16, pg8::GSched, true, true, 1>(lds, g, S, E, TID());
            }
            SEAM(pb + 10);
        }
    }
    if (IN(1 + DEPTH * NPH) && EN(101)) { LAS unsigned char* lds = LDSL(); unsigned char* ws = PWS();
        final_norm((const bf16_t*)(ws + WS_XB), POUT(), PIN(8), (const float*)(ws + WS_TAB) + TAB_MOD + (size_t)3 * 9 * 6144, (const Route*)(ws + WS_ROUTE), (const bf16_t*)(ws + WS_OCAT), GW(), NGW(), LANE()); }
#undef IN
#undef SEAM
}

extern "C" void kernel_launch(void* const* d_in, const int* in_sizes, int n_in, void* d_out, int out_size, void* d_ws, size_t ws_size, hipStream_t stream) {
    static int grid = 0;
    if (grid == 0) {
        if (n_in != 24 || out_size != TL * DM || ws_size < WS_END) { fprintf(stderr, "kernel_launch: unexpected shapes (n_in %d, out %d, ws %zu)\n", n_in, out_size, ws_size); grid = -1; return; }
        int dev = 0, cus = 0, per_cu = 0;
        if (hipGetDevice(&dev) != hipSuccess || hipDeviceGetAttribute(&cus, hipDeviceAttributeMultiprocessorCount, dev) != hipSuccess) { grid = -1; return; }
        if (hipFuncSetAttribute((const void*)mega, hipFuncAttributeMaxDynamicSharedMemorySize, LDS_BYTES) != hipSuccess) { fprintf(stderr, "kernel_launch: hipFuncSetAttribute failed\n"); grid = -1; return; }
        if (hipOccupancyMaxActiveBlocksPerMultiprocessor(&per_cu, (const void*)mega, NWAVES * 64, LDS_BYTES) != hipSuccess || per_cu < 1) { fprintf(stderr, "kernel_launch: occupancy query reports %d\n", per_cu); }
        (void)hipGetLastError();
        grid = cus;
    }
    if (grid < 0) return;
    if (hipMemsetAsync((char*)d_ws + WS_CTL, 0, CTL_ZERO_BYTES, stream) != hipSuccess) return;
    Args a{};
    for (int i = 0; i < 24; ++i) a.in[i] = (const float*)d_in[i];
    a.out = (float*)d_out; a.ws = (unsigned char*)d_ws;
#if MK_SINGLE
    a.ph_lo = 0; a.ph_hi = N_PHASES;
    hipLaunchKernelGGL(mega, dim3(grid), dim3(NWAVES * 64), LDS_BYTES, stream, a);
#else
    for (int p = 0; p < N_PHASES; ++p) {
        const int k = (p - 1) % NPH, l = (p - 1) / NPH;
        if (p >= 1 && p < 1 + DEPTH * NPH && k == 8 && !(l & 1)) continue;
        a.ph_lo = p; a.ph_hi = p + 1;
        hipLaunchKernelGGL(mega, dim3(grid), dim3(NWAVES * 64), LDS_BYTES, stream, a);
    }
#endif
}
```

```cpp
#include <hip/hip_runtime.h>
#include <cstdio>
#include <cstdint>

#ifndef MK_SINGLE
#define MK_SINGLE 1
#endif

#define LAS __attribute__((address_space(3)))
#define GAS __attribute__((address_space(1)))

typedef unsigned short bf16_t;
typedef short bf16x8 __attribute__((ext_vector_type(8)));
typedef short s16x4 __attribute__((ext_vector_type(4)));
typedef float f32x2 __attribute__((ext_vector_type(2)));
typedef float f32x4 __attribute__((ext_vector_type(4)));
typedef float f32x16 __attribute__((ext_vector_type(16)));
typedef unsigned u32x2 __attribute__((ext_vector_type(2)));
typedef unsigned u32x4 __attribute__((ext_vector_type(4)));
typedef int i32x4 __attribute__((ext_vector_type(4)));
typedef int i32x8 __attribute__((ext_vector_type(8)));
typedef __bf16 bf16x2_t __attribute__((ext_vector_type(2)));

constexpr int DM = 1024, NB = 8, SEQ = 4096, CTXL = 256, DEPTH = 4;
constexpr int TL = NB * SEQ;
constexpr int TC = NB * CTXL;
constexpr int TT = TL + TC;
constexpr int DIN = 6912, DFF = 2816, NEXP = 8, OCW = 1536;
constexpr int DINP = 3840;
constexpr int NMT = 136;
constexpr int C_QA = 0, C_KA = 512, C_VA = 640, C_QB = 768, C_KB = 1024, C_VB = 1280, C_GB = 1792, C_QD = 2304, C_KD = 2816, C_VD = 3328, C_GL = 3840;
constexpr float NORM_EPS = 1e-6f;
constexpr float SM_C2 = 0.125f * 1.4426950408889634f;
constexpr float LOG2E = 1.4426950408889634f;
constexpr int NCHK = 34;

__device__ __forceinline__ unsigned pk2(float lo, float hi) { f32x2 v = {lo, hi}; bf16x2_t b = __builtin_convertvector(v, bf16x2_t); return __builtin_bit_cast(unsigned, b); }
constexpr int DENSE_F8 = 0;
constexpr float F8_SH = 8.0f, F8_SW13 = 256.0f, F8_SU = 8.0f, F8_SW2 = 256.0f, F8_INV13 = 1.0f / (F8_SH * F8_SW13), F8_INV2 = 1.0f / (F8_SU * F8_SW2);
__device__ __forceinline__ unsigned pk4f8(float a, float b, float c, float d) {
    a = __builtin_amdgcn_fmed3f(a, -448.0f, 448.0f); b = __builtin_amdgcn_fmed3f(b, -448.0f, 448.0f); c = __builtin_amdgcn_fmed3f(c, -448.0f, 448.0f); d = __builtin_amdgcn_fmed3f(d, -448.0f, 448.0f);
    int w = __builtin_amdgcn_cvt_pk_fp8_f32(a, b, 0, false); w = __builtin_amdgcn_cvt_pk_fp8_f32(c, d, w, true); return (unsigned)w;
}
constexpr float I8_CLIP = 4.0f;
__device__ __forceinline__ unsigned pk4i8(float a, float b, float c, float d) {
    const float M = 12582912.0f;
    const unsigned ua = __float_as_uint(a + M), ub = __float_as_uint(b + M), uc = __float_as_uint(c + M), ud = __float_as_uint(d + M);
    return __builtin_amdgcn_perm(ub, ua, 0x0c0c0400u) | __builtin_amdgcn_perm(ud, uc, 0x04000c0cu);
}
__device__ __forceinline__ f32x4 acc_i2f(const f32x4& a) { return __builtin_convertvector(__builtin_bit_cast(i32x4, a), f32x4); }
template <int CTRL> __device__ __forceinline__ float dpp_f(float v) { return __builtin_bit_cast(float, __builtin_amdgcn_update_dpp(0, __builtin_bit_cast(int, v), CTRL, 0xF, 0xF, true)); }
__device__ __forceinline__ float row16_sum(float v) {
    v += dpp_f<0xB1>(v); v += dpp_f<0x4E>(v); v += dpp_f<0x141>(v); v += dpp_f<0x140>(v); return v; }
__device__ __forceinline__ float row16_max(float v) {
    v = fmaxf(v, dpp_f<0xB1>(v)); v = fmaxf(v, dpp_f<0x4E>(v)); v = fmaxf(v, dpp_f<0x141>(v)); v = fmaxf(v, dpp_f<0x140>(v)); return v; }
__device__ __forceinline__ float half32_sum(float v) {
    v = row16_sum(v); const auto sw = __builtin_amdgcn_permlane16_swap(__float_as_uint(v), __float_as_uint(v), false, false); return __uint_as_float(sw[0]) + __uint_as_float(sw[1]); }
__device__ __forceinline__ float wave_sum(float v) {
    v = half32_sum(v); const auto sw = __builtin_amdgcn_permlane32_swap(__float_as_uint(v), __float_as_uint(v), false, false); return __uint_as_float(sw[0]) + __uint_as_float(sw[1]); }
__device__ __forceinline__ float wave_max(float v) {
    v = row16_max(v);
    { const auto sw = __builtin_amdgcn_permlane16_swap(__float_as_uint(v), __float_as_uint(v), false, false); v = fmaxf(__uint_as_float(sw[0]), __uint_as_float(sw[1])); }
    { const auto sw = __builtin_amdgcn_permlane32_swap(__float_as_uint(v), __float_as_uint(v), false, false); v = fmaxf(__uint_as_float(sw[0]), __uint_as_float(sw[1])); }
    return v; }
__device__ __forceinline__ float bf_lo(unsigned u) { return __uint_as_float(u << 16); }
__device__ __forceinline__ float bf_hi(unsigned u) { return __uint_as_float(u & 0xffff0000u); }
__device__ __forceinline__ float bf1(bf16_t u) { return __uint_as_float(((unsigned)u) << 16); }
__device__ __forceinline__ float fexp2(float x) { return __builtin_amdgcn_exp2f(x); }
__device__ __forceinline__ float sigmoidf_(float x) { return __builtin_amdgcn_rcpf(1.0f + __builtin_amdgcn_exp2f(-LOG2E * x)); }
__device__ __forceinline__ float siluf_(float x) { return x * __builtin_amdgcn_rcpf(1.0f + __builtin_amdgcn_exp2f(-LOG2E * x)); }
#define LDS_WAIT() asm volatile("s_waitcnt lgkmcnt(0)" ::: "memory")
#define VM_WAIT() asm volatile("s_waitcnt vmcnt(0)" ::: "memory")

namespace pg8 {
#define PG8_LAS __attribute__((address_space(3)))
constexpr int BM = 256, BK = 64, HALF = 128, HTB = HALF * BK * 2  , STAGE_BYTES = 8 * HTB, NXCD = 8, WGM = 8;

__host__ __device__ __forceinline__ int lds_byte(int r, int c) { const int st = (r >> 4) * 2 + (c >> 5), rr = r & 15, cc = c & 31, ob = rr * 64 + cc * 2; return st * 1024 + (ob ^ (((ob >> 9) & 1) << 5)); }
__host__ __device__ __forceinline__ void stage_rc(int b, int& R, int& C) { const int st = b / 1024, sb = b % 1024, swz = sb ^ (((sb >> 9) & 1) << 5); R = (st >> 1) * 16 + swz / 64; C = (st & 1) * 32 + (swz % 64) / 2; }
__host__ __device__ __forceinline__ int perm32(int rho) { const int n = rho >> 4, i = rho & 15; return 8 * (i >> 2) + 4 * n + (i & 3); }

struct Unit { int pm, pn; size_t bo; int ge; };
struct Gemm { const bf16_t* A; const bf16_t* Bt; int K; };

struct GSched {
    int nM, nN, nwg, G, c, wgm; int grouped; size_t bstride; const PG8_LAS int* ts;
    int nx; unsigned long long xtab;
    __device__ __forceinline__ void init(int nM_, int nN_, int G_, int c_, int wgm_ = 4) { nM = nM_; nN = nN_; nwg = nM * nN; G = G_; c = c_; wgm = wgm_; grouped = 0; bstride = 0; ts = nullptr; nx = 0; xtab = 0; }
    __device__ __forceinline__ bool next(int i, Unit& u) const {
        const long L = (long)i * G + c; if (L >= nwg) return false;
        const int nmain = nwg - nx;
        u.ge = 0; if (L >= nmain) { const int j = (int)L - nmain; u.pm = nM + (j >> 3); u.pn = (int)((xtab >> (4 * (j & 7))) & 15ull); u.bo = 0; return true; }
        int wgid = (int)L; { const int q = nmain / NXCD, r = nmain % NXCD, xcd = wgid % NXCD, off = wgid / NXCD; wgid = (xcd < r ? xcd * (q + 1) : r * (q + 1) + (xcd - r) * q) + off; }
        const int nig = wgm * nN, gid = wgid / nig, fm = gid * wgm, gsz = (nM - fm) < wgm ? (nM - fm) : wgm;
        u.pm = fm + ((wgid % nig) % gsz); u.pn = (wgid % nig) / gsz; u.bo = 0;
        if (grouped) { int e = 0;
#pragma unroll
            for (int j = 1; j < 8; ++j) e += (u.pm >= ts[j]) ? 1 : 0;
            e = __builtin_amdgcn_readfirstlane(e);
            u.bo = (size_t)e * bstride; u.ge = e; }
        return true;
    }
    __device__ __forceinline__ void a_ready(const Unit&) const {}
    __device__ __forceinline__ void done(const Unit&) const {}
};
#define ROT2(V, I, c, s) do { const float a_ = V[I] * (c) - V[I + 1] * (s), b_ = V[I + 1] * (c) + V[I] * (s); V[I] = a_; V[I + 1] = b_; } while (0)

struct EpiProj {
    static constexpr bool PERM = true, AFTER_DRAIN = false, KHOOK = false;
    bf16_t* O; const float* rope; u32x2* GB; const float* rs; float wsc;
    __device__ __forceinline__ void operator()(const f32x4 (&acc)[2][2][4][2], const Unit& u, int wr, int wc, int fr, int fq) const {
        const int pn = u.pn; const bool latent = u.pm < TL / 256;
        float rsc[2][4];
#pragma unroll
        for (int ai = 0; ai < 2; ++ai)
#pragma unroll
            for (int m = 0; m < 4; ++m) rsc[ai][m] = rs[u.pm * 256 + wr * 64 + fr + ai * 128 + m * 16] * wsc;
        if (pn >= 15) {
            const int gi = (pn - 15) >> 2, pnl = (pn - 15) & 3;
            u32x2* gp = GB + ((size_t)(((gi * NMT + u.pm) * 4 + pnl) * 8 + wr * 4 + wc) * 16) * 64 + fq * 16 + fr;
#pragma unroll
            for (int ai = 0; ai < 2; ++ai)
#pragma unroll
                for (int m = 0; m < 4; ++m)
#pragma unroll
                    for (int bj = 0; bj < 2; ++bj) { const f32x4 v0 = acc_i2f(acc[ai][bj][m][0]) * rsc[ai][m], v1 = acc_i2f(acc[ai][bj][m][1]) * rsc[ai][m];
#define SG_(x) ((unsigned)fminf(fmaxf(sigmoidf_(x) * 255.0f + 0.5f, 1.0f), 255.0f))
                        u32x2 w; w.x = SG_(v0[0]) | (SG_(v0[1]) << 8) | (SG_(v0[2]) << 16) | (SG_(v0[3]) << 24); w.y = SG_(v1[0]) | (SG_(v1[1]) << 8) | (SG_(v1[2]) << 16) | (SG_(v1[3]) << 24);
#undef SG_
                        __builtin_nontemporal_store(w, gp + (ai * 8 + m * 2 + bj) * 64); }
            return;
        }
        int rmask = 0; if (pn <= 1 || pn == 3 || pn == 4 || (pn >= 9 && pn <= 12)) rmask = 3; else if (pn == 2) rmask = 1;
        if (!latent) rmask = 0;
        const float sc = (pn == 4) ? 0.125f : SM_C2;
        const int row0 = u.pm * 256 + wr * 64 + fr, col0 = pn * 256 + wc * 32 + 8 * fq, axis = wc & 1;
#pragma unroll
        for (int ai = 0; ai < 2; ++ai)
#pragma unroll
            for (int m = 0; m < 4; ++m) {
                const int row = row0 + ai * 128 + m * 16;
                f32x4 cs0 = {1.f, 0.f, 1.f, 0.f}, cs1 = {1.f, 0.f, 1.f, 0.f};
                if (rmask) { const int pos = axis ? (row & 63) : ((row >> 6) & 63); const f32x4* tp = (const f32x4*)(rope + (pos * 16 + 4 * fq) * 2); cs0 = tp[0]; cs1 = tp[1]; }
                bf16_t* rowp = O + (size_t)row * DINP + col0;
#pragma unroll
                for (int bj = 0; bj < 2; ++bj) {
                    f32x4 v0 = acc_i2f(acc[ai][bj][m][0]) * rsc[ai][m], v1 = acc_i2f(acc[ai][bj][m][1]) * rsc[ai][m];
                    if ((rmask >> bj) & 1) { ROT2(v0, 0, cs0[0], cs0[1]); ROT2(v0, 2, cs0[2], cs0[3]); ROT2(v1, 0, cs1[0], cs1[1]); ROT2(v1, 2, cs1[2], cs1[3]); }
                    if (pn == 4 || pn <= 1 || pn == 9 || pn == 10) { v0 = v0 * sc; v1 = v1 * sc; }
                    u32x4 w; w.x = pk2(v0[0], v0[1]); w.y = pk2(v0[2], v0[3]); w.z = pk2(v1[0], v1[1]); w.w = pk2(v1[2], v1[3]);
                    __builtin_nontemporal_store(w, (u32x4*)(rowp + bj * 128));
                }
            }
    }
};

struct EpiMerge {
    static constexpr bool PERM = true, AFTER_DRAIN = false, KHOOK = true;
    bf16_t* Y; const u32x2* GB;
#define UB_(w, k) ((float)(((w) >> (8 * (k))) & 0xffu))
    __device__ __forceinline__ void khook(int t, f32x4 (&acc)[2][2][4][2], const Unit& u, int wr, int wc, int fr, int fq) const {
        const int gi = (t == 8) ? 0 : 1;
        const u32x2* ga = GB + ((size_t)(((gi * NMT + u.pm) * 4 + u.pn) * 8 + wr * 4 + wc) * 16) * 64 + fq * 16 + fr;
        const u32x2* gb = ga + (size_t)NMT * 4 * 8 * 16 * 64;
        u32x2 a[16], b[16];
#pragma unroll
        for (int j = 0; j < 16; ++j) { a[j] = ga[j * 64]; b[j] = gb[j * 64]; }
        __builtin_amdgcn_sched_barrier(0);
#pragma unroll
        for (int grp = 0; grp < 16; ++grp) { const int ai = grp >> 3, m = (grp >> 1) & 3, bj = grp & 1;
            f32x4 v0 = acc[ai][bj][m][0], v1 = acc[ai][bj][m][1];
#define MG_R(wa, wb, k) (UB_(wa, k) * __builtin_amdgcn_rcpf(UB_(wb, k)))
            v0[0] *= MG_R(a[grp].x, b[grp].x, 0); v0[1] *= MG_R(a[grp].x, b[grp].x, 1); v0[2] *= MG_R(a[grp].x, b[grp].x, 2); v0[3] *= MG_R(a[grp].x, b[grp].x, 3);
            v1[0] *= MG_R(a[grp].y, b[grp].y, 0); v1[1] *= MG_R(a[grp].y, b[grp].y, 1); v1[2] *= MG_R(a[grp].y, b[grp].y, 2); v1[3] *= MG_R(a[grp].y, b[grp].y, 3);
#undef MG_R
            acc[ai][bj][m][0] = v0; acc[ai][bj][m][1] = v1; }
        asm volatile("" ::: "memory"); __builtin_amdgcn_sched_barrier(0);
    }
    __device__ __forceinline__ void operator()(const f32x4 (&acc)[2][2][4][2], const Unit& u, int wr, int wc, int fr, int fq) const {
        const int row0 = u.pm * 256 + wr * 64 + fr, col0 = u.pn * 256 + wc * 32 + 8 * fq;
        const u32x2* gc = GB + ((size_t)(((2 * NMT + u.pm) * 4 + u.pn) * 8 + wr * 4 + wc) * 16) * 64 + fq * 16 + fr;
        u32x2 g[16];
#pragma unroll
        for (int j = 0; j < 16; ++j) g[j] = gc[j * 64];
        constexpr float q = 1.0f / 255.0f;
#pragma unroll
        for (int grp = 0; grp < 16; ++grp) { const int ai = grp >> 3, m = (grp >> 1) & 3, bj = grp & 1;
            const f32x4 v0 = acc[ai][bj][m][0] * q, v1 = acc[ai][bj][m][1] * q;
            u32x4 w; w.x = pk2(v0[0] * UB_(g[grp].x, 0), v0[1] * UB_(g[grp].x, 1)); w.y = pk2(v0[2] * UB_(g[grp].x, 2), v0[3] * UB_(g[grp].x, 3));
            w.z = pk2(v1[0] * UB_(g[grp].y, 0), v1[1] * UB_(g[grp].y, 1)); w.w = pk2(v1[2] * UB_(g[grp].y, 2), v1[3] * UB_(g[grp].y, 3));
            *(u32x4*)(Y + (size_t)(row0 + ai * 128 + m * 16) * DM + col0 + bj * 128) = w; }
    }
#undef UB_
};

struct EpiRes {
    static constexpr bool PERM = true, AFTER_DRAIN = false, KHOOK = false;
    const void* srcL; const void* srcC; bf16_t* dstL; bf16_t* dstC; const float* mod; int goff; float scl; int src32;
    __device__ __forceinline__ void operator()(const f32x4 (&acc)[2][2][4][2], const Unit& u, int wr, int wc, int fr, int fq) const {
        const bool latent = u.pm < TL / 256; const int mb = latent ? (u.pm >> 4) : 8;
        const float* g = mod + mb * 6144 + goff;
        const int rloc = (latent ? u.pm * 256 : u.pm * 256 - TL) + wr * 64 + fr, col0 = u.pn * 256 + wc * 32 + 8 * fq;
        const void* src = latent ? srcL : srcC; bf16_t* dst = latent ? dstL : dstC;
        f32x4 gv[2][2];
#pragma unroll
        for (int bj = 0; bj < 2; ++bj) { gv[bj][0] = *(const f32x4*)(g + col0 + bj * 128) * scl; gv[bj][1] = *(const f32x4*)(g + col0 + bj * 128 + 4) * scl; }
#pragma unroll
        for (int ai = 0; ai < 2; ++ai)
#pragma unroll
            for (int m = 0; m < 4; ++m) {
                const size_t off = (size_t)(rloc + ai * 128 + m * 16) * DM + col0;
#pragma unroll
                for (int bj = 0; bj < 2; ++bj) {
                    f32x4 x0, x1;
                    if (src32) { x0 = *(const f32x4*)((const float*)src + off + bj * 128); x1 = *(const f32x4*)((const float*)src + off + bj * 128 + 4); }
                    else { const u32x4 t = *(const u32x4*)((const bf16_t*)src + off + bj * 128); x0 = (f32x4){bf_lo(t.x), bf_hi(t.x), bf_lo(t.y), bf_hi(t.y)}; x1 = (f32x4){bf_lo(t.z), bf_hi(t.z), bf_lo(t.w), bf_hi(t.w)}; }
                    x0 += gv[bj][0] * acc[ai][bj][m][0]; x1 += gv[bj][1] * acc[ai][bj][m][1];
                    u32x4 w; w.x = pk2(x0[0], x0[1]); w.y = pk2(x0[2], x0[3]); w.z = pk2(x1[0], x1[1]); w.w = pk2(x1[2], x1[3]);
                    *(u32x4*)(dst + off + bj * 128) = w;
                }
                if (m & 1) asm volatile("" ::: "memory");
            }
    }
};

template <bool OUT8>
struct EpiSwiglu {
    static constexpr bool PERM = true, AFTER_DRAIN = false, KHOOK = false;
    unsigned char* U; const float* rs; const float* wsc; int d3;
    __device__ __forceinline__ void operator()(const f32x4 (&acc)[2][2][4][2], const Unit& u, int wr, int wc, int fr, int fq) const {
        const int row0 = u.pm * 256 + wr * 64 + fr, col0 = u.pn * 128 + wc * 32 + 8 * fq;
        const float w1s = wsc[2 * u.ge], w3s = wsc[2 * u.ge + d3] * (OUT8 ? F8_SU : 1.0f);
#pragma unroll
        for (int ai = 0; ai < 2; ++ai)
#pragma unroll
            for (int m = 0; m < 4; ++m) {
                const int row = row0 + ai * 128 + m * 16; const float r = rs[row], ra = r * w1s, rb = r * w3s;
                const f32x4 a0 = acc_i2f(acc[ai][0][m][0]) * ra, a1 = acc_i2f(acc[ai][0][m][1]) * ra, b0 = acc_i2f(acc[ai][1][m][0]) * rb, b1 = acc_i2f(acc[ai][1][m][1]) * rb;
                if constexpr (OUT8) {
                    u32x2 w; w.x = pk4f8(siluf_(a0[0]) * b0[0], siluf_(a0[1]) * b0[1], siluf_(a0[2]) * b0[2], siluf_(a0[3]) * b0[3]);
                    w.y = pk4f8(siluf_(a1[0]) * b1[0], siluf_(a1[1]) * b1[1], siluf_(a1[2]) * b1[2], siluf_(a1[3]) * b1[3]);
                    *(u32x2*)(U + (size_t)row * DFF + col0) = w;
                } else {
                    u32x4 w; w.x = pk2(siluf_(a0[0]) * b0[0], siluf_(a0[1]) * b0[1]); w.y = pk2(siluf_(a0[2]) * b0[2], siluf_(a0[3]) * b0[3]);
                    w.z = pk2(siluf_(a1[0]) * b1[0], siluf_(a1[1]) * b1[1]); w.w = pk2(siluf_(a1[2]) * b1[2], siluf_(a1[3]) * b1[3]);
                    *(u32x4*)((bf16_t*)U + (size_t)row * DFF + col0) = w;
                }
            }
    }
};

struct EpiBf16 {
    static constexpr bool PERM = true, AFTER_DRAIN = false, KHOOK = false;
    bf16_t* O; int ldc; float scl;
    __device__ __forceinline__ void operator()(const f32x4 (&acc)[2][2][4][2], const Unit& u, int wr, int wc, int fr, int fq) const {
        const int row0 = u.pm * 256 + wr * 64 + fr, col0 = u.pn * 256 + wc * 32 + 8 * fq;
#pragma unroll
        for (int ai = 0; ai < 2; ++ai)
#pragma unroll
            for (int m = 0; m < 4; ++m) { bf16_t* rowp = O + (size_t)(row0 + ai * 128 + m * 16) * ldc + col0;
#pragma unroll
                for (int bj = 0; bj < 2; ++bj) { const f32x4 v0 = acc[ai][bj][m][0] * scl, v1 = acc[ai][bj][m][1] * scl;
                    u32x4 w; w.x = pk2(v0[0], v0[1]); w.y = pk2(v0[2], v0[3]); w.z = pk2(v1[0], v1[1]); w.w = pk2(v1[2], v1[3]);
                    *(u32x4*)(rowp + bj * 128) = w; } }
    }
};

template <class Epi, class Sched, bool ALIGN_EPI = false, bool SP2 = false, int MODE = 0>
__device__ __forceinline__ void gemm_phase(PG8_LAS unsigned char* lds, const Gemm g, const Sched& S, const Epi& E, int tid_in) {
    int tid = tid_in; asm volatile("" : "+v"(tid));
    const int wid = __builtin_amdgcn_readfirstlane(tid >> 6), lane = tid & 63, wr = wid >> 2, wc = wid & 3, fr = lane & 15, fq = lane >> 4;
    const int K = g.K, nt = K / BK;
    unsigned voffA[2], voffB[2];
#pragma unroll
    for (int i = 0; i < 2; ++i) { int R, C; stage_rc(tid * 16 + i * 8192, R, C); const int Rb = Epi::PERM ? ((R & ~31) + perm32(R & 31)) : R;
        voffA[i] = (unsigned)(R * K + C) * 2u; voffB[i] = (unsigned)(Rb * K + C) * 2u; }
    const size_t kstep = (size_t)(BK * 2);
    const size_t hstep = (size_t)HALF * K * 2;
    const size_t tstep = 2 * hstep;
    const unsigned ldsw = (unsigned)wid * 1024u;
    const int aoff = lds_byte(wr * 64 + fr, fq * 8), boff = lds_byte(wc * 32 + fr, fq * 8);
#define PG8_SA(b, h) (((b) * 2 + (h)) * HTB)
#define PG8_SB(b, h) ((4 + (b) * 2 + (h)) * HTB)
#define PG8_STAGE(bufoff, gbase, voff) do { _Pragma("unroll") for (int _i = 0; _i < 2; ++_i) \
        __builtin_amdgcn_global_load_lds((const unsigned*)((const char*)(gbase) + (voff)[_i]), (PG8_LAS unsigned*)(lds + (bufoff) + ldsw + _i * 8192), 16, 0, 0); } while (0)
#define PG8_LDA(dst, b, h) do { _Pragma("unroll") for (int m = 0; m < 4; ++m) _Pragma("unroll") for (int k = 0; k < 2; ++k) dst[m][k] = *(const PG8_LAS bf16x8*)(lds + PG8_SA(b, h) + aoff + m * 2048 + k * 1024); } while (0)
#define PG8_LDB(dst, b, h) do { _Pragma("unroll") for (int n = 0; n < 2; ++n) _Pragma("unroll") for (int k = 0; k < 2; ++k) dst[n][k] = *(const PG8_LAS bf16x8*)(lds + PG8_SB(b, h) + boff + n * 2048 + k * 1024); } while (0)
#define PG8_CAT(x) __builtin_shufflevector(__builtin_bit_cast(i32x4, (x)[0]), __builtin_bit_cast(i32x4, (x)[1]), 0, 1, 2, 3, 4, 5, 6, 7)
#define PG8_MMA(ai, bj, At, Bt) do { __builtin_amdgcn_s_setprio(1); _Pragma("unroll") for (int m = 0; m < 4; ++m) _Pragma("unroll") for (int n = 0; n < 2; ++n) { \
        if constexpr (MODE == 1) { const i32x8 b8_ = PG8_CAT(Bt[n]), a8_ = PG8_CAT(At[m]); asm volatile("v_mfma_f32_16x16x128_f8f6f4 %0, %1, %2, %0" : "+v"(acc[ai][bj][m][n]) : "v"(b8_), "v"(a8_)); } \
          \
        else if constexpr (MODE == 2) { _Pragma("unroll") for (int k = 0; k < 2; ++k) asm volatile("v_mfma_i32_16x16x64_i8 %0, %1, %2, %0" : "+v"(acc[ai][bj][m][n]) : "v"(Bt[n][k]), "v"(At[m][k])); } \
        else { _Pragma("unroll") for (int k = 0; k < 2; ++k) acc[ai][bj][m][n] = __builtin_amdgcn_mfma_f32_16x16x32_bf16(Bt[n][k], At[m][k], acc[ai][bj][m][n], 0, 0, 0); } } \
        __builtin_amdgcn_s_setprio(0); } while (0)
#define PG8_WAIT_V(n) asm volatile("s_waitcnt vmcnt(" #n ")" ::: "memory")
#define PG8_WAIT_L(n) asm volatile("s_waitcnt lgkmcnt(" #n ")" ::: "memory")
#define PG8_BAR __builtin_amdgcn_s_barrier()
#define PG8_SCHED __builtin_amdgcn_sched_barrier(0)
    Unit cur, nxt; int ui = 0;
    if (!S.next(0, cur)) return;
    f32x4 acc[2][2][4][2];
#pragma unroll
    for (int a = 0; a < 2; ++a)
#pragma unroll
        for (int b = 0; b < 2; ++b)
#pragma unroll
            for (int m = 0; m < 4; ++m)
#pragma unroll
                for (int n = 0; n < 2; ++n) acc[a][b][m][n] = (f32x4){0.f, 0.f, 0.f, 0.f};
    bf16x8 At[4][2], B0[2][2], B1[2][2];
    const char* cA = (const char*)g.A + (size_t)cur.pm * tstep; const char* cB = (const char*)g.Bt + cur.bo * 2 + (size_t)cur.pn * tstep;
    S.a_ready(cur);
    if constexpr (SP2) {
        PG8_STAGE(PG8_SB(0, 0), cB, voffB); PG8_STAGE(PG8_SB(0, 1), cB + hstep, voffB); PG8_STAGE(PG8_SA(0, 0), cA, voffA); PG8_STAGE(PG8_SA(0, 1), cA + hstep, voffA);
        if (wr == 1) PG8_BAR;
        PG8_WAIT_V(2); PG8_BAR;
        PG8_STAGE(PG8_SB(1, 0), cB + kstep, voffB); PG8_STAGE(PG8_SA(1, 0), cA + kstep, voffA); PG8_STAGE(PG8_SB(1, 1), cB + hstep + kstep, voffB);
        PG8_WAIT_V(6); PG8_BAR;
    } else {
        PG8_STAGE(PG8_SB(0, 0), cB, voffB); PG8_STAGE(PG8_SA(0, 0), cA, voffA); PG8_STAGE(PG8_SB(0, 1), cB + hstep, voffB); PG8_STAGE(PG8_SA(0, 1), cA + hstep, voffA);
        if (wr == 1) PG8_BAR;
        PG8_WAIT_V(4); PG8_BAR;
        PG8_STAGE(PG8_SB(1, 0), cB + kstep, voffB); PG8_STAGE(PG8_SA(1, 0), cA + kstep, voffA); PG8_STAGE(PG8_SB(1, 1), cB + hstep + kstep, voffB);
        PG8_WAIT_V(6); PG8_BAR;
    }
    for (;;) {
        const bool has_next = S.next(ui + 1, nxt);
        const char* nA = has_next ? (const char*)g.A + (size_t)nxt.pm * tstep : cA; const char* nB = has_next ? (const char*)g.Bt + nxt.bo * 2 + (size_t)nxt.pn * tstep : cB;
        for (int t = 0; t < nt; t += 2) {
            const bool last = (t == nt - 2);
            const char* a1 = cA + (size_t)(t + 1) * kstep;
            const char* a2 = last ? nA : cA + (size_t)(t + 2) * kstep; const char* b2 = last ? nB : cB + (size_t)(t + 2) * kstep;
            const char* a3 = a2 + kstep; const char* b3 = b2 + kstep;
            if (last && has_next) S.a_ready(nxt);
            if constexpr (Epi::KHOOK) { if (t == 8 || t == 16) E.khook(t, acc, cur, wr, wc, fr, fq); }
            if constexpr (SP2) {
            PG8_LDB(B0, 0, 0); PG8_LDB(B1, 0, 1); PG8_SCHED; PG8_LDA(At, 0, 0); PG8_STAGE(PG8_SA(1, 1), a1 + hstep, voffA);
            PG8_WAIT_V(8); PG8_WAIT_L(0); PG8_BAR; PG8_MMA(0, 0, At, B0); PG8_MMA(0, 1, At, B1); PG8_BAR; PG8_SCHED;
            PG8_LDA(At, 0, 1); PG8_STAGE(PG8_SB(0, 0), b2, voffB); PG8_STAGE(PG8_SB(0, 1), b2 + hstep, voffB); PG8_STAGE(PG8_SA(0, 0), a2, voffA);
            PG8_WAIT_V(8); PG8_WAIT_L(0); PG8_BAR; PG8_MMA(1, 0, At, B0); PG8_MMA(1, 1, At, B1); PG8_BAR; PG8_SCHED;
            PG8_LDB(B0, 1, 0); PG8_LDB(B1, 1, 1); PG8_SCHED; PG8_LDA(At, 1, 0); PG8_STAGE(PG8_SA(0, 1), a2 + hstep, voffA);
            PG8_WAIT_V(8); PG8_WAIT_L(0); PG8_BAR; PG8_MMA(0, 0, At, B0); PG8_MMA(0, 1, At, B1); PG8_BAR; PG8_SCHED;
            PG8_LDA(At, 1, 1); PG8_STAGE(PG8_SB(1, 0), b3, voffB); PG8_STAGE(PG8_SB(1, 1), b3 + hstep, voffB); PG8_STAGE(PG8_SA(1, 0), a3, voffA);
            PG8_WAIT_V(8); PG8_WAIT_L(0); PG8_BAR; PG8_MMA(1, 0, At, B0); PG8_MMA(1, 1, At, B1); PG8_BAR; PG8_SCHED;
            } else {
            PG8_LDB(B0, 0, 0); PG8_SCHED; PG8_LDA(At, 0, 0); PG8_STAGE(PG8_SA(1, 1), a1 + hstep, voffA);
            PG8_WAIT_L(8); PG8_BAR; PG8_WAIT_L(0); PG8_MMA(0, 0, At, B0); PG8_BAR; PG8_SCHED;
            PG8_LDB(B1, 0, 1); PG8_STAGE(PG8_SB(0, 0), b2, voffB);
            PG8_BAR; PG8_WAIT_L(0); PG8_MMA(0, 1, At, B1); PG8_BAR;
            PG8_LDA(At, 0, 1); PG8_STAGE(PG8_SA(0, 0), a2, voffA);
            PG8_BAR; PG8_WAIT_L(0); PG8_MMA(1, 0, At, B0); PG8_BAR; PG8_SCHED;
            PG8_STAGE(PG8_SB(0, 1), b2 + hstep, voffB);
            PG8_WAIT_V(6); PG8_BAR; PG8_MMA(1, 1, At, B1); PG8_BAR;
            PG8_LDB(B0, 1, 0); PG8_SCHED; PG8_LDA(At, 1, 0); PG8_STAGE(PG8_SA(0, 1), a2 + hstep, voffA);
            PG8_WAIT_L(8); PG8_BAR; PG8_WAIT_L(0); PG8_MMA(0, 0, At, B0); PG8_BAR; PG8_SCHED;
            PG8_LDB(B1, 1, 1); PG8_STAGE(PG8_SB(1, 0), b3, voffB);
            PG8_BAR; PG8_WAIT_L(0); PG8_MMA(0, 1, At, B1); PG8_BAR;
            PG8_LDA(At, 1, 1); PG8_STAGE(PG8_SA(1, 0), a3, voffA);
            PG8_BAR; PG8_WAIT_L(0); PG8_MMA(1, 0, At, B0); PG8_BAR; PG8_SCHED;
            PG8_STAGE(PG8_SB(1, 1), b3 + hstep, voffB);
            PG8_WAIT_V(6); PG8_BAR; PG8_MMA(1, 1, At, B1); PG8_BAR;
            }
        }
        if constexpr (MODE != 0) asm volatile("s_nop 15\n\ts_nop 15" ::: "memory");
        if constexpr (ALIGN_EPI) { if (wr == 0) PG8_BAR; }
        if constexpr (!Epi::AFTER_DRAIN) { int ln_; asm volatile("v_mbcnt_lo_u32_b32 %0, -1, 0\n\tv_mbcnt_hi_u32_b32 %0, -1, %0" : "=v"(ln_));
            E(acc, cur, wr, wc, ln_ & 15, ln_ >> 4); S.done(cur); }
        if (!has_next) break;
#pragma unroll
        for (int a = 0; a < 2; ++a)
#pragma unroll
            for (int b = 0; b < 2; ++b)
#pragma unroll
                for (int m = 0; m < 4; ++m)
#pragma unroll
                    for (int n = 0; n < 2; ++n) acc[a][b][m][n] = (f32x4){0.f, 0.f, 0.f, 0.f};
        cur = nxt; cA = nA; cB = nB; ++ui;
        if constexpr (ALIGN_EPI) { if (wr == 1) PG8_BAR; }
    }
    PG8_WAIT_V(0);
    if constexpr (!ALIGN_EPI) { if (wr == 0) PG8_BAR; }
    PG8_BAR;
    if constexpr (Epi::AFTER_DRAIN) { E.fused(acc, cur, wr, wc, fr, fq, lds, wid, lane); S.done(cur); }
#undef PG8_SA
#undef PG8_SB
#undef PG8_STAGE
#undef PG8_LDA
#undef PG8_LDB
#undef PG8_MMA
#undef PG8_CAT
#undef PG8_WAIT_V
#undef PG8_WAIT_L
#undef PG8_BAR
#undef PG8_SCHED
}
}
namespace at {
__device__ __forceinline__ int crow(int r, int hi) { return (r & 3) + 8 * (r >> 2) + 4 * hi; }
typedef short v4i16_t __attribute__((ext_vector_type(4)));
__device__ __forceinline__ s16x4 vtr(const LAS unsigned char* p) { return __builtin_bit_cast(s16x4, __builtin_amdgcn_ds_read_tr16_b64_v4i16((LAS v4i16_t*)p)); }
__device__ __forceinline__ bf16x8 cat8(s16x4 lo, s16x4 hi) { return (bf16x8){lo[0], lo[1], lo[2], lo[3], hi[0], hi[1], hi[2], hi[3]}; }
#define MFMA32(a, b, c) __builtin_amdgcn_mfma_f32_32x32x16_bf16((a), (b), (c), 0, 0, 0)
constexpr int KSTR = 144;
constexpr float NEG_BIG = -1.0e30f;

__device__ __forceinline__ bf16x8 tr_frag(const LAS unsigned char* tile, int vstr, int ks, int colb, int lane) {
    const int hi = lane >> 5, ql = (lane & 15) >> 2, blk = (lane >> 4) & 1, p = lane & 3;
    const LAS unsigned char* a = tile + (16 * ks + 4 * hi + ql) * vstr + (colb + 16 * blk + 4 * p) * 2;
    return cat8(vtr(a), vtr(a + 8 * vstr));
}

template <int N> __device__ __forceinline__ void wait_bar() { asm volatile("s_waitcnt vmcnt(%0) lgkmcnt(0)\n\ts_barrier" :: "n"(N) : "memory"); }
template <int DV, int NK> struct AtGeo { static constexpr int KB = 8192, VB = DV * 128, STAGE = NK * KB + VB, NP = (NK * 8 + DV / 8) / 8  , LDS = 3 * STAGE + 2048; };
__device__ __forceinline__ bf16x8 v_frag(const LAS unsigned char* Vt, int ks, int c, int lane) {
    const int hi = lane >> 5, ql = (lane & 15) >> 2, blk = (lane >> 4) & 1, p = lane & 3;
    const int ch = (4 * (c & 1) + 2 * blk + (p >> 1)) ^ ((ql & 2) << 1);
    const LAS unsigned char* a = Vt + (c >> 1) * 8192 + (16 * ks + 4 * hi + ql) * 128 + ch * 16 + 8 * (p & 1);
    return cat8(vtr(a), vtr(a + 1024));
}
template <int DV, int NK> struct AtCtx {
    LAS unsigned char* lds; LAS float* scr; bf16x8 qr[4]; f32x16 o[DV / 32]; f32x16 negm; float m, l; int lane, r32, hi, ksel, qpos, kpos0, nloc; bool exact0;
};
template <int DV, int NK, bool BAND, bool HAS_QK, bool HAS_PV, bool EX0>
__device__ __forceinline__ void at_step(AtCtx<DV, NK>& C, int t, int koff, int voff, const u32x4 (&pw)[4], u32x4 (&pn)[4]) {
    constexpr int KB = 8192, NC = DV / 32, NG = NC * 4  , EPG = 16 / NG  ;
    const LAS unsigned char* Kt = C.lds + koff + C.ksel * KB;
    const LAS unsigned char* Vt = C.lds + voff;
    const int lane = C.lane, r32 = C.r32, hi = C.hi;
    f32x16 s0, s1; bf16x8 vf[2][4];
    bool resc = false;
    if (HAS_QK) {
        bf16x8 kf[8];
#pragma unroll
        for (int d0 = 0; d0 < 4; ++d0) { const int ko = r32 * 128 + (((2 * d0 + hi) ^ ((r32 >> 1) & 7)) << 4);
            kf[2 * d0] = *(const LAS bf16x8*)(Kt + ko); kf[2 * d0 + 1] = *(const LAS bf16x8*)(Kt + 4096 + ko); }
        __builtin_amdgcn_sched_barrier(0);
        __builtin_amdgcn_s_setprio(1);
        s0 = MFMA32(kf[0], C.qr[0], C.negm); s1 = MFMA32(kf[1], C.qr[0], C.negm);
#pragma unroll
        for (int d0 = 1; d0 < 4; ++d0) { s0 = MFMA32(kf[2 * d0], C.qr[d0], s0); s1 = MFMA32(kf[2 * d0 + 1], C.qr[d0], s1); }
        __builtin_amdgcn_s_setprio(0);
        __builtin_amdgcn_sched_barrier(0);
    }
    if (HAS_PV) {
#pragma unroll
        for (int c = 0; c < 2; ++c)
#pragma unroll
            for (int ks = 0; ks < 4; ++ks) vf[c][ks] = v_frag(Vt, ks, c, lane);
        __builtin_amdgcn_sched_barrier(0);
    }
    if (HAS_QK) {
        if (BAND && t < C.nloc) {
            const int kb = C.kpos0 + 64 * t - C.qpos;
#pragma unroll
            for (int r = 0; r < 16; ++r) { const int d = kb + crow(r, hi); if (d > 128 || d < -128) s0[r] = NEG_BIG; if (d + 32 > 128 || d + 32 < -128) s1[r] = NEG_BIG; }
        }
        float mt = fmaxf(fmaxf(s0[0], s1[0]), s0[1]);
#pragma unroll
        for (int r = 2; r < 16; r += 2) mt = fmaxf(fmaxf(mt, s0[r]), s0[r + 1]);
#pragma unroll
        for (int r = 1; r < 16; r += 2) mt = fmaxf(fmaxf(mt, s1[r]), s1[(r + 1) & 15]);
        { const auto sw = __builtin_amdgcn_permlane32_swap(__float_as_uint(mt), __float_as_uint(mt), false, false); mt = fmaxf(__uint_as_float(sw[0]), __uint_as_float(sw[1])); }
        const float dl = (!HAS_PV && EX0) ? mt : ((mt > 8.0f) ? mt : 0.0f);
        resc = (!HAS_PV && EX0) ? true : __any(dl > 0.0f);
        if (resc) { const float f = (!HAS_PV && EX0) ? 1.0f : fexp2(-dl);     C.l *= f; C.m += dl; if (hi == 0) C.scr[r32] = f;
#pragma unroll
            for (int r = 0; r < 16; ++r) { s0[r] -= dl; s1[r] -= dl; C.negm[r] = -C.m; } }
        __builtin_amdgcn_sched_barrier(0);
    }
    {
        float ls = 0.f;
        __builtin_amdgcn_s_setprio(1);
#pragma unroll
        for (int g = 0; g < NG; ++g) {
            const int c = g >> 2, ks = g & 3;
            if (HAS_PV) {
                C.o[c] = MFMA32(__builtin_bit_cast(bf16x8, pw[ks]), vf[c & 1][ks], C.o[c]);
                if (ks == 3 && c + 2 < NC) {
#pragma unroll
                    for (int k2 = 0; k2 < 4; ++k2) vf[c & 1][k2] = v_frag(Vt, k2, c + 2, lane);
                }
            }
            if (HAS_QK) {
#pragma unroll
                for (int e = 0; e < EPG; ++e) { const int r = g * EPG + e;
                    s0[r] = fexp2(s0[r]); s1[r] = fexp2(s1[r]); ls += s0[r] + s1[r];
                    if (r & 1) { const unsigned w0 = pk2(s0[r - 1], s0[r]), w1 = pk2(s1[r - 1], s1[r]); pn[r >> 3][(r >> 1) & 3] = w0; pn[2 + (r >> 3)][(r >> 1) & 3] = w1; } }
            }
        }
        if (HAS_QK) { C.l += ls; asm volatile("" : "+v"(pn[0]), "+v"(pn[1]), "+v"(pn[2]), "+v"(pn[3]), "+v"(C.l)); }
        __builtin_amdgcn_s_setprio(0);
        if (HAS_QK && HAS_PV) {
#pragma unroll
            for (int g = 0; g < NG; ++g) { __builtin_amdgcn_sched_group_barrier(0x008, 1, 0); __builtin_amdgcn_sched_group_barrier(0x002, 6 * EPG, 0); if (g < (NC - 2) * 4) __builtin_amdgcn_sched_group_barrier(0x100, 2, 0); }
        }
        __builtin_amdgcn_sched_barrier(0);
    }
    if (resc) {
        LDS_WAIT();
#pragma unroll
        for (int j = 0; j < 4; ++j) { const f32x4 fv = *(const LAS f32x4*)(C.scr + 8 * j + 4 * hi);
#pragma unroll
            for (int c = 0; c < NC; ++c) { C.o[c][4 * j] *= fv[0]; C.o[c][4 * j + 1] *= fv[1]; C.o[c][4 * j + 2] *= fv[2]; C.o[c][4 * j + 3] *= fv[3]; } }
        LDS_WAIT();
    }
}
template <int DV, int NK, bool BAND, bool EX0>
__device__ __forceinline__ void attn_core(LAS unsigned char* lds, const bf16_t* __restrict__ proj, int NT, int nloc, int locrow0, int ctxrow0, int kcol, int vcol,
                                          const bf16_t* qp, int ksel, int qpos, int kpos0, float m_init, float l_init, f32x16 (&o)[DV / 32], float& l_out, int tid) {
    typedef AtGeo<DV, NK> Geo;
    constexpr int KB = Geo::KB, VB = Geo::VB, NPK = NK, NPV = DV / 64, NP = NPK + NPV;
    AtCtx<DV, NK> C;
    C.lds = lds; C.lane = tid & 63; C.r32 = C.lane & 31; C.hi = C.lane >> 5; C.ksel = ksel; C.qpos = qpos; C.kpos0 = kpos0; C.nloc = nloc;
    const int lane = C.lane; const int wid = __builtin_amdgcn_readfirstlane(tid >> 6);
    C.scr = (LAS float*)(lds + 3 * Geo::STAGE) + wid * 64;
#pragma unroll
    for (int d0 = 0; d0 < 4; ++d0) C.qr[d0] = *(const bf16x8*)(qp + d0 * 16 + C.hi * 8);
    unsigned ksoff[NPK], vsoff[NPV]; int kdoff[NPK], vdoff[NPV];
#pragma unroll
    for (int i = 0; i < NPK; ++i) { const int pc = wid + 8 * i, j = pc >> 3, key = 8 * (pc & 7) + (lane >> 3), ch = (lane & 7) ^ ((key >> 1) & 7);
        ksoff[i] = (unsigned)key * DINP + kcol + j * 64 + ch * 8; kdoff[i] = pc * 1024; }
#pragma unroll
    for (int i = 0; i < NPV; ++i) { const int pv = wid + 8 * i, cp = pv >> 3, key = 8 * (pv & 7) + (lane >> 3), ch = (lane & 7) ^ (((key >> 1) & 1) << 2);
        vsoff[i] = (unsigned)key * DINP + vcol + cp * 64 + ch * 8; vdoff[i] = 3 * NK * KB + pv * 1024; }
#define AT_ROW0(t) ((t) < nloc ? locrow0 + 64 * (t) : ctxrow0 + 64 * ((t) - nloc))
#define AT_DMA_K(t, s) do { const bf16_t* tb = proj + (size_t)AT_ROW0(t) * DINP; \
        _Pragma("unroll") for (int i = 0; i < NPK; ++i) __builtin_amdgcn_global_load_lds((const unsigned*)(tb + ksoff[i]), (LAS unsigned*)(lds + (s) * (NK * KB) + kdoff[i]), 16, 0, 0); } while (0)
#define AT_DMA_V(t, s) do { const bf16_t* tb = proj + (size_t)AT_ROW0(t) * DINP; \
        _Pragma("unroll") for (int i = 0; i < NPV; ++i) __builtin_amdgcn_global_load_lds((const unsigned*)(tb + vsoff[i]), (LAS unsigned*)(lds + (s) * VB + vdoff[i]), 16, 0, 0); } while (0)
    C.m = m_init; C.l = l_init; C.exact0 = EX0;
#pragma unroll
    for (int r = 0; r < 16; ++r) C.negm[r] = -m_init;
#pragma unroll
    for (int c = 0; c < DV / 32; ++c) C.o[c] = (f32x16){0.f};
    u32x4 pa[4], pb[4];
    AT_DMA_K(0, 0);
    AT_DMA_K(1, 1); AT_DMA_V(0, 0);
    wait_bar<NP>();
    if (2 < NT) AT_DMA_K(2, 2);
    AT_DMA_V(1, 1);
    at_step<DV, NK, BAND, true, false, EX0>(C, 0, 0, 0, pb, pa);
    int s1 = 1, s0 = 0;
    for (int t = 1; t < NT; ++t) {
        if (t + 1 < NT) wait_bar<NP>(); else wait_bar<NPV>();
        const int s2 = s1 == 2 ? 0 : s1 + 1;
        if (t + 2 < NT) AT_DMA_K(t + 2, s0);
        if (t + 1 < NT) AT_DMA_V(t + 1, s2);
        at_step<DV, NK, BAND, true, true, EX0>(C, t, s1 * (NK * KB), 3 * NK * KB + s0 * VB, pa, pb);
#pragma unroll
        for (int i_ = 0; i_ < 4; ++i_) pa[i_] = pb[i_];
        s0 = s1; s1 = s2;
    }
    wait_bar<0>();
    at_step<DV, NK, BAND, false, true, EX0>(C, NT, 0, 3 * NK * KB + s0 * VB, pa, pb);
    wait_bar<0>();
#undef AT_ROW0
#undef AT_DMA_K
#undef AT_DMA_V
#pragma unroll
    for (int c = 0; c < DV / 32; ++c) o[c] = C.o[c];
    l_out = C.l + __shfl_xor(C.l, 32);
}
template <int DV, int NK> struct AtGeoP { static constexpr int KT = NK * 8192, VT = DV * 128, VRING = 4 * KT, SCR = 4 * KT + 4 * VT, LDS = SCR + 2048; };
template <int DV, int NK, bool EX0>
__device__ __forceinline__ void attn_core_pair(LAS unsigned char* lds, const bf16_t* __restrict__ proj, int NT, int nloc, int locrow0, int ctxrow0, int kcol, int vcol,
                                               const bf16_t* qp, int ksel, float m_init, float l_init, f32x16 (&o)[DV / 32], float& l_out, int tid) {
    typedef AtGeoP<DV, NK> Geo;
    constexpr int KT = Geo::KT, VT = Geo::VT, VRING = Geo::VRING, NPK = NK, NPV = DV / 64;
    AtCtx<DV, NK> C;
    C.lds = lds; C.lane = tid & 63; C.r32 = C.lane & 31; C.hi = C.lane >> 5; C.ksel = ksel; C.qpos = 0; C.kpos0 = 0; C.nloc = nloc;
    const int lane = C.lane; const int wid = __builtin_amdgcn_readfirstlane(tid >> 6);
    C.scr = (LAS float*)(lds + Geo::SCR) + wid * 64;
#pragma unroll
    for (int d0 = 0; d0 < 4; ++d0) C.qr[d0] = *(const bf16x8*)(qp + d0 * 16 + C.hi * 8);
    unsigned ksoff[NPK], vsoff[NPV]; int kdoff[NPK], vdoff[NPV];
#pragma unroll
    for (int i = 0; i < NPK; ++i) { const int pc = wid + 8 * i, j = pc >> 3, key = 8 * (pc & 7) + (lane >> 3), ch = (lane & 7) ^ ((key >> 1) & 7);
        ksoff[i] = (unsigned)key * DINP + kcol + j * 64 + ch * 8; kdoff[i] = pc * 1024; }
#pragma unroll
    for (int i = 0; i < NPV; ++i) { const int pv = wid + 8 * i, cp = pv >> 3, key = 8 * (pv & 7) + (lane >> 3), ch = (lane & 7) ^ (((key >> 1) & 1) << 2);
        vsoff[i] = (unsigned)key * DINP + vcol + cp * 64 + ch * 8; vdoff[i] = VRING + pv * 1024; }
#define ATP_ROW0(t) ((t) < nloc ? locrow0 + 64 * (t) : ctxrow0 + 64 * ((t) - nloc))
#define ATP_OFF(t, T_) ((((t) >> 1) & 1) * 2 * (T_) + ((t) & 1) * (T_))
#define ATP_DMA_K(t) do { const bf16_t* tb = proj + (size_t)ATP_ROW0(t) * DINP; const int so_ = ATP_OFF(t, KT); \
        _Pragma("unroll") for (int i = 0; i < NPK; ++i) __builtin_amdgcn_global_load_lds((const unsigned*)(tb + ksoff[i]), (LAS unsigned*)(lds + so_ + kdoff[i]), 16, 0, 0); } while (0)
#define ATP_DMA_V(t) do { const bf16_t* tb = proj + (size_t)ATP_ROW0(t) * DINP; const int so_ = ATP_OFF(t, VT); \
        _Pragma("unroll") for (int i = 0; i < NPV; ++i) __builtin_amdgcn_global_load_lds((const unsigned*)(tb + vsoff[i]), (LAS unsigned*)(lds + so_ + vdoff[i]), 16, 0, 0); } while (0)
    C.m = m_init; C.l = l_init; C.exact0 = EX0;
#pragma unroll
    for (int r = 0; r < 16; ++r) C.negm[r] = -m_init;
#pragma unroll
    for (int c = 0; c < DV / 32; ++c) C.o[c] = (f32x16){0.f};
    u32x4 pa[4], pb[4];
    ATP_DMA_K(0); ATP_DMA_K(1); ATP_DMA_V(0);
    wait_bar<0>();
    if (2 < NT) { ATP_DMA_K(2); ATP_DMA_K(3); ATP_DMA_V(2); }
    ATP_DMA_V(1);
    at_step<DV, NK, false, true, false, EX0>(C, 0, ATP_OFF(0, KT), 0, pb, pa);
    at_step<DV, NK, false, true, true, EX0>(C, 1, ATP_OFF(1, KT), VRING + ATP_OFF(0, VT), pa, pb);
#pragma unroll
    for (int i_ = 0; i_ < 4; ++i_) pa[i_] = pb[i_];
    for (int t = 2; t < NT; t += 2) {
        wait_bar<0>();
        if (t + 2 < NT) { ATP_DMA_K(t + 2); ATP_DMA_K(t + 3); ATP_DMA_V(t + 2); }
        ATP_DMA_V(t + 1);
        at_step<DV, NK, false, true, true, EX0>(C, t, ATP_OFF(t, KT), VRING + ATP_OFF(t - 1, VT), pa, pb);
#pragma unroll
        for (int i_ = 0; i_ < 4; ++i_) pa[i_] = pb[i_];
        at_step<DV, NK, false, true, true, EX0>(C, t + 1, ATP_OFF(t + 1, KT), VRING + ATP_OFF(t, VT), pa, pb);
#pragma unroll
        for (int i_ = 0; i_ < 4; ++i_) pa[i_] = pb[i_];
    }
    wait_bar<0>();
    at_step<DV, NK, false, false, true, EX0>(C, NT, 0, VRING + ATP_OFF(NT - 1, VT), pa, pb);
    wait_bar<0>();
#undef ATP_ROW0
#undef ATP_OFF
#undef ATP_DMA_K
#undef ATP_DMA_V
#pragma unroll
    for (int c = 0; c < DV / 32; ++c) o[c] = C.o[c];
    l_out = C.l + __shfl_xor(C.l, 32);
}
template <int NC>
__device__ __forceinline__ void scale_rows(f32x16 (&o)[NC], float v, LAS float* scr, int r32, int hi) {
    LDS_WAIT();
    if (hi == 0) scr[r32] = v;
    LDS_WAIT();
#pragma unroll
    for (int j = 0; j < 4; ++j) { const f32x4 fv = *(const LAS f32x4*)(scr + 8 * j + 4 * hi);
#pragma unroll
        for (int c = 0; c < NC; ++c) { o[c][4 * j] *= fv[0]; o[c][4 * j + 1] *= fv[1]; o[c][4 * j + 2] *= fv[2]; o[c][4 * j + 3] *= fv[3]; } }
    LDS_WAIT();
}
constexpr int AT_A_LDS = AtGeo<64, 1>::LDS;
constexpr int AT_C_LDS = AtGeoP<128, 2>::LDS;

__device__ __forceinline__ void attnA_unit(LAS unsigned char* lds, const bf16_t* proj, bf16_t* ocat, const float* sink, int b, int g, int qb, int lat, int tid) {
    const int lane = tid & 63, r32 = lane & 31, hi = lane >> 5; const int wid = __builtin_amdgcn_readfirstlane(tid >> 6);
    const int head = g * 4 + (wid >> 1), qloc = qb * 64 + (wid & 1) * 32;
    const int qrow0 = (lat ? b * SEQ : TL + b * CTXL) + qloc;
    int nloc = 0, kt0 = 0;
    if (lat) { kt0 = qb - 2 < 0 ? 0 : qb - 2; const int kt1 = qb + 2 > 63 ? 63 : qb + 2; nloc = kt1 - kt0 + 1; }
    const int NT = nloc + 4;
    f32x16 o[2]; float l;
    attn_core<64, 1, true, false>(lds, proj, NT, nloc, b * SEQ + 64 * kt0, TL + b * CTXL, C_KA + g * 64, C_VA + g * 64,
                           proj + (size_t)(qrow0 + r32) * DINP + C_QA + head * 64, 0, qloc + r32, 64 * kt0, sink[head] * LOG2E, hi == 0 ? 1.0f : 0.0f, o, l, tid);
    LAS float* scr = (LAS float*)(lds + 3 * AtGeo<64, 1>::STAGE) + wid * 64;
    scale_rows<2>(o, __builtin_amdgcn_rcpf(l), scr, r32, hi);
    bf16_t* op = ocat + (size_t)qrow0 * OCW + head * 64 + r32;
#pragma unroll
    for (int r = 0; r < 16; ++r) { const int row = crow(r, hi);
#pragma unroll
        for (int c = 0; c < 2; ++c) op[(size_t)row * OCW + 32 * c] = (bf16_t)(pk2(o[c][r], 0.f) & 0xffffu); }
}

__device__ __forceinline__ void attnC_unit(LAS unsigned char* lds, const bf16_t* proj, bf16_t* ocat, const float* dgain, float lam, float oml, int b, int h, int qb, int lat, int tid) {
    const int lane = tid & 63, r32 = lane & 31, hi = lane >> 5; const int wid = __builtin_amdgcn_readfirstlane(tid >> 6);
    const int comp = wid >> 2, qloc = qb * 128 + (wid & 3) * 32;
    const int qrow0 = (lat ? b * SEQ : TL + b * CTXL) + qloc;
    const int nloc = lat ? 64 : 0, NT = nloc + 4;
    f32x16 o[4]; float l;
    attn_core_pair<128, 2, true>(lds, proj, NT, nloc, b * SEQ, TL + b * CTXL, C_KD + h * 128, C_VD + h * 128,
                           proj + (size_t)(qrow0 + r32) * DINP + C_QD + h * 128 + comp * 64, comp, 0.0f, 0.0f, o, l, tid);
    LAS float* scr = (LAS float*)(lds + AtGeoP<128, 2>::SCR) + wid * 64;
    scale_rows<4>(o, __builtin_amdgcn_rcpf(l), scr, r32, hi);
    LAS float* X = (LAS float*)lds + (wid & 3) * 4096;
    if (comp == 1) {
#pragma unroll
        for (int c = 0; c < 4; ++c)
#pragma unroll
            for (int r = 0; r < 16; ++r) X[(c * 16 + r) * 64 + lane] = o[c][r];
    }
    __syncthreads();
    if (comp == 0) {
        float ss[16];
#pragma unroll
        for (int r = 0; r < 16; ++r) ss[r] = 0.f;
#pragma unroll
        for (int c = 0; c < 4; ++c)
#pragma unroll
            for (int r = 0; r < 16; ++r) { const float v = o[c][r] - lam * X[(c * 16 + r) * 64 + lane]; o[c][r] = v; ss[r] += v * v; }
#pragma unroll
        for (int r = 0; r < 16; ++r) {
            ss[r] = half32_sum(ss[r]);
            ss[r] = __builtin_amdgcn_rsqf(ss[r] * (1.0f / 128.0f) + NORM_EPS) * oml;
        }
        bf16_t* op = ocat + (size_t)qrow0 * OCW + 1024 + h * 128 + r32;
#pragma unroll
        for (int c = 0; c < 4; ++c) { const float gn = dgain[32 * c + r32];
#pragma unroll
            for (int r = 0; r < 16; ++r) op[(size_t)crow(r, hi) * OCW + 32 * c] = (bf16_t)(pk2(o[c][r] * ss[r] * gn, 0.f) & 0xffffu); }
    }
    __syncthreads();
}
__device__ __forceinline__ int chunk_row0(int b, int ci) { return ci < 2 ? TL + b * CTXL + ci * 128 : b * SEQ + (ci - 2) * 128; }
constexpr int RSTR = 192;
constexpr int VSTR128 = 320;
constexpr int R1_LDS = 2 * 128 * RSTR + 128 * VSTR128;
__device__ __forceinline__ void ret_kv_phase(LAS unsigned char* lds, const bf16_t* __restrict__ proj, bf16_t* kvT, const float* lg2, int blk, int G, int tid) {
    const int lane = tid & 63, hi = lane >> 5; const int wid = __builtin_amdgcn_readfirstlane(tid >> 6);
    LAS unsigned char* Kf = lds; LAS unsigned char* Kb = lds + 128 * RSTR; LAS unsigned char* Vt = lds + 2 * 128 * RSTR;
    constexpr int NU = NB * 4 * NCHK;
    int u = blk; if (u >= NU) return;
    u32x4 kreg[2], vreg[4];
#define R1_LOAD(uu) do { const int ci_ = (uu) % NCHK, bh_ = (uu) / NCHK, row0_ = chunk_row0(bh_ >> 2, ci_), h_ = bh_ & 3; \
        _Pragma("unroll") for (int i = 0; i < 2; ++i) { const int c = tid + 512 * i, k = c >> 3, ch = c & 7; kreg[i] = *(const u32x4*)(proj + (size_t)(row0_ + k) * DINP + C_KB + h_ * 64 + ch * 8); } \
        _Pragma("unroll") for (int i = 0; i < 4; ++i) { const int c = tid + 512 * i, k = c >> 4, ch = c & 15; vreg[i] = *(const u32x4*)(proj + (size_t)(row0_ + k) * DINP + C_VB + h_ * 128 + ch * 8); } } while (0)
    R1_LOAD(u);
    for (;;) {
        const int ci = u % NCHK, bh = u / NCHK, b = bh >> 2, h = bh & 3;
        const float lgf2 = lg2[h], lgb2 = lg2[4 + h];
#pragma unroll
        for (int i = 0; i < 2; ++i) { const int c = tid + 512 * i, k = c >> 3, ch = c & 7;
            const u32x4 v = kreg[i];
            const float wf = fexp2((float)(127 - k) * lgf2), wb = fexp2((float)k * lgb2);
            u32x4 a, d;
#pragma unroll
            for (int j = 0; j < 4; ++j) { const float x0 = bf_lo(v[j]), x1 = bf_hi(v[j]); a[j] = pk2(x0 * wf, x1 * wf); d[j] = pk2(x0 * wb, x1 * wb); }
            *(LAS u32x4*)(Kf + k * RSTR + ch * 16) = a; *(LAS u32x4*)(Kb + k * RSTR + ch * 16) = d; }
#pragma unroll
        for (int i = 0; i < 4; ++i) { const int c = tid + 512 * i, k = c >> 4, ch = c & 15; *(LAS u32x4*)(Vt + k * VSTR128 + ch * 16) = vreg[i]; }
        __syncthreads();
        const int un = u + G;
        if (un < NU) R1_LOAD(un);
        const int dir = wid >> 2, mt = (wid >> 1) & 1, nt0 = (wid & 1) * 2;
        const LAS unsigned char* Kt = dir ? Kb : Kf;
        f32x16 acc0 = (f32x16){0.f}, acc1 = (f32x16){0.f};
#pragma unroll
        for (int ks = 0; ks < 8; ++ks) {
            const bf16x8 af = tr_frag(Kt, RSTR, ks, 32 * mt, lane);
            acc0 = MFMA32(af, tr_frag(Vt, VSTR128, ks, 32 * nt0, lane), acc0);
            acc1 = MFMA32(af, tr_frag(Vt, VSTR128, ks, 32 * nt0 + 32, lane), acc1);
        }
        bf16_t* out = kvT + ((size_t)(((b * 4 + h) * NCHK + ci) * 2 + dir)) * 8192;
#pragma unroll
        for (int j = 0; j < 4; ++j) {
            u32x2 w0, w1; w0.x = pk2(acc0[4 * j], acc0[4 * j + 1]); w0.y = pk2(acc0[4 * j + 2], acc0[4 * j + 3]); w1.x = pk2(acc1[4 * j], acc1[4 * j + 1]); w1.y = pk2(acc1[4 * j + 2], acc1[4 * j + 3]);
            *(u32x2*)(out + (size_t)(32 * nt0 + (lane & 31)) * 64 + 32 * mt + 8 * j + 4 * hi) = w0;
            *(u32x2*)(out + (size_t)(32 * nt0 + 32 + (lane & 31)) * 64 + 32 * mt + 8 * j + 4 * hi) = w1;
        }
        __syncthreads();
        if (un >= NU) break;
        u = un;
    }
#undef R1_LOAD
}
__device__ __forceinline__ void ret_scan(const bf16_t* kvT, bf16_t* SpT, const float* lg2  , int gtid, int gthreads) {
    for (int q = gtid; q < 64 * 2048; q += gthreads) {
        const int combo = q >> 11, e4 = (q & 2047) * 4, dir = combo & 1, h = (combo >> 1) & 3, b = combo >> 3;
        const float g128 = fexp2(128.0f * lg2[dir * 4 + h]);
        f32x4 S = {0.f, 0.f, 0.f, 0.f};
        for (int s = 0; s < NCHK; ++s) {
            const int ci = dir ? (s == 0 ? 1 : (s == 1 ? 0 : 35 - s)) : s;
            const size_t off = ((size_t)(((b * 4 + h) * NCHK + ci) * 2 + dir)) * 8192 + e4;
            const u32x2 kw = *(const u32x2*)(kvT + off); const f32x4 kv = {bf_lo(kw.x), bf_hi(kw.x), bf_lo(kw.y), bf_hi(kw.y)};
            u32x2 w; w.x = pk2(S[0], S[1]); w.y = pk2(S[2], S[3]);
            *(u32x2*)(SpT + off) = w;
            S = S * g128 + kv;
        }
    }
}
constexpr int R3_K = 0, R3_V = 128 * KSTR, R3_SF = R3_V + 128 * VSTR128, R3_SB = R3_SF + 128 * KSTR, R3_X = R3_SB + 128 * KSTR, R3_SCR = R3_X + 1024, R3_LDS = R3_SCR + 2048;
__device__ __forceinline__ void ret_out_unit(LAS unsigned char* lds, const bf16_t* __restrict__ proj, const bf16_t* __restrict__ SpT, bf16_t* ocat, float lgf2, float lgb2, int b, int h, int ci, int tid) {
    const int lane = tid & 63, r32 = lane & 31, hi = lane >> 5; const int wid = __builtin_amdgcn_readfirstlane(tid >> 6);
    const int row0 = chunk_row0(b, ci), qs = wid & 3, dh = wid >> 2;
    const bf16_t* sp = SpT + ((size_t)(((b * 4 + h) * NCHK + ci) * 2)) * 8192;
#pragma unroll
    for (int i = 0; i < 2; ++i) { const int c = tid + 512 * i, k = c >> 3, ch = c & 7;
        *(LAS u32x4*)(lds + R3_K + k * KSTR + ch * 16) = *(const u32x4*)(proj + (size_t)(row0 + k) * DINP + C_KB + h * 64 + ch * 8);
        *(LAS u32x4*)(lds + R3_SF + k * KSTR + ch * 16) = *(const u32x4*)(sp + (size_t)k * 64 + ch * 8);
        *(LAS u32x4*)(lds + R3_SB + k * KSTR + ch * 16) = *(const u32x4*)(sp + 8192 + (size_t)k * 64 + ch * 8); }
#pragma unroll
    for (int i = 0; i < 4; ++i) { const int c = tid + 512 * i, k = c >> 4, ch = c & 15;
        *(LAS u32x4*)(lds + R3_V + k * VSTR128 + ch * 16) = *(const u32x4*)(proj + (size_t)(row0 + k) * DINP + C_VB + h * 128 + ch * 8); }
    bf16x8 qr[4];
    { const bf16_t* qp = proj + (size_t)(row0 + 32 * qs + r32) * DINP + C_QB + h * 64;
#pragma unroll
      for (int d0 = 0; d0 < 4; ++d0) qr[d0] = *(const bf16x8*)(qp + d0 * 16 + hi * 8); }
    bf16_t gt[2][16];
    { const bf16_t* gp0 = proj + (size_t)(row0 + 32 * qs) * DINP + C_GB + h * 128 + 64 * dh + r32;
#pragma unroll
      for (int r = 0; r < 16; ++r)
#pragma unroll
          for (int c = 0; c < 2; ++c) gt[c][r] = gp0[(size_t)crow(r, hi) * DINP + 32 * c]; }
    __syncthreads();
    f32x16 o[2];
#pragma unroll
    for (int c = 0; c < 2; ++c) {
        f32x16 tf = (f32x16){0.f}, tb = (f32x16){0.f};
        const int srow = 64 * dh + 32 * c + r32;
#pragma unroll
        for (int d0 = 0; d0 < 4; ++d0) {
            tf = MFMA32(qr[d0], *(const LAS bf16x8*)(lds + R3_SF + srow * KSTR + (16 * d0 + 8 * hi) * 2), tf);
            tb = MFMA32(qr[d0], *(const LAS bf16x8*)(lds + R3_SB + srow * KSTR + (16 * d0 + 8 * hi) * 2), tb);
        }
#pragma unroll
        for (int r = 0; r < 16; ++r) { const int cp = 32 * qs + crow(r, hi); o[c][r] = fexp2((float)(cp + 1) * lgf2) * tf[r] + fexp2((float)(128 - cp) * lgb2) * tb[r]; }
    }
    const int qpos = 32 * qs + r32;
#pragma unroll 1
    for (int kt = 0; kt < 4; ++kt) {
        f32x16 p = (f32x16){0.f};
#pragma unroll
        for (int d0 = 0; d0 < 4; ++d0) p = MFMA32(*(const LAS bf16x8*)(lds + R3_K + (32 * kt + r32) * KSTR + (16 * d0 + 8 * hi) * 2), qr[d0], p);
#pragma unroll
        for (int r = 0; r < 16; ++r) { const int d = qpos - (32 * kt + crow(r, hi));
            const float wf = d >= 0 ? fexp2((float)d * lgf2) : 0.f, wb = d <= 0 ? fexp2((float)(-d) * lgb2) : 0.f; p[r] *= (wf + wb); }
        u32x4 w0, w1;
        w0.x = pk2(p[0], p[1]); w0.y = pk2(p[2], p[3]); w0.z = pk2(p[4], p[5]); w0.w = pk2(p[6], p[7]);
        w1.x = pk2(p[8], p[9]); w1.y = pk2(p[10], p[11]); w1.z = pk2(p[12], p[13]); w1.w = pk2(p[14], p[15]);
        const bf16x8 pa = __builtin_bit_cast(bf16x8, w0), pb = __builtin_bit_cast(bf16x8, w1);
#pragma unroll
        for (int c = 0; c < 2; ++c) {
            o[c] = MFMA32(pa, tr_frag(lds + R3_V, VSTR128, 2 * kt, 64 * dh + 32 * c, lane), o[c]);
            o[c] = MFMA32(pb, tr_frag(lds + R3_V, VSTR128, 2 * kt + 1, 64 * dh + 32 * c, lane), o[c]);
        }
    }
    float ss[16];
#pragma unroll
    for (int r = 0; r < 16; ++r) ss[r] = half32_sum(o[0][r] * o[0][r] + o[1][r] * o[1][r]);
    LAS float* X = (LAS float*)(lds + R3_X);
    if (r32 == 0) {
#pragma unroll
        for (int r = 0; r < 16; ++r) X[dh * 128 + 32 * qs + crow(r, hi)] = ss[r];
    }
    __syncthreads();
    bf16_t* op = ocat + (size_t)(row0 + 32 * qs) * OCW + 512 + h * 128 + 64 * dh + r32;
#pragma unroll
    for (int r = 0; r < 16; ++r) { const int row = crow(r, hi);
        const float rstd = __builtin_amdgcn_rsqf((X[32 * qs + row] + X[128 + 32 * qs + row]) * (1.0f / 128.0f) + NORM_EPS);
#pragma unroll
        for (int c = 0; c < 2; ++c) { const float gte = bf1(gt[c][r]);
            op[(size_t)row * OCW + 32 * c] = (bf16_t)(pk2(o[c][r] * rstd * siluf_(gte), 0.f) & 0xffffu); } }
    __syncthreads();
}
#undef MFMA32
}
constexpr size_t MiB = 1u << 20;
constexpr size_t WS_CTL = 0, CTL_ZERO_BYTES = 128 * 1024;
constexpr int CW_BAR = 1024;
constexpr int CW_MOE = 8192;
constexpr int CW_CUR = 12288;
constexpr int CW_DEP = 20480;
constexpr int CW_DONE = 16384;
constexpr size_t WS_TAB = 1 * MiB;
constexpr int TAB_MOD = 0, TAB_ROPE = DEPTH * 9 * 6144, TAB_LAM = TAB_ROPE + 2048, TAB_LG2 = TAB_LAM + 8, TAB_WSC = TAB_LG2 + 32;
constexpr size_t WS_XC = 2 * MiB;
constexpr size_t WS_ROUTE = 10 * MiB;
constexpr size_t WS_RS = 11 * MiB + 256 * 1024;
constexpr size_t WS_RSS = 11 * MiB + 512 * 1024;
constexpr size_t WS_MIX = 12 * MiB, MIX_STRIDE = 19 * MiB;
constexpr size_t MIX_WB = 14 * MiB, MIX_WO = 17 * MiB;
constexpr size_t WS_FD = 88 * MiB, FD_STRIDE = 17 * MiB, FD_W2 = 11 * MiB;
constexpr size_t WS_W13 = 122 * MiB;
constexpr size_t WS_W2 = 166 * MiB;
constexpr size_t WS_XB = 188 * MiB;
constexpr size_t WS_H = 254 * MiB;
constexpr size_t WS_PROJ = 322 * MiB;
constexpr size_t WS_GATE = WS_PROJ + 256 * MiB;
constexpr size_t WS_OCAT = 782 * MiB;
constexpr size_t WS_Y = 884 * MiB;
constexpr size_t WS_END = 952 * MiB;
static_assert((size_t)DIN * DM * 2 <= MIX_WB && MIX_WB + (size_t)DM * OCW * 2 <= MIX_WO && MIX_WO + (size_t)DM * DM * 2 <= MIX_STRIDE && WS_MIX + DEPTH * MIX_STRIDE <= WS_FD, "ws map (mixer weights)");
static_assert((size_t)2 * DFF * DM * 2 <= FD_W2 && FD_W2 + (size_t)DM * DFF * 2 <= FD_STRIDE && WS_FD + 2 * FD_STRIDE <= WS_W13, "ws map (dense ffn weights)");
static_assert(WS_W13 + (size_t)NEXP * 2 * DFF * DM <= WS_W2 && WS_W2 + (size_t)NEXP * DM * DFF <= WS_XB && WS_XB + (size_t)TL * DM * 2 <= WS_H && WS_H + (size_t)TT * DM * 2 <= WS_PROJ, "ws map (moe weights, x, h)");
static_assert(WS_PROJ + (size_t)TT * DINP * 2 <= WS_GATE && WS_GATE + (size_t)3 * NMT * 4 * 8 * 16 * 64 * 16 <= WS_OCAT && WS_OCAT + (size_t)TT * OCW * 2 <= WS_Y && WS_Y + (size_t)TT * DM * 2 <= WS_END, "ws map (activations)");
constexpr int MOE_SLOTS = 2 * TT + NEXP * 256;
static_assert(WS_PROJ + (size_t)MOE_SLOTS * DFF * 2 <= WS_OCAT && WS_OCAT + (size_t)MOE_SLOTS * DM * 2 <= WS_END, "ws map (MoE overlays)");
static_assert((size_t)NB * 4 * NCHK * 2 * 8192 * 4 <= (size_t)TT * DM * 2 && (size_t)NB * 4 * NCHK * 2 * 8192 * 2 <= (size_t)TT * DM * 2, "ws map (retention overlays)");

#define XB_TMO      128
#define XB_XCNT(j)  (256  + 64 * (j))
#define XB_XSUB(j)  (1280 + 64 * (j))
#define XB_XGEN(j)  (2304 + 64 * (j))
#define XB_TOP      3328
#define XB_TOPGEN   3392
#define XCD_BAR_WORDS 3456
#define XB_SPIN_CAP (1u << 18)

__device__ __forceinline__ unsigned xb_ld(unsigned* p)              { return __hip_atomic_load(p, __ATOMIC_RELAXED, __HIP_MEMORY_SCOPE_AGENT); }
__device__ __forceinline__ unsigned xb_add(unsigned* p, unsigned v) { return __hip_atomic_fetch_add(p, v, __ATOMIC_RELAXED, __HIP_MEMORY_SCOPE_AGENT); }
__device__ __forceinline__ unsigned xb_xcc_id() { return (unsigned)__builtin_amdgcn_s_getreg((3 << 11) | 20) & 0xFu; }
#define XB_SPIN(cond, bar) do { unsigned _sp = 0; while (cond) { __builtin_amdgcn_s_sleep(1); \
    if ((++_sp & 255u) == 0u) { if (xb_ld(&(bar)[XB_TMO])) break; if (_sp > XB_SPIN_CAP) { atomicAdd(&(bar)[XB_TMO], 1u); break; } } } } while (0)

struct XcdBarrier {
    unsigned* bar; unsigned x;
    volatile LAS unsigned* st;
};
__device__ __forceinline__ XcdBarrier xcd_barrier_post(unsigned* bar, volatile LAS unsigned* st, int tid) {
    XcdBarrier b; b.bar = bar; b.x = xb_xcc_id(); b.st = st;
    if (tid == 0) (void)xb_add(&bar[XB_XCNT(b.x)], 1u);
    return b;
}
__device__ __forceinline__ void xcd_barrier_complete(unsigned* bar, unsigned x, unsigned& nloc, unsigned& nx) {
    const unsigned G = gridDim.x * gridDim.y * gridDim.z;
    unsigned sum, cnt, mine, sp = 0u;
    for (;;) {
        sum = 0u; cnt = 0u; mine = 0u;
#pragma unroll
        for (unsigned j = 0; j < 16; ++j) { const unsigned c = xb_ld(&bar[XB_XCNT(j)]); sum += c; cnt += (c > 0u) ? 1u : 0u; mine = (j == x) ? c : mine; }
        if (sum == G) break;
        __builtin_amdgcn_s_sleep(1);
        if ((++sp & 255u) == 0u) { if (xb_ld(&bar[XB_TMO])) break; if (sp > XB_SPIN_CAP) { atomicAdd(&bar[XB_TMO], 1u); break; } }
    }
    nloc = mine > 0u ? mine : 1u; nx = cnt > 0u ? cnt : 1u;
}
__device__ __forceinline__ void xcd_barrier(const XcdBarrier& b_in, int tid) {
    XcdBarrier b = b_in; b.x = xb_xcc_id();
    asm volatile("s_waitcnt vmcnt(0)" ::: "memory");
    __syncthreads();
    if (tid == 0) {
        unsigned* bar = b.bar; asm volatile("" : "+s"(bar));
        __builtin_amdgcn_s_waitcnt(0);
        unsigned nloc = b.st[0], nx = b.st[1];
        if (nloc == 0u) { xcd_barrier_complete(bar, b.x, nloc, nx); b.st[0] = nloc; b.st[1] = nx; }
        const unsigned old = xb_add(&bar[XB_XSUB(b.x)], 1u);
        const unsigned gen = old / nloc;
        if (old + 1u == (gen + 1u) * nloc) {
            __builtin_amdgcn_fence(__ATOMIC_RELEASE, "agent");
            asm volatile("s_waitcnt vmcnt(0)" ::: "memory");
            const unsigned og = xb_add(&bar[XB_TOP], 1u);
            const unsigned tg = og / nx;
            if (og + 1u == (tg + 1u) * nx) xb_add(&bar[XB_TOPGEN], 1u);
            else XB_SPIN(xb_ld(&bar[XB_TOPGEN]) == tg, bar);
            __builtin_amdgcn_fence(__ATOMIC_ACQUIRE, "agent");
            xb_add(&bar[XB_XGEN(b.x)], 1u);
            asm volatile("s_waitcnt vmcnt(0)" ::: "memory");
        } else {
            XB_SPIN(xb_ld(&bar[XB_XGEN(b.x)]) == gen, bar);
            __builtin_amdgcn_fence(__ATOMIC_ACQUIRE, "agent");
            asm volatile("s_waitcnt vmcnt(0)" ::: "memory");
        }
    }
    __syncthreads();
}
struct Route { int sa, sb; float ga, gb; int ea, pa, eb, pb; };

__device__ __forceinline__ void p0_mod(LAS unsigned char* lds, const float* c, const float* cctx, const float* wmod, const float* bmod, float* mod, int blk, int G, int tid) {
    LAS float* sc = (LAS float*)lds;
    LAS float* red = sc + 9 * 1024;
    for (int i = tid; i < 9 * 1024; i += 512) { const float v = i < 8192 ? c[i] : cctx[i - 8192]; sc[i] = siluf_(v); }
    __syncthreads();
    const int cq = tid & 31, kg = tid >> 5;
    for (int u = blk; u < DEPTH * 48; u += G) {
        const int l = u / 48, n = (u % 48) * 128 + 4 * cq;
        f32x4 acc[9];
#pragma unroll
        for (int r = 0; r < 9; ++r) acc[r] = (f32x4){0.f, 0.f, 0.f, 0.f};
        const float* wp = wmod + ((size_t)l * DM + kg * 64) * 6144 + n;
        for (int k0 = 0; k0 < 64; k0 += 16) {
            f32x4 w[16];
#pragma unroll
            for (int k = 0; k < 16; ++k) w[k] = *(const f32x4*)(wp + (size_t)(k0 + k) * 6144);
#pragma unroll
            for (int k = 0; k < 16; ++k)
#pragma unroll
                for (int r = 0; r < 9; ++r) acc[r] += w[k] * sc[r * 1024 + kg * 64 + k0 + k];
        }
#pragma unroll
        for (int r = 0; r < 9; ++r) *(LAS f32x4*)(red + ((kg * 32 + cq) * 9 + r) * 4) = acc[r];
        __syncthreads();
        if (tid < 32 * 9) { const int q = tid / 9, r = tid % 9; f32x4 s = {0.f, 0.f, 0.f, 0.f};
#pragma unroll
            for (int g = 0; g < 16; ++g) s += *(const LAS f32x4*)(red + ((g * 32 + q) * 9 + r) * 4);
            const int nn = (u % 48) * 128 + 4 * q;
            *(f32x4*)(mod + ((size_t)l * 9 + r) * 6144 + nn) = s + *(const f32x4*)(bmod + (size_t)l * 6144 + nn); }
        __syncthreads();
    }
}
__device__ __forceinline__ void p0_tables(float* tab, const float* dlam, const float* decf, const float* decb, int tid) {
    for (int i = tid; i < 1024; i += 512) { const int pos = i >> 4, f = i & 15;
        const float inv = 1.0f / powf(10000.0f, (float)f / 16.0f), ang = (float)pos * inv;
        tab[TAB_ROPE + 2 * i] = cosf(ang); tab[TAB_ROPE + 2 * i + 1] = sinf(ang); }
    if (tid < 4) { const float* lp = dlam + tid * 256; float s01 = 0.f, s23 = 0.f;
        for (int k = 0; k < 64; ++k) { s01 += lp[k] * lp[64 + k]; s23 += lp[128 + k] * lp[192 + k]; }
        const float li = 0.8f - 0.6f * expf(-0.3f * (float)tid);
        tab[TAB_LAM + 2 * tid] = expf(s01) - expf(s23) + li; tab[TAB_LAM + 2 * tid + 1] = 1.0f - li; }
    if (tid >= 64 && tid < 96) { const int i = tid - 64, l = i >> 3, dir = (i >> 2) & 1, h = i & 3;
        const float x = (dir ? decb : decf)[l * 4 + h];
        tab[TAB_LG2 + i] = -log1pf(expf(-x)) * LOG2E; }
}

__device__ __forceinline__ float sample_rms(const float* W, int n, LAS float* red, int tid) {
    const int stride = n / 16384 - 1; float s = 0.f; float v[32];
#pragma unroll
    for (int i = 0; i < 32; ++i) v[i] = W[(size_t)(tid * 32 + i) * stride];
#pragma unroll
    for (int i = 0; i < 32; ++i) s += v[i] * v[i];
    s = wave_sum(s);
    __syncthreads(); if ((tid & 63) == 0) red[tid >> 6] = s; __syncthreads();
    float t = 0.f;
#pragma unroll
    for (int w = 0; w < 8; ++w) t += red[w];
    __syncthreads();
    return sqrtf(t * (1.0f / 16384.0f));
}
struct CvtD { const float* src; unsigned char* dst; int ldw; int mode; float scale; };
__device__ __forceinline__ CvtD cvt_desc(const float* W, int ldw, int k0, int sc, unsigned char* WTrow0  , int ldt_bytes, int mode, float scale, int lane) {
    const int n = lane & 31, hi = lane >> 5; CvtD d;
    d.src = W + (size_t)(k0 + 32 * hi) * ldw + sc; d.ldw = ldw; d.mode = mode; d.scale = scale;
    d.dst = WTrow0 + (size_t)n * ldt_bytes + 32 * hi * (mode == 0 ? 2 : 1); return d;
}
__device__ __forceinline__ void cvt_load(const CvtD& d, float (&v)[32]) {
#pragma unroll
    for (int i = 0; i < 32; ++i) v[i] = __builtin_nontemporal_load(d.src + (size_t)i * d.ldw);
}
__device__ __forceinline__ void cvt_store(const CvtD& d, const float (&v)[32]) {
    if (d.mode == 0) {
#pragma unroll
        for (int q = 0; q < 4; ++q) { u32x4 o; o.x = pk2(v[8 * q], v[8 * q + 1]); o.y = pk2(v[8 * q + 2], v[8 * q + 3]); o.z = pk2(v[8 * q + 4], v[8 * q + 5]); o.w = pk2(v[8 * q + 6], v[8 * q + 7]);
            *(u32x4*)(d.dst + 16 * q) = o; }
    } else if (d.mode == 1) { const float sc = d.scale;
#pragma unroll
        for (int q = 0; q < 2; ++q) { u32x4 o;
#define F4_(b) pk4f8(v[b] * sc, v[(b) + 1] * sc, v[(b) + 2] * sc, v[(b) + 3] * sc)
            o.x = F4_(16 * q); o.y = F4_(16 * q + 4); o.z = F4_(16 * q + 8); o.w = F4_(16 * q + 12);
#undef F4_
            *(u32x4*)(d.dst + 16 * q) = o; }
    } else { const float sc = d.scale;
#pragma unroll
        for (int q = 0; q < 2; ++q) { u32x4 o;
#define CL_(x) __builtin_amdgcn_fmed3f((x) * sc, -127.0f, 127.0f)
#define I4_(b) pk4i8(CL_(v[b]), CL_(v[(b) + 1]), CL_(v[(b) + 2]), CL_(v[(b) + 3]))
            o.x = I4_(16 * q); o.y = I4_(16 * q + 4); o.z = I4_(16 * q + 8); o.w = I4_(16 * q + 12);
#undef I4_
#undef CL_
            *(u32x4*)(d.dst + 16 * q) = o; }
    }
}
__device__ __forceinline__ int win_src(int n) {
    const bool rp = (n < 640) || (n >= 768 && n < 1280) || (n >= 2304 && n < 3328);
    if (!rp) return n;
    const int p = n & 63, j = p >> 1, e = p & 1;
    return (n & ~63) + (j >> 4) * 32 + e * 16 + (j & 15);
}
constexpr int I_IN = 16 * 216, I_B = 3 * 8 * 32, I_O = 16 * 32, I_MIX = I_IN + I_B + I_O, I_F1 = 16 * 88, I_F2 = 44 * 32, I_FE = 2 * I_F1 + I_F2;
__device__ __forceinline__ CvtD mix_desc(const float* win, const float* wb, const float* wo, unsigned char* mixbase, int r, float qs_in, int lane) {
    if (r < I_IN) { const int kb = r / 216, nb = r % 216; return cvt_desc(win, DIN, 64 * kb, win_src(32 * nb + (lane & 31)), mixbase + (size_t)(32 * nb) * DM + 64 * kb, DM, 2, qs_in, lane); } r -= I_IN;
    if (r < I_B) { const int i = r / 256, q = r % 256, kb = q / 32, nb = q % 32;
        return cvt_desc(wb + (size_t)i * 512 * DM, DM, 64 * kb, 32 * nb + (lane & 31), mixbase + MIX_WB + ((size_t)(32 * nb) * OCW + i * 512 + 64 * kb) * 2, OCW * 2, 0, 1.0f, lane); } r -= I_B;
    { const int kb = r / 32, nb = r % 32; return cvt_desc(wo, DM, 64 * kb, 32 * nb + (lane & 31), mixbase + MIX_WO + ((size_t)(32 * nb) * DM + 64 * kb) * 2, DM * 2, 0, 1.0f, lane); }
}
__device__ __forceinline__ CvtD ffn_desc(const float* f1, const float* f3, const float* f2, unsigned char* w13, unsigned char* w2, int r, float qs1, float qs3, int f8dn, int lane) {
    if (r < 2 * I_F1) { const int which = r / I_F1, q = r % I_F1, kb = q / 88, nb = q % 88, j0 = 32 * nb;
        const int drow = (j0 >> 7) * 256 + which * 128 + (j0 & 127);
        return cvt_desc(which ? f3 : f1, DFF, 64 * kb, j0 + (lane & 31), w13 + (size_t)drow * DM + 64 * kb, DM, 2, which ? qs3 : qs1, lane); } r -= 2 * I_F1;
    { const int kb = r / 32, nb = r % 32;
        if (f8dn) return cvt_desc(f2, DM, 64 * kb, 32 * nb + (lane & 31), w2 + (size_t)(32 * nb) * DFF + 64 * kb, DFF, 1, F8_SW2, lane);
        return cvt_desc(f2, DM, 64 * kb, 32 * nb + (lane & 31), w2 + ((size_t)(32 * nb) * DFF + 64 * kb) * 2, DFF * 2, 0, 1.0f, lane); }
}
constexpr int N_RANGES = 7;
__device__ __forceinline__ int range_items(int k) { return (k == 0 || k == 4) ? I_FE : (k == 3 || k == 6) ? NEXP * I_FE : I_MIX; }
__device__ __forceinline__ CvtD range_desc(int k, int r, LAS unsigned char* lds, unsigned char* ws, int lane);

__device__ __forceinline__ void norm_rows(LAS unsigned char* lds, const void* xinL, const void* xinC, int in32, bf16_t* xoutL, bf16_t* xoutC, const float* gain, const float* mod, const float* modc, int shoff,
                                          bf16_t* hout, int qmode, float* rsout, int nrows, int combine, const Route* route, const bf16_t* fbuf, const float* wrouter, int do_route, Route* route_out, unsigned* gcnt,
                                          int blk, int G, int wave, int lane, int tid) {
    LAS float* wr = (LAS float*)lds;
    LAS int* lcnt = (LAS int*)(lds + 32768);
    LAS int* rec = (LAS int*)(lds + 32768 + 64);
    if (do_route) { for (int i = tid; i < 8192; i += 512) wr[i] = wrouter[i]; }
    const int per = (nrows + G - 1) / G, r0 = blk * per, r1 = (r0 + per < nrows) ? r0 + per : nrows;
    for (int cs = r0; cs < r1; cs += 256) {
        const int ce = cs + 256 < r1 ? cs + 256 : r1;
        if (do_route) { if (tid < 8) lcnt[tid] = 0; __syncthreads(); }
        u32x4 vn[4];
#define NR_LOAD(rr) do { const size_t ro_ = (rr) < TL ? (size_t)(rr) * DM : (size_t)((rr) - TL) * DM; const void* xb_ = (rr) < TL ? xinL : xinC; \
            if (in32) { _Pragma("unroll") for (int j = 0; j < 4; ++j) vn[j] = *(const u32x4*)((const float*)xb_ + ro_ + 4 * lane + 256 * j); } \
            else { _Pragma("unroll") for (int j = 0; j < 4; ++j) { const u32x2 t_ = *(const u32x2*)((const bf16_t*)xb_ + ro_ + 4 * lane + 256 * j); vn[j].x = t_.x; vn[j].y = t_.y; } } } while (0)
        if (cs + wave < ce) NR_LOAD(cs + wave);
        for (int row = cs + wave; row < ce; row += 8) {
            const bool lat = row < TL; const int mb = lat ? (row >> 12) : 8;
            f32x4 v[4];
#pragma unroll
            for (int j = 0; j < 4; ++j) v[j] = in32 ? __builtin_bit_cast(f32x4, vn[j]) : (f32x4){bf_lo(vn[j].x), bf_hi(vn[j].x), bf_lo(vn[j].y), bf_hi(vn[j].y)};
            if (row + 8 < ce) NR_LOAD(row + 8);
            if (combine) {
                const Route rt = route[row]; const float* g2 = modc + mb * 6144 + 5120;
                bf16_t* xo = lat ? xoutL + (size_t)row * DM : xoutC + (size_t)(row - TL) * DM;
#pragma unroll
                for (int j = 0; j < 4; ++j) { const int col = 4 * lane + 256 * j;
                    const u32x2 fa = *(const u32x2*)(fbuf + (size_t)rt.sa * DM + col), fb = *(const u32x2*)(fbuf + (size_t)rt.sb * DM + col);
                    const f32x4 gg = *(const f32x4*)(g2 + col);
                    v[j][0] += gg[0] * (rt.ga * bf_lo(fa.x) + rt.gb * bf_lo(fb.x)); v[j][1] += gg[1] * (rt.ga * bf_hi(fa.x) + rt.gb * bf_hi(fb.x));
                    v[j][2] += gg[2] * (rt.ga * bf_lo(fa.y) + rt.gb * bf_lo(fb.y)); v[j][3] += gg[3] * (rt.ga * bf_hi(fa.y) + rt.gb * bf_hi(fb.y));
                    u32x2 w_; w_.x = pk2(v[j][0], v[j][1]); w_.y = pk2(v[j][2], v[j][3]); *(u32x2*)(xo + col) = w_;
                    v[j] = (f32x4){bf_lo(w_.x), bf_hi(w_.x), bf_lo(w_.y), bf_hi(w_.y)}; }
            }
            float s = 0.f;
#pragma unroll
            for (int j = 0; j < 4; ++j) s += (v[j][0] * v[j][0] + v[j][1] * v[j][1]) + (v[j][2] * v[j][2] + v[j][3] * v[j][3]);
            const float rstd = 1.0f / sqrtf(wave_sum(s) * (1.0f / DM) + NORM_EPS);
            const float* sh = mod + mb * 6144 + shoff; const float* scp = sh + 1024;
            float lg[8];
#pragma unroll
            for (int e = 0; e < 8; ++e) lg[e] = 0.f;
            float qs = 1.0f;
            if (qmode == 2) {
                float am = 0.f;
#pragma unroll
                for (int j = 0; j < 4; ++j) { const int col = 4 * lane + 256 * j;
                    const f32x4 gn = *(const f32x4*)(gain + col), s1 = *(const f32x4*)(scp + col), s0 = *(const f32x4*)(sh + col);
#pragma unroll
                    for (int k = 0; k < 4; ++k) am = fmaxf(am, fabsf(v[j][k] * rstd * gn[k] * (1.0f + s1[k]) + s0[k])); }
                am = fmaxf(wave_max(am), 1.0e-20f); qs = 127.0f / am;
                if (lane == 0) rsout[row] = am * (1.0f / 127.0f);
            }
#pragma unroll
            for (int j = 0; j < 4; ++j) { const int col = 4 * lane + 256 * j;
                const f32x4 gn = *(const f32x4*)(gain + col), s1 = *(const f32x4*)(scp + col), s0 = *(const f32x4*)(sh + col);
                f32x4 hv;
#pragma unroll
                for (int k = 0; k < 4; ++k) hv[k] = v[j][k] * rstd * gn[k] * (1.0f + s1[k]) + s0[k];
                if (qmode == 2) *(unsigned*)((unsigned char*)hout + (size_t)row * DM + col) = pk4i8(fminf(hv[0] * qs, 127.0f), fminf(hv[1] * qs, 127.0f), fminf(hv[2] * qs, 127.0f), fminf(hv[3] * qs, 127.0f));
                else if (qmode == 1) *(unsigned*)((unsigned char*)hout + (size_t)row * DM + col) = pk4f8(hv[0] * F8_SH, hv[1] * F8_SH, hv[2] * F8_SH, hv[3] * F8_SH);
                else { u32x2 w; w.x = pk2(hv[0], hv[1]); w.y = pk2(hv[2], hv[3]); *(u32x2*)(hout + (size_t)row * DM + col) = w; }
                if (do_route) {
#pragma unroll
                    for (int k = 0; k < 4; ++k) { const f32x4 wa = *(const LAS f32x4*)(wr + (col + k) * 8), wb = *(const LAS f32x4*)(wr + (col + k) * 8 + 4);
                        lg[0] += hv[k] * wa[0]; lg[1] += hv[k] * wa[1]; lg[2] += hv[k] * wa[2]; lg[3] += hv[k] * wa[3];
                        lg[4] += hv[k] * wb[0]; lg[5] += hv[k] * wb[1]; lg[6] += hv[k] * wb[2]; lg[7] += hv[k] * wb[3]; }
                }
            }
            if (do_route) {
#pragma unroll
                for (int e = 0; e < 8; ++e) lg[e] = wave_sum(lg[e]);
                if (lane == 0) {
                    int e1 = 0; float v1 = lg[0];
#pragma unroll
                    for (int e = 1; e < 8; ++e) if (lg[e] > v1) { v1 = lg[e]; e1 = e; }
                    int e2 = -1; float v2 = -3.0e38f;
#pragma unroll
                    for (int e = 0; e < 8; ++e) if (e != e1 && lg[e] > v2) { v2 = lg[e]; e2 = e; }
                    const float gb_ = 1.0f / (1.0f + __expf(v1 - v2)), ga_ = 1.0f - gb_;
                    const int i = row - cs;
                    rec[i * 6 + 0] = e1; rec[i * 6 + 1] = __hip_atomic_fetch_add(&lcnt[e1], 1, __ATOMIC_RELAXED, __HIP_MEMORY_SCOPE_WORKGROUP); rec[i * 6 + 2] = e2; rec[i * 6 + 3] = __hip_atomic_fetch_add(&lcnt[e2], 1, __ATOMIC_RELAXED, __HIP_MEMORY_SCOPE_WORKGROUP);
                    rec[i * 6 + 4] = __float_as_int(ga_); rec[i * 6 + 5] = __float_as_int(gb_);
                }
            }
        }
        if (do_route) {
            __syncthreads();
            if (tid < 8) lcnt[8 + tid] = (int)__hip_atomic_fetch_add(gcnt + 64 * tid, (unsigned)lcnt[tid], __ATOMIC_RELAXED, __HIP_MEMORY_SCOPE_AGENT);
            __syncthreads();
            for (int i = tid; i < ce - cs; i += 512) { Route rt; rt.sa = 0; rt.sb = 0;
                rt.ea = rec[i * 6 + 0]; rt.pa = lcnt[8 + rt.ea] + rec[i * 6 + 1]; rt.eb = rec[i * 6 + 2]; rt.pb = lcnt[8 + rt.eb] + rec[i * 6 + 3];
                rt.ga = __int_as_float(rec[i * 6 + 4]); rt.gb = __int_as_float(rec[i * 6 + 5]); route_out[cs + i] = rt; }
            __syncthreads();
        }
    }
}
__device__ __forceinline__ void moe_gather(const unsigned char* h2, unsigned char* hs, const float* rs, float* rss, Route* route, unsigned* gcnt, int nrows, int gw, int ngw, int lane) {
    int off[8]; { int a = 0;
#pragma unroll
        for (int e = 0; e < 8; ++e) { off[e] = a; const int c = (int)__hip_atomic_load(gcnt + 64 * e, __ATOMIC_RELAXED, __HIP_MEMORY_SCOPE_AGENT); a += (c + 255) & ~255; } }
    u32x4 an; Route rn;
    if (gw < nrows) { rn = route[gw]; an = *(const u32x4*)(h2 + (size_t)gw * DM + 16 * lane); }
    for (int row = gw; row < nrows; row += ngw) {
        const Route rt = rn; const u32x4 a = an;
        if (row + ngw < nrows) { rn = route[row + ngw]; an = *(const u32x4*)(h2 + (size_t)(row + ngw) * DM + 16 * lane); }
        int oa = 0, ob = 0;
#pragma unroll
        for (int e = 0; e < 8; ++e) { oa = (rt.ea == e) ? off[e] : oa; ob = (rt.eb == e) ? off[e] : ob; }
        const int sa = oa + rt.pa, sb = ob + rt.pb;
        *(u32x4*)(hs + (size_t)sa * DM + 16 * lane) = a;
        *(u32x4*)(hs + (size_t)sb * DM + 16 * lane) = a;
        if (lane == 0) { route[row].sa = sa; route[row].sb = sb; const float r = rs[row]; rss[sa] = r; rss[sb] = r; }
    }
}
__device__ __forceinline__ void final_norm(const bf16_t* x, float* out, const float* gain, const float* mod, const Route* route, const bf16_t* fbuf, int gw, int ngw, int lane) {
    for (int row = gw; row < TL; row += ngw) {
        const int mb = row >> 12; const bf16_t* xr = x + (size_t)row * DM; float* orow = out + (size_t)row * DM;
        const Route rt = route[row]; const float* g2 = mod + mb * 6144 + 5120;
        f32x4 v[4]; float s = 0.f;
#pragma unroll
        for (int j = 0; j < 4; ++j) { const int col = 4 * lane + 256 * j; { const u32x2 t = *(const u32x2*)(xr + col); v[j] = (f32x4){bf_lo(t.x), bf_hi(t.x), bf_lo(t.y), bf_hi(t.y)}; }
            const u32x2 fa = *(const u32x2*)(fbuf + (size_t)rt.sa * DM + col), fb = *(const u32x2*)(fbuf + (size_t)rt.sb * DM + col);
            const f32x4 gg = *(const f32x4*)(g2 + col);
            v[j][0] += gg[0] * (rt.ga * bf_lo(fa.x) + rt.gb * bf_lo(fb.x)); v[j][1] += gg[1] * (rt.ga * bf_hi(fa.x) + rt.gb * bf_hi(fb.x));
            v[j][2] += gg[2] * (rt.ga * bf_lo(fa.y) + rt.gb * bf_lo(fb.y)); v[j][3] += gg[3] * (rt.ga * bf_hi(fa.y) + rt.gb * bf_hi(fb.y));
            s += (v[j][0] * v[j][0] + v[j][1] * v[j][1]) + (v[j][2] * v[j][2] + v[j][3] * v[j][3]); }
        const float rstd = 1.0f / sqrtf(wave_sum(s) * (1.0f / DM) + NORM_EPS);
#pragma unroll
        for (int j = 0; j < 4; ++j) { const int col = 4 * lane + 256 * j; const f32x4 gn = *(const f32x4*)(gain + col); *(f32x4*)(orow + col) = v[j] * rstd * gn; }
    }
}
constexpr int NWAVES = 8;
constexpr int LDS_MISC = pg8::STAGE_BYTES + 2048, LDS_PTAB = LDS_MISC + 64;
constexpr int LDS_BYTES = pg8::STAGE_BYTES + 2048 + 1024;
static_assert(at::AT_A_LDS <= pg8::STAGE_BYTES && at::AT_C_LDS <= pg8::STAGE_BYTES + 2048 && at::R1_LDS <= pg8::STAGE_BYTES && at::R3_LDS <= pg8::STAGE_BYTES, "LDS");
constexpr int NPH = 11;
constexpr int N_PHASES = 1 + DEPTH * NPH + 1;

struct Args { const float* in[24]; float* out; unsigned char* ws; int ph_lo, ph_hi; };
static_assert(sizeof(Args) == 24 * 8 + 8 + 8 + 8, "Args has no padding");

__device__ __forceinline__ void* ldptr(LAS unsigned char* lds, int i) {
    const u32x2 v = *(const LAS u32x2*)(lds + LDS_PTAB + 8 * i);
    const unsigned lo = __builtin_amdgcn_readfirstlane(v.x), hi = __builtin_amdgcn_readfirstlane(v.y);
    GAS void* g = (GAS void*)(((unsigned long long)hi << 32) | lo);
    return (void*)g;
}
#define PIN(i) ((const float*)ldptr(lds, (i)))
#define PWS() ((unsigned char*)ldptr(lds, 25))
#define POUT() ((float*)ldptr(lds, 24))
__device__ __forceinline__ CvtD range_desc(int k, int r, LAS unsigned char* lds, unsigned char* ws, int lane) {
    const float* wsc = (const float*)(ws + WS_TAB) + TAB_WSC;
    if (k == 1 || k == 2 || k == 5) { const int l = (k == 5) ? 3 : k;
        return mix_desc(PIN(9) + (size_t)l * DM * DIN, PIN(15) + (size_t)l * 3 * 512 * DM, PIN(16) + (size_t)l * DM * DM, ws + WS_MIX + l * MIX_STRIDE, r, wsc[2 * l], lane); }
    if (k == 0 || k == 4) { const int j = (k == 0) ? 0 : 1;
        return ffn_desc(PIN(17) + (size_t)j * DM * DFF, PIN(18) + (size_t)j * DM * DFF, PIN(19) + (size_t)j * DFF * DM, ws + WS_FD + j * FD_STRIDE, ws + WS_FD + j * FD_STRIDE + FD_W2, r, wsc[2 * (4 + j)], wsc[2 * (6 + j)], DENSE_F8, lane); }
    { const int j = (k == 3) ? 0 : 1, e = r / I_FE, rr = r % I_FE; const size_t eo = ((size_t)j * NEXP + e) * DM * DFF;
        return ffn_desc(PIN(21) + eo, PIN(22) + eo, PIN(23) + eo, ws + WS_W13 + (size_t)e * 2 * DFF * DM, ws + WS_W2 + (size_t)e * DM * DFF, rr, wsc[2 * (8 + j * 8 + e)], wsc[2 * (24 + j * 8 + e)], 1, lane); }
}
__device__ __forceinline__ int range_base(int k) { return k == 0 ? 0 : k == 1 ? I_FE : k == 2 ? I_FE + I_MIX : k == 3 ? I_FE + 2 * I_MIX : k == 4 ? I_FE + 2 * I_MIX + NEXP * I_FE : k == 5 ? 2 * I_FE + 2 * I_MIX + NEXP * I_FE
                                                          : k == 6 ? 2 * I_FE + 3 * I_MIX + NEXP * I_FE : 2 * I_FE + 3 * I_MIX + 2 * NEXP * I_FE; }
__device__ __forceinline__ int range_of(int g) { int k = 0;
#pragma unroll
    for (int j = 1; j < N_RANGES; ++j) k += (g >= range_base(j)) ? 1 : 0;
    return k; }
__device__ __forceinline__ void bg_static(LAS unsigned char* lds, unsigned char* ws, int g0, int g1, int worker, int nworkers, int wave, int lane) {
    for (int g = g0 + worker; g < g1; g += 2 * nworkers) {
        const int gb = g + nworkers; const bool two = gb < g1;
        const int ka = range_of(g), kb = range_of(two ? gb : g);
        const CvtD da = range_desc(ka, g - range_base(ka), lds, ws, lane), db = range_desc(kb, (two ? gb : g) - range_base(kb), lds, ws, lane);
        float va[32], vb[32];
        cvt_load(da, va); if (two) cvt_load(db, vb);
        cvt_store(da, va); if (two) cvt_store(db, vb);
    }
}
constexpr int WGM_MOE = 4;
constexpr int Q_B = 2, Q_F = 7, Q_G = 5, Q_I = 2, Q_J = 14;
#define TAIL_BOOK(nwg_in, quota, drain) const int tb_nwg = (nwg_in), tb_maxu = (tb_nwg + G - 1) / G, tb_nh = (tb_nwg % G == 0) ? G : tb_nwg - (tb_maxu - 1) * G, tb_nt = G - tb_nh; \
        const int tb_lim = range_base(kmax + 1), tb_g0 = gc; int tb_take = tb_nt * NWAVES * (quota); if (tb_take > tb_lim - gc) tb_take = tb_lim - gc; if (tb_take < 0) tb_take = 0; \
        const int tb_g1 = tb_g0 + tb_take; const int tb_e = (drain) >= 0 ? range_base((drain) + 1) : 0; const int tb_g2 = tb_e > tb_g1 ? tb_e : tb_g1; gc = tb_g2
#define TAIL_RUN() do { if (blk >= tb_nh && tb_take > 0) bg_static(lds, ws, tb_g0, tb_g1, (blk - tb_nh) * NWAVES + wave, tb_nt * NWAVES, wave, LANE()); \
        if (tb_g2 > tb_g1) bg_static(lds, ws, tb_g1, tb_g2, GW(), NGW(), wave, LANE()); } while (0)

__global__ void __launch_bounds__(NWAVES * 64, 2) mega(Args a) {
    extern __shared__ __attribute__((aligned(16))) unsigned char lds_raw[];
    LAS unsigned char* lds = (LAS unsigned char*)lds_raw;
    LAS unsigned char* const lds_k = lds;
#define LDSL() ({ LAS unsigned char* p_ = lds_k; asm volatile("" : "+s"(p_)); p_; })
    const int wave = __builtin_amdgcn_readfirstlane((int)threadIdx.x >> 6);
    const int G = gridDim.x, blk = blockIdx.x;
#define LANE0() ({ int t_; asm volatile("v_mbcnt_lo_u32_b32 %0, -1, 0\n\tv_mbcnt_hi_u32_b32 %0, -1, %0" : "=v"(t_)); t_; })
#define LANE() LANE0()
#define TID0() ((wave << 6) | LANE0())
#define TID() TID0()
    if (threadIdx.x == 0) {
        LAS unsigned long long* pt = (LAS unsigned long long*)(lds + LDS_PTAB);
#pragma unroll
        for (int i = 0; i < 24; ++i) pt[i] = (unsigned long long)a.in[i];
        pt[24] = (unsigned long long)a.out; pt[25] = (unsigned long long)a.ws;
        ((LAS unsigned*)(lds + LDS_MISC))[0] = 0u; ((LAS unsigned*)(lds + LDS_MISC))[1] = 0u; ((LAS unsigned*)(lds + LDS_MISC))[2] = 0u; ((LAS unsigned*)(lds + LDS_MISC))[3] = 0u;
    }
    __syncthreads();
#if MK_SINGLE
    (void)xcd_barrier_post((unsigned*)PWS() + CW_BAR, (volatile LAS unsigned*)(lds + LDS_MISC), TID());
#define GRID_BAR() do { XcdBarrier b_; b_.bar = (unsigned*)PWS() + CW_BAR; b_.x = 0; b_.st = (volatile LAS unsigned*)(lds_k + LDS_MISC); xcd_barrier(b_, TID()); } while (0)
#else
#define GRID_BAR() do { } while (0)
#endif
#if !MK_SINGLE
    const int lo = a.ph_lo, hi = a.ph_hi;
#endif
#ifndef PROBE_MASK
#define PROBE_MASK 0xffff
#endif
#define EN(k) (((PROBE_MASK) >> ((k) >= 100 ? (k) - 89 : (k))) & 1)
#if MK_SINGLE
#define IN(k) true
#else
#define IN(k) (lo <= (k) && (k) < hi)
#endif
#define SEAM(k) do { if (IN(k) && IN((k) + 1)) GRID_BAR(); } while (0)
#define LAUNDER_S(x) ({ int x_ = (x); asm volatile("" : "+s"(x_)); x_; })
#ifndef PROBE_DUP
#define PROBE_DUP 0
#endif
#define DUP(k) (1 + (((PROBE_DUP) >> (k)) & 1))
#define GW() (blk * NWAVES + wave)
#define NGW() (G * NWAVES)

    if (IN(0) && EN(100)) { LAS unsigned char* lds = LDSL();
        float* tab = (float*)(PWS() + WS_TAB);
        p0_mod(lds, PIN(1), PIN(3), PIN(4), PIN(5), tab + TAB_MOD, blk, G, TID());
        if (blk == G - 1) p0_tables(tab, PIN(13), PIN(11), PIN(12), TID());
        __syncthreads();
        const float rms0 = fmaxf(sample_rms(PIN(9), DM * DIN, (LAS float*)(lds + 32768), TID()), 1.0e-30f), qs0 = 127.0f / (I8_CLIP * rms0);
        if (blk == 0 && TID() == 0) { tab[TAB_WSC] = qs0; tab[TAB_WSC + 1] = 1.0f / qs0; }
        if (blk >= 1 && blk < 40) {
            const float* W = blk < 4 ? PIN(9) + (size_t)blk * DM * DIN : blk < 6 ? PIN(17) + (size_t)(blk - 4) * DM * DFF : blk < 8 ? PIN(18) + (size_t)(blk - 6) * DM * DFF
                           : blk < 24 ? PIN(21) + (size_t)(blk - 8) * DM * DFF : PIN(22) + (size_t)(blk - 24) * DM * DFF;
            const float r = fmaxf(sample_rms(W, blk < 4 ? DM * DIN : DM * DFF, (LAS float*)(lds + 32768), TID()), 1.0e-30f), q = 127.0f / (I8_CLIP * r);
            if (TID() == 0) { tab[TAB_WSC + 2 * blk] = q; tab[TAB_WSC + 2 * blk + 1] = 1.0f / q; } }
        {
            unsigned char* ws = PWS(); const int ln = LANE();
            for (int it = (G - 1 - blk) * NWAVES + wave; it < I_MIX; it += 2 * NGW()) { const int ib = it + NGW(); const bool two = ib < I_MIX;
                const CvtD da = mix_desc(PIN(9), PIN(15), PIN(16), ws + WS_MIX, it, qs0, ln), db = mix_desc(PIN(9), PIN(15), PIN(16), ws + WS_MIX, two ? ib : it, qs0, ln);
                float va[32], vb[32];
                cvt_load(da, va); if (two) cvt_load(db, vb);
                cvt_store(da, va); if (two) cvt_store(db, vb); }
        }
    }
    SEAM(0);

    int gc = 0;
    for (int l = 0; l < DEPTH; ++l) {
        const int pb = 1 + l * NPH;
        const bool moe = (l & 1) != 0, last = (l == DEPTH - 1), first = (l == 0);
        const int nrows = last ? TL : TT;
        const int kmax = l <= 1 ? 5 : 6;
        if (IN(pb + 0) && EN(0)) { LAS unsigned char* lds = LDSL();
            unsigned char* ws = PWS();
            __syncthreads();
            const bool comb = (l == 2);
            const float* modl = (const float*)(ws + WS_TAB) + TAB_MOD + (size_t)l * 9 * 6144;
            bf16_t* xL = (bf16_t*)(ws + WS_XB); bf16_t* xc = (bf16_t*)(ws + WS_XC);
            for (int dup = 0; dup < (comb ? 1 : DUP(8)); ++dup) norm_rows(lds, first ? (const void*)PIN(0) : (const void*)xL, first ? (const void*)PIN(2) : (const void*)xc, first ? 1 : 0, xL, xc, PIN(6) + l * DM, modl, modl - 9 * 6144, 0, (bf16_t*)(ws + WS_H), 2, (float*)(ws + WS_RS), TT, comb ? 1 : 0,
                      (const Route*)(ws + WS_ROUTE), (const bf16_t*)(ws + WS_OCAT), nullptr, 0, nullptr, nullptr, blk, G, wave, LANE(), TID());
        }
        SEAM(pb + 0);
        { TAIL_BOOK(last ? (TL / 256) * (DIN / 256) + 64 : (TT / 256) * (DIN / 256), Q_B, -1);
        if (IN(pb + 1) && EN(1)) { LAS unsigned char* lds = LDSL();
            unsigned char* ws = PWS();
            pg8::Gemm g{(const bf16_t*)(ws + WS_H), (const bf16_t*)(ws + WS_MIX + l * MIX_STRIDE), DM / 2}; pg8::GSched S; S.init(last ? TL / 256 : TT / 256, DIN / 256, LAUNDER_S(G), LAUNDER_S(blk));
            if (last) { S.nx = 64; S.nwg += 64; S.xtab = 0xEDCB6542ull; }
            pg8::EpiProj E{(bf16_t*)(ws + WS_PROJ), (const float*)(ws + WS_TAB) + TAB_ROPE, (u32x2*)(ws + WS_GATE), (const float*)(ws + WS_RS), ((const float*)(ws + WS_TAB))[TAB_WSC + 2 * l + 1]};
            for (int dup = 0; dup < DUP(1); ++dup) pg8::gemm_phase<pg8::EpiProj, pg8::GSched, true, true, 2>(lds, g, S, E, TID());
            TAIL_RUN();
        } }
        SEAM(pb + 1);
        if (IN(pb + 2) && EN(2)) { LAS unsigned char* lds = LDSL();
            unsigned char* ws = PWS(); const float* lg2 = (const float*)(ws + WS_TAB) + TAB_LG2 + l * 8;
            for (int dup = 0; dup < DUP(10); ++dup) at::ret_kv_phase(lds, (const bf16_t*)(ws + WS_PROJ), (bf16_t*)(ws + WS_Y), lg2, blk, G, TID());
        }
        SEAM(pb + 2);
        if (IN(pb + 3) && EN(3)) for (int dup = 0; dup < DUP(11); ++dup) { unsigned char* ws = PWS(); at::ret_scan((const bf16_t*)(ws + WS_Y), (bf16_t*)(ws + WS_H), (const float*)(ws + WS_TAB) + TAB_LG2 + l * 8, blk * 512 + TID(), G * 512); }
        SEAM(pb + 3);
        if (IN(pb + 4) && EN(4)) { LAS unsigned char* lds = LDSL();
            {
                unsigned char* ws = PWS(); const float* tab = (const float*)(ws + WS_TAB);
                const float lam = tab[TAB_LAM + 2 * l], oml = tab[TAB_LAM + 2 * l + 1]; const float* dn = PIN(14) + l * 128;
                for (int dup = 0; dup < DUP(0); ++dup) for (int r = blk; r < 1024; r += G) { const int rnd = r >> 8, bi = r & 255, bh = rnd * 8 + (bi & 7), qb = bi >> 3;
                    at::attnC_unit(lds, (const bf16_t*)(ws + WS_PROJ), (bf16_t*)(ws + WS_OCAT), dn, lam, oml, bh >> 2, bh & 3, qb, 1, TID()); }
                if (!last) for (int r = blk; r < 64; r += G) { const int bh = r >> 1, qb = r & 1;
                    at::attnC_unit(lds, (const bf16_t*)(ws + WS_PROJ), (bf16_t*)(ws + WS_OCAT), dn, lam, oml, bh >> 2, bh & 3, qb, 0, TID()); }
            }
            {
                unsigned char* ws = PWS(); const float* lg2 = (const float*)(ws + WS_TAB) + TAB_LG2 + l * 8;
                const int nR = last ? NB * 4 * 32 : NB * 4 * NCHK;
                for (int dup = 0; dup < DUP(3); ++dup) for (int r = blk; r < nR; r = (r + G < (nR / G) * G) ? r + G : (r < (nR / G) * G ? (nR / G) * G + ((blk + G - 64) % G) : nR)) { int bh, ci; if (last) { bh = r >> 5; ci = 2 + (r & 31); } else { bh = r / NCHK; ci = r % NCHK; }
                    at::ret_out_unit(lds, (const bf16_t*)(ws + WS_PROJ), (const bf16_t*)(ws + WS_H), (bf16_t*)(ws + WS_OCAT), lg2[bh & 3], lg2[4 + (bh & 3)], bh >> 2, bh & 3, ci, TID()); }
            }
            {
                unsigned char* ws = PWS(); const float* sink = PIN(10) + l * 8;
                for (int dup = 0; dup < DUP(13); ++dup) for (int r = blk; r < 1024; r += G) { const int bg = r >> 6, qb = r & 63; at::attnA_unit(lds, (const bf16_t*)(ws + WS_PROJ), (bf16_t*)(ws + WS_OCAT), sink, bg >> 1, bg & 1, qb, 1, TID()); }
                if (!last) for (int r = (blk + G - 128) % G; r < 64; r += G) { const int bg = r >> 2, qb = r & 3; at::attnA_unit(lds, (const bf16_t*)(ws + WS_PROJ), (bf16_t*)(ws + WS_OCAT), sink, bg >> 1, bg & 1, qb, 0, TID()); }
            }
        }
        SEAM(pb + 4);
#ifdef PROBE_XBAR
        for (int xb_ = 0; xb_ < PROBE_XBAR; ++xb_) GRID_BAR();
#endif
        { TAIL_BOOK((nrows / 256) * (DM / 256), Q_F, -1);
        if (IN(pb + 5) && EN(5)) { LAS unsigned char* lds = LDSL();
            unsigned char* ws = PWS();
            pg8::Gemm g{(const bf16_t*)(ws + WS_OCAT), (const bf16_t*)(ws + WS_MIX + l * MIX_STRIDE + MIX_WB), OCW}; pg8::GSched S; S.init(nrows / 256, DM / 256, LAUNDER_S(G), LAUNDER_S(blk));
            pg8::EpiMerge E{(bf16_t*)(ws + WS_Y), (const u32x2*)(ws + WS_GATE)};
            for (int dup = 0; dup < DUP(2); ++dup) pg8::gemm_phase<pg8::EpiMerge, pg8::GSched, true, true>(lds, g, S, E, TID());
            TAIL_RUN();
        } }
        SEAM(pb + 5);
        { TAIL_BOOK((nrows / 256) * (DM / 256), Q_G, (l == 0 ? 0 : l == 1 ? 3 : l == 2 ? 4 : 6));
        if (IN(pb + 6) && EN(6)) { LAS unsigned char* lds = LDSL();
            unsigned char* ws = PWS(); bf16_t* xL = (bf16_t*)(ws + WS_XB); bf16_t* xc = (bf16_t*)(ws + WS_XC);
            pg8::Gemm g{(const bf16_t*)(ws + WS_Y), (const bf16_t*)(ws + WS_MIX + l * MIX_STRIDE + MIX_WO), DM}; pg8::GSched S; S.init(nrows / 256, DM / 256, LAUNDER_S(G), LAUNDER_S(blk));
            pg8::EpiRes E{first ? (const void*)PIN(0) : (const void*)xL, first ? (const void*)PIN(2) : (const void*)xc, xL, xc, (const float*)(ws + WS_TAB) + TAB_MOD + (size_t)l * 9 * 6144, 2048, 1.0f, first ? 1 : 0};
            pg8::gemm_phase<pg8::EpiRes, pg8::GSched, true, true>(lds, g, S, E, TID());
            TAIL_RUN();
        } }
        SEAM(pb + 6);
        if (IN(pb + 7) && EN(7)) { LAS unsigned char* lds = LDSL();
            unsigned char* ws = PWS(); bf16_t* xL = (bf16_t*)(ws + WS_XB); bf16_t* xc = (bf16_t*)(ws + WS_XC);
            const float* modl = (const float*)(ws + WS_TAB) + TAB_MOD + (size_t)l * 9 * 6144;
            for (int dup = 0; dup < (moe ? 1 : DUP(9)); ++dup) norm_rows(lds, xL, xc, 0, xL, xc, PIN(7) + l * DM, modl, modl, 3072, (bf16_t*)(ws + WS_H), 2, (float*)(ws + WS_RS), nrows, 0, (const Route*)(ws + WS_ROUTE), (const bf16_t*)(ws + WS_OCAT),
                      moe ? PIN(20) + (size_t)(l >> 1) * DM * NEXP : nullptr, moe ? 1 : 0, (Route*)(ws + WS_ROUTE), (unsigned*)ws + CW_MOE + (l >> 1) * 1024, blk, G, wave, LANE(), TID());
        }
        SEAM(pb + 7);
        if (!moe) {
            { TAIL_BOOK((nrows / 256) * (2 * DFF / 256), Q_I, -1);
            if (IN(pb + 9) && EN(9)) { LAS unsigned char* lds = LDSL();
                unsigned char* ws = PWS();
                pg8::Gemm g{(const bf16_t*)(ws + WS_H), (const bf16_t*)(ws + WS_FD + (l >> 1) * FD_STRIDE), DM / 2}; pg8::GSched S; S.init(nrows / 256, 2 * DFF / 256, LAUNDER_S(G), LAUNDER_S(blk));
                pg8::EpiSwiglu<DENSE_F8 != 0> E{ws + WS_PROJ, (const float*)(ws + WS_RS), (const float*)(ws + WS_TAB) + TAB_WSC + 2 * (4 + (l >> 1)) + 1, 4};
                for (int dup = 0; dup < DUP(4); ++dup) pg8::gemm_phase<pg8::EpiSwiglu<DENSE_F8 != 0>, pg8::GSched, true, true, 2>(lds, g, S, E, TID());
                TAIL_RUN();
            } }
            SEAM(pb + 9);
            { TAIL_BOOK((nrows / 256) * (DM / 256), Q_J, (l == 0 ? 1 : 5));
            if (IN(pb + 10) && EN(10)) { LAS unsigned char* lds = LDSL();
                unsigned char* ws = PWS(); bf16_t* xL = (bf16_t*)(ws + WS_XB); bf16_t* xc = (bf16_t*)(ws + WS_XC);
                pg8::Gemm g{(const bf16_t*)(ws + WS_PROJ), (const bf16_t*)(ws + WS_FD + (l >> 1) * FD_STRIDE + FD_W2), DENSE_F8 ? DFF / 2 : DFF}; pg8::GSched S; S.init(nrows / 256, DM / 256, LAUNDER_S(G), LAUNDER_S(blk));
                pg8::EpiRes E{xL, xc, xL, xc, (const float*)(ws + WS_TAB) + TAB_MOD + (size_t)l * 9 * 6144, 5120, DENSE_F8 ? F8_INV2 : 1.0f, 0};
                pg8::gemm_phase<pg8::EpiRes, pg8::GSched, true, true, DENSE_F8 ? 1 : 0>(lds, g, S, E, TID());
                TAIL_RUN();
            } }
            SEAM(pb + 10);
        } else {
            if (IN(pb + 8) && EN(8)) for (int dup = 0; dup < DUP(12); ++dup) { unsigned char* ws = PWS(); moe_gather(ws + WS_H, ws + WS_OCAT, (const float*)(ws + WS_RS), (float*)(ws + WS_RSS), (Route*)(ws + WS_ROUTE), (unsigned*)ws + CW_MOE + (l >> 1) * 1024, nrows, GW(), NGW(), LANE()); }
            SEAM(pb + 8);
            if (IN(pb + 9) && EN(9)) { LAS unsigned char* lds = LDSL();
                unsigned char* ws = PWS(); unsigned* gcnt = (unsigned*)ws + CW_MOE + (l >> 1) * 1024;
                pg8::GSched S; LAS int* tsl = (LAS int*)(lds + LDS_MISC + 512);
                if (TID() == 0) { int a0 = 0;
                    for (int e = 0; e < 8; ++e) { tsl[e] = a0; const int c = (int)__hip_atomic_load(gcnt + 64 * e, __ATOMIC_RELAXED, __HIP_MEMORY_SCOPE_AGENT); a0 += (c + 255) >> 8; }
                    tsl[8] = a0; }
                __syncthreads();
                S.ts = tsl; S.nM = __builtin_amdgcn_readfirstlane(tsl[8]); S.nN = 2 * DFF / 256; S.nwg = S.nM * S.nN; S.G = LAUNDER_S(G); S.c = LAUNDER_S(blk); S.wgm = WGM_MOE; S.nx = 0; S.xtab = 0; S.grouped = 1; S.bstride = (size_t)DFF * DM;
                pg8::Gemm g{(const bf16_t*)(ws + WS_OCAT), (const bf16_t*)(ws + WS_W13), DM / 2};
                pg8::EpiSwiglu<true> E{ws + WS_PROJ, (const float*)(ws + WS_RSS), (const float*)(ws + WS_TAB) + TAB_WSC + 2 * (8 + (l >> 1) * 8) + 1, 32};
                for (int dup = 0; dup < DUP(5); ++dup) pg8::gemm_phase<pg8::EpiSwiglu<true>, pg8::GSched, true, true, 2>(lds, g, S, E, TID());
            }
            SEAM(pb + 9);
            if (IN(pb + 10) && EN(10)) { LAS unsigned char* lds = LDSL();
                unsigned char* ws = PWS(); unsigned* gcnt = (unsigned*)ws + CW_MOE + (l >> 1) * 1024;
                pg8::GSched S; LAS int* tsl = (LAS int*)(lds + LDS_MISC + 512);
                if (TID() == 0) { int a0 = 0;
                    for (int e = 0; e < 8; ++e) { tsl[e] = a0; const int c = (int)__hip_atomic_load(gcnt + 64 * e, __ATOMIC_RELAXED, __HIP_MEMORY_SCOPE_AGENT); a0 += (c + 255) >> 8; }
                    tsl[8] = a0; }
                __syncthreads();
                S.ts = tsl; S.nM = __builtin_amdgcn_readfirstlane(tsl[8]); S.nN = DM / 256; S.nwg = S.nM * S.nN; S.G = LAUNDER_S(G); S.c = LAUNDER_S(blk); S.wgm = WGM_MOE; S.nx = 0; S.xtab = 0; S.grouped = 1; S.bstride = (size_t)DM * DFF / 2;
                pg8::Gemm g{(const bf16_t*)(ws + WS_PROJ), (const bf16_t*)(ws + WS_W2), DFF / 2}; pg8::EpiBf16 E{(bf16_t*)(ws + WS_OCAT), DM, F8_INV2};
                for (int dup = 0; dup < DUP(6); ++dup) pg8::gemm_phase<pg8::EpiBf16, pg8::GSched, true, true, 1>(lds, g, S, E, TID());
            }
            SEAM(pb + 10);
        }
    }
    if (IN(1 + DEPTH * NPH) && EN(101)) { LAS unsigned char* lds = LDSL(); unsigned char* ws = PWS();
        final_norm((const bf16_t*)(ws + WS_XB), POUT(), PIN(8), (const float*)(ws + WS_TAB) + TAB_MOD + (size_t)3 * 9 * 6144, (const Route*)(ws + WS_ROUTE), (const bf16_t*)(ws + WS_OCAT), GW(), NGW(), LANE()); }
#undef IN
#undef SEAM
}

extern "C" void kernel_launch(void* const* d_in, const int* in_sizes, int n_in, void* d_out, int out_size, void* d_ws, size_t ws_size, hipStream_t stream) {
    static int grid = 0;
    if (grid == 0) {
        if (n_in != 24 || out_size != TL * DM || ws_size < WS_END) { fprintf(stderr, "kernel_launch: unexpected shapes (n_in %d, out %d, ws %zu)\n", n_in, out_size, ws_size); grid = -1; return; }
        int dev = 0, cus = 0, per_cu = 0;
        if (hipGetDevice(&dev) != hipSuccess || hipDeviceGetAttribute(&cus, hipDeviceAttributeMultiprocessorCount, dev) != hipSuccess) { grid = -1; return; }
        if (hipFuncSetAttribute((const void*)mega, hipFuncAttributeMaxDynamicSharedMemorySize, LDS_BYTES) != hipSuccess) { fprintf(stderr, "kernel_launch: hipFuncSetAttribute failed\n"); grid = -1; return; }
        if (hipOccupancyMaxActiveBlocksPerMultiprocessor(&per_cu, (const void*)mega, NWAVES * 64, LDS_BYTES) != hipSuccess || per_cu < 1) { fprintf(stderr, "kernel_launch: occupancy query reports %d\n", per_cu); }
        (void)hipGetLastError();
        grid = cus;
    }
    if (grid < 0) return;
    if (hipMemsetAsync((char*)d_ws + WS_CTL, 0, CTL_ZERO_BYTES, stream) != hipSuccess) return;
    Args a{};
    for (int i = 0; i < 24; ++i) a.in[i] = (const float*)d_in[i];
    a.out = (float*)d_out; a.ws = (unsigned char*)d_ws;
#if MK_SINGLE
    a.ph_lo = 0; a.ph_hi = N_PHASES;
    hipLaunchKernelGGL(mega, dim3(grid), dim3(NWAVES * 64), LDS_BYTES, stream, a);
#else
    for (int p = 0; p < N_PHASES; ++p) {
        const int k = (p - 1) % NPH, l = (p - 1) / NPH;
        if (p >= 1 && p < 1 + DEPTH * NPH && k == 8 && !(l & 1)) continue;
        a.ph_lo = p; a.ph_hi = p + 1;
        hipLaunchKernelGGL(mega, dim3(grid), dim3(NWAVES * 64), LDS_BYTES, stream, a);
    }
#endif
}
```
